# Optimizing an MI355X kernel written in HIP

```python
import jax, jax.numpy as jnp
from jax import lax
import numpy as np

D_MODEL = 2048
BATCH = 4
SEQ = 4096
DEPTH = 1

GRID_W = 64
CTX_LEN = 256
RWKV_WIDTH = 1024
RWKV_HEAD = 64
RWKV_HEADS = RWKV_WIDTH // RWKV_HEAD
LORA = 64
GN_EPS = 64e-5
ATT_WIDTH = D_MODEL - RWKV_WIDTH
HEAD_DIM = 64
N_HEADS = ATT_WIDTH // HEAD_DIM
KV_HEADS = 4
GROUP = N_HEADS // KV_HEADS
KV_WIDTH = KV_HEADS * HEAD_DIM
WINDOW = 128
BLOCK = 128
ROPE_THETA = 10000.0
NORM_EPS = 1e-6
SHIFT_COLS = 3 * RWKV_WIDTH + 4 * LORA
IN_COLS = SHIFT_COLS + RWKV_WIDTH + ATT_WIDTH + 2 * KV_WIDTH + ATT_WIDTH

kernel_name = "hymba_rwkv7_swa_prefix_dit_block"


def _rms(t, g):
    tf = t.astype(jnp.float32)
    return tf * lax.rsqrt(jnp.mean(tf * tf, axis=-1, keepdims=True) + NORM_EPS) * g


def _adaln(cvec, w_ada, b_ada):
    return jax.nn.silu(cvec) @ w_ada + b_ada


def _modulate(xs, mod, norm_g):
    shift, scale, gate = jnp.split(mod, 3, axis=-1)
    xn = _rms(xs, norm_g) * (1.0 + scale[..., None, :]) + shift[..., None, :]
    return xn, gate[..., None, :]


def _centred_shift(p, mu):
    zeros = jnp.zeros_like(p[:, :1])
    prev = jnp.concatenate([zeros, p[:, :-1]], axis=1)
    nxt = jnp.concatenate([p[:, 1:], zeros], axis=1)
    return p + mu * (0.5 * (prev + nxt) - p)


def _project(xn, w_in, mu_shift):
    p = jnp.einsum('bld,de->ble', xn, w_in)
    cuts = [int(i) for i in np.cumsum([SHIFT_COLS, RWKV_WIDTH, ATT_WIDTH, KV_WIDTH, KV_WIDTH])]
    sh, z_r, q, k, v, z_a = jnp.split(p, cuts, axis=-1)
    return _centred_shift(sh, mu_shift), z_r, q, k, v, z_a


def _rwkv_prep(sh, w0, w2, a0, a2, k_k, k_a):
    B, L, _ = sh.shape
    sh = sh.astype(jnp.float32)
    r, k, v, lw, la = jnp.split(sh, [RWKV_WIDTH, 2 * RWKV_WIDTH, 3 * RWKV_WIDTH, 3 * RWKV_WIDTH + 2 * LORA], axis=-1)
    heads = lambda t: t.reshape(B, L, RWKV_HEADS, RWKV_HEAD)
    lw = lw.reshape(B, L, 2, LORA)
    la = la.reshape(B, L, 2, LORA)
    w_log = -jax.nn.softplus(-(w0 + jnp.einsum('bldr,drc->bldc', jnp.tanh(lw), w2))) - 0.5
    decay = jnp.exp(-jnp.exp(w_log)).reshape(B, L, 2, RWKV_HEADS, RWKV_HEAD)
    a = jax.nn.sigmoid(a0 + jnp.einsum('bldr,drc->bldc', la, a2)).reshape(B, L, 2, RWKV_HEADS, RWKV_HEAD)
    r, k, v = heads(r), heads(k), heads(v)
    kk = k * k_k.reshape(RWKV_HEADS, RWKV_HEAD)
    kk = kk / jnp.maximum(jnp.linalg.norm(kk, axis=-1, keepdims=True), 1e-12)
    kd = k[:, :, None] * (1.0 + (a - 1.0) * k_a.reshape(RWKV_HEADS, RWKV_HEAD))
    return r, v, kk, decay, a, kd


def _rwkv_scan(S0, r, w, k, v, kk, a, reverse):
    xs = tuple(jnp.moveaxis(t, 1, 0) for t in (r, w, k, v, kk, a))

    def step(S, inp):
        r_t, w_t, k_t, v_t, kk_t, a_t = inp
        s_kk = jnp.einsum('bhvk,bhk->bhv', S, kk_t)
        S = (S * w_t[:, :, None, :] - s_kk[..., None] * (kk_t * a_t)[:, :, None, :]
             + v_t[..., None] * k_t[:, :, None, :])
        return S, jnp.einsum('bhvk,bhk->bhv', S, r_t)

    S, ys = lax.scan(step, S0, xs, reverse=reverse)
    return S, jnp.moveaxis(ys, 0, 1)


def _bidirectional_rwkv(lat, ctx):
    r, v, kk, decay, a, kd = lat
    rc, vc, kkc, decayc, ac, kdc = ctx
    S0 = jnp.zeros((r.shape[0], RWKV_HEADS, RWKV_HEAD, RWKV_HEAD), jnp.float32)
    S_cf, yc_f = _rwkv_scan(S0, rc, decayc[:, :, 0], kdc[:, :, 0], vc, kkc, ac[:, :, 0], False)
    _, yl_f = _rwkv_scan(S_cf, r, decay[:, :, 0], kd[:, :, 0], v, kk, a[:, :, 0], False)
    S_cb, yc_b = _rwkv_scan(S0, rc, decayc[:, :, 1], kdc[:, :, 1], vc, kkc, ac[:, :, 1], True)
    _, yl_b = _rwkv_scan(S_cb, r, decay[:, :, 1], kd[:, :, 1], v, kk, a[:, :, 1], True)
    return yl_f + yl_b, yc_f + yc_b


def _rwkv_output(y, prep, r_k, ln_g, ln_b):
    r, v, _, _, _, kd = prep
    B, L = y.shape[:2]
    mu = jnp.mean(y, axis=-1, keepdims=True)
    var = jnp.mean(jnp.square(y - mu), axis=-1, keepdims=True)
    yn = ((y - mu) * lax.rsqrt(var + GN_EPS)).reshape(B, L, RWKV_WIDTH) * ln_g + ln_b
    bonus = jnp.einsum('blhn,bldhn,hn->blh', r, kd, r_k)[..., None] * v
    return yn + bonus.reshape(B, L, RWKV_WIDTH)


def _axial_rope_tables(L):
    rows = L // GRID_W
    row_ids = jnp.repeat(jnp.arange(rows), GRID_W).astype(jnp.float32)
    col_ids = jnp.tile(jnp.arange(GRID_W), rows).astype(jnp.float32)
    half = HEAD_DIM // 4
    inv = ROPE_THETA ** (-jnp.arange(half, dtype=jnp.float32) / half)
    ang_r = row_ids[:, None] * inv
    ang_c = col_ids[:, None] * inv
    ang = jnp.concatenate([ang_r, ang_r, ang_c, ang_c], axis=-1)
    return jnp.cos(ang), jnp.sin(ang)


def _apply_rope(t, cos, sin):
    parts = t.reshape(*t.shape[:-1], 2, 2, HEAD_DIM // 4)
    rot = jnp.stack([-parts[..., 1, :], parts[..., 0, :]], axis=-2).reshape(t.shape)
    return t * cos[None, :, None, :] + rot * sin[None, :, None, :]


def _sink_softmax(scores, sink):
    m = sink
    for s in scores:
        m = jnp.maximum(m, jnp.max(s, axis=-1, keepdims=True))
    ps = [jnp.exp(s - m) for s in scores]
    denom = jnp.exp(sink - m)
    for p in ps:
        denom = denom + jnp.sum(p, axis=-1, keepdims=True)
    return [p / denom for p in ps]


def _window_attention(q, k, v, kc, vc, sink):
    B, L = q.shape[:2]
    nb = L // BLOCK
    qb = q.reshape(B, nb, BLOCK, KV_HEADS, GROUP, HEAD_DIM) * (HEAD_DIM ** -0.5)
    pad = ((0, 0), (BLOCK, BLOCK), (0, 0), (0, 0))
    kp = jnp.pad(k, pad).reshape(B, nb + 2, BLOCK, KV_HEADS, HEAD_DIM)
    vp = jnp.pad(v, pad).reshape(B, nb + 2, BLOCK, KV_HEADS, HEAD_DIM)
    band = lambda t: jnp.concatenate([t[:, :-2], t[:, 1:-1], t[:, 2:]], axis=2)
    kb, vb = band(kp), band(vp)
    s_lat = jnp.einsum('bnqhgd,bnshd->bhgnqs', qb, kb)
    s_ctx = jnp.einsum('bnqhgd,bshd->bhgnqs', qb, kc)
    qpos = jnp.arange(nb)[:, None, None] * BLOCK + jnp.arange(BLOCK)[None, :, None]
    kpos = (jnp.arange(nb)[:, None, None] - 1) * BLOCK + jnp.arange(3 * BLOCK)[None, None, :]
    valid = (jnp.abs(qpos - kpos) <= WINDOW) & (kpos >= 0) & (kpos < L)
    s_lat = jnp.where(valid, s_lat, -jnp.inf)
    p_lat, p_ctx = _sink_softmax([s_lat, s_ctx], sink.astype(jnp.float32).reshape(1, KV_HEADS, GROUP, 1, 1, 1))
    o = jnp.einsum('bhgnqs,bnshd->bnqhgd', p_lat, vb) + jnp.einsum('bhgnqs,bshd->bnqhgd', p_ctx, vc)
    return o.reshape(B, L, ATT_WIDTH)


def _context_attention(qc, kc, vc, sink):
    B, C = qc.shape[:2]
    qg = qc.reshape(B, C, KV_HEADS, GROUP, HEAD_DIM) * (HEAD_DIM ** -0.5)
    s = jnp.einsum('bqhgd,bshd->bhgqs', qg, kc)
    (p,) = _sink_softmax([s], sink.astype(jnp.float32).reshape(1, KV_HEADS, GROUP, 1, 1))
    return jnp.einsum('bhgqs,bshd->bqhgd', p, vc).reshape(B, C, ATT_WIDTH)


def setup_inputs(seed: int = 0) -> dict:
    key = jax.random.key(seed)
    ks = jax.random.split(key, 24)
    f32 = jnp.float32
    nrm = lambda k, shape, s: jax.random.normal(k, shape, f32) * s
    D = D_MODEL
    ramp = -7.0 + 5.0 * (jnp.arange(RWKV_WIDTH, dtype=f32) / (RWKV_WIDTH - 1)) ** 0.85 + 0.5
    return {
        "x": nrm(ks[0], (BATCH, SEQ, D), 1.0),
        "c": nrm(ks[1], (BATCH, D), 1.0),
        "ctx": nrm(ks[2], (BATCH, CTX_LEN, D), 1.0),
        "c_ctx": nrm(ks[3], (D,), 1.0),
        "w_ada": nrm(ks[4], (DEPTH, D, 3 * D), 0.5 * D ** -0.5),
        "b_ada": nrm(ks[5], (DEPTH, 3 * D), 0.01),
        "norm_g": 1.0 + nrm(ks[6], (DEPTH, D), 0.02),
        "w_in": nrm(ks[7], (DEPTH, D, IN_COLS), D ** -0.5),
        "mu_shift": jax.random.uniform(ks[8], (DEPTH, SHIFT_COLS), f32),
        "w0": ramp + nrm(ks[9], (DEPTH, 2, RWKV_WIDTH), 0.1),
        "w2": nrm(ks[10], (DEPTH, 2, LORA, RWKV_WIDTH), 0.5 * LORA ** -0.5),
        "a0": nrm(ks[11], (DEPTH, 2, RWKV_WIDTH), 0.5),
        "a2": nrm(ks[12], (DEPTH, 2, LORA, RWKV_WIDTH), 0.5 * LORA ** -0.5),
        "k_k": 0.85 + nrm(ks[13], (DEPTH, RWKV_WIDTH), 0.05),
        "k_a": 1.0 + nrm(ks[14], (DEPTH, RWKV_WIDTH), 0.05),
        "r_k": nrm(ks[15], (DEPTH, RWKV_HEADS, RWKV_HEAD), 0.1),
        "ln_x_g": 1.0 + nrm(ks[16], (DEPTH, RWKV_WIDTH), 0.02),
        "ln_x_b": nrm(ks[17], (DEPTH, RWKV_WIDTH), 0.01),
        "q_norm_g": 1.0 + nrm(ks[18], (DEPTH, HEAD_DIM), 0.02),
        "k_norm_g": 1.0 + nrm(ks[19], (DEPTH, HEAD_DIM), 0.02),
        "sink": nrm(ks[20], (DEPTH, N_HEADS), 0.5),
        "w_out": nrm(ks[21], (DEPTH, D, D), D ** -0.5),
    }


def reference(x, c, ctx, c_ctx, w_ada, b_ada, norm_g, w_in, mu_shift, w0, w2, a0, a2, k_k, k_a, r_k,
              ln_x_g, ln_x_b, q_norm_g, k_norm_g, sink, w_out):
    B, L, _ = x.shape
    C = ctx.shape[1]
    cos, sin = _axial_rope_tables(L)
    for l in range(DEPTH):
        mod = _adaln(c, w_ada[l], b_ada[l])
        mod_c = _adaln(c_ctx, w_ada[l], b_ada[l])
        xn, gate = _modulate(x, mod, norm_g[l])
        xcn, gate_c = _modulate(ctx, mod_c, norm_g[l])
        sh, z_r, q, k, v, z_a = _project(xn, w_in[l], mu_shift[l])
        sh_c, z_rc, q_c, k_c, v_c, z_ac = _project(xcn, w_in[l], mu_shift[l])

        prep = _rwkv_prep(sh, w0[l], w2[l], a0[l], a2[l], k_k[l], k_a[l])
        prep_c = _rwkv_prep(sh_c, w0[l], w2[l], a0[l], a2[l], k_k[l], k_a[l])
        y_lat, y_ctx = _bidirectional_rwkv(prep, prep_c)
        rw_out = _rwkv_output(y_lat, prep, r_k[l], ln_x_g[l], ln_x_b[l])

        qh = _apply_rope(_rms(q.reshape(B, L, N_HEADS, HEAD_DIM), q_norm_g[l]), cos, sin)
        kh = _apply_rope(_rms(k.reshape(B, L, KV_HEADS, HEAD_DIM), k_norm_g[l]), cos, sin)
        vh = v.reshape(B, L, KV_HEADS, HEAD_DIM).astype(jnp.float32)
        kch = _rms(k_c.reshape(B, C, KV_HEADS, HEAD_DIM), k_norm_g[l])
        vch = v_c.reshape(B, C, KV_HEADS, HEAD_DIM).astype(jnp.float32)
        att_out = _window_attention(qh, kh, vh, kch, vch, sink[l])

        mixed = jnp.concatenate([rw_out * jax.nn.silu(z_r), att_out * jax.nn.silu(z_a)], axis=-1)
        x_new = x + gate * (mixed @ w_out[l])

        if l + 1 < DEPTH:
            rw_c = _rwkv_output(y_ctx, prep_c, r_k[l], ln_x_g[l], ln_x_b[l])
            qch = _rms(q_c.reshape(B, C, N_HEADS, HEAD_DIM), q_norm_g[l])
            att_c = _context_attention(qch, kch, vch, sink[l])
            mixed_c = jnp.concatenate([rw_c * jax.nn.silu(z_rc), att_c * jax.nn.silu(z_ac)], axis=-1)
            ctx = (ctx + gate_c * (mixed_c @ w_out[l])).astype(ctx.dtype)
        x = x_new.astype(x.dtype)
    return x
```

```cpp
#include <hip/hip_runtime.h>
#include <cstdio>
#include <cstdint>
namespace pg8 {
#define PG8_LAS __attribute__((address_space(3)))
typedef unsigned short bf16_t;
typedef short bf16x8 __attribute__((ext_vector_type(8)));
typedef float f32x4 __attribute__((ext_vector_type(4)));
typedef unsigned u32x4 __attribute__((ext_vector_type(4)));
constexpr int BM = 256, BK = 64, HALF = 128, HTB = HALF * BK * 2  , STAGE_BYTES = 8 * HTB, NXCD = 8, WGM = 8;

__host__ __device__ __forceinline__ int lds_byte(int r, int c) { const int st = (r >> 4) * 2 + (c >> 5), rr = r & 15, cc = c & 31, ob = rr * 64 + cc * 2; return st * 1024 + (ob ^ (((ob >> 9) & 1) << 5)); }
__host__ __device__ __forceinline__ void stage_rc(int b, int& R, int& C) { const int st = b / 1024, sb = b % 1024, swz = sb ^ (((sb >> 9) & 1) << 5); R = (st >> 1) * 16 + swz / 64; C = (st & 1) * 32 + (swz % 64) / 2; }
__host__ __device__ __forceinline__ int perm32(int rho) { const int n = rho >> 4, i = rho & 15; return 8 * (i >> 2) + 4 * n + (i & 3); }

struct Unit { int pm, pn; };
struct Gemm { const bf16_t* A; const bf16_t* Bt; int M, N, K; };

struct StaticOrder {
    int nM, nN, nwg, G, c;
    __host__ __device__ void init(int M, int N, int G_, int c_) { nM = M / BM; nN = N / BM; nwg = nM * nN; G = G_; c = c_; }
    __host__ __device__ bool next(int i, Unit& u) const {
        const long L = (long)i * G + c; if (L >= nwg) return false;
        int wgid = (int)L; { const int q = nwg / NXCD, r = nwg % NXCD, xcd = wgid % NXCD, off = wgid / NXCD; wgid = (xcd < r ? xcd * (q + 1) : r * (q + 1) + (xcd - r) * q) + off; }
        const int nig = WGM * nN, gid = wgid / nig, fm = gid * WGM, gsz = (nM - fm) < WGM ? (nM - fm) : WGM;
        u.pm = fm + ((wgid % nig) % gsz); u.pn = (wgid % nig) / gsz; return true;
    }
    __device__ __forceinline__ void a_ready(const Unit&) const {}
    __device__ __forceinline__ void done(const Unit&) const {}
};

__device__ __forceinline__ unsigned cvt_pk_bf16(float lo, float hi) { unsigned r; asm volatile("v_cvt_pk_bf16_f32 %0, %1, %2" : "=v"(r) : "v"(lo), "v"(hi)); return r; }
typedef float f32x2 __attribute__((ext_vector_type(2)));
__device__ __forceinline__ f32x2 gelu_pk(f32x2 v) {
    const f32x2 av = __builtin_elementwise_abs(v), d = av * 0.2316418882f + 1.0f;
    f32x2 t; t.x = __builtin_amdgcn_rcpf(d.x); t.y = __builtin_amdgcn_rcpf(d.y);
    f32x2 q = t * 0.5307027145f + (-0.7265760135f); q = q * t + 0.7107068705f; q = q * t + (-0.142248368f); q = q * t + 0.127414796f; q = q * t;
    const f32x2 s = (v * v) * (-0.72134752044f);
    f32x2 e; e.x = __builtin_amdgcn_exp2f(s.x); e.y = __builtin_amdgcn_exp2f(s.y);
    const f32x2 m = v * (q * e), r = v - m;
    f32x2 o; o.x = v.x < 0.f ? m.x : r.x; o.y = v.y < 0.f ? m.y : r.y; return o;
}

template <int ACT  > struct EpiBf16 {
    static constexpr bool PERM = true, AFTER_DRAIN = false; static_assert(ACT == 0 || ACT == 1, "EpiBf16: ACT is 0 (none) or 1 (gelu_pk)");
    bf16_t* O; int ldc; const float* bias; int split_cols; size_t split_stride; float scale0;
    __device__ __forceinline__ void operator()(const f32x4 (&acc)[2][2][4][2], const Unit& u, int wr, int wc, int fr, int fq) const {
        const int row0 = u.pm * BM + wr * 64 + fr; int colt = u.pn * BM; bf16_t* base = O;
        float sc = 1.f; if (split_cols) { const int t = colt / split_cols; base += (size_t)t * split_stride; colt -= t * split_cols; if (t == 0) sc = scale0; }
        const int col0 = colt + wc * 32 + 8 * fq, bcol0 = u.pn * BM + wc * 32 + 8 * fq;
        f32x4 bv[2][2];
#pragma unroll
        for (int bj = 0; bj < 2; ++bj)
#pragma unroll
            for (int n = 0; n < 2; ++n) bv[bj][n] = bias ? *(const f32x4*)(bias + bcol0 + bj * HALF + 4 * n) : (f32x4){0.f, 0.f, 0.f, 0.f};
#pragma unroll
        for (int ai = 0; ai < 2; ++ai)
#pragma unroll
            for (int m = 0; m < 4; ++m) { bf16_t* rowp = base + (size_t)(row0 + ai * HALF + m * 16) * ldc + col0;
#pragma unroll
                for (int bj = 0; bj < 2; ++bj) { f32x4 v0 = acc[ai][bj][m][0] + bv[bj][0], v1 = acc[ai][bj][m][1] + bv[bj][1];
                    if (ACT == 1) { f32x2 a = gelu_pk((f32x2){v0[0], v0[1]}), b = gelu_pk((f32x2){v0[2], v0[3]}), c = gelu_pk((f32x2){v1[0], v1[1]}), d = gelu_pk((f32x2){v1[2], v1[3]});
                        v0 = (f32x4){a.x, a.y, b.x, b.y}; v1 = (f32x4){c.x, c.y, d.x, d.y}; }
                    v0 = v0 * sc; v1 = v1 * sc; u32x4 w; w.x = cvt_pk_bf16(v0[0], v0[1]); w.y = cvt_pk_bf16(v0[2], v0[3]); w.z = cvt_pk_bf16(v1[0], v1[1]); w.w = cvt_pk_bf16(v1[2], v1[3]);
                    *(u32x4*)(rowp + bj * HALF) = w; } }
    }
};


struct EpiGate {
    static constexpr bool PERM = false, AFTER_DRAIN = false;
    const float* x; float* out; const float* gate; int ldc;
    __device__ __forceinline__ void operator()(const f32x4 (&acc)[2][2][4][2], const Unit& u, int wr, int wc, int fr, int fq) const {
        const int col0 = u.pn * BM + wc * 32 + 4 * fq;
        const int b = (u.pm * BM) >> 12;
        f32x4 gv[2][2];
#pragma unroll
        for (int bj = 0; bj < 2; ++bj)
#pragma unroll
            for (int n = 0; n < 2; ++n) gv[bj][n] = *(const f32x4*)(gate + (size_t)b * 6144 + col0 + bj * HALF + n * 16);
#pragma unroll
        for (int ai = 0; ai < 2; ++ai)
#pragma unroll
            for (int m = 0; m < 4; ++m) { const size_t off = (size_t)(u.pm * BM + ai * HALF + wr * 64 + m * 16 + fr) * ldc + col0;
#pragma unroll
                for (int bj = 0; bj < 2; ++bj)
#pragma unroll
                    for (int n = 0; n < 2; ++n) { const f32x4 xv = *(const f32x4*)(x + off + bj * HALF + n * 16);
                        *(f32x4*)(out + off + bj * HALF + n * 16) = xv + gv[bj][n] * acc[ai][bj][m][n]; }
                if (m & 1) asm volatile("" ::: "memory"); }
    }
};
template <class Epi, class Sched, bool ALIGN_EPI = false, bool SP2 = false>
__device__ __forceinline__ void gemm_phase(PG8_LAS unsigned char* lds, const Gemm g, const Sched& S, const Epi& E) {
    const int tid = threadIdx.x, wid = __builtin_amdgcn_readfirstlane(tid >> 6), lane = tid & 63, wr = wid >> 2, wc = wid & 3, fr = lane & 15, fq = lane >> 4;
    const int K = g.K, nt = K / BK;
    unsigned voffA[2], voffB[2];
#pragma unroll
    for (int i = 0; i < 2; ++i) { int R, C; stage_rc(tid * 16 + i * 8192, R, C); const int Rb = Epi::PERM ? ((R & ~31) + perm32(R & 31)) : R;
        voffA[i] = (unsigned)(R * K + C) * 2u; voffB[i] = (unsigned)(Rb * K + C) * 2u; }
    const size_t kstep = (size_t)(BK * 2);
    const size_t hstep = (size_t)HALF * K * 2;
    const size_t tstep = 2 * hstep;
    const unsigned ldsw = (unsigned)wid * 1024u;
    const int aoff = lds_byte(wr * 64 + fr, fq * 8), boff = lds_byte(wc * 32 + fr, fq * 8);
#define PG8_SA(b, h) (((b) * 2 + (h)) * HTB)
#define PG8_SB(b, h) ((4 + (b) * 2 + (h)) * HTB)
#define PG8_STAGE(bufoff, gbase, voff) do { _Pragma("unroll") for (int _i = 0; _i < 2; ++_i) \
        __builtin_amdgcn_global_load_lds((const unsigned*)((const char*)(gbase) + (voff)[_i]), (PG8_LAS unsigned*)(lds + (bufoff) + ldsw + _i * 8192), 16, 0, 0); } while (0)
#define PG8_LDA(dst, b, h) do { _Pragma("unroll") for (int m = 0; m < 4; ++m) _Pragma("unroll") for (int k = 0; k < 2; ++k) dst[m][k] = *(const PG8_LAS bf16x8*)(lds + PG8_SA(b, h) + aoff + m * 2048 + k * 1024); } while (0)
#define PG8_LDB(dst, b, h) do { _Pragma("unroll") for (int n = 0; n < 2; ++n) _Pragma("unroll") for (int k = 0; k < 2; ++k) dst[n][k] = *(const PG8_LAS bf16x8*)(lds + PG8_SB(b, h) + boff + n * 2048 + k * 1024); } while (0)
#define PG8_MMA(ai, bj, At, Bt) do { __builtin_amdgcn_s_setprio(1); _Pragma("unroll") for (int m = 0; m < 4; ++m) _Pragma("unroll") for (int n = 0; n < 2; ++n) _Pragma("unroll") for (int k = 0; k < 2; ++k) \
        acc[ai][bj][m][n] = __builtin_amdgcn_mfma_f32_16x16x32_bf16(Bt[n][k], At[m][k], acc[ai][bj][m][n], 0, 0, 0); __builtin_amdgcn_s_setprio(0); } while (0)
#define PG8_WAIT_V(n) asm volatile("s_waitcnt vmcnt(" #n ")" ::: "memory")
#define PG8_WAIT_L(n) asm volatile("s_waitcnt lgkmcnt(" #n ")" ::: "memory")
#define PG8_BAR __builtin_amdgcn_s_barrier()
#define PG8_SCHED __builtin_amdgcn_sched_barrier(0)
    Unit cur, nxt; int ui = 0;
    if (!S.next(0, cur)) return;
    f32x4 acc[2][2][4][2];
#pragma unroll
    for (int a = 0; a < 2; ++a)
#pragma unroll
        for (int b = 0; b < 2; ++b)
#pragma unroll
            for (int m = 0; m < 4; ++m)
#pragma unroll
                for (int n = 0; n < 2; ++n) acc[a][b][m][n] = (f32x4){0.f, 0.f, 0.f, 0.f};
    bf16x8 At[4][2], B0[2][2], B1[2][2];
    const char* cA = (const char*)g.A + (size_t)cur.pm * tstep; const char* cB = (const char*)g.Bt + (size_t)cur.pn * tstep;
    S.a_ready(cur);
    if constexpr (SP2) {
        PG8_STAGE(PG8_SB(0, 0), cB, voffB); PG8_STAGE(PG8_SB(0, 1), cB + hstep, voffB); PG8_STAGE(PG8_SA(0, 0), cA, voffA); PG8_STAGE(PG8_SA(0, 1), cA + hstep, voffA);
        if (wr == 1) PG8_BAR;
        PG8_WAIT_V(2); PG8_BAR;
        PG8_STAGE(PG8_SB(1, 0), cB + kstep, voffB); PG8_STAGE(PG8_SA(1, 0), cA + kstep, voffA); PG8_STAGE(PG8_SB(1, 1), cB + hstep + kstep, voffB);
        PG8_WAIT_V(6); PG8_BAR;
    } else {
        PG8_STAGE(PG8_SB(0, 0), cB, voffB); PG8_STAGE(PG8_SA(0, 0), cA, voffA); PG8_STAGE(PG8_SB(0, 1), cB + hstep, voffB); PG8_STAGE(PG8_SA(0, 1), cA + hstep, voffA);
        if (wr == 1) PG8_BAR;
        PG8_WAIT_V(4); PG8_BAR;
        PG8_STAGE(PG8_SB(1, 0), cB + kstep, voffB); PG8_STAGE(PG8_SA(1, 0), cA + kstep, voffA); PG8_STAGE(PG8_SB(1, 1), cB + hstep + kstep, voffB);
        PG8_WAIT_V(6); PG8_BAR;
    }
    for (;;) {
        const bool has_next = S.next(ui + 1, nxt);
        const char* nA = has_next ? (const char*)g.A + (size_t)nxt.pm * tstep : cA; const char* nB = has_next ? (const char*)g.Bt + (size_t)nxt.pn * tstep : cB;
        for (int t = 0; t < nt; t += 2) {
            const bool last = (t == nt - 2);
            const char* a1 = cA + (size_t)(t + 1) * kstep;
            const char* a2 = last ? nA : cA + (size_t)(t + 2) * kstep; const char* b2 = last ? nB : cB + (size_t)(t + 2) * kstep;
            const char* a3 = a2 + kstep; const char* b3 = b2 + kstep;
            if (last && has_next) S.a_ready(nxt);
            if constexpr (SP2) {
            PG8_LDB(B0, 0, 0); PG8_LDB(B1, 0, 1); PG8_SCHED; PG8_LDA(At, 0, 0); PG8_STAGE(PG8_SA(1, 1), a1 + hstep, voffA);
            PG8_WAIT_V(8); PG8_WAIT_L(0); PG8_BAR; PG8_MMA(0, 0, At, B0); PG8_MMA(0, 1, At, B1); PG8_BAR; PG8_SCHED;
            PG8_LDA(At, 0, 1); PG8_STAGE(PG8_SB(0, 0), b2, voffB); PG8_STAGE(PG8_SB(0, 1), b2 + hstep, voffB); PG8_STAGE(PG8_SA(0, 0), a2, voffA);
            PG8_WAIT_V(8); PG8_WAIT_L(0); PG8_BAR; PG8_MMA(1, 0, At, B0); PG8_MMA(1, 1, At, B1); PG8_BAR; PG8_SCHED;
            PG8_LDB(B0, 1, 0); PG8_LDB(B1, 1, 1); PG8_SCHED; PG8_LDA(At, 1, 0); PG8_STAGE(PG8_SA(0, 1), a2 + hstep, voffA);
            PG8_WAIT_V(8); PG8_WAIT_L(0); PG8_BAR; PG8_MMA(0, 0, At, B0); PG8_MMA(0, 1, At, B1); PG8_BAR; PG8_SCHED;
            PG8_LDA(At, 1, 1); PG8_STAGE(PG8_SB(1, 0), b3, voffB); PG8_STAGE(PG8_SB(1, 1), b3 + hstep, voffB); PG8_STAGE(PG8_SA(1, 0), a3, voffA);
            PG8_WAIT_V(8); PG8_WAIT_L(0); PG8_BAR; PG8_MMA(1, 0, At, B0); PG8_MMA(1, 1, At, B1); PG8_BAR; PG8_SCHED;
            } else {
            PG8_LDB(B0, 0, 0); PG8_SCHED; PG8_LDA(At, 0, 0); PG8_STAGE(PG8_SA(1, 1), a1 + hstep, voffA);
            PG8_WAIT_L(8); PG8_BAR; PG8_WAIT_L(0); PG8_MMA(0, 0, At, B0); PG8_BAR; PG8_SCHED;
            PG8_LDB(B1, 0, 1); PG8_STAGE(PG8_SB(0, 0), b2, voffB);
            PG8_BAR; PG8_WAIT_L(0); PG8_MMA(0, 1, At, B1); PG8_BAR;
            PG8_LDA(At, 0, 1); PG8_STAGE(PG8_SA(0, 0), a2, voffA);
            PG8_BAR; PG8_WAIT_L(0); PG8_MMA(1, 0, At, B0); PG8_BAR; PG8_SCHED;
            PG8_STAGE(PG8_SB(0, 1), b2 + hstep, voffB);
            PG8_WAIT_V(6); PG8_BAR; PG8_MMA(1, 1, At, B1); PG8_BAR;
            PG8_LDB(B0, 1, 0); PG8_SCHED; PG8_LDA(At, 1, 0); PG8_STAGE(PG8_SA(0, 1), a2 + hstep, voffA);
            PG8_WAIT_L(8); PG8_BAR; PG8_WAIT_L(0); PG8_MMA(0, 0, At, B0); PG8_BAR; PG8_SCHED;
            PG8_LDB(B1, 1, 1); PG8_STAGE(PG8_SB(1, 0), b3, voffB);
            PG8_BAR; PG8_WAIT_L(0); PG8_MMA(0, 1, At, B1); PG8_BAR;
            PG8_LDA(At, 1, 1); PG8_STAGE(PG8_SA(1, 0), a3, voffA);
            PG8_BAR; PG8_WAIT_L(0); PG8_MMA(1, 0, At, B0); PG8_BAR; PG8_SCHED;
            PG8_STAGE(PG8_SB(1, 1), b3 + hstep, voffB);
            PG8_WAIT_V(6); PG8_BAR; PG8_MMA(1, 1, At, B1); PG8_BAR;
            }
        }
        if constexpr (ALIGN_EPI) { if (wr == 0) PG8_BAR; }
        if constexpr (!Epi::AFTER_DRAIN) { E(acc, cur, wr, wc, fr, fq); S.done(cur); }
        if (!has_next) break;
#pragma unroll
        for (int a = 0; a < 2; ++a)
#pragma unroll
            for (int b = 0; b < 2; ++b)
#pragma unroll
                for (int m = 0; m < 4; ++m)
#pragma unroll
                    for (int n = 0; n < 2; ++n) acc[a][b][m][n] = (f32x4){0.f, 0.f, 0.f, 0.f};
        cur = nxt; cA = nA; cB = nB; ++ui;
        if constexpr (ALIGN_EPI) { if (wr == 1) PG8_BAR; }
    }
    PG8_WAIT_V(0);
    if constexpr (!ALIGN_EPI) { if (wr == 0) PG8_BAR; }
    PG8_BAR;
    if constexpr (Epi::AFTER_DRAIN) { E.fused(acc, cur, wr, wc, fr, fq, lds, wid, lane); S.done(cur); }
#undef PG8_SA
#undef PG8_SB
#undef PG8_STAGE
#undef PG8_LDA
#undef PG8_LDB
#undef PG8_MMA
#undef PG8_WAIT_V
#undef PG8_WAIT_L
#undef PG8_BAR
#undef PG8_SCHED
}
}

#ifndef MK_N_LAUNCHES
#define MK_N_LAUNCHES 7
#endif
constexpr int N_PHASES = 7;
constexpr int NWAVES = 8;
constexpr int DM = 2048, NB = 4, SEQ = 4096, CTXL = 256;
constexpr int ML = NB * SEQ, MC = NB * CTXL, MT = ML + MC;
constexpr int NIN = 6912;
constexpr int C_R = 0, C_K = 1024, C_V = 2048, C_LW = 3072, C_LA = 3200, C_ZR = 3328, C_Q = 4352, C_KA = 5376, C_VA = 5632, C_ZA = 5888;
constexpr float LOG2E = 1.4426950408889634f;

constexpr size_t MiB = 1u << 20;
constexpr size_t WS_CTL = 0, CTL_ZERO_BYTES = 64 * 1024;
constexpr size_t WS_MOD = 1 * MiB;
constexpr size_t WS_ROPE = 1 * MiB + 128 * 1024;
constexpr size_t WS_W2T = 1 * MiB + 256 * 1024;
constexpr size_t WS_A2T = 1 * MiB + 512 * 1024;
constexpr size_t WS_WOUT = 2 * MiB;
constexpr size_t WS_P = 10 * MiB;
constexpr size_t WS_XN = 240 * MiB;
constexpr size_t WS_WIN = 308 * MiB;
constexpr size_t WS_UA = 240 * MiB;
constexpr size_t WS_YF = 376 * MiB, WS_YB = 408 * MiB;
constexpr size_t WS_BON = 440 * MiB;
constexpr size_t WS_MIX = 442 * MiB;
constexpr size_t WS_END = 506 * MiB;
static_assert(WS_P + (size_t)MT * NIN * 2 <= WS_XN && WS_XN + (size_t)MT * DM * 2 <= WS_WIN && WS_WIN + (size_t)NIN * DM * 2 <= WS_YF && WS_UA + (size_t)2 * MT * 4096 <= WS_YF, "ws map");

constexpr int CW_BAR = 1024;
constexpr int LDS_BYTES = 147456;
constexpr int MISC_OFF = LDS_BYTES - 256;

#define GAS __attribute__((address_space(1)))
#define LAS __attribute__((address_space(3)))
typedef unsigned short bf16;
typedef float f32x4 __attribute__((ext_vector_type(4)));
typedef float f32x16 __attribute__((ext_vector_type(16)));
typedef short bf16x8 __attribute__((ext_vector_type(8)));
typedef unsigned u32x4 __attribute__((ext_vector_type(4)));
typedef unsigned u32x2 __attribute__((ext_vector_type(2)));
typedef _Float16 h8 __attribute__((ext_vector_type(8)));
typedef _Float16 h4 __attribute__((ext_vector_type(4)));
typedef _Float16 h2 __attribute__((ext_vector_type(2)));
typedef GAS unsigned gu32;

__device__ __forceinline__ unsigned f2bf(float f) { unsigned u = __builtin_bit_cast(unsigned, f); return (u + 0x7fffu + ((u >> 16) & 1u)) >> 16; }
typedef float f32x2_t __attribute__((ext_vector_type(2))); typedef __bf16 bf16x2_t __attribute__((ext_vector_type(2)));
__device__ __forceinline__ unsigned pk2(float lo, float hi) { f32x2_t v = {lo, hi}; bf16x2_t b = __builtin_convertvector(v, bf16x2_t); return __builtin_bit_cast(unsigned, b); }
__device__ __forceinline__ float bflo(unsigned w) { return __builtin_bit_cast(float, w << 16); }
__device__ __forceinline__ float bfhi(unsigned w) { return __builtin_bit_cast(float, w & 0xffff0000u); }
__device__ __forceinline__ void unpack8(const u32x4 r, float* v) { v[0] = bflo(r.x); v[1] = bfhi(r.x); v[2] = bflo(r.y); v[3] = bfhi(r.y); v[4] = bflo(r.z); v[5] = bfhi(r.z); v[6] = bflo(r.w); v[7] = bfhi(r.w); }
__device__ __forceinline__ unsigned pkh(float a, float b) { h2 v = {(_Float16)a, (_Float16)b}; return __builtin_bit_cast(unsigned, v); }
__device__ __forceinline__ float wave_sum(float v) {
#pragma unroll
    for (int o = 1; o < 64; o <<= 1) v += __shfl_xor(v, o);
    return v;
}
__device__ __forceinline__ float fast_exp(float x) { return __builtin_amdgcn_exp2f(x * LOG2E); }
__device__ __forceinline__ float sigmoidf_(float x) { return __builtin_amdgcn_rcpf(1.0f + fast_exp(-x)); }
__device__ __forceinline__ float siluf_(float x) { return x * sigmoidf_(x); }
template <int CTRL> __device__ __forceinline__ float dpp_f(float x) { return __builtin_bit_cast(float, __builtin_amdgcn_update_dpp(0, __builtin_bit_cast(int, x), CTRL, 0xF, 0xF, false)); }

#define XB_TMO      128
#define XB_XCNT(j)  (256  + 64 * (j))
#define XB_XSUB(j)  (1280 + 64 * (j))
#define XB_XGEN(j)  (2304 + 64 * (j))
#define XB_TOP      3328
#define XB_TOPGEN   3392
#define XCD_BAR_WORDS 3456
#define XB_SPIN_CAP (1u << 18)
__device__ __forceinline__ unsigned xb_ld(unsigned* p)              { return __hip_atomic_load(p, __ATOMIC_RELAXED, __HIP_MEMORY_SCOPE_AGENT); }
__device__ __forceinline__ unsigned xb_add(unsigned* p, unsigned v) { return __hip_atomic_fetch_add(p, v, __ATOMIC_RELAXED, __HIP_MEMORY_SCOPE_AGENT); }
__device__ __forceinline__ unsigned xb_xcc_id() { return (unsigned)__builtin_amdgcn_s_getreg((3 << 11) | 20) & 0xFu; }
#define XB_SPIN(cond, bar) do { unsigned _sp = 0; while (cond) { __builtin_amdgcn_s_sleep(1); \
    if ((++_sp & 255u) == 0u) { if (xb_ld(&(bar)[XB_TMO])) break; if (_sp > XB_SPIN_CAP) { atomicAdd(&(bar)[XB_TMO], 1u); break; } } } } while (0)
struct XcdBarrier { unsigned* bar; unsigned x; volatile LAS unsigned* st; };
__device__ __forceinline__ XcdBarrier xcd_barrier_post(unsigned* bar, volatile LAS unsigned* st) {
    XcdBarrier b; b.bar = bar; b.x = xb_xcc_id(); b.st = st;
    if (threadIdx.x == 0) (void)xb_add(&bar[XB_XCNT(b.x)], 1u);
    return b;
}
__device__ __forceinline__ void xcd_barrier_complete(unsigned* bar, unsigned x, unsigned& nloc, unsigned& nx) {
    const unsigned G = gridDim.x * gridDim.y * gridDim.z;
    unsigned sum, cnt, mine, sp = 0u;
    for (;;) {
        sum = 0u; cnt = 0u; mine = 0u;
#pragma unroll
        for (unsigned j = 0; j < 16; ++j) { const unsigned c = xb_ld(&bar[XB_XCNT(j)]); sum += c; cnt += (c > 0u) ? 1u : 0u; mine = (j == x) ? c : mine; }
        if (sum == G) break;
        __builtin_amdgcn_s_sleep(1);
        if ((++sp & 255u) == 0u) { if (xb_ld(&bar[XB_TMO])) break; if (sp > XB_SPIN_CAP) { atomicAdd(&bar[XB_TMO], 1u); break; } }
    }
    nloc = mine > 0u ? mine : 1u; nx = cnt > 0u ? cnt : 1u;
}
__device__ __forceinline__ void xcd_barrier(const XcdBarrier& b) {
    asm volatile("s_waitcnt vmcnt(0)" ::: "memory");
    __syncthreads();
    if (threadIdx.x == 0) {
        unsigned* bar = b.bar;
        __builtin_amdgcn_s_waitcnt(0);
        unsigned nloc = b.st[0], nx = b.st[1];
        if (nloc == 0u) { xcd_barrier_complete(bar, b.x, nloc, nx); b.st[0] = nloc; b.st[1] = nx; }
        const unsigned old = xb_add(&bar[XB_XSUB(b.x)], 1u);
        const unsigned gen = old / nloc;
        if (old + 1u == (gen + 1u) * nloc) {
            __builtin_amdgcn_fence(__ATOMIC_RELEASE, "agent");
            asm volatile("s_waitcnt vmcnt(0)" ::: "memory");
            const unsigned og = xb_add(&bar[XB_TOP], 1u);
            const unsigned tg = og / nx;
            if (og + 1u == (tg + 1u) * nx) xb_add(&bar[XB_TOPGEN], 1u);
            else XB_SPIN(xb_ld(&bar[XB_TOPGEN]) == tg, bar);
            __builtin_amdgcn_fence(__ATOMIC_ACQUIRE, "agent");
            xb_add(&bar[XB_XGEN(b.x)], 1u);
            asm volatile("s_waitcnt vmcnt(0)" ::: "memory");
        } else {
            XB_SPIN(xb_ld(&bar[XB_XGEN(b.x)]) == gen, bar);
            __builtin_amdgcn_fence(__ATOMIC_ACQUIRE, "agent");
            asm volatile("s_waitcnt vmcnt(0)" ::: "memory");
        }
    }
    __syncthreads();
}

struct Frame {
    LAS unsigned char* lds;
    int tid, lane, wave, G, bid;
    const float *x, *c, *ctx, *c_ctx, *w_ada, *b_ada, *norm_g, *w_in, *mu_shift, *w0, *w2, *a0, *a2, *k_k, *k_a, *r_k, *ln_g, *ln_b, *qng, *kng, *sink, *w_out;
    float* out;
    float *MOD, *ROPE, *BON;
    bf16 *W2T, *A2T, *WOUT, *P, *XN, *WIN, *YF, *YB, *MIX;
    _Float16* UA;
};


typedef const float* cfp_t;
__device__ __forceinline__ const float* karg_f(int idx) { int off = idx * 8; asm volatile("" : "+s"(off)); const __attribute__((address_space(4))) char* kp = (const __attribute__((address_space(4))) char*)__builtin_amdgcn_kernarg_segment_ptr(); return *(const __attribute__((address_space(4))) cfp_t*)(kp + off); }
__device__ __forceinline__ void fresh(Frame& F) {
    int t_ = threadIdx.x; asm volatile("" : "+v"(t_)); F.tid = t_; F.lane = t_ & 63; F.wave = __builtin_amdgcn_readfirstlane(t_ >> 6);
    int b_ = blockIdx.x; asm volatile("" : "+s"(b_)); F.bid = b_;
    F.x = karg_f(0); F.c = karg_f(1); F.ctx = karg_f(2); F.c_ctx = karg_f(3); F.w_ada = karg_f(4); F.b_ada = karg_f(5); F.norm_g = karg_f(6); F.w_in = karg_f(7);
    F.mu_shift = karg_f(8); F.w0 = karg_f(9); F.w2 = karg_f(10); F.a0 = karg_f(11); F.a2 = karg_f(12); F.k_k = karg_f(13); F.k_a = karg_f(14); F.r_k = karg_f(15);
    F.ln_g = karg_f(16); F.ln_b = karg_f(17); F.qng = karg_f(18); F.kng = karg_f(19); F.sink = karg_f(20); F.w_out = karg_f(21);
    F.out = (float*)karg_f(22);
    unsigned char* ws = (unsigned char*)karg_f(23);
    F.MOD = (float*)(ws + WS_MOD); F.ROPE = (float*)(ws + WS_ROPE); F.BON = (float*)(ws + WS_BON);
    F.W2T = (bf16*)(ws + WS_W2T); F.A2T = (bf16*)(ws + WS_A2T); F.WOUT = (bf16*)(ws + WS_WOUT); F.P = (bf16*)(ws + WS_P); F.XN = (bf16*)(ws + WS_XN); F.WIN = (bf16*)(ws + WS_WIN);
    F.YF = (bf16*)(ws + WS_YF); F.YB = (bf16*)(ws + WS_YB); F.MIX = (bf16*)(ws + WS_MIX); F.UA = (_Float16*)(ws + WS_UA);
}

struct Sched1 {
    int G, c;
    __device__ __forceinline__ void init(int G_, int c_) { G = G_; c = c_; }
    __device__ __forceinline__ bool next(int i, pg8::Unit& u) const {
        int grp, loc;
        if (G == 256) { if (i >= 7) return false; grp = c & 7; loc = i * 32 + (c >> 3); if (loc >= 216) { const int j = grp * 8 + (loc - 216); if (j >= 60) return false; u.pm = 64 + j / 15; const int q = j % 15; u.pn = q < 13 ? q : q + 8; return true; } }
        else { const int L = i * G + c; if (L >= 1788) return false; if (L >= 1728) { const int j = L - 1728; u.pm = 64 + j / 15; const int q = j % 15; u.pn = q < 13 ? q : q + 8; return true; } grp = L / 216; loc = L % 216; }
        u.pm = grp * 8 + (loc & 7); u.pn = loc >> 3; return true;
    }
    __device__ __forceinline__ void a_ready(const pg8::Unit&) const {}
    __device__ __forceinline__ void done(const pg8::Unit&) const {}
};

__device__ __forceinline__ void p0_transpose_item(const float* W, int K, int N, bf16* WT, LAS float* scr, int item, int lane) {
    const int nblk = N / 32, kb = item / nblk, nb = item % nblk, k0 = 64 * kb, n0 = 32 * nb;
#pragma unroll 8
    for (int i = 0; i < 32; ++i) { const int kk = 2 * i + (lane >> 5); scr[kk * 33 + (lane & 31)] = W[(size_t)(k0 + kk) * N + n0 + (lane & 31)]; }
    asm volatile("s_waitcnt lgkmcnt(0)" ::: "memory");
    const int c = lane & 7;
#pragma unroll
    for (int j = 0; j < 4; ++j) { const int n = (lane >> 3) + 8 * j; const LAS float* s = scr + (8 * c) * 33 + n;
        u32x4 o; o.x = pk2(s[0 * 33], s[1 * 33]); o.y = pk2(s[2 * 33], s[3 * 33]); o.z = pk2(s[4 * 33], s[5 * 33]); o.w = pk2(s[6 * 33], s[7 * 33]);
        *(GAS u32x4*)(WT + (size_t)(n0 + n) * K + k0 + 8 * c) = o; }
    asm volatile("s_waitcnt lgkmcnt(0)" ::: "memory");
}
__device__ __forceinline__ void p0_prologue(Frame& F) {
    const int tid = F.tid, lane = F.lane, wave = F.wave;
    if (F.bid < 192) {
        LAS float* sl = (LAS float*)F.lds;
        LAS float* red = sl + 5 * 2048;
        for (int i = tid; i < 5 * 2048; i += NWAVES * 64) { const int v = i >> 11, k = i & 2047; const float cv = v < 4 ? F.c[v * 2048 + k] : F.c_ctx[k]; sl[i] = cv / (1.0f + __expf(-cv)); }
        __syncthreads();
        const int n0 = 32 * F.bid, col = lane & 31, slot = wave * 2 + (lane >> 5);
        float acc[5] = {0.f, 0.f, 0.f, 0.f, 0.f};
        const float* wp = F.w_ada + n0 + col;
#pragma unroll 8
        for (int k = slot; k < 2048; k += 16) { const float w = wp[(size_t)k * 6144];
#pragma unroll
            for (int v = 0; v < 5; ++v) acc[v] += sl[v * 2048 + k] * w; }
#pragma unroll
        for (int v = 0; v < 5; ++v) red[(slot * 5 + v) * 32 + col] = acc[v];
        __syncthreads();
        if (tid < 160) { const int v = tid >> 5, cc = tid & 31; float s = 0.f;
#pragma unroll
            for (int q = 0; q < 16; ++q) s += red[(q * 5 + v) * 32 + cc];
            F.MOD[v * 6144 + n0 + cc] = s + F.b_ada[n0 + cc]; }
        __syncthreads();
    }
    if (F.bid == F.G - 1) {
        for (int i = tid; i < 1024; i += NWAVES * 64) { const int pos = i >> 4, f = i & 15; const float inv = exp2f(-(float)f * (13.287712379549449f / 16.0f)); const float ang = (float)pos * inv;
            F.ROPE[i] = cosf(ang); F.ROPE[1024 + i] = sinf(ang); }
    }
    LAS float* scr = (LAS float*)(F.lds + wave * 16384);
    const int gw = F.bid * NWAVES + wave, NGW = F.G * NWAVES;
    constexpr int I_IN = (DM / 64) * (NIN / 32), I_OUT = (DM / 64) * (DM / 32), I_L = 1024 / 32;
    constexpr int NITEMS = I_IN + I_OUT + 4 * I_L;
    for (int it = gw; it < NITEMS; it += NGW) {
        int r = it;
        if (r < I_IN) { p0_transpose_item(F.w_in, DM, NIN, F.WIN, scr, r, lane); continue; } r -= I_IN;
        if (r < I_OUT) { p0_transpose_item(F.w_out, DM, DM, F.WOUT, scr, r, lane); continue; } r -= I_OUT;
        const int q = r / I_L; r -= q * I_L;
        p0_transpose_item((q < 2 ? F.w2 : F.a2) + (size_t)(q & 1) * 64 * 1024, 64, 1024, (q < 2 ? F.W2T : F.A2T) + (size_t)(q & 1) * 1024 * 64, scr, r, lane);
    }
}

__device__ __forceinline__ void p1_modulate(Frame& F) {
    const int gw = F.bid * NWAVES + F.wave, NGW = F.G * NWAVES, lane = F.lane;
    for (int m = gw; m < MT; m += NGW) {
        const float* src = m < ML ? F.x + (size_t)m * DM : F.ctx + (size_t)(m - ML) * DM;
        const float* mod = F.MOD + (m < ML ? (m >> 12) : 4) * 6144;
        const GAS f32x4* xr = (const GAS f32x4*)src + lane;
        f32x4 v[8]; float s = 0.f;
#pragma unroll
        for (int j = 0; j < 8; ++j) { v[j] = xr[64 * j]; s += (v[j].x * v[j].x + v[j].y * v[j].y) + (v[j].z * v[j].z + v[j].w * v[j].w); }
        const float rr = 1.0f / sqrtf(wave_sum(s) * (1.0f / DM) + 1e-6f);
        GAS u32x2* o8 = (GAS u32x2*)(F.XN + (size_t)m * DM) + lane;
#pragma unroll
        for (int j = 0; j < 8; ++j) { const int d0 = (64 * j + lane) * 4;
            const f32x4 g = *(const f32x4*)(F.norm_g + d0), sc = *(const f32x4*)(mod + 2048 + d0), sh = *(const f32x4*)(mod + d0);
            const f32x4 o = v[j] * rr * g * (1.0f + sc) + sh;
            u32x2 w; w.x = pk2(o.x, o.y); w.y = pk2(o.z, o.w); o8[64 * j] = w; }
    }
}

__device__ __forceinline__ int seq_lo(int m) { return m < ML ? (m & ~(SEQ - 1)) : ML + ((m - ML) & ~(CTXL - 1)); }
__device__ __forceinline__ int seq_hi(int m) { return m < ML ? (m | (SEQ - 1)) : ML + ((m - ML) | (CTXL - 1)); }
__device__ __forceinline__ void p3_lora(Frame& F) {
    const int tid = F.tid, lane = F.lane, wave = F.wave, l31 = lane & 31, hi = lane >> 5;
    LAS unsigned char* TT = F.lds;
    LAS unsigned char* LT = F.lds + 8192;
    for (int it = F.bid; it < 2 * (MT / 64); it += F.G) {
        const int d = it & 1, m0 = (it >> 1) * 64;
        {
            const int row = tid >> 3, ch = tid & 7, m = m0 + row, lo = seq_lo(m), hi_ = seq_hi(m);
            const bf16* pc = F.P + (size_t)m * NIN;
            const u32x4 z = {0u, 0u, 0u, 0u};
            const int cw = C_LW + d * 64 + 8 * ch, ca = C_LA + d * 64 + 8 * ch;
            const u32x4 w_c = *(const u32x4*)(pc + cw), a_c = *(const u32x4*)(pc + ca);
            const u32x4 w_p = m > lo ? *(const u32x4*)(pc - NIN + cw) : z, a_p = m > lo ? *(const u32x4*)(pc - NIN + ca) : z;
            const u32x4 w_n = m < hi_ ? *(const u32x4*)(pc + NIN + cw) : z, a_n = m < hi_ ? *(const u32x4*)(pc + NIN + ca) : z;
            float wc[8], wp[8], wn[8], ac[8], ap[8], an[8];
            unpack8(w_c, wc); unpack8(w_p, wp); unpack8(w_n, wn); unpack8(a_c, ac); unpack8(a_p, ap); unpack8(a_n, an);
            float tw[8], ta[8];
#pragma unroll
            for (int j = 0; j < 8; ++j) { const float muw = F.mu_shift[cw + j], mua = F.mu_shift[ca + j];
                const float sw = wc[j] + muw * (0.5f * (wp[j] + wn[j]) - wc[j]); ta[j] = ac[j] + mua * (0.5f * (ap[j] + an[j]) - ac[j]);
                tw[j] = 1.0f - 2.0f * __builtin_amdgcn_rcpf(1.0f + fast_exp(2.0f * sw)); }
            const int off = row * 128 + ((ch ^ ((row >> 1) & 7)) << 4);
            u32x4 o; o.x = pk2(tw[0], tw[1]); o.y = pk2(tw[2], tw[3]); o.z = pk2(tw[4], tw[5]); o.w = pk2(tw[6], tw[7]); *(LAS u32x4*)(TT + off) = o;
            o.x = pk2(ta[0], ta[1]); o.y = pk2(ta[2], ta[3]); o.z = pk2(ta[4], ta[5]); o.w = pk2(ta[6], ta[7]); *(LAS u32x4*)(LT + off) = o;
        }
        __syncthreads();
#pragma unroll 1
        for (int which = 0; which < 2; ++which) {
            LAS unsigned char* T = which ? LT : TT;
            const bf16* BT = (which ? F.A2T : F.W2T) + (size_t)d * 1024 * 64;
            const float* bias = (which ? F.a0 : F.w0) + d * 1024;
            bf16x8 af[2][4];
#pragma unroll
            for (int mb = 0; mb < 2; ++mb)
#pragma unroll
                for (int ks = 0; ks < 4; ++ks) { const int row = mb * 32 + l31, ch = 2 * ks + hi; af[mb][ks] = *(const LAS bf16x8*)(T + row * 128 + ((ch ^ ((row >> 1) & 7)) << 4)); }
#pragma unroll 1
            for (int nb = 0; nb < 4; ++nb) {
                const int col = wave * 128 + nb * 32 + l31;
                bf16x8 bfr[4];
#pragma unroll
                for (int ks = 0; ks < 4; ++ks) bfr[ks] = *(const bf16x8*)(BT + (size_t)col * 64 + 16 * ks + 8 * hi);
                const float bz = bias[col];
#pragma unroll
                for (int mb = 0; mb < 2; ++mb) {
                    f32x16 acc = {0.f, 0.f, 0.f, 0.f, 0.f, 0.f, 0.f, 0.f, 0.f, 0.f, 0.f, 0.f, 0.f, 0.f, 0.f, 0.f};
#pragma unroll
                    for (int ks = 0; ks < 4; ++ks) acc = __builtin_amdgcn_mfma_f32_32x32x16_bf16(af[mb][ks], bfr[ks], acc, 0, 0, 0);
                    _Float16* dst = F.UA + (((size_t)d * MT + m0 + mb * 32) * 16 + (col >> 6)) * 128 + which * 64 + (col & 63);
#pragma unroll
                    for (int r = 0; r < 16; ++r) { const int i = (r & 3) + 8 * (r >> 2) + 4 * hi;
                        const float sg = sigmoidf_(acc[r] + bz);
                        const float val = which ? sg : 1.0f - fast_exp(-0.6065306597126334f * sg);
                        dst[(size_t)i * 2048] = (_Float16)val; }
                }
            }
        }
        __syncthreads();
    }
}

constexpr int SC_BUF = 49152;
constexpr int SC_A1 = 0, SC_A2 = 16384, SC_A3 = 32768, SC_V = 40960, SC_Y = 2 * SC_BUF, SC_CONST = SC_Y + 8192;
struct ScanRegs { u32x4 r[3], k[3], v[3], ua[2]; };
__device__ __forceinline__ int scan_row(int b, int d, int blk, int tok) {
    const int j = blk < 4 ? blk * 64 + tok : (blk - 4) * 64 + tok;
    if (blk < 4) return ML + b * CTXL + (d ? (CTXL - 1 - j) : j);
    return b * SEQ + (d ? (SEQ - 1 - j) : j);
}
__device__ __forceinline__ void scan_load(Frame& F, ScanRegs& R, int b, int h, int d, int half, int blk) {
    const int tok = F.tid >> 3, ch = F.tid & 7, m = scan_row(b, d, blk, tok), lo = seq_lo(m), hi_ = seq_hi(m);
    const bf16* pc = F.P + (size_t)m * NIN + h * 64 + 8 * ch;
    const u32x4 z = {0u, 0u, 0u, 0u};
    const bool hp = m > lo, hn = m < hi_, hv = (ch >> 2) == half;
    R.r[1] = *(const u32x4*)(pc + C_R); R.k[1] = *(const u32x4*)(pc + C_K); R.v[1] = hv ? *(const u32x4*)(pc + C_V) : z;
    R.r[0] = hp ? *(const u32x4*)(pc - NIN + C_R) : z; R.k[0] = hp ? *(const u32x4*)(pc - NIN + C_K) : z; R.v[0] = (hp && hv) ? *(const u32x4*)(pc - NIN + C_V) : z;
    R.r[2] = hn ? *(const u32x4*)(pc + NIN + C_R) : z; R.k[2] = hn ? *(const u32x4*)(pc + NIN + C_K) : z; R.v[2] = (hn && hv) ? *(const u32x4*)(pc + NIN + C_V) : z;
    const _Float16* ua = F.UA + (((size_t)d * MT + m) * 16 + h) * 128 + 8 * ch;
    R.ua[0] = *(const u32x4*)ua; R.ua[1] = *(const u32x4*)(ua + 64);
}
__device__ __forceinline__ void scan_stage(Frame& F, const ScanRegs& R, LAS unsigned char* buf, int b, int h, int d, int half, int blk) {
    const int tok = F.tid >> 3, ch = F.tid & 7;
    const LAS f32x4* cs = (const LAS f32x4*)(F.lds + SC_CONST) + 2 * ch;
    float rc[8], rp[8], rn[8], kc[8], kp[8], kn[8];
    unpack8(R.r[1], rc); unpack8(R.r[0], rp); unpack8(R.r[2], rn); unpack8(R.k[1], kc); unpack8(R.k[0], kp); unpack8(R.k[2], kn);
    float sr[8], sk[8], kk[8], ss = 0.f;
    { const f32x4 m0 = cs[0], m1 = cs[1], n0 = cs[16], n1 = cs[17], q0 = cs[48], q1 = cs[49];
#pragma unroll
    for (int j = 0; j < 8; ++j) { const float mur = j < 4 ? m0[j & 3] : m1[j & 3], muk = j < 4 ? n0[j & 3] : n1[j & 3], kkc = j < 4 ? q0[j & 3] : q1[j & 3];
        sr[j] = rc[j] + mur * (0.5f * (rp[j] + rn[j]) - rc[j]); sk[j] = kc[j] + muk * (0.5f * (kp[j] + kn[j]) - kc[j]);
        kk[j] = sk[j] * kkc; ss += kk[j] * kk[j]; } }
    ss += __shfl_xor(ss, 1); ss += __shfl_xor(ss, 2); ss += __shfl_xor(ss, 4);
    const float inv = 1.0f / fmaxf(sqrtf(ss), 1e-12f);
    const h8 uu = __builtin_bit_cast(h8, R.ua[0]), aa = __builtin_bit_cast(h8, R.ua[1]);
    float kd[8], kka[8], bon = 0.f;
    { const f32x4 m0 = cs[64], m1 = cs[65], n0 = cs[80], n1 = cs[81];
#pragma unroll
    for (int j = 0; j < 8; ++j) { const float a = (float)aa[j], kac = j < 4 ? m0[j & 3] : m1[j & 3], rkc = j < 4 ? n0[j & 3] : n1[j & 3];
        kk[j] *= inv; kka[j] = kk[j] * a; kd[j] = sk[j] * (1.0f + (a - 1.0f) * kac); bon += sr[j] * kd[j] * rkc; } }
    bon += __shfl_xor(bon, 1); bon += __shfl_xor(bon, 2); bon += __shfl_xor(bon, 4);
    if (ch == 0 && half == 0 && blk >= 4) F.BON[((size_t)d * ML + scan_row(b, d, blk, tok)) * 16 + h] = bon;
#pragma unroll
    for (int q = 0; q < 2; ++q) { const int cg = 2 * ch + q, j0 = 4 * q;
        u32x4 o1; o1.x = pkh(kk[j0], kk[j0 + 1]); o1.y = pkh(kk[j0 + 2], kk[j0 + 3]); o1.z = pkh(kka[j0], kka[j0 + 1]); o1.w = pkh(kka[j0 + 2], kka[j0 + 3]);
        *(LAS u32x4*)(buf + SC_A1 + (tok * 16 + cg) * 16) = o1;
        u32x4 o2; o2.x = pkh(kd[j0], kd[j0 + 1]); o2.y = pkh(kd[j0 + 2], kd[j0 + 3]); o2.z = pkh(sr[j0], sr[j0 + 1]); o2.w = pkh(sr[j0 + 2], sr[j0 + 3]);
        *(LAS u32x4*)(buf + SC_A2 + (tok * 16 + cg) * 16) = o2;
        u32x2 o3; o3.x = q ? R.ua[0].z : R.ua[0].x; o3.y = q ? R.ua[0].w : R.ua[0].y;
        *(LAS u32x2*)(buf + SC_A3 + (tok * 16 + cg) * 8) = o3; }
    if ((ch >> 2) == half) {
        float vc[8], vp[8], vn[8]; unpack8(R.v[1], vc); unpack8(R.v[0], vp); unpack8(R.v[2], vn);
        const f32x4 m0 = cs[32], m1 = cs[33];
        f32x4 o0, o1;
#pragma unroll
        for (int j = 0; j < 8; ++j) { const float muv = j < 4 ? m0[j & 3] : m1[j & 3]; const float sv = vc[j] + muv * (0.5f * (vp[j] + vn[j]) - vc[j]); if (j < 4) o0[j] = sv; else o1[j - 4] = sv; }
        LAS f32x4* vd = (LAS f32x4*)(buf + SC_V + (tok * 32 + 8 * (ch & 3)) * 4); vd[0] = o0; vd[1] = o1;
    }
}
__device__ __forceinline__ void p4_scan(Frame& F, int item) {
    const int half = item & 1, d = (item >> 1) & 1, h = (item >> 2) & 15, b = item >> 6;
    const int lane = F.lane, wave = F.wave, cg = lane & 15, rl = lane >> 4, row = wave * 4 + rl;
    LAS unsigned char* lds = F.lds;
    if (F.tid < 384) { const int q = F.tid >> 6, n = F.tid & 63, c = h * 64 + n;
        const float val = q == 0 ? F.mu_shift[C_R + c] : q == 1 ? F.mu_shift[C_K + c] : q == 2 ? F.mu_shift[C_V + c] : q == 3 ? F.k_k[c] : q == 4 ? F.k_a[c] : F.r_k[c];
        ((LAS float*)(lds + SC_CONST))[F.tid] = val; }
    __syncthreads();
    ScanRegs R;
    scan_load(F, R, b, h, d, half, 0);
    scan_stage(F, R, lds, b, h, d, half, 0);
    __syncthreads();
    float S0 = 0.f, S1 = 0.f, S2 = 0.f, S3 = 0.f;
    bf16* Y = d ? F.YB : F.YF;
#pragma unroll 1
    for (int blk = 0; blk < 68; ++blk) {
        LAS unsigned char* buf = lds + (blk & 1) * SC_BUF;
        if (blk + 1 < 68) scan_load(F, R, b, h, d, half, blk + 1);
        const LAS unsigned char* p1 = buf + SC_A1 + cg * 16, * p2 = buf + SC_A2 + cg * 16, * p3 = buf + SC_A3 + cg * 8, * pv = buf + SC_V + row * 4;
        LAS float* yb = (LAS float*)(lds + SC_Y) + row;
#pragma unroll 4
        for (int i = 0; i < 64; ++i) {
            const h8 a1 = *(const LAS h8*)(p1 + i * 256), a2 = *(const LAS h8*)(p2 + i * 256);
            const h4 a3 = *(const LAS h4*)(p3 + i * 128);
            const float vv = *(const LAS float*)(pv + i * 128);
            float p = S0 * (float)a1[0]; p = __builtin_fmaf(S1, (float)a1[1], p); p = __builtin_fmaf(S2, (float)a1[2], p); p = __builtin_fmaf(S3, (float)a1[3], p);
            p += dpp_f<0xB1>(p); p += dpp_f<0x4E>(p); p += dpp_f<0x124>(p); p += dpp_f<0x128>(p);
            const float ns = -p;
            S0 = __builtin_fmaf(-(float)a3[0], S0, S0); S1 = __builtin_fmaf(-(float)a3[1], S1, S1); S2 = __builtin_fmaf(-(float)a3[2], S2, S2); S3 = __builtin_fmaf(-(float)a3[3], S3, S3);
            S0 = __builtin_fmaf(ns, (float)a1[4], S0); S1 = __builtin_fmaf(ns, (float)a1[5], S1); S2 = __builtin_fmaf(ns, (float)a1[6], S2); S3 = __builtin_fmaf(ns, (float)a1[7], S3);
            S0 = __builtin_fmaf(vv, (float)a2[0], S0); S1 = __builtin_fmaf(vv, (float)a2[1], S1); S2 = __builtin_fmaf(vv, (float)a2[2], S2); S3 = __builtin_fmaf(vv, (float)a2[3], S3);
            float y = S0 * (float)a2[4]; y = __builtin_fmaf(S1, (float)a2[5], y); y = __builtin_fmaf(S2, (float)a2[6], y); y = __builtin_fmaf(S3, (float)a2[7], y);
            y += dpp_f<0xB1>(y); y += dpp_f<0x4E>(y); y += dpp_f<0x124>(y); y += dpp_f<0x128>(y);
            if (cg == 0) yb[i * 32] = y;
        }
        __syncthreads();
        if (blk >= 4) {
            const int tok = F.tid >> 3, r4 = (F.tid & 7) * 4, m = scan_row(b, d, blk, tok);
            const f32x4 yv = *(const LAS f32x4*)(lds + SC_Y + (tok * 32 + r4) * 4);
            u32x2 o; o.x = pk2(yv.x, yv.y); o.y = pk2(yv.z, yv.w);
            *(u32x2*)(Y + (size_t)m * 1024 + h * 64 + half * 32 + r4) = o;
        }
        if (blk + 1 < 68) scan_stage(F, R, lds + ((blk + 1) & 1) * SC_BUF, b, h, d, half, blk + 1);
        __syncthreads();
    }
}

constexpr int AT_K = 0, AT_V = 16384, AT_BUF = 16384 + 64 * 272;
struct KVRegs { u32x4 k1, k2, v0, v1; };
__device__ __forceinline__ void at_load(Frame& F, KVRegs& R, int mrow0, int kvh) {
    const int tid = F.tid;
    { const int key = tid >> 2, q4 = tid & 3, a = q4 >> 1, e = q4 & 1;
      const bf16* p = F.P + (size_t)(mrow0 + key) * NIN + C_KA + kvh * 64 + a * 32 + 8 * e; R.k1 = *(const u32x4*)p; R.k2 = *(const u32x4*)(p + 16); }
    { const int kp = tid >> 3, dc = tid & 7; const bf16* p = F.P + (size_t)(mrow0 + 2 * kp) * NIN + C_VA + kvh * 64 + 8 * dc; R.v0 = *(const u32x4*)p; R.v1 = *(const u32x4*)(p + NIN); }
}
__device__ __forceinline__ void at_write(Frame& F, const KVRegs& R, LAS unsigned char* buf, int kpos0, bool rope) {
    const int tid = F.tid;
    { const int key = tid >> 2, q4 = tid & 3, a = q4 >> 1, e = q4 & 1;
      float x1[8], x2[8]; unpack8(R.k1, x1); unpack8(R.k2, x2);
      float ss = 0.f;
#pragma unroll
      for (int j = 0; j < 8; ++j) ss += x1[j] * x1[j] + x2[j] * x2[j];
      ss += __shfl_xor(ss, 1); ss += __shfl_xor(ss, 2);
      const float rr = 1.0f / sqrtf(ss * (1.0f / 64.0f) + 1e-6f);
      const int kpos = kpos0 + key, pos = a == 0 ? (kpos >> 6) : (kpos & 63);
#pragma unroll
      for (int j = 0; j < 8; ++j) { float y1 = x1[j] * rr * F.kng[a * 32 + 8 * e + j], y2 = x2[j] * rr * F.kng[a * 32 + 16 + 8 * e + j];
          if (rope) { const float c = F.ROPE[pos * 16 + 8 * e + j], s = F.ROPE[1024 + pos * 16 + 8 * e + j]; const float t1 = y1 * c - y2 * s, t2 = y2 * c + y1 * s; y1 = t1; y2 = t2; }
          x1[j] = y1; x2[j] = y2; }
      const int c1 = 4 * a + e, c2 = c1 + 2, sw = (key >> 1) & 7;
      u32x4 o; o.x = pk2(x1[0], x1[1]); o.y = pk2(x1[2], x1[3]); o.z = pk2(x1[4], x1[5]); o.w = pk2(x1[6], x1[7]); *(LAS u32x4*)(buf + AT_K + key * 128 + ((c1 ^ sw) << 4)) = o;
      o.x = pk2(x2[0], x2[1]); o.y = pk2(x2[2], x2[3]); o.z = pk2(x2[4], x2[5]); o.w = pk2(x2[6], x2[7]); *(LAS u32x4*)(buf + AT_K + key * 128 + ((c2 ^ sw) << 4)) = o; }
    { const int kp = tid >> 3, dc = tid & 7, kq = kp >> 1;
        const int pos0 = (kq >> 2) * 16 + (kq & 1) * 8 + ((kq >> 1) & 1) * 4 + (kp & 1) * 2;
#pragma unroll
        for (int w = 0; w < 4; ++w) {
            const unsigned a0 = R.v0[w], a1 = R.v1[w];
            *(LAS unsigned*)(buf + AT_V + (8 * dc + 2 * w) * 272 + pos0 * 2) = __builtin_amdgcn_perm(a1, a0, 0x05040100u);
            *(LAS unsigned*)(buf + AT_V + (8 * dc + 2 * w + 1) * 272 + pos0 * 2) = __builtin_amdgcn_perm(a1, a0, 0x07060302u); }
    }
}
__device__ __forceinline__ void p4_attn(Frame& F, int item) {
    const int n = item & 31, kvh = (item >> 5) & 3, b = item >> 7;
    const int lane = F.lane, wave = F.wave, l31 = lane & 31, hi = lane >> 5;
    const int hh = kvh * 4 + (wave >> 1), qloc = (wave & 1) * 64;
    LAS unsigned char* lds = F.lds;
    const int kfirst = n > 0 ? 0 : 1, nbnd = 3 - (n == 0 ? 1 : 0) - (n == 31 ? 1 : 0), nt = nbnd + 2;
#define TL_KIND(t) ((t) < nbnd ? kfirst + (t) : 3)
#define TL_ROW(t) ((t) < nbnd ? b * SEQ + (n - 1 + kfirst + (t)) * 128 : ML + b * CTXL + ((t) - nbnd) * 128)
#define TL_KPOS(t) ((t) < nbnd ? (n - 1 + kfirst + (t)) * 128 : 0)
    KVRegs R;
    at_load(F, R, TL_ROW(0), kvh);
    LAS unsigned char* qlds = lds + 2 * AT_BUF + wave * 8192 + lane * 16;
#pragma unroll
    for (int qb = 0; qb < 2; ++qb) {
        const int query = n * 128 + qloc + qb * 32 + l31;
        const bf16* src = F.P + (size_t)(b * SEQ + query) * NIN + C_Q + hh * 64 + 8 * hi;
        float v[4][8]; float ss = 0.f;
#pragma unroll
        for (int ks = 0; ks < 4; ++ks) { unpack8(*(const u32x4*)(src + 16 * ks), v[ks]);
#pragma unroll
            for (int j = 0; j < 8; ++j) ss += v[ks][j] * v[ks][j]; }
        ss += __shfl_xor(ss, 32);
        const float rr = (0.125f * LOG2E) / sqrtf(ss * (1.0f / 64.0f) + 1e-6f);
#pragma unroll
        for (int ks = 0; ks < 4; ++ks)
#pragma unroll
            for (int j = 0; j < 8; ++j) v[ks][j] *= rr * F.qng[16 * ks + 8 * hi + j];
#pragma unroll
        for (int a = 0; a < 2; ++a) { const int pos = a == 0 ? (query >> 6) : (query & 63);
#pragma unroll
            for (int j = 0; j < 8; ++j) { const float c = F.ROPE[pos * 16 + 8 * hi + j], s = F.ROPE[1024 + pos * 16 + 8 * hi + j];
                const float x1 = v[2 * a][j], x2 = v[2 * a + 1][j]; v[2 * a][j] = x1 * c - x2 * s; v[2 * a + 1][j] = x2 * c + x1 * s; } }
#pragma unroll
        for (int ks = 0; ks < 4; ++ks) { u32x4 o; o.x = pk2(v[ks][0], v[ks][1]); o.y = pk2(v[ks][2], v[ks][3]); o.z = pk2(v[ks][4], v[ks][5]); o.w = pk2(v[ks][6], v[ks][7]); *(LAS u32x4*)(qlds + (qb * 4 + ks) * 1024) = o; }
    }
    at_write(F, R, lds, TL_KPOS(0), true);
    __syncthreads();
    float mrun[2] = {-1e30f, -1e30f}, lrun[2] = {0.f, 0.f};
    f32x16 ot[2][2];
#pragma unroll
    for (int qb = 0; qb < 2; ++qb)
#pragma unroll
        for (int db = 0; db < 2; ++db)
#pragma unroll
            for (int r = 0; r < 16; ++r) ot[qb][db][r] = 0.f;
#pragma unroll 1
    for (int t = 0; t < nt; ++t) {
        LAS unsigned char* buf = lds + (t & 1) * AT_BUF;
        if (t + 1 < nt) at_load(F, R, TL_ROW(t + 1), kvh);
        const int kind = TL_KIND(t);
#pragma unroll 1
        for (int st = 0; st < 4; ++st) {
            bf16x8 kf[4];
#pragma unroll
            for (int ks = 0; ks < 4; ++ks) { const int key = st * 32 + l31, ch = 2 * ks + hi; kf[ks] = *(const LAS bf16x8*)(buf + AT_K + key * 128 + ((ch ^ ((key >> 1) & 7)) << 4)); }
            f32x16 sc0 = {0.f, 0.f, 0.f, 0.f, 0.f, 0.f, 0.f, 0.f, 0.f, 0.f, 0.f, 0.f, 0.f, 0.f, 0.f, 0.f}, sc1 = sc0;
            { bf16x8 qf[4];
#pragma unroll
              for (int ks = 0; ks < 4; ++ks) qf[ks] = *(const LAS bf16x8*)(qlds + ks * 1024);
#pragma unroll
              for (int ks = 0; ks < 4; ++ks) sc0 = __builtin_amdgcn_mfma_f32_32x32x16_bf16(kf[ks], qf[ks], sc0, 0, 0, 0);
#pragma unroll
              for (int ks = 0; ks < 4; ++ks) qf[ks] = *(const LAS bf16x8*)(qlds + (4 + ks) * 1024);
#pragma unroll
              for (int ks = 0; ks < 4; ++ks) sc1 = __builtin_amdgcn_mfma_f32_32x32x16_bf16(kf[ks], qf[ks], sc1, 0, 0, 0); }
            bf16x8 vf[2][2];
#pragma unroll
            for (int db = 0; db < 2; ++db)
#pragma unroll
                for (int s = 0; s < 2; ++s) vf[db][s] = *(const LAS bf16x8*)(buf + AT_V + (db * 32 + l31) * 272 + ((st * 2 + s) * 16 + hi * 8) * 2);
#define AT_SOFTMAX(SC, QB, PF) do { \
                const int qq = qloc + (QB) * 32 + l31; \
                if (kind == 0 || kind == 2) { \
                    _Pragma("unroll") for (int r = 0; r < 16; ++r) { const int kk = st * 32 + (r & 3) + 8 * (r >> 2) + 4 * hi; const bool ok = kind == 0 ? (kk >= qq) : (kk <= qq); SC[r] = ok ? SC[r] : -__builtin_inff(); } } \
                float tm = SC[0]; \
                _Pragma("unroll") for (int r = 1; r < 16; ++r) tm = fmaxf(tm, SC[r]); \
                tm = fmaxf(tm, __shfl_xor(tm, 32)); \
                if (__any(tm > mrun[QB] + 6.0f)) { \
                    const float mn = fmaxf(mrun[QB], tm), al = __builtin_amdgcn_exp2f(mrun[QB] - mn); \
                    mrun[QB] = mn; lrun[QB] *= al; \
                    _Pragma("unroll") for (int db = 0; db < 2; ++db) _Pragma("unroll") for (int r = 0; r < 16; ++r) ot[QB][db][r] *= al; } \
                float ps = 0.f; const float mm = mrun[QB]; \
                _Pragma("unroll") for (int r = 0; r < 16; ++r) { SC[r] = __builtin_amdgcn_exp2f(SC[r] - mm); ps += SC[r]; } \
                lrun[QB] += ps; \
                _Pragma("unroll") for (int s = 0; s < 2; ++s) { u32x4 o; o.x = pk2(SC[8 * s], SC[8 * s + 1]); o.y = pk2(SC[8 * s + 2], SC[8 * s + 3]); o.z = pk2(SC[8 * s + 4], SC[8 * s + 5]); o.w = pk2(SC[8 * s + 6], SC[8 * s + 7]); PF[s] = __builtin_bit_cast(bf16x8, o); } \
            } while (0)
            bf16x8 pf0[2], pf1[2];
            __builtin_amdgcn_sched_barrier(0);
            AT_SOFTMAX(sc0, 0, pf0);
            __builtin_amdgcn_sched_barrier(0);
            AT_SOFTMAX(sc1, 1, pf1);
            __builtin_amdgcn_sched_barrier(0);
#undef AT_SOFTMAX
#pragma unroll
            for (int db = 0; db < 2; ++db)
#pragma unroll
                for (int s = 0; s < 2; ++s) { ot[0][db] = __builtin_amdgcn_mfma_f32_32x32x16_bf16(vf[db][s], pf0[s], ot[0][db], 0, 0, 0); ot[1][db] = __builtin_amdgcn_mfma_f32_32x32x16_bf16(vf[db][s], pf1[s], ot[1][db], 0, 0, 0); }
        }
        if (t + 1 < nt) at_write(F, R, lds + ((t + 1) & 1) * AT_BUF, TL_KPOS(t + 1), (t + 1) < nbnd);
        __syncthreads();
    }
    const float sk2 = F.sink[hh] * LOG2E;
#pragma unroll
    for (int qb = 0; qb < 2; ++qb) {
        float l = lrun[qb]; l += __shfl_xor(l, 32); l += __builtin_amdgcn_exp2f(sk2 - mrun[qb]);
        const float il = 1.0f / l;
        const size_t m = (size_t)b * SEQ + n * 128 + qloc + qb * 32 + l31;
#pragma unroll
        for (int db = 0; db < 2; ++db)
#pragma unroll
            for (int rg = 0; rg < 4; ++rg) { const int d0 = db * 32 + 8 * rg + 4 * hi;
                const u32x2 za = *(const u32x2*)(F.P + m * NIN + C_ZA + hh * 64 + d0);
                const float z0 = bflo(za.x), z1 = bfhi(za.x), z2 = bflo(za.y), z3 = bfhi(za.y);
                u32x2 o; o.x = pk2(ot[qb][db][4 * rg] * il * siluf_(z0), ot[qb][db][4 * rg + 1] * il * siluf_(z1)); o.y = pk2(ot[qb][db][4 * rg + 2] * il * siluf_(z2), ot[qb][db][4 * rg + 3] * il * siluf_(z3));
                *(u32x2*)(F.MIX + m * DM + 1024 + hh * 64 + d0) = o; }
    }
#undef TL_KIND
#undef TL_ROW
#undef TL_KPOS
}

__device__ __forceinline__ void p5_mix(Frame& F) {
    const int total = F.G * NWAVES * 64;
    for (int idx = F.bid * NWAVES * 64 + F.tid; idx < ML * 16 * 8; idx += total) {
        const int ch = idx & 7, h = (idx >> 3) & 15, m = idx >> 7, c0 = h * 64 + 8 * ch, t = m & (SEQ - 1);
        float yf[8], yb[8], y[8];
        unpack8(*(const u32x4*)(F.YF + (size_t)m * 1024 + c0), yf); unpack8(*(const u32x4*)(F.YB + (size_t)m * 1024 + c0), yb);
        float s = 0.f;
#pragma unroll
        for (int j = 0; j < 8; ++j) { y[j] = yf[j] + yb[j]; s += y[j]; }
        s += __shfl_xor(s, 1); s += __shfl_xor(s, 2); s += __shfl_xor(s, 4);
        const float mu = s * (1.0f / 64.0f); float q = 0.f;
#pragma unroll
        for (int j = 0; j < 8; ++j) { y[j] -= mu; q += y[j] * y[j]; }
        q += __shfl_xor(q, 1); q += __shfl_xor(q, 2); q += __shfl_xor(q, 4);
        const float rs = 1.0f / sqrtf(q * (1.0f / 64.0f) + 64e-5f);
        const float bonus = F.BON[(size_t)m * 16 + h] + F.BON[(size_t)(ML + m) * 16 + h];
        const bf16* pc = F.P + (size_t)m * NIN;
        const u32x4 z = {0u, 0u, 0u, 0u};
        float vc[8], vp[8], vn[8], zr[8];
        unpack8(*(const u32x4*)(pc + C_V + c0), vc); unpack8(t > 0 ? *(const u32x4*)(pc - NIN + C_V + c0) : z, vp); unpack8(t < SEQ - 1 ? *(const u32x4*)(pc + NIN + C_V + c0) : z, vn);
        unpack8(*(const u32x4*)(pc + C_ZR + c0), zr);
        float o[8];
#pragma unroll
        for (int j = 0; j < 8; ++j) { const float sv = vc[j] + F.mu_shift[C_V + c0 + j] * (0.5f * (vp[j] + vn[j]) - vc[j]);
            const float yn = y[j] * rs * F.ln_g[c0 + j] + F.ln_b[c0 + j];
            o[j] = (yn + bonus * sv) * siluf_(zr[j]); }
        u32x4 w; w.x = pk2(o[0], o[1]); w.y = pk2(o[2], o[3]); w.z = pk2(o[4], o[5]); w.w = pk2(o[6], o[7]);
        *(u32x4*)(F.MIX + (size_t)m * DM + c0) = w;
    }
}

struct Args { const float* in[22]; float* out; unsigned char* ws; int ph_lo, ph_hi; };
__global__ void __launch_bounds__(NWAVES * 64, 2) hymba_fwd(Args args) {
    extern __shared__ __attribute__((aligned(16))) unsigned char lds_raw[];
    Frame F;
    F.lds = (LAS unsigned char*)lds_raw;
    F.tid = threadIdx.x; F.G = gridDim.x;
    unsigned char* ws = args.ws;
    volatile LAS unsigned* MISC = (volatile LAS unsigned*)(F.lds + MISC_OFF);
    for (int u = F.tid; u < 64; u += NWAVES * 64) MISC[u] = 0u;
    __syncthreads();
    const int lo = args.ph_lo, hi = args.ph_hi;
    XcdBarrier bar; bar.bar = (unsigned*)(ws + WS_CTL) + CW_BAR; bar.x = 0; bar.st = nullptr;
    if (hi - lo > 1) bar = xcd_barrier_post((unsigned*)(ws + WS_CTL) + CW_BAR, MISC + 8);
#define IN(k) (lo <= (k) && (k) < hi)
#define SEAM(k) do { if (IN(k) && IN((k) + 1)) xcd_barrier(bar); } while (0)
    if (IN(0)) { fresh(F); p0_prologue(F); } SEAM(0);
    if (IN(1)) { fresh(F); p1_modulate(F); } SEAM(1);
    if (IN(2)) {
        fresh(F);
        pg8::Gemm g{F.XN, F.WIN, MT, NIN, DM}; Sched1 S; S.init(F.G, F.bid);
        pg8::EpiBf16<0> E{F.P, NIN, nullptr, 0, 0, 1.f};
        pg8::gemm_phase<pg8::EpiBf16<0>, Sched1, true, true>(F.lds, g, S, E);
    } SEAM(2);
    if (IN(3)) { fresh(F); p3_lora(F); } SEAM(3);
    if (IN(4)) {
        fresh(F);
        for (int it = F.bid; it < 256; it += F.G) { p4_scan(F, it); __syncthreads(); }
        fresh(F);
        for (int it = F.bid; it < 512; it += F.G) { p4_attn(F, it); __syncthreads(); }
    } SEAM(4);
    if (IN(5)) { fresh(F); p5_mix(F); } SEAM(5);
    if (IN(6)) {
        fresh(F);
        pg8::Gemm g{F.MIX, F.WOUT, ML, DM, DM}; pg8::StaticOrder S; S.init(ML, DM, F.G, F.bid);
        pg8::EpiGate E{F.x, F.out, F.MOD + 4096, DM};
        pg8::gemm_phase<pg8::EpiGate, pg8::StaticOrder, true, true>(F.lds, g, S, E);
    }
#undef IN
#undef SEAM
}

extern "C" void kernel_launch(void* const* d_in, const int* in_sizes, int n_in, void* d_out, int out_size, void* d_ws, size_t ws_size, hipStream_t stream) {
    static int grid = 0;
    if (grid == 0) {
        if (n_in != 22 || out_size != ML * DM || ws_size < WS_END) { fprintf(stderr, "kernel_launch: unexpected problem shape (n_in %d, out %d, ws %zu)\n", n_in, out_size, ws_size); grid = -1; return; }
        int dev = 0, cus = 0;
        if (hipGetDevice(&dev) != hipSuccess || hipDeviceGetAttribute(&cus, hipDeviceAttributeMultiprocessorCount, dev) != hipSuccess) { grid = -1; return; }
        if (hipFuncSetAttribute((const void*)hymba_fwd, hipFuncAttributeMaxDynamicSharedMemorySize, LDS_BYTES) != hipSuccess) { fprintf(stderr, "kernel_launch: hipFuncSetAttribute failed\n"); grid = -1; return; }
        (void)hipGetLastError();
        grid = cus;
    }
    if (grid < 0) return;
    (void)hipMemsetAsync((char*)d_ws + WS_CTL, 0, CTL_ZERO_BYTES, stream);
    Args a{};
    for (int i = 0; i < 22; ++i) a.in[i] = (const float*)d_in[i];
    a.out = (float*)d_out; a.ws = (unsigned char*)d_ws;
    if (MK_N_LAUNCHES == 1) { a.ph_lo = 0; a.ph_hi = N_PHASES; hipLaunchKernelGGL(hymba_fwd, dim3(grid), dim3(NWAVES * 64), LDS_BYTES, stream, a); }
    else for (int p = 0; p < N_PHASES; ++p) { a.ph_lo = p; a.ph_hi = p + 1; hipLaunchKernelGGL(hymba_fwd, dim3(grid), dim3(NWAVES * 64), LDS_BYTES, stream, a); }
}
```

```cpp
#include <hip/hip_runtime.h>
#include <cstdio>
#include <cstdint>
namespace pg8 {
#define PG8_LAS __attribute__((address_space(3)))
typedef unsigned short bf16_t;
typedef short bf16x8 __attribute__((ext_vector_type(8)));
typedef float f32x4 __attribute__((ext_vector_type(4)));
typedef unsigned u32x4 __attribute__((ext_vector_type(4)));
constexpr int BM = 256, BK = 64, HALF = 128, HTB = HALF * BK * 2  , STAGE_BYTES = 8 * HTB, NXCD = 8, WGM = 8;

__host__ __device__ __forceinline__ int lds_byte(int r, int c) { const int st = (r >> 4) * 2 + (c >> 5), rr = r & 15, cc = c & 31, ob = rr * 64 + cc * 2; return st * 1024 + (ob ^ (((ob >> 9) & 1) << 5)); }
__host__ __device__ __forceinline__ void stage_rc(int b, int& R, int& C) { const int st = b / 1024, sb = b % 1024, swz = sb ^ (((sb >> 9) & 1) << 5); R = (st >> 1) * 16 + swz / 64; C = (st & 1) * 32 + (swz % 64) / 2; }
__host__ __device__ __forceinline__ int perm32(int rho) { const int n = rho >> 4, i = rho & 15; return 8 * (i >> 2) + 4 * n + (i & 3); }

struct Unit { int pm, pn; };
struct Gemm { const bf16_t* A; const bf16_t* Bt; int M, N, K; };

struct StaticOrder {
    int nM, nN, nwg, G, c;
    __host__ __device__ void init(int M, int N, int G_, int c_) { nM = M / BM; nN = N / BM; nwg = nM * nN; G = G_; c = c_; }
    __host__ __device__ bool next(int i, Unit& u) const {
        const long L = (long)i * G + c; if (L >= nwg) return false;
        int wgid = (int)L; { const int q = nwg / NXCD, r = nwg % NXCD, xcd = wgid % NXCD, off = wgid / NXCD; wgid = (xcd < r ? xcd * (q + 1) : r * (q + 1) + (xcd - r) * q) + off; }
        const int nig = WGM * nN, gid = wgid / nig, fm = gid * WGM, gsz = (nM - fm) < WGM ? (nM - fm) : WGM;
        u.pm = fm + ((wgid % nig) % gsz); u.pn = (wgid % nig) / gsz; return true;
    }
    __device__ __forceinline__ void a_ready(const Unit&) const {}
    __device__ __forceinline__ void done(const Unit&) const {}
};

__device__ __forceinline__ unsigned cvt_pk_bf16(float lo, float hi) { unsigned r; asm volatile("v_cvt_pk_bf16_f32 %0, %1, %2" : "=v"(r) : "v"(lo), "v"(hi)); return r; }
typedef float f32x2 __attribute__((ext_vector_type(2)));
__device__ __forceinline__ f32x2 gelu_pk(f32x2 v) {
    const f32x2 av = __builtin_elementwise_abs(v), d = av * 0.2316418882f + 1.0f;
    f32x2 t; t.x = __builtin_amdgcn_rcpf(d.x); t.y = __builtin_amdgcn_rcpf(d.y);
    f32x2 q = t * 0.5307027145f + (-0.7265760135f); q = q * t + 0.7107068705f; q = q * t + (-0.142248368f); q = q * t + 0.127414796f; q = q * t;
    const f32x2 s = (v * v) * (-0.72134752044f);
    f32x2 e; e.x = __builtin_amdgcn_exp2f(s.x); e.y = __builtin_amdgcn_exp2f(s.y);
    const f32x2 m = v * (q * e), r = v - m;
    f32x2 o; o.x = v.x < 0.f ? m.x : r.x; o.y = v.y < 0.f ? m.y : r.y; return o;
}

template <int ACT  > struct EpiBf16 {
    static constexpr bool PERM = true, AFTER_DRAIN = false; static_assert(ACT == 0 || ACT == 1, "EpiBf16: ACT is 0 (none) or 1 (gelu_pk)");
    bf16_t* O; int ldc; const float* bias; int split_cols; size_t split_stride; float scale0;
    __device__ __forceinline__ void operator()(const f32x4 (&acc)[2][2][4][2], const Unit& u, int wr, int wc, int fr, int fq) const {
        const int row0 = u.pm * BM + wr * 64 + fr; int colt = u.pn * BM; bf16_t* base = O;
        float sc = 1.f; if (split_cols) { const int t = colt / split_cols; base += (size_t)t * split_stride; colt -= t * split_cols; if (t == 0) sc = scale0; }
        const int col0 = colt + wc * 32 + 8 * fq, bcol0 = u.pn * BM + wc * 32 + 8 * fq;
        f32x4 bv[2][2];
#pragma unroll
        for (int bj = 0; bj < 2; ++bj)
#pragma unroll
            for (int n = 0; n < 2; ++n) bv[bj][n] = bias ? *(const f32x4*)(bias + bcol0 + bj * HALF + 4 * n) : (f32x4){0.f, 0.f, 0.f, 0.f};
#pragma unroll
        for (int ai = 0; ai < 2; ++ai)
#pragma unroll
            for (int m = 0; m < 4; ++m) { bf16_t* rowp = base + (size_t)(row0 + ai * HALF + m * 16) * ldc + col0;
#pragma unroll
                for (int bj = 0; bj < 2; ++bj) { f32x4 v0 = acc[ai][bj][m][0] + bv[bj][0], v1 = acc[ai][bj][m][1] + bv[bj][1];
                    if (ACT == 1) { f32x2 a = gelu_pk((f32x2){v0[0], v0[1]}), b = gelu_pk((f32x2){v0[2], v0[3]}), c = gelu_pk((f32x2){v1[0], v1[1]}), d = gelu_pk((f32x2){v1[2], v1[3]});
                        v0 = (f32x4){a.x, a.y, b.x, b.y}; v1 = (f32x4){c.x, c.y, d.x, d.y}; }
                    v0 = v0 * sc; v1 = v1 * sc; u32x4 w; w.x = cvt_pk_bf16(v0[0], v0[1]); w.y = cvt_pk_bf16(v0[2], v0[3]); w.z = cvt_pk_bf16(v1[0], v1[1]); w.w = cvt_pk_bf16(v1[2], v1[3]);
                    *(u32x4*)(rowp + bj * HALF) = w; } }
    }
};


struct EpiGate {
    static constexpr bool PERM = false, AFTER_DRAIN = false;
    const float* x; float* out; const float* gate; int ldc;
    __device__ __forceinline__ void operator()(const f32x4 (&acc)[2][2][4][2], const Unit& u, int wr, int wc, int fr, int fq) const {
        const int col0 = u.pn * BM + wc * 32 + 4 * fq;
        const int b = (u.pm * BM) >> 12;
        f32x4 gv[2][2];
#pragma unroll
        for (int bj = 0; bj < 2; ++bj)
#pragma unroll
            for (int n = 0; n < 2; ++n) gv[bj][n] = *(const f32x4*)(gate + (size_t)b * 6144 + col0 + bj * HALF + n * 16);
#pragma unroll
        for (int ai = 0; ai < 2; ++ai)
#pragma unroll
            for (int m = 0; m < 4; ++m) { const size_t off = (size_t)(u.pm * BM + ai * HALF + wr * 64 + m * 16 + fr) * ldc + col0;
#pragma unroll
                for (int bj = 0; bj < 2; ++bj)
#pragma unroll
                    for (int n = 0; n < 2; ++n) { const f32x4 xv = *(const f32x4*)(x + off + bj * HALF + n * 16);
                        *(f32x4*)(out + off + bj * HALF + n * 16) = xv + gv[bj][n] * acc[ai][bj][m][n]; }
                if (m & 1) asm volatile("" ::: "memory"); }
    }
};
template <class Epi, class Sched, bool ALIGN_EPI = false, bool SP2 = false>
__device__ __forceinline__ void gemm_phase(PG8_LAS unsigned char* lds, const Gemm g, const Sched& S, const Epi& E) {
    const int tid = threadIdx.x, wid = __builtin_amdgcn_readfirstlane(tid >> 6), lane = tid & 63, wr = wid >> 2, wc = wid & 3, fr = lane & 15, fq = lane >> 4;
    const int K = g.K, nt = K / BK;
    unsigned voffA[2], voffB[2];
#pragma unroll
    for (int i = 0; i < 2; ++i) { int R, C; stage_rc(tid * 16 + i * 8192, R, C); const int Rb = Epi::PERM ? ((R & ~31) + perm32(R & 31)) : R;
        voffA[i] = (unsigned)(R * K + C) * 2u; voffB[i] = (unsigned)(Rb * K + C) * 2u; }
    const size_t kstep = (size_t)(BK * 2);
    const size_t hstep = (size_t)HALF * K * 2;
    const size_t tstep = 2 * hstep;
    const unsigned ldsw = (unsigned)wid * 1024u;
    const int aoff = lds_byte(wr * 64 + fr, fq * 8), boff = lds_byte(wc * 32 + fr, fq * 8);
#define PG8_SA(b, h) (((b) * 2 + (h)) * HTB)
#define PG8_SB(b, h) ((4 + (b) * 2 + (h)) * HTB)
#define PG8_STAGE(bufoff, gbase, voff) do { _Pragma("unroll") for (int _i = 0; _i < 2; ++_i) \
        __builtin_amdgcn_global_load_lds((const unsigned*)((const char*)(gbase) + (voff)[_i]), (PG8_LAS unsigned*)(lds + (bufoff) + ldsw + _i * 8192), 16, 0, 0); } while (0)
#define PG8_LDA(dst, b, h) do { _Pragma("unroll") for (int m = 0; m < 4; ++m) _Pragma("unroll") for (int k = 0; k < 2; ++k) dst[m][k] = *(const PG8_LAS bf16x8*)(lds + PG8_SA(b, h) + aoff + m * 2048 + k * 1024); } while (0)
#define PG8_LDB(dst, b, h) do { _Pragma("unroll") for (int n = 0; n < 2; ++n) _Pragma("unroll") for (int k = 0; k < 2; ++k) dst[n][k] = *(const PG8_LAS bf16x8*)(lds + PG8_SB(b, h) + boff + n * 2048 + k * 1024); } while (0)
#define PG8_MMA(ai, bj, At, Bt) do { __builtin_amdgcn_s_setprio(1); _Pragma("unroll") for (int m = 0; m < 4; ++m) _Pragma("unroll") for (int n = 0; n < 2; ++n) _Pragma("unroll") for (int k = 0; k < 2; ++k) \
        acc[ai][bj][m][n] = __builtin_amdgcn_mfma_f32_16x16x32_bf16(Bt[n][k], At[m][k], acc[ai][bj][m][n], 0, 0, 0); __builtin_amdgcn_s_setprio(0); } while (0)
#define PG8_WAIT_V(n) asm volatile("s_waitcnt vmcnt(" #n ")" ::: "memory")
#define PG8_WAIT_L(n) asm volatile("s_waitcnt lgkmcnt(" #n ")" ::: "memory")
#define PG8_BAR __builtin_amdgcn_s_barrier()
#define PG8_SCHED __builtin_amdgcn_sched_barrier(0)
    Unit cur, nxt; int ui = 0;
    if (!S.next(0, cur)) return;
    f32x4 acc[2][2][4][2];
#pragma unroll
    for (int a = 0; a < 2; ++a)
#pragma unroll
        for (int b = 0; b < 2; ++b)
#pragma unroll
            for (int m = 0; m < 4; ++m)
#pragma unroll
                for (int n = 0; n < 2; ++n) acc[a][b][m][n] = (f32x4){0.f, 0.f, 0.f, 0.f};
    bf16x8 At[4][2], B0[2][2], B1[2][2];
    const char* cA = (const char*)g.A + (size_t)cur.pm * tstep; const char* cB = (const char*)g.Bt + (size_t)cur.pn * tstep;
    S.a_ready(cur);
    if constexpr (SP2) {
        PG8_STAGE(PG8_SB(0, 0), cB, voffB); PG8_STAGE(PG8_SB(0, 1), cB + hstep, voffB); PG8_STAGE(PG8_SA(0, 0), cA, voffA); PG8_STAGE(PG8_SA(0, 1), cA + hstep, voffA);
        if (wr == 1) PG8_BAR;
        PG8_WAIT_V(2); PG8_BAR;
        PG8_STAGE(PG8_SB(1, 0), cB + kstep, voffB); PG8_STAGE(PG8_SA(1, 0), cA + kstep, voffA); PG8_STAGE(PG8_SB(1, 1), cB + hstep + kstep, voffB);
        PG8_WAIT_V(6); PG8_BAR;
    } else {
        PG8_STAGE(PG8_SB(0, 0), cB, voffB); PG8_STAGE(PG8_SA(0, 0), cA, voffA); PG8_STAGE(PG8_SB(0, 1), cB + hstep, voffB); PG8_STAGE(PG8_SA(0, 1), cA + hstep, voffA);
        if (wr == 1) PG8_BAR;
        PG8_WAIT_V(4); PG8_BAR;
        PG8_STAGE(PG8_SB(1, 0), cB + kstep, voffB); PG8_STAGE(PG8_SA(1, 0), cA + kstep, voffA); PG8_STAGE(PG8_SB(1, 1), cB + hstep + kstep, voffB);
        PG8_WAIT_V(6); PG8_BAR;
    }
    for (;;) {
        const bool has_next = S.next(ui + 1, nxt);
        const char* nA = has_next ? (const char*)g.A + (size_t)nxt.pm * tstep : cA; const char* nB = has_next ? (const char*)g.Bt + (size_t)nxt.pn * tstep : cB;
        for (int t = 0; t < nt; t += 2) {
            const bool last = (t == nt - 2);
            const char* a1 = cA + (size_t)(t + 1) * kstep;
            const char* a2 = last ? nA : cA + (size_t)(t + 2) * kstep; const char* b2 = last ? nB : cB + (size_t)(t + 2) * kstep;
            const char* a3 = a2 + kstep; const char* b3 = b2 + kstep;
            if (last && has_next) S.a_ready(nxt);
            if constexpr (SP2) {
            PG8_LDB(B0, 0, 0); PG8_LDB(B1, 0, 1); PG8_SCHED; PG8_LDA(At, 0, 0); PG8_STAGE(PG8_SA(1, 1), a1 + hstep, voffA);
            PG8_WAIT_V(8); PG8_WAIT_L(0); PG8_BAR; PG8_MMA(0, 0, At, B0); PG8_MMA(0, 1, At, B1); PG8_BAR; PG8_SCHED;
            PG8_LDA(At, 0, 1); PG8_STAGE(PG8_SB(0, 0), b2, voffB); PG8_STAGE(PG8_SB(0, 1), b2 + hstep, voffB); PG8_STAGE(PG8_SA(0, 0), a2, voffA);
            PG8_WAIT_V(8); PG8_WAIT_L(0); PG8_BAR; PG8_MMA(1, 0, At, B0); PG8_MMA(1, 1, At, B1); PG8_BAR; PG8_SCHED;
            PG8_LDB(B0, 1, 0); PG8_LDB(B1, 1, 1); PG8_SCHED; PG8_LDA(At, 1, 0); PG8_STAGE(PG8_SA(0, 1), a2 + hstep, voffA);
            PG8_WAIT_V(8); PG8_WAIT_L(0); PG8_BAR; PG8_MMA(0, 0, At, B0); PG8_MMA(0, 1, At, B1); PG8_BAR; PG8_SCHED;
            PG8_LDA(At, 1, 1); PG8_STAGE(PG8_SB(1, 0), b3, voffB); PG8_STAGE(PG8_SB(1, 1), b3 + hstep, voffB); PG8_STAGE(PG8_SA(1, 0), a3, voffA);
            PG8_WAIT_V(8); PG8_WAIT_L(0); PG8_BAR; PG8_MMA(1, 0, At, B0); PG8_MMA(1, 1, At, B1); PG8_BAR; PG8_SCHED;
            } else {
            PG8_LDB(B0, 0, 0); PG8_SCHED; PG8_LDA(At, 0, 0); PG8_STAGE(PG8_SA(1, 1), a1 + hstep, voffA);
            PG8_WAIT_L(8); PG8_BAR; PG8_WAIT_L(0); PG8_MMA(0, 0, At, B0); PG8_BAR; PG8_SCHED;
            PG8_LDB(B1, 0, 1); PG8_STAGE(PG8_SB(0, 0), b2, voffB);
            PG8_BAR; PG8_WAIT_L(0); PG8_MMA(0, 1, At, B1); PG8_BAR;
            PG8_LDA(At, 0, 1); PG8_STAGE(PG8_SA(0, 0), a2, voffA);
            PG8_BAR; PG8_WAIT_L(0); PG8_MMA(1, 0, At, B0); PG8_BAR; PG8_SCHED;
            PG8_STAGE(PG8_SB(0, 1), b2 + hstep, voffB);
            PG8_WAIT_V(6); PG8_BAR; PG8_MMA(1, 1, At, B1); PG8_BAR;
            PG8_LDB(B0, 1, 0); PG8_SCHED; PG8_LDA(At, 1, 0); PG8_STAGE(PG8_SA(0, 1), a2 + hstep, voffA);
            PG8_WAIT_L(8); PG8_BAR; PG8_WAIT_L(0); PG8_MMA(0, 0, At, B0); PG8_BAR; PG8_SCHED;
            PG8_LDB(B1, 1, 1); PG8_STAGE(PG8_SB(1, 0), b3, voffB);
            PG8_BAR; PG8_WAIT_L(0); PG8_MMA(0, 1, At, B1); PG8_BAR;
            PG8_LDA(At, 1, 1); PG8_STAGE(PG8_SA(1, 0), a3, voffA);
            PG8_BAR; PG8_WAIT_L(0); PG8_MMA(1, 0, At, B0); PG8_BAR; PG8_SCHED;
            PG8_STAGE(PG8_SB(1, 1), b3 + hstep, voffB);
            PG8_WAIT_V(6); PG8_BAR; PG8_MMA(1, 1, At, B1); PG8_BAR;
            }
        }
        if constexpr (ALIGN_EPI) { if (wr == 0) PG8_BAR; }
        if constexpr (!Epi::AFTER_DRAIN) { E(acc, cur, wr, wc, fr, fq); S.done(cur); }
        if (!has_next) break;
#pragma unroll
        for (int a = 0; a < 2; ++a)
#pragma unroll
            for (int b = 0; b < 2; ++b)
#pragma unroll
                for (int m = 0; m < 4; ++m)
#pragma unroll
                    for (int n = 0; n < 2; ++n) acc[a][b][m][n] = (f32x4){0.f, 0.f, 0.f, 0.f};
        cur = nxt; cA = nA; cB = nB; ++ui;
        if constexpr (ALIGN_EPI) { if (wr == 1) PG8_BAR; }
    }
    PG8_WAIT_V(0);
    if constexpr (!ALIGN_EPI) { if (wr == 0) PG8_BAR; }
    PG8_BAR;
    if constexpr (Epi::AFTER_DRAIN) { E.fused(acc, cur, wr, wc, fr, fq, lds, wid, lane); S.done(cur); }
#undef PG8_SA
#undef PG8_SB
#undef PG8_STAGE
#undef PG8_LDA
#undef PG8_LDB
#undef PG8_MMA
#undef PG8_WAIT_V
#undef PG8_WAIT_L
#undef PG8_BAR
#undef PG8_SCHED
}
}

#ifndef MK_N_LAUNCHES
#define MK_N_LAUNCHES 1
#endif
constexpr int N_PHASES = 7;
constexpr int NWAVES = 8;
constexpr int DM = 2048, NB = 4, SEQ = 4096, CTXL = 256;
constexpr int ML = NB * SEQ, MC = NB * CTXL, MT = ML + MC;
constexpr int NIN = 6912;
constexpr int C_R = 0, C_K = 1024, C_V = 2048, C_LW = 3072, C_LA = 3200, C_ZR = 3328, C_Q = 4352, C_KA = 5376, C_VA = 5632, C_ZA = 5888;
constexpr float LOG2E = 1.4426950408889634f;

constexpr size_t MiB = 1u << 20;
constexpr size_t WS_CTL = 0, CTL_ZERO_BYTES = 64 * 1024;
constexpr size_t WS_MOD = 1 * MiB;
constexpr size_t WS_ROPE = 1 * MiB + 128 * 1024;
constexpr size_t WS_W2T = 1 * MiB + 256 * 1024;
constexpr size_t WS_A2T = 1 * MiB + 512 * 1024;
constexpr size_t WS_WOUT = 2 * MiB;
constexpr size_t WS_P = 10 * MiB;
constexpr size_t WS_XN = 240 * MiB;
constexpr size_t WS_WIN = 308 * MiB;
constexpr size_t WS_UA = 240 * MiB;
constexpr size_t WS_YF = 376 * MiB, WS_YB = 408 * MiB;
constexpr size_t WS_BON = 440 * MiB;
constexpr size_t WS_MIX = 442 * MiB;
constexpr size_t WS_END = 506 * MiB;
static_assert(WS_P + (size_t)MT * NIN * 2 <= WS_XN && WS_XN + (size_t)MT * DM * 2 <= WS_WIN && WS_WIN + (size_t)NIN * DM * 2 <= WS_YF && WS_UA + (size_t)2 * MT * 4096 <= WS_YF, "ws map");

constexpr int CW_BAR = 1024;
constexpr int LDS_BYTES = 147456;
constexpr int MISC_OFF = LDS_BYTES - 256;

#define GAS __attribute__((address_space(1)))
#define LAS __attribute__((address_space(3)))
typedef unsigned short bf16;
typedef float f32x4 __attribute__((ext_vector_type(4)));
typedef float f32x16 __attribute__((ext_vector_type(16)));
typedef short bf16x8 __attribute__((ext_vector_type(8)));
typedef unsigned u32x4 __attribute__((ext_vector_type(4)));
typedef unsigned u32x2 __attribute__((ext_vector_type(2)));
typedef _Float16 h8 __attribute__((ext_vector_type(8)));
typedef _Float16 h4 __attribute__((ext_vector_type(4)));
typedef _Float16 h2 __attribute__((ext_vector_type(2)));
typedef GAS unsigned gu32;

__device__ __forceinline__ unsigned f2bf(float f) { unsigned u = __builtin_bit_cast(unsigned, f); return (u + 0x7fffu + ((u >> 16) & 1u)) >> 16; }
typedef float f32x2_t __attribute__((ext_vector_type(2))); typedef __bf16 bf16x2_t __attribute__((ext_vector_type(2)));
__device__ __forceinline__ unsigned pk2(float lo, float hi) { f32x2_t v = {lo, hi}; bf16x2_t b = __builtin_convertvector(v, bf16x2_t); return __builtin_bit_cast(unsigned, b); }
__device__ __forceinline__ float bflo(unsigned w) { return __builtin_bit_cast(float, w << 16); }
__device__ __forceinline__ float bfhi(unsigned w) { return __builtin_bit_cast(float, w & 0xffff0000u); }
__device__ __forceinline__ void unpack8(const u32x4 r, float* v) { v[0] = bflo(r.x); v[1] = bfhi(r.x); v[2] = bflo(r.y); v[3] = bfhi(r.y); v[4] = bflo(r.z); v[5] = bfhi(r.z); v[6] = bflo(r.w); v[7] = bfhi(r.w); }
__device__ __forceinline__ unsigned pkh(float a, float b) { h2 v = {(_Float16)a, (_Float16)b}; return __builtin_bit_cast(unsigned, v); }
__device__ __forceinline__ float wave_sum(float v) {
#pragma unroll
    for (int o = 1; o < 64; o <<= 1) v += __shfl_xor(v, o);
    return v;
}
__device__ __forceinline__ float fast_exp(float x) { return __builtin_amdgcn_exp2f(x * LOG2E); }
__device__ __forceinline__ float sigmoidf_(float x) { return __builtin_amdgcn_rcpf(1.0f + fast_exp(-x)); }
__device__ __forceinline__ float siluf_(float x) { return x * sigmoidf_(x); }
template <int CTRL> __device__ __forceinline__ float dpp_f(float x) { return __builtin_bit_cast(float, __builtin_amdgcn_update_dpp(0, __builtin_bit_cast(int, x), CTRL, 0xF, 0xF, false)); }

#define XB_TMO      128
#define XB_XCNT(j)  (256  + 64 * (j))
#define XB_XSUB(j)  (1280 + 64 * (j))
#define XB_XGEN(j)  (2304 + 64 * (j))
#define XB_TOP      3328
#define XB_TOPGEN   3392
#define XCD_BAR_WORDS 3456
#define XB_SPIN_CAP (1u << 18)
__device__ __forceinline__ unsigned xb_ld(unsigned* p)              { return __hip_atomic_load(p, __ATOMIC_RELAXED, __HIP_MEMORY_SCOPE_AGENT); }
__device__ __forceinline__ unsigned xb_add(unsigned* p, unsigned v) { return __hip_atomic_fetch_add(p, v, __ATOMIC_RELAXED, __HIP_MEMORY_SCOPE_AGENT); }
__device__ __forceinline__ unsigned xb_xcc_id() { return (unsigned)__builtin_amdgcn_s_getreg((3 << 11) | 20) & 0xFu; }
#define XB_SPIN(cond, bar) do { unsigned _sp = 0; while (cond) { __builtin_amdgcn_s_sleep(1); \
    if ((++_sp & 255u) == 0u) { if (xb_ld(&(bar)[XB_TMO])) break; if (_sp > XB_SPIN_CAP) { atomicAdd(&(bar)[XB_TMO], 1u); break; } } } } while (0)
struct XcdBarrier { unsigned* bar; unsigned x; volatile LAS unsigned* st; };
__device__ __forceinline__ XcdBarrier xcd_barrier_post(unsigned* bar, volatile LAS unsigned* st) {
    XcdBarrier b; b.bar = bar; b.x = xb_xcc_id(); b.st = st;
    if (threadIdx.x == 0) (void)xb_add(&bar[XB_XCNT(b.x)], 1u);
    return b;
}
__device__ __forceinline__ void xcd_barrier_complete(unsigned* bar, unsigned x, unsigned& nloc, unsigned& nx) {
    const unsigned G = gridDim.x * gridDim.y * gridDim.z;
    unsigned sum, cnt, mine, sp = 0u;
    for (;;) {
        sum = 0u; cnt = 0u; mine = 0u;
#pragma unroll
        for (unsigned j = 0; j < 16; ++j) { const unsigned c = xb_ld(&bar[XB_XCNT(j)]); sum += c; cnt += (c > 0u) ? 1u : 0u; mine = (j == x) ? c : mine; }
        if (sum == G) break;
        __builtin_amdgcn_s_sleep(1);
        if ((++sp & 255u) == 0u) { if (xb_ld(&bar[XB_TMO])) break; if (sp > XB_SPIN_CAP) { atomicAdd(&bar[XB_TMO], 1u); break; } }
    }
    nloc = mine > 0u ? mine : 1u; nx = cnt > 0u ? cnt : 1u;
}
__device__ __forceinline__ void xcd_barrier(const XcdBarrier& b) {
    asm volatile("s_waitcnt vmcnt(0)" ::: "memory");
    __syncthreads();
    if (threadIdx.x == 0) {
        unsigned* bar = b.bar;
        __builtin_amdgcn_s_waitcnt(0);
        unsigned nloc = b.st[0], nx = b.st[1];
        if (nloc == 0u) { xcd_barrier_complete(bar, b.x, nloc, nx); b.st[0] = nloc; b.st[1] = nx; }
        const unsigned old = xb_add(&bar[XB_XSUB(b.x)], 1u);
        const unsigned gen = old / nloc;
        if (old + 1u == (gen + 1u) * nloc) {
            __builtin_amdgcn_fence(__ATOMIC_RELEASE, "agent");
            asm volatile("s_waitcnt vmcnt(0)" ::: "memory");
            const unsigned og = xb_add(&bar[XB_TOP], 1u);
            const unsigned tg = og / nx;
            if (og + 1u == (tg + 1u) * nx) xb_add(&bar[XB_TOPGEN], 1u);
            else XB_SPIN(xb_ld(&bar[XB_TOPGEN]) == tg, bar);
            __builtin_amdgcn_fence(__ATOMIC_ACQUIRE, "agent");
            xb_add(&bar[XB_XGEN(b.x)], 1u);
            asm volatile("s_waitcnt vmcnt(0)" ::: "memory");
        } else {
            XB_SPIN(xb_ld(&bar[XB_XGEN(b.x)]) == gen, bar);
            __builtin_amdgcn_fence(__ATOMIC_ACQUIRE, "agent");
            asm volatile("s_waitcnt vmcnt(0)" ::: "memory");
        }
    }
    __syncthreads();
}

struct Frame {
    LAS unsigned char* lds;
    int tid, lane, wave, G, bid;
    const float *x, *c, *ctx, *c_ctx, *w_ada, *b_ada, *norm_g, *w_in, *mu_shift, *w0, *w2, *a0, *a2, *k_k, *k_a, *r_k, *ln_g, *ln_b, *qng, *kng, *sink, *w_out;
    float* out;
    float *MOD, *ROPE, *BON;
    bf16 *W2T, *A2T, *WOUT, *P, *XN, *WIN, *YF, *YB, *MIX;
    _Float16* UA;
};


typedef const float* cfp_t;
__device__ __forceinline__ const float* karg_f(int idx) { int off = idx * 8; asm volatile("" : "+s"(off)); const __attribute__((address_space(4))) char* kp = (const __attribute__((address_space(4))) char*)__builtin_amdgcn_kernarg_segment_ptr(); return *(const __attribute__((address_space(4))) cfp_t*)(kp + off); }
__device__ __forceinline__ void fresh(Frame& F) {
    int t_ = threadIdx.x; asm volatile("" : "+v"(t_)); F.tid = t_; F.lane = t_ & 63; F.wave = __builtin_amdgcn_readfirstlane(t_ >> 6);
    int b_ = blockIdx.x; asm volatile("" : "+s"(b_)); F.bid = b_;
    F.x = karg_f(0); F.c = karg_f(1); F.ctx = karg_f(2); F.c_ctx = karg_f(3); F.w_ada = karg_f(4); F.b_ada = karg_f(5); F.norm_g = karg_f(6); F.w_in = karg_f(7);
    F.mu_shift = karg_f(8); F.w0 = karg_f(9); F.w2 = karg_f(10); F.a0 = karg_f(11); F.a2 = karg_f(12); F.k_k = karg_f(13); F.k_a = karg_f(14); F.r_k = karg_f(15);
    F.ln_g = karg_f(16); F.ln_b = karg_f(17); F.qng = karg_f(18); F.kng = karg_f(19); F.sink = karg_f(20); F.w_out = karg_f(21);
    F.out = (float*)karg_f(22);
    unsigned char* ws = (unsigned char*)karg_f(23);
    F.MOD = (float*)(ws + WS_MOD); F.ROPE = (float*)(ws + WS_ROPE); F.BON = (float*)(ws + WS_BON);
    F.W2T = (bf16*)(ws + WS_W2T); F.A2T = (bf16*)(ws + WS_A2T); F.WOUT = (bf16*)(ws + WS_WOUT); F.P = (bf16*)(ws + WS_P); F.XN = (bf16*)(ws + WS_XN); F.WIN = (bf16*)(ws + WS_WIN);
    F.YF = (bf16*)(ws + WS_YF); F.YB = (bf16*)(ws + WS_YB); F.MIX = (bf16*)(ws + WS_MIX); F.UA = (_Float16*)(ws + WS_UA);
}

struct Sched1 {
    int G, c;
    __device__ __forceinline__ void init(int G_, int c_) { G = G_; c = c_; }
    __device__ __forceinline__ bool next(int i, pg8::Unit& u) const {
        int grp, loc;
        if (G == 256) { if (i >= 7) return false; grp = c & 7; loc = i * 32 + (c >> 3); if (loc >= 216) { const int j = grp * 8 + (loc - 216); if (j >= 60) return false; u.pm = 64 + j / 15; const int q = j % 15; u.pn = q < 13 ? q : q + 8; return true; } }
        else { const int L = i * G + c; if (L >= 1788) return false; if (L >= 1728) { const int j = L - 1728; u.pm = 64 + j / 15; const int q = j % 15; u.pn = q < 13 ? q : q + 8; return true; } grp = L / 216; loc = L % 216; }
        u.pm = grp * 8 + (loc & 7); u.pn = loc >> 3; return true;
    }
    __device__ __forceinline__ void a_ready(const pg8::Unit&) const {}
    __device__ __forceinline__ void done(const pg8::Unit&) const {}
};

__device__ __forceinline__ void p0_transpose_item(const float* W, int K, int N, bf16* WT, LAS float* scr, int item, int lane) {
    const int nblk = N / 32, kb = item / nblk, nb = item % nblk, k0 = 64 * kb, n0 = 32 * nb;
#pragma unroll 8
    for (int i = 0; i < 32; ++i) { const int kk = 2 * i + (lane >> 5); scr[kk * 33 + (lane & 31)] = W[(size_t)(k0 + kk) * N + n0 + (lane & 31)]; }
    asm volatile("s_waitcnt lgkmcnt(0)" ::: "memory");
    const int c = lane & 7;
#pragma unroll
    for (int j = 0; j < 4; ++j) { const int n = (lane >> 3) + 8 * j; const LAS float* s = scr + (8 * c) * 33 + n;
        u32x4 o; o.x = pk2(s[0 * 33], s[1 * 33]); o.y = pk2(s[2 * 33], s[3 * 33]); o.z = pk2(s[4 * 33], s[5 * 33]); o.w = pk2(s[6 * 33], s[7 * 33]);
        *(GAS u32x4*)(WT + (size_t)(n0 + n) * K + k0 + 8 * c) = o; }
    asm volatile("s_waitcnt lgkmcnt(0)" ::: "memory");
}
__device__ __forceinline__ void p0_prologue(Frame& F) {
    const int tid = F.tid, lane = F.lane, wave = F.wave;
    if (F.bid < 192) {
        LAS float* sl = (LAS float*)F.lds;
        LAS float* red = sl + 5 * 2048;
        for (int i = tid; i < 5 * 2048; i += NWAVES * 64) { const int v = i >> 11, k = i & 2047; const float cv = v < 4 ? F.c[v * 2048 + k] : F.c_ctx[k]; sl[i] = cv / (1.0f + __expf(-cv)); }
        __syncthreads();
        const int n0 = 32 * F.bid, col = lane & 31, slot = wave * 2 + (lane >> 5);
        float acc[5] = {0.f, 0.f, 0.f, 0.f, 0.f};
        const float* wp = F.w_ada + n0 + col;
#pragma unroll 8
        for (int k = slot; k < 2048; k += 16) { const float w = wp[(size_t)k * 6144];
#pragma unroll
            for (int v = 0; v < 5; ++v) acc[v] += sl[v * 2048 + k] * w; }
#pragma unroll
        for (int v = 0; v < 5; ++v) red[(slot * 5 + v) * 32 + col] = acc[v];
        __syncthreads();
        if (tid < 160) { const int v = tid >> 5, cc = tid & 31; float s = 0.f;
#pragma unroll
            for (int q = 0; q < 16; ++q) s += red[(q * 5 + v) * 32 + cc];
            F.MOD[v * 6144 + n0 + cc] = s + F.b_ada[n0 + cc]; }
        __syncthreads();
    }
    if (F.bid == F.G - 1) {
        for (int i = tid; i < 1024; i += NWAVES * 64) { const int pos = i >> 4, f = i & 15; const float inv = exp2f(-(float)f * (13.287712379549449f / 16.0f)); const float ang = (float)pos * inv;
            F.ROPE[i] = cosf(ang); F.ROPE[1024 + i] = sinf(ang); }
    }
    LAS float* scr = (LAS float*)(F.lds + wave * 16384);
    const int gw = F.bid * NWAVES + wave, NGW = F.G * NWAVES;
    constexpr int I_IN = (DM / 64) * (NIN / 32), I_OUT = (DM / 64) * (DM / 32), I_L = 1024 / 32;
    constexpr int NITEMS = I_IN + I_OUT + 4 * I_L;
    for (int it = gw; it < NITEMS; it += NGW) {
        int r = it;
        if (r < I_IN) { p0_transpose_item(F.w_in, DM, NIN, F.WIN, scr, r, lane); continue; } r -= I_IN;
        if (r < I_OUT) { p0_transpose_item(F.w_out, DM, DM, F.WOUT, scr, r, lane); continue; } r -= I_OUT;
        const int q = r / I_L; r -= q * I_L;
        p0_transpose_item((q < 2 ? F.w2 : F.a2) + (size_t)(q & 1) * 64 * 1024, 64, 1024, (q < 2 ? F.W2T : F.A2T) + (size_t)(q & 1) * 1024 * 64, scr, r, lane);
    }
}

__device__ __forceinline__ void p1_modulate(Frame& F) {
    const int gw = F.bid * NWAVES + F.wave, NGW = F.G * NWAVES, lane = F.lane;
    for (int m = gw; m < MT; m += NGW) {
        const float* src = m < ML ? F.x + (size_t)m * DM : F.ctx + (size_t)(m - ML) * DM;
        const float* mod = F.MOD + (m < ML ? (m >> 12) : 4) * 6144;
        const GAS f32x4* xr = (const GAS f32x4*)src + lane;
        f32x4 v[8]; float s = 0.f;
#pragma unroll
        for (int j = 0; j < 8; ++j) { v[j] = xr[64 * j]; s += (v[j].x * v[j].x + v[j].y * v[j].y) + (v[j].z * v[j].z + v[j].w * v[j].w); }
        const float rr = 1.0f / sqrtf(wave_sum(s) * (1.0f / DM) + 1e-6f);
        GAS u32x2* o8 = (GAS u32x2*)(F.XN + (size_t)m * DM) + lane;
#pragma unroll
        for (int j = 0; j < 8; ++j) { const int d0 = (64 * j + lane) * 4;
            const f32x4 g = *(const f32x4*)(F.norm_g + d0), sc = *(const f32x4*)(mod + 2048 + d0), sh = *(const f32x4*)(mod + d0);
            const f32x4 o = v[j] * rr * g * (1.0f + sc) + sh;
            u32x2 w; w.x = pk2(o.x, o.y); w.y = pk2(o.z, o.w); o8[64 * j] = w; }
    }
}

__device__ __forceinline__ int seq_lo(int m) { return m < ML ? (m & ~(SEQ - 1)) : ML + ((m - ML) & ~(CTXL - 1)); }
__device__ __forceinline__ int seq_hi(int m) { return m < ML ? (m | (SEQ - 1)) : ML + ((m - ML) | (CTXL - 1)); }
__device__ __forceinline__ void p3_lora(Frame& F) {
    const int tid = F.tid, lane = F.lane, wave = F.wave, l31 = lane & 31, hi = lane >> 5;
    LAS unsigned char* TT = F.lds;
    LAS unsigned char* LT = F.lds + 8192;
    for (int it = F.bid; it < 2 * (MT / 64); it += F.G) {
        const int d = it & 1, m0 = (it >> 1) * 64;
        {
            const int row = tid >> 3, ch = tid & 7, m = m0 + row, lo = seq_lo(m), hi_ = seq_hi(m);
            const bf16* pc = F.P + (size_t)m * NIN;
            const u32x4 z = {0u, 0u, 0u, 0u};
            const int cw = C_LW + d * 64 + 8 * ch, ca = C_LA + d * 64 + 8 * ch;
            const u32x4 w_c = *(const u32x4*)(pc + cw), a_c = *(const u32x4*)(pc + ca);
            const u32x4 w_p = m > lo ? *(const u32x4*)(pc - NIN + cw) : z, a_p = m > lo ? *(const u32x4*)(pc - NIN + ca) : z;
            const u32x4 w_n = m < hi_ ? *(const u32x4*)(pc + NIN + cw) : z, a_n = m < hi_ ? *(const u32x4*)(pc + NIN + ca) : z;
            float wc[8], wp[8], wn[8], ac[8], ap[8], an[8];
            unpack8(w_c, wc); unpack8(w_p, wp); unpack8(w_n, wn); unpack8(a_c, ac); unpack8(a_p, ap); unpack8(a_n, an);
            float tw[8], ta[8];
#pragma unroll
            for (int j = 0; j < 8; ++j) { const float muw = F.mu_shift[cw + j], mua = F.mu_shift[ca + j];
                const float sw = wc[j] + muw * (0.5f * (wp[j] + wn[j]) - wc[j]); ta[j] = ac[j] + mua * (0.5f * (ap[j] + an[j]) - ac[j]);
                tw[j] = 1.0f - 2.0f * __builtin_amdgcn_rcpf(1.0f + fast_exp(2.0f * sw)); }
            const int off = row * 128 + ((ch ^ ((row >> 1) & 7)) << 4);
            u32x4 o; o.x = pk2(tw[0], tw[1]); o.y = pk2(tw[2], tw[3]); o.z = pk2(tw[4], tw[5]); o.w = pk2(tw[6], tw[7]); *(LAS u32x4*)(TT + off) = o;
            o.x = pk2(ta[0], ta[1]); o.y = pk2(ta[2], ta[3]); o.z = pk2(ta[4], ta[5]); o.w = pk2(ta[6], ta[7]); *(LAS u32x4*)(LT + off) = o;
        }
        __syncthreads();
#pragma unroll 1
        for (int which = 0; which < 2; ++which) {
            LAS unsigned char* T = which ? LT : TT;
            const bf16* BT = (which ? F.A2T : F.W2T) + (size_t)d * 1024 * 64;
            const float* bias = (which ? F.a0 : F.w0) + d * 1024;
            bf16x8 af[2][4];
#pragma unroll
            for (int mb = 0; mb < 2; ++mb)
#pragma unroll
                for (int ks = 0; ks < 4; ++ks) { const int row = mb * 32 + l31, ch = 2 * ks + hi; af[mb][ks] = *(const LAS bf16x8*)(T + row * 128 + ((ch ^ ((row >> 1) & 7)) << 4)); }
#pragma unroll 1
            for (int nb = 0; nb < 4; ++nb) {
                const int col = wave * 128 + nb * 32 + l31;
                bf16x8 bfr[4];
#pragma unroll
                for (int ks = 0; ks < 4; ++ks) bfr[ks] = *(const bf16x8*)(BT + (size_t)col * 64 + 16 * ks + 8 * hi);
                const float bz = bias[col];
#pragma unroll
                for (int mb = 0; mb < 2; ++mb) {
                    f32x16 acc = {0.f, 0.f, 0.f, 0.f, 0.f, 0.f, 0.f, 0.f, 0.f, 0.f, 0.f, 0.f, 0.f, 0.f, 0.f, 0.f};
#pragma unroll
                    for (int ks = 0; ks < 4; ++ks) acc = __builtin_amdgcn_mfma_f32_32x32x16_bf16(af[mb][ks], bfr[ks], acc, 0, 0, 0);
                    _Float16* dst = F.UA + (((size_t)d * MT + m0 + mb * 32) * 16 + (col >> 6)) * 128 + which * 64 + (col & 63);
#pragma unroll
                    for (int r = 0; r < 16; ++r) { const int i = (r & 3) + 8 * (r >> 2) + 4 * hi;
                        const float sg = sigmoidf_(acc[r] + bz);
                        const float val = which ? sg : 1.0f - fast_exp(-0.6065306597126334f * sg);
                        dst[(size_t)i * 2048] = (_Float16)val; }
                }
            }
        }
        __syncthreads();
    }
}

constexpr int SC_BUF = 49152;
constexpr int SC_A1 = 0, SC_A2 = 16384, SC_A3 = 32768, SC_V = 40960, SC_Y = 2 * SC_BUF, SC_CONST = SC_Y + 8192;
struct ScanRegs { u32x4 r[3], k[3], v[3], ua[2]; };
__device__ __forceinline__ int scan_row(int b, int d, int blk, int tok) {
    const int j = blk < 4 ? blk * 64 + tok : (blk - 4) * 64 + tok;
    if (blk < 4) return ML + b * CTXL + (d ? (CTXL - 1 - j) : j);
    return b * SEQ + (d ? (SEQ - 1 - j) : j);
}
__device__ __forceinline__ void scan_load(Frame& F, ScanRegs& R, int b, int h, int d, int half, int blk) {
    const int tok = F.tid >> 3, ch = F.tid & 7, m = scan_row(b, d, blk, tok), lo = seq_lo(m), hi_ = seq_hi(m);
    const bf16* pc = F.P + (size_t)m * NIN + h * 64 + 8 * ch;
    const u32x4 z = {0u, 0u, 0u, 0u};
    const bool hp = m > lo, hn = m < hi_, hv = (ch >> 2) == half;
    R.r[1] = *(const u32x4*)(pc + C_R); R.k[1] = *(const u32x4*)(pc + C_K); R.v[1] = hv ? *(const u32x4*)(pc + C_V) : z;
    R.r[0] = hp ? *(const u32x4*)(pc - NIN + C_R) : z; R.k[0] = hp ? *(const u32x4*)(pc - NIN + C_K) : z; R.v[0] = (hp && hv) ? *(const u32x4*)(pc - NIN + C_V) : z;
    R.r[2] = hn ? *(const u32x4*)(pc + NIN + C_R) : z; R.k[2] = hn ? *(const u32x4*)(pc + NIN + C_K) : z; R.v[2] = (hn && hv) ? *(const u32x4*)(pc + NIN + C_V) : z;
    const _Float16* ua = F.UA + (((size_t)d * MT + m) * 16 + h) * 128 + 8 * ch;
    R.ua[0] = *(const u32x4*)ua; R.ua[1] = *(const u32x4*)(ua + 64);
}
__device__ __forceinline__ void scan_stage(Frame& F, const ScanRegs& R, LAS unsigned char* buf, int b, int h, int d, int half, int blk) {
    const int tok = F.tid >> 3, ch = F.tid & 7;
    const LAS f32x4* cs = (const LAS f32x4*)(F.lds + SC_CONST) + 2 * ch;
    float rc[8], rp[8], rn[8], kc[8], kp[8], kn[8];
    unpack8(R.r[1], rc); unpack8(R.r[0], rp); unpack8(R.r[2], rn); unpack8(R.k[1], kc); unpack8(R.k[0], kp); unpack8(R.k[2], kn);
    float sr[8], sk[8], kk[8], ss = 0.f;
    { const f32x4 m0 = cs[0], m1 = cs[1], n0 = cs[16], n1 = cs[17], q0 = cs[48], q1 = cs[49];
#pragma unroll
    for (int j = 0; j < 8; ++j) { const float mur = j < 4 ? m0[j & 3] : m1[j & 3], muk = j < 4 ? n0[j & 3] : n1[j & 3], kkc = j < 4 ? q0[j & 3] : q1[j & 3];
        sr[j] = rc[j] + mur * (0.5f * (rp[j] + rn[j]) - rc[j]); sk[j] = kc[j] + muk * (0.5f * (kp[j] + kn[j]) - kc[j]);
        kk[j] = sk[j] * kkc; ss += kk[j] * kk[j]; } }
    ss += __shfl_xor(ss, 1); ss += __shfl_xor(ss, 2); ss += __shfl_xor(ss, 4);
    const float inv = 1.0f / fmaxf(sqrtf(ss), 1e-12f);
    const h8 uu = __builtin_bit_cast(h8, R.ua[0]), aa = __builtin_bit_cast(h8, R.ua[1]);
    float kd[8], kka[8], bon = 0.f;
    { const f32x4 m0 = cs[64], m1 = cs[65], n0 = cs[80], n1 = cs[81];
#pragma unroll
    for (int j = 0; j < 8; ++j) { const float a = (float)aa[j], kac = j < 4 ? m0[j & 3] : m1[j & 3], rkc = j < 4 ? n0[j & 3] : n1[j & 3];
        kk[j] *= inv; kka[j] = kk[j] * a; kd[j] = sk[j] * (1.0f + (a - 1.0f) * kac); bon += sr[j] * kd[j] * rkc; } }
    bon += __shfl_xor(bon, 1); bon += __shfl_xor(bon, 2); bon += __shfl_xor(bon, 4);
    if (ch == 0 && half == 0 && blk >= 4) F.BON[((size_t)d * ML + scan_row(b, d, blk, tok)) * 16 + h] = bon;
#pragma unroll
    for (int q = 0; q < 2; ++q) { const int cg = 2 * ch + q, j0 = 4 * q;
        u32x4 o1; o1.x = pkh(kk[j0], kk[j0 + 1]); o1.y = pkh(kk[j0 + 2], kk[j0 + 3]); o1.z = pkh(kka[j0], kka[j0 + 1]); o1.w = pkh(kka[j0 + 2], kka[j0 + 3]);
        *(LAS u32x4*)(buf + SC_A1 + (tok * 16 + cg) * 16) = o1;
        u32x4 o2; o2.x = pkh(kd[j0], kd[j0 + 1]); o2.y = pkh(kd[j0 + 2], kd[j0 + 3]); o2.z = pkh(sr[j0], sr[j0 + 1]); o2.w = pkh(sr[j0 + 2], sr[j0 + 3]);
        *(LAS u32x4*)(buf + SC_A2 + (tok * 16 + cg) * 16) = o2;
        u32x2 o3; o3.x = q ? R.ua[0].z : R.ua[0].x; o3.y = q ? R.ua[0].w : R.ua[0].y;
        *(LAS u32x2*)(buf + SC_A3 + (tok * 16 + cg) * 8) = o3; }
    if ((ch >> 2) == half) {
        float vc[8], vp[8], vn[8]; unpack8(R.v[1], vc); unpack8(R.v[0], vp); unpack8(R.v[2], vn);
        const f32x4 m0 = cs[32], m1 = cs[33];
        f32x4 o0, o1;
#pragma unroll
        for (int j = 0; j < 8; ++j) { const float muv = j < 4 ? m0[j & 3] : m1[j & 3]; const float sv = vc[j] + muv * (0.5f * (vp[j] + vn[j]) - vc[j]); if (j < 4) o0[j] = sv; else o1[j - 4] = sv; }
        LAS f32x4* vd = (LAS f32x4*)(buf + SC_V + (tok * 32 + 8 * (ch & 3)) * 4); vd[0] = o0; vd[1] = o1;
    }
}
__device__ __forceinline__ void p4_scan(Frame& F, int item) {
    const int half = item & 1, d = (item >> 1) & 1, h = (item >> 2) & 15, b = item >> 6;
    const int lane = F.lane, wave = F.wave, cg = lane & 15, rl = lane >> 4, row = wave * 4 + rl;
    LAS unsigned char* lds = F.lds;
    if (F.tid < 384) { const int q = F.tid >> 6, n = F.tid & 63, c = h * 64 + n;
        const float val = q == 0 ? F.mu_shift[C_R + c] : q == 1 ? F.mu_shift[C_K + c] : q == 2 ? F.mu_shift[C_V + c] : q == 3 ? F.k_k[c] : q == 4 ? F.k_a[c] : F.r_k[c];
        ((LAS float*)(lds + SC_CONST))[F.tid] = val; }
    __syncthreads();
    ScanRegs R;
    scan_load(F, R, b, h, d, half, 0);
    scan_stage(F, R, lds, b, h, d, half, 0);
    __syncthreads();
    float S0 = 0.f, S1 = 0.f, S2 = 0.f, S3 = 0.f;
    bf16* Y = d ? F.YB : F.YF;
#pragma unroll 1
    for (int blk = 0; blk < 68; ++blk) {
        LAS unsigned char* buf = lds + (blk & 1) * SC_BUF;
        if (blk + 1 < 68) scan_load(F, R, b, h, d, half, blk + 1);
        const LAS unsigned char* p1 = buf + SC_A1 + cg * 16, * p2 = buf + SC_A2 + cg * 16, * p3 = buf + SC_A3 + cg * 8, * pv = buf + SC_V + row * 4;
        LAS float* yb = (LAS float*)(lds + SC_Y) + row;
#pragma unroll 4
        for (int i = 0; i < 64; ++i) {
            const h8 a1 = *(const LAS h8*)(p1 + i * 256), a2 = *(const LAS h8*)(p2 + i * 256);
            const h4 a3 = *(const LAS h4*)(p3 + i * 128);
            const float vv = *(const LAS float*)(pv + i * 128);
            float p = S0 * (float)a1[0]; p = __builtin_fmaf(S1, (float)a1[1], p); p = __builtin_fmaf(S2, (float)a1[2], p); p = __builtin_fmaf(S3, (float)a1[3], p);
            p += dpp_f<0xB1>(p); p += dpp_f<0x4E>(p); p += dpp_f<0x124>(p); p += dpp_f<0x128>(p);
            const float ns = -p;
            S0 = __builtin_fmaf(-(float)a3[0], S0, S0); S1 = __builtin_fmaf(-(float)a3[1], S1, S1); S2 = __builtin_fmaf(-(float)a3[2], S2, S2); S3 = __builtin_fmaf(-(float)a3[3], S3, S3);
            S0 = __builtin_fmaf(ns, (float)a1[4], S0); S1 = __builtin_fmaf(ns, (float)a1[5], S1); S2 = __builtin_fmaf(ns, (float)a1[6], S2); S3 = __builtin_fmaf(ns, (float)a1[7], S3);
            S0 = __builtin_fmaf(vv, (float)a2[0], S0); S1 = __builtin_fmaf(vv, (float)a2[1], S1); S2 = __builtin_fmaf(vv, (float)a2[2], S2); S3 = __builtin_fmaf(vv, (float)a2[3], S3);
            float y = S0 * (float)a2[4]; y = __builtin_fmaf(S1, (float)a2[5], y); y = __builtin_fmaf(S2, (float)a2[6], y); y = __builtin_fmaf(S3, (float)a2[7], y);
            y += dpp_f<0xB1>(y); y += dpp_f<0x4E>(y); y += dpp_f<0x124>(y); y += dpp_f<0x128>(y);
            if (cg == 0) yb[i * 32] = y;
        }
        __syncthreads();
        if (blk >= 4) {
            const int tok = F.tid >> 3, r4 = (F.tid & 7) * 4, m = scan_row(b, d, blk, tok);
            const f32x4 yv = *(const LAS f32x4*)(lds + SC_Y + (tok * 32 + r4) * 4);
            u32x2 o; o.x = pk2(yv.x, yv.y); o.y = pk2(yv.z, yv.w);
            *(u32x2*)(Y + (size_t)m * 1024 + h * 64 + half * 32 + r4) = o;
        }
        if (blk + 1 < 68) scan_stage(F, R, lds + ((blk + 1) & 1) * SC_BUF, b, h, d, half, blk + 1);
        __syncthreads();
    }
}

constexpr int AT_K = 0, AT_V = 16384, AT_BUF = 16384 + 64 * 272;
struct KVRegs { u32x4 k1, k2, v0, v1; };
__device__ __forceinline__ void at_load(Frame& F, KVRegs& R, int mrow0, int kvh) {
    const int tid = F.tid;
    { const int key = tid >> 2, q4 = tid & 3, a = q4 >> 1, e = q4 & 1;
      const bf16* p = F.P + (size_t)(mrow0 + key) * NIN + C_KA + kvh * 64 + a * 32 + 8 * e; R.k1 = *(const u32x4*)p; R.k2 = *(const u32x4*)(p + 16); }
    { const int kp = tid >> 3, dc = tid & 7; const bf16* p = F.P + (size_t)(mrow0 + 2 * kp) * NIN + C_VA + kvh * 64 + 8 * dc; R.v0 = *(const u32x4*)p; R.v1 = *(const u32x4*)(p + NIN); }
}
__device__ __forceinline__ void at_write(Frame& F, const KVRegs& R, LAS unsigned char* buf, int kpos0, bool rope) {
    const int tid = F.tid;
    { const int key = tid >> 2, q4 = tid & 3, a = q4 >> 1, e = q4 & 1;
      float x1[8], x2[8]; unpack8(R.k1, x1); unpack8(R.k2, x2);
      float ss = 0.f;
#pragma unroll
      for (int j = 0; j < 8; ++j) ss += x1[j] * x1[j] + x2[j] * x2[j];
      ss += __shfl_xor(ss, 1); ss += __shfl_xor(ss, 2);
      const float rr = 1.0f / sqrtf(ss * (1.0f / 64.0f) + 1e-6f);
      const int kpos = kpos0 + key, pos = a == 0 ? (kpos >> 6) : (kpos & 63);
#pragma unroll
      for (int j = 0; j < 8; ++j) { float y1 = x1[j] * rr * F.kng[a * 32 + 8 * e + j], y2 = x2[j] * rr * F.kng[a * 32 + 16 + 8 * e + j];
          if (rope) { const float c = F.ROPE[pos * 16 + 8 * e + j], s = F.ROPE[1024 + pos * 16 + 8 * e + j]; const float t1 = y1 * c - y2 * s, t2 = y2 * c + y1 * s; y1 = t1; y2 = t2; }
          x1[j] = y1; x2[j] = y2; }
      const int c1 = 4 * a + e, c2 = c1 + 2, sw = (key >> 1) & 7;
      u32x4 o; o.x = pk2(x1[0], x1[1]); o.y = pk2(x1[2], x1[3]); o.z = pk2(x1[4], x1[5]); o.w = pk2(x1[6], x1[7]); *(LAS u32x4*)(buf + AT_K + key * 128 + ((c1 ^ sw) << 4)) = o;
      o.x = pk2(x2[0], x2[1]); o.y = pk2(x2[2], x2[3]); o.z = pk2(x2[4], x2[5]); o.w = pk2(x2[6], x2[7]); *(LAS u32x4*)(buf + AT_K + key * 128 + ((c2 ^ sw) << 4)) = o; }
    { const int kp = tid >> 3, dc = tid & 7, kq = kp >> 1;
        const int pos0 = (kq >> 2) * 16 + (kq & 1) * 8 + ((kq >> 1) & 1) * 4 + (kp & 1) * 2;
#pragma unroll
        for (int w = 0; w < 4; ++w) {
            const unsigned a0 = R.v0[w], a1 = R.v1[w];
            *(LAS unsigned*)(buf + AT_V + (8 * dc + 2 * w) * 272 + pos0 * 2) = __builtin_amdgcn_perm(a1, a0, 0x05040100u);
            *(LAS unsigned*)(buf + AT_V + (8 * dc + 2 * w + 1) * 272 + pos0 * 2) = __builtin_amdgcn_perm(a1, a0, 0x07060302u); }
    }
}
__device__ __forceinline__ void p4_attn(Frame& F, int item) {
    const int n = item & 31, kvh = (item >> 5) & 3, b = item >> 7;
    const int lane = F.lane, wave = F.wave, l31 = lane & 31, hi = lane >> 5;
    const int hh = kvh * 4 + (wave >> 1), qloc = (wave & 1) * 64;
    LAS unsigned char* lds = F.lds;
    const int kfirst = n > 0 ? 0 : 1, nbnd = 3 - (n == 0 ? 1 : 0) - (n == 31 ? 1 : 0), nt = nbnd + 2;
#define TL_KIND(t) ((t) < nbnd ? kfirst + (t) : 3)
#define TL_ROW(t) ((t) < nbnd ? b * SEQ + (n - 1 + kfirst + (t)) * 128 : ML + b * CTXL + ((t) - nbnd) * 128)
#define TL_KPOS(t) ((t) < nbnd ? (n - 1 + kfirst + (t)) * 128 : 0)
    KVRegs R;
    at_load(F, R, TL_ROW(0), kvh);
    LAS unsigned char* qlds = lds + 2 * AT_BUF + wave * 8192 + lane * 16;
#pragma unroll
    for (int qb = 0; qb < 2; ++qb) {
        const int query = n * 128 + qloc + qb * 32 + l31;
        const bf16* src = F.P + (size_t)(b * SEQ + query) * NIN + C_Q + hh * 64 + 8 * hi;
        float v[4][8]; float ss = 0.f;
#pragma unroll
        for (int ks = 0; ks < 4; ++ks) { unpack8(*(const u32x4*)(src + 16 * ks), v[ks]);
#pragma unroll
            for (int j = 0; j < 8; ++j) ss += v[ks][j] * v[ks][j]; }
        ss += __shfl_xor(ss, 32);
        const float rr = (0.125f * LOG2E) / sqrtf(ss * (1.0f / 64.0f) + 1e-6f);
#pragma unroll
        for (int ks = 0; ks < 4; ++ks)
#pragma unroll
            for (int j = 0; j < 8; ++j) v[ks][j] *= rr * F.qng[16 * ks + 8 * hi + j];
#pragma unroll
        for (int a = 0; a < 2; ++a) { const int pos = a == 0 ? (query >> 6) : (query & 63);
#pragma unroll
            for (int j = 0; j < 8; ++j) { const float c = F.ROPE[pos * 16 + 8 * hi + j], s = F.ROPE[1024 + pos * 16 + 8 * hi + j];
                const float x1 = v[2 * a][j], x2 = v[2 * a + 1][j]; v[2 * a][j] = x1 * c - x2 * s; v[2 * a + 1][j] = x2 * c + x1 * s; } }
#pragma unroll
        for (int ks = 0; ks < 4; ++ks) { u32x4 o; o.x = pk2(v[ks][0], v[ks][1]); o.y = pk2(v[ks][2], v[ks][3]); o.z = pk2(v[ks][4], v[ks][5]); o.w = pk2(v[ks][6], v[ks][7]); *(LAS u32x4*)(qlds + (qb * 4 + ks) * 1024) = o; }
    }
    at_write(F, R, lds, TL_KPOS(0), true);
    __syncthreads();
    float mrun[2] = {-1e30f, -1e30f}, lrun[2] = {0.f, 0.f};
    f32x16 ot[2][2];
#pragma unroll
    for (int qb = 0; qb < 2; ++qb)
#pragma unroll
        for (int db = 0; db < 2; ++db)
#pragma unroll
            for (int r = 0; r < 16; ++r) ot[qb][db][r] = 0.f;
#pragma unroll 1
    for (int t = 0; t < nt; ++t) {
        LAS unsigned char* buf = lds + (t & 1) * AT_BUF;
        if (t + 1 < nt) at_load(F, R, TL_ROW(t + 1), kvh);
        const int kind = TL_KIND(t);
#pragma unroll 1
        for (int st = 0; st < 4; ++st) {
            bf16x8 kf[4];
#pragma unroll
            for (int ks = 0; ks < 4; ++ks) { const int key = st * 32 + l31, ch = 2 * ks + hi; kf[ks] = *(const LAS bf16x8*)(buf + AT_K + key * 128 + ((ch ^ ((key >> 1) & 7)) << 4)); }
            f32x16 sc0 = {0.f, 0.f, 0.f, 0.f, 0.f, 0.f, 0.f, 0.f, 0.f, 0.f, 0.f, 0.f, 0.f, 0.f, 0.f, 0.f}, sc1 = sc0;
            { bf16x8 qf[4];
#pragma unroll
              for (int ks = 0; ks < 4; ++ks) qf[ks] = *(const LAS bf16x8*)(qlds + ks * 1024);
#pragma unroll
              for (int ks = 0; ks < 4; ++ks) sc0 = __builtin_amdgcn_mfma_f32_32x32x16_bf16(kf[ks], qf[ks], sc0, 0, 0, 0);
#pragma unroll
              for (int ks = 0; ks < 4; ++ks) qf[ks] = *(const LAS bf16x8*)(qlds + (4 + ks) * 1024);
#pragma unroll
              for (int ks = 0; ks < 4; ++ks) sc1 = __builtin_amdgcn_mfma_f32_32x32x16_bf16(kf[ks], qf[ks], sc1, 0, 0, 0); }
            bf16x8 vf[2][2];
#pragma unroll
            for (int db = 0; db < 2; ++db)
#pragma unroll
                for (int s = 0; s < 2; ++s) vf[db][s] = *(const LAS bf16x8*)(buf + AT_V + (db * 32 + l31) * 272 + ((st * 2 + s) * 16 + hi * 8) * 2);
#define AT_SOFTMAX(SC, QB, PF) do { \
                const int qq = qloc + (QB) * 32 + l31; \
                if (kind == 0 || kind == 2) { \
                    _Pragma("unroll") for (int r = 0; r < 16; ++r) { const int kk = st * 32 + (r & 3) + 8 * (r >> 2) + 4 * hi; const bool ok = kind == 0 ? (kk >= qq) : (kk <= qq); SC[r] = ok ? SC[r] : -__builtin_inff(); } } \
                float tm = SC[0]; \
                _Pragma("unroll") for (int r = 1; r < 16; ++r) tm = fmaxf(tm, SC[r]); \
                tm = fmaxf(tm, __shfl_xor(tm, 32)); \
                if (__any(tm > mrun[QB] + 6.0f)) { \
                    const float mn = fmaxf(mrun[QB], tm), al = __builtin_amdgcn_exp2f(mrun[QB] - mn); \
                    mrun[QB] = mn; lrun[QB] *= al; \
                    _Pragma("unroll") for (int db = 0; db < 2; ++db) _Pragma("unroll") for (int r = 0; r < 16; ++r) ot[QB][db][r] *= al; } \
                float ps = 0.f; const float mm = mrun[QB]; \
                _Pragma("unroll") for (int r = 0; r < 16; ++r) { SC[r] = __builtin_amdgcn_exp2f(SC[r] - mm); ps += SC[r]; } \
                lrun[QB] += ps; \
                _Pragma("unroll") for (int s = 0; s < 2; ++s) { u32x4 o; o.x = pk2(SC[8 * s], SC[8 * s + 1]); o.y = pk2(SC[8 * s + 2], SC[8 * s + 3]); o.z = pk2(SC[8 * s + 4], SC[8 * s + 5]); o.w = pk2(SC[8 * s + 6], SC[8 * s + 7]); PF[s] = __builtin_bit_cast(bf16x8, o); } \
            } while (0)
            bf16x8 pf0[2], pf1[2];
            __builtin_amdgcn_sched_barrier(0);
            AT_SOFTMAX(sc0, 0, pf0);
            __builtin_amdgcn_sched_barrier(0);
            AT_SOFTMAX(sc1, 1, pf1);
            __builtin_amdgcn_sched_barrier(0);
#undef AT_SOFTMAX
#pragma unroll
            for (int db = 0; db < 2; ++db)
#pragma unroll
                for (int s = 0; s < 2; ++s) { ot[0][db] = __builtin_amdgcn_mfma_f32_32x32x16_bf16(vf[db][s], pf0[s], ot[0][db], 0, 0, 0); ot[1][db] = __builtin_amdgcn_mfma_f32_32x32x16_bf16(vf[db][s], pf1[s], ot[1][db], 0, 0, 0); }
        }
        if (t + 1 < nt) at_write(F, R, lds + ((t + 1) & 1) * AT_BUF, TL_KPOS(t + 1), (t + 1) < nbnd);
        __syncthreads();
    }
    const float sk2 = F.sink[hh] * LOG2E;
#pragma unroll
    for (int qb = 0; qb < 2; ++qb) {
        float l = lrun[qb]; l += __shfl_xor(l, 32); l += __builtin_amdgcn_exp2f(sk2 - mrun[qb]);
        const float il = 1.0f / l;
        const size_t m = (size_t)b * SEQ + n * 128 + qloc + qb * 32 + l31;
#pragma unroll
        for (int db = 0; db < 2; ++db)
#pragma unroll
            for (int rg = 0; rg < 4; ++rg) { const int d0 = db * 32 + 8 * rg + 4 * hi;
                const u32x2 za = *(const u32x2*)(F.P + m * NIN + C_ZA + hh * 64 + d0);
                const float z0 = bflo(za.x), z1 = bfhi(za.x), z2 = bflo(za.y), z3 = bfhi(za.y);
                u32x2 o; o.x = pk2(ot[qb][db][4 * rg] * il * siluf_(z0), ot[qb][db][4 * rg + 1] * il * siluf_(z1)); o.y = pk2(ot[qb][db][4 * rg + 2] * il * siluf_(z2), ot[qb][db][4 * rg + 3] * il * siluf_(z3));
                *(u32x2*)(F.MIX + m * DM + 1024 + hh * 64 + d0) = o; }
    }
#undef TL_KIND
#undef TL_ROW
#undef TL_KPOS
}

__device__ __forceinline__ void p5_mix(Frame& F) {
    const int total = F.G * NWAVES * 64;
    for (int idx = F.bid * NWAVES * 64 + F.tid; idx < ML * 16 * 8; idx += total) {
        const int ch = idx & 7, h = (idx >> 3) & 15, m = idx >> 7, c0 = h * 64 + 8 * ch, t = m & (SEQ - 1);
        float yf[8], yb[8], y[8];
        unpack8(*(const u32x4*)(F.YF + (size_t)m * 1024 + c0), yf); unpack8(*(const u32x4*)(F.YB + (size_t)m * 1024 + c0), yb);
        float s = 0.f;
#pragma unroll
        for (int j = 0; j < 8; ++j) { y[j] = yf[j] + yb[j]; s += y[j]; }
        s += __shfl_xor(s, 1); s += __shfl_xor(s, 2); s += __shfl_xor(s, 4);
        const float mu = s * (1.0f / 64.0f); float q = 0.f;
#pragma unroll
        for (int j = 0; j < 8; ++j) { y[j] -= mu; q += y[j] * y[j]; }
        q += __shfl_xor(q, 1); q += __shfl_xor(q, 2); q += __shfl_xor(q, 4);
        const float rs = 1.0f / sqrtf(q * (1.0f / 64.0f) + 64e-5f);
        const float bonus = F.BON[(size_t)m * 16 + h] + F.BON[(size_t)(ML + m) * 16 + h];
        const bf16* pc = F.P + (size_t)m * NIN;
        const u32x4 z = {0u, 0u, 0u, 0u};
        float vc[8], vp[8], vn[8], zr[8];
        unpack8(*(const u32x4*)(pc + C_V + c0), vc); unpack8(t > 0 ? *(const u32x4*)(pc - NIN + C_V + c0) : z, vp); unpack8(t < SEQ - 1 ? *(const u32x4*)(pc + NIN + C_V + c0) : z, vn);
        unpack8(*(const u32x4*)(pc + C_ZR + c0), zr);
        float o[8];
#pragma unroll
        for (int j = 0; j < 8; ++j) { const float sv = vc[j] + F.mu_shift[C_V + c0 + j] * (0.5f * (vp[j] + vn[j]) - vc[j]);
            const float yn = y[j] * rs * F.ln_g[c0 + j] + F.ln_b[c0 + j];
            o[j] = (yn + bonus * sv) * siluf_(zr[j]); }
        u32x4 w; w.x = pk2(o[0], o[1]); w.y = pk2(o[2], o[3]); w.z = pk2(o[4], o[5]); w.w = pk2(o[6], o[7]);
        *(u32x4*)(F.MIX + (size_t)m * DM + c0) = w;
    }
}

struct Args { const float* in[22]; float* out; unsigned char* ws; int ph_lo, ph_hi; };
__global__ void __launch_bounds__(NWAVES * 64, 2) hymba_fwd(Args args) {
    extern __shared__ __attribute__((aligned(16))) unsigned char lds_raw[];
    Frame F;
    F.lds = (LAS unsigned char*)lds_raw;
    F.tid = threadIdx.x; F.G = gridDim.x;
    unsigned char* ws = args.ws;
    volatile LAS unsigned* MISC = (volatile LAS unsigned*)(F.lds + MISC_OFF);
    for (int u = F.tid; u < 64; u += NWAVES * 64) MISC[u] = 0u;
    __syncthreads();
    const int lo = args.ph_lo, hi = args.ph_hi;
    XcdBarrier bar; bar.bar = (unsigned*)(ws + WS_CTL) + CW_BAR; bar.x = 0; bar.st = nullptr;
    if (hi - lo > 1) bar = xcd_barrier_post((unsigned*)(ws + WS_CTL) + CW_BAR, MISC + 8);
#define IN(k) (lo <= (k) && (k) < hi)
#define SEAM(k) do { if (IN(k) && IN((k) + 1)) xcd_barrier(bar); } while (0)
    if (IN(0)) { fresh(F); p0_prologue(F); } SEAM(0);
    if (IN(1)) { fresh(F); p1_modulate(F); } SEAM(1);
    if (IN(2)) {
        fresh(F);
        pg8::Gemm g{F.XN, F.WIN, MT, NIN, DM}; Sched1 S; S.init(F.G, F.bid);
        pg8::EpiBf16<0> E{F.P, NIN, nullptr, 0, 0, 1.f};
        pg8::gemm_phase<pg8::EpiBf16<0>, Sched1, true, true>(F.lds, g, S, E);
    } SEAM(2);
    if (IN(3)) { fresh(F); p3_lora(F); } SEAM(3);
    if (IN(4)) {
        fresh(F);
        for (int it = F.bid; it < 256; it += F.G) { p4_scan(F, it); __syncthreads(); }
        fresh(F);
        for (int it = F.bid; it < 512; it += F.G) { p4_attn(F, it); __syncthreads(); }
    } SEAM(4);
    if (IN(5)) { fresh(F); p5_mix(F); } SEAM(5);
    if (IN(6)) {
        fresh(F);
        pg8::Gemm g{F.MIX, F.WOUT, ML, DM, DM}; pg8::StaticOrder S; S.init(ML, DM, F.G, F.bid);
        pg8::EpiGate E{F.x, F.out, F.MOD + 4096, DM};
        pg8::gemm_phase<pg8::EpiGate, pg8::StaticOrder, true, true>(F.lds, g, S, E);
    }
#undef IN
#undef SEAM
}

extern "C" void kernel_launch(void* const* d_in, const int* in_sizes, int n_in, void* d_out, int out_size, void* d_ws, size_t ws_size, hipStream_t stream) {
    static int grid = 0;
    if (grid == 0) {
        if (n_in != 22 || out_size != ML * DM || ws_size < WS_END) { fprintf(stderr, "kernel_launch: unexpected problem shape (n_in %d, out %d, ws %zu)\n", n_in, out_size, ws_size); grid = -1; return; }
        int dev = 0, cus = 0;
        if (hipGetDevice(&dev) != hipSuccess || hipDeviceGetAttribute(&cus, hipDeviceAttributeMultiprocessorCount, dev) != hipSuccess) { grid = -1; return; }
        if (hipFuncSetAttribute((const void*)hymba_fwd, hipFuncAttributeMaxDynamicSharedMemorySize, LDS_BYTES) != hipSuccess) { fprintf(stderr, "kernel_launch: hipFuncSetAttribute failed\n"); grid = -1; return; }
        (void)hipGetLastError();
        grid = cus;
    }
    if (grid < 0) return;
    (void)hipMemsetAsync((char*)d_ws + WS_CTL, 0, CTL_ZERO_BYTES, stream);
    Args a{};
    for (int i = 0; i < 22; ++i) a.in[i] = (const float*)d_in[i];
    a.out = (float*)d_out; a.ws = (unsigned char*)d_ws;
    if (MK_N_LAUNCHES == 1) { a.ph_lo = 0; a.ph_hi = N_PHASES; hipLaunchKernelGGL(hymba_fwd, dim3(grid), dim3(NWAVES * 64), LDS_BYTES, stream, a); }
    else for (int p = 0; p < N_PHASES; ++p) { a.ph_lo = p; a.ph_hi = p + 1; hipLaunchKernelGGL(hymba_fwd, dim3(grid), dim3(NWAVES * 64), LDS_BYTES, stream, a); }
}
```

```cpp
#include <hip/hip_runtime.h>
#include <cstdio>
#include <cstdint>
#ifndef DBG_SEL
#define DBG_SEL -1
#endif
#ifndef DBG_SEL2
#define DBG_SEL2 0
#endif
#ifndef DBG_BLOCK
#define DBG_BLOCK 0
#endif
#ifndef DBG_END
#define DBG_END 0
#endif
namespace pg8 {
#define PG8_LAS __attribute__((address_space(3)))
typedef unsigned short bf16_t;
typedef short bf16x8 __attribute__((ext_vector_type(8)));
typedef float f32x4 __attribute__((ext_vector_type(4)));
typedef unsigned u32x4 __attribute__((ext_vector_type(4)));
constexpr int BM = 256, BK = 64, HALF = 128, HTB = HALF * BK * 2  , STAGE_BYTES = 8 * HTB, NXCD = 8, WGM = 8;

__host__ __device__ __forceinline__ int lds_byte(int r, int c) { const int st = (r >> 4) * 2 + (c >> 5), rr = r & 15, cc = c & 31, ob = rr * 64 + cc * 2; return st * 1024 + (ob ^ (((ob >> 9) & 1) << 5)); }
__host__ __device__ __forceinline__ void stage_rc(int b, int& R, int& C) { const int st = b / 1024, sb = b % 1024, swz = sb ^ (((sb >> 9) & 1) << 5); R = (st >> 1) * 16 + swz / 64; C = (st & 1) * 32 + (swz % 64) / 2; }
__host__ __device__ __forceinline__ int perm32(int rho) { const int n = rho >> 4, i = rho & 15; return 8 * (i >> 2) + 4 * n + (i & 3); }

struct Unit { int pm, pn; };
struct Gemm { const bf16_t* A; const bf16_t* Bt; int M, N, K, lda; };

struct StaticOrder {
    int nM, nN, nwg, G, c;
    __host__ __device__ void init(int M, int N, int G_, int c_) { nM = M / BM; nN = N / BM; nwg = nM * nN; G = G_; c = c_; }
    __host__ __device__ bool next(int i, Unit& u) const {
        const long L = (long)i * G + c; if (L >= nwg) return false;
        int wgid = (int)L; { const int q = nwg / NXCD, r = nwg % NXCD, xcd = wgid % NXCD, off = wgid / NXCD; wgid = (xcd < r ? xcd * (q + 1) : r * (q + 1) + (xcd - r) * q) + off; }
        const int nig = WGM * nN, gid = wgid / nig, fm = gid * WGM, gsz = (nM - fm) < WGM ? (nM - fm) : WGM;
        u.pm = fm + ((wgid % nig) % gsz); u.pn = (wgid % nig) / gsz; return true;
    }
    __device__ __forceinline__ void a_ready(const Unit&) const {}
    __device__ __forceinline__ void done(const Unit&) const {}
};

__device__ __forceinline__ unsigned cvt_pk_bf16(float lo, float hi) { unsigned r; asm volatile("v_cvt_pk_bf16_f32 %0, %1, %2" : "=v"(r) : "v"(lo), "v"(hi)); return r; }
typedef float f32x2 __attribute__((ext_vector_type(2)));
__device__ __forceinline__ f32x2 gelu_pk(f32x2 v) {
    const f32x2 av = __builtin_elementwise_abs(v), d = av * 0.2316418882f + 1.0f;
    f32x2 t; t.x = __builtin_amdgcn_rcpf(d.x); t.y = __builtin_amdgcn_rcpf(d.y);
    f32x2 q = t * 0.5307027145f + (-0.7265760135f); q = q * t + 0.7107068705f; q = q * t + (-0.142248368f); q = q * t + 0.127414796f; q = q * t;
    const f32x2 s = (v * v) * (-0.72134752044f);
    f32x2 e; e.x = __builtin_amdgcn_exp2f(s.x); e.y = __builtin_amdgcn_exp2f(s.y);
    const f32x2 m = v * (q * e), r = v - m;
    f32x2 o; o.x = v.x < 0.f ? m.x : r.x; o.y = v.y < 0.f ? m.y : r.y; return o;
}

template <int ACT  > struct EpiBf16 {
    static constexpr bool PERM = true, AFTER_DRAIN = false; static_assert(ACT == 0 || ACT == 1, "EpiBf16: ACT is 0 (none) or 1 (gelu_pk)");
    bf16_t* O; int ldc; const float* bias; int split_cols; size_t split_stride; float scale0;
    __device__ __forceinline__ void operator()(const f32x4 (&acc)[2][2][4][2], const Unit& u, int wr, int wc, int fr, int fq) const {
        const int row0 = u.pm * BM + wr * 64 + fr; int colt = u.pn * BM; bf16_t* base = O;
        float sc = 1.f; if (split_cols) { const int t = colt / split_cols; base += (size_t)t * split_stride; colt -= t * split_cols; if (t == 0) sc = scale0; }
        const int col0 = colt + wc * 32 + 8 * fq, bcol0 = u.pn * BM + wc * 32 + 8 * fq;
        f32x4 bv[2][2];
#pragma unroll
        for (int bj = 0; bj < 2; ++bj)
#pragma unroll
            for (int n = 0; n < 2; ++n) bv[bj][n] = bias ? *(const f32x4*)(bias + bcol0 + bj * HALF + 4 * n) : (f32x4){0.f, 0.f, 0.f, 0.f};
#pragma unroll
        for (int ai = 0; ai < 2; ++ai)
#pragma unroll
            for (int m = 0; m < 4; ++m) { bf16_t* rowp = base + (size_t)(row0 + ai * HALF + m * 16) * ldc + col0;
#pragma unroll
                for (int bj = 0; bj < 2; ++bj) { f32x4 v0 = acc[ai][bj][m][0] + bv[bj][0], v1 = acc[ai][bj][m][1] + bv[bj][1];
                    if (ACT == 1) { f32x2 a = gelu_pk((f32x2){v0[0], v0[1]}), b = gelu_pk((f32x2){v0[2], v0[3]}), c = gelu_pk((f32x2){v1[0], v1[1]}), d = gelu_pk((f32x2){v1[2], v1[3]});
                        v0 = (f32x4){a.x, a.y, b.x, b.y}; v1 = (f32x4){c.x, c.y, d.x, d.y}; }
                    v0 = v0 * sc; v1 = v1 * sc; u32x4 w; w.x = cvt_pk_bf16(v0[0], v0[1]); w.y = cvt_pk_bf16(v0[2], v0[3]); w.z = cvt_pk_bf16(v1[0], v1[1]); w.w = cvt_pk_bf16(v1[2], v1[3]);
                    *(u32x4*)(rowp + bj * HALF) = w; } }
    }
};


struct EpiGate {
    static constexpr bool PERM = false, AFTER_DRAIN = false;
    const float* x; float* out; const float* gate; int ldc; float dbg0, dbg1;
    __device__ __forceinline__ void operator()(const f32x4 (&acc)[2][2][4][2], const Unit& u, int wr, int wc, int fr, int fq) const {
        const int col0 = u.pn * BM + wc * 32 + 4 * fq;
        const int b = (u.pm * BM) >> 12;
        f32x4 gv[2][2];
#pragma unroll
        for (int bj = 0; bj < 2; ++bj)
#pragma unroll
            for (int n = 0; n < 2; ++n) gv[bj][n] = *(const f32x4*)(gate + (size_t)b * 6144 + col0 + bj * HALF + n * 16);
#pragma unroll
        for (int ai = 0; ai < 2; ++ai)
#pragma unroll
            for (int m = 0; m < 4; ++m) { const size_t off = (size_t)(u.pm * BM + ai * HALF + wr * 64 + m * 16 + fr) * ldc + col0;
#pragma unroll
                for (int bj = 0; bj < 2; ++bj)
#pragma unroll
                    for (int n = 0; n < 2; ++n) { const f32x4 xv = *(const f32x4*)(x + off + bj * HALF + n * 16);
                        f32x4 o = xv + gv[bj][n] * acc[ai][bj][m][n];
                        if (DBG_SEL >= 0) { o = o + dbg0; if (off + bj * HALF + n * 16 == 0) o.x += dbg1; }
                        *(f32x4*)(out + off + bj * HALF + n * 16) = o; }
                if (m & 1) asm volatile("" ::: "memory"); }
    }
};
template <class Epi, class Sched, bool ALIGN_EPI = false, bool SP2 = false>
__device__ __forceinline__ void gemm_phase(PG8_LAS unsigned char* lds, const Gemm g, const Sched& S, const Epi& E) {
    const int tid = threadIdx.x, wid = __builtin_amdgcn_readfirstlane(tid >> 6), lane = tid & 63, wr = wid >> 2, wc = wid & 3, fr = lane & 15, fq = lane >> 4;
    const int K = g.K, nt = K / BK, lda = g.lda;
    unsigned voffA[2], voffB[2];
#pragma unroll
    for (int i = 0; i < 2; ++i) { int R, C; stage_rc(tid * 16 + i * 8192, R, C); const int Rb = Epi::PERM ? ((R & ~31) + perm32(R & 31)) : R;
        voffA[i] = (unsigned)(R * lda + C) * 2u; voffB[i] = (unsigned)(Rb * K + C) * 2u; }
    const size_t kstep = (size_t)(BK * 2);
    const size_t hstepA = (size_t)HALF * lda * 2, hstepB = (size_t)HALF * K * 2;
    const size_t tstepA = 2 * hstepA, tstepB = 2 * hstepB;
    const unsigned ldsw = (unsigned)wid * 1024u;
    const int aoff = lds_byte(wr * 64 + fr, fq * 8), boff = lds_byte(wc * 32 + fr, fq * 8);
#define PG8_SA(b, h) (((b) * 2 + (h)) * HTB)
#define PG8_SB(b, h) ((4 + (b) * 2 + (h)) * HTB)
#define PG8_STAGE(bufoff, gbase, voff) do { _Pragma("unroll") for (int _i = 0; _i < 2; ++_i) \
        __builtin_amdgcn_global_load_lds((const unsigned*)((const char*)(gbase) + (voff)[_i]), (PG8_LAS unsigned*)(lds + (bufoff) + ldsw + _i * 8192), 16, 0, 0); } while (0)
#define PG8_LDA(dst, b, h) do { _Pragma("unroll") for (int m = 0; m < 4; ++m) _Pragma("unroll") for (int k = 0; k < 2; ++k) dst[m][k] = *(const PG8_LAS bf16x8*)(lds + PG8_SA(b, h) + aoff + m * 2048 + k * 1024); } while (0)
#define PG8_LDB(dst, b, h) do { _Pragma("unroll") for (int n = 0; n < 2; ++n) _Pragma("unroll") for (int k = 0; k < 2; ++k) dst[n][k] = *(const PG8_LAS bf16x8*)(lds + PG8_SB(b, h) + boff + n * 2048 + k * 1024); } while (0)
#define PG8_MMA(ai, bj, At, Bt) do { __builtin_amdgcn_s_setprio(1); _Pragma("unroll") for (int m = 0; m < 4; ++m) _Pragma("unroll") for (int n = 0; n < 2; ++n) _Pragma("unroll") for (int k = 0; k < 2; ++k) \
        acc[ai][bj][m][n] = __builtin_amdgcn_mfma_f32_16x16x32_bf16(Bt[n][k], At[m][k], acc[ai][bj][m][n], 0, 0, 0); __builtin_amdgcn_s_setprio(0); } while (0)
#define PG8_WAIT_V(n) asm volatile("s_waitcnt vmcnt(" #n ")" ::: "memory")
#define PG8_WAIT_L(n) asm volatile("s_waitcnt lgkmcnt(" #n ")" ::: "memory")
#define PG8_BAR __builtin_amdgcn_s_barrier()
#define PG8_SCHED __builtin_amdgcn_sched_barrier(0)
    Unit cur, nxt; int ui = 0;
    if (!S.next(0, cur)) return;
    f32x4 acc[2][2][4][2];
#pragma unroll
    for (int a = 0; a < 2; ++a)
#pragma unroll
        for (int b = 0; b < 2; ++b)
#pragma unroll
            for (int m = 0; m < 4; ++m)
#pragma unroll
                for (int n = 0; n < 2; ++n) acc[a][b][m][n] = (f32x4){0.f, 0.f, 0.f, 0.f};
    bf16x8 At[4][2], B0[2][2], B1[2][2];
    const char* cA = (const char*)g.A + (size_t)cur.pm * tstepA; const char* cB = (const char*)g.Bt + (size_t)cur.pn * tstepB;
    S.a_ready(cur);
    if constexpr (SP2) {
        PG8_STAGE(PG8_SB(0, 0), cB, voffB); PG8_STAGE(PG8_SB(0, 1), cB + hstepB, voffB); PG8_STAGE(PG8_SA(0, 0), cA, voffA); PG8_STAGE(PG8_SA(0, 1), cA + hstepA, voffA);
        if (wr == 1) PG8_BAR;
        PG8_WAIT_V(2); PG8_BAR;
        PG8_STAGE(PG8_SB(1, 0), cB + kstep, voffB); PG8_STAGE(PG8_SA(1, 0), cA + kstep, voffA); PG8_STAGE(PG8_SB(1, 1), cB + hstepB + kstep, voffB);
        PG8_WAIT_V(6); PG8_BAR;
    } else {
        PG8_STAGE(PG8_SB(0, 0), cB, voffB); PG8_STAGE(PG8_SA(0, 0), cA, voffA); PG8_STAGE(PG8_SB(0, 1), cB + hstepB, voffB); PG8_STAGE(PG8_SA(0, 1), cA + hstepA, voffA);
        if (wr == 1) PG8_BAR;
        PG8_WAIT_V(4); PG8_BAR;
        PG8_STAGE(PG8_SB(1, 0), cB + kstep, voffB); PG8_STAGE(PG8_SA(1, 0), cA + kstep, voffA); PG8_STAGE(PG8_SB(1, 1), cB + hstepB + kstep, voffB);
        PG8_WAIT_V(6); PG8_BAR;
    }
    for (;;) {
        const bool has_next = S.next(ui + 1, nxt);
        const char* nA = has_next ? (const char*)g.A + (size_t)nxt.pm * tstepA : cA; const char* nB = has_next ? (const char*)g.Bt + (size_t)nxt.pn * tstepB : cB;
        for (int t = 0; t < nt; t += 2) {
            const bool last = (t == nt - 2);
            const char* a1 = cA + (size_t)(t + 1) * kstep;
            const char* a2 = last ? nA : cA + (size_t)(t + 2) * kstep; const char* b2 = last ? nB : cB + (size_t)(t + 2) * kstep;
            const char* a3 = a2 + kstep; const char* b3 = b2 + kstep;
            if (last && has_next) S.a_ready(nxt);
            if constexpr (SP2) {
            PG8_LDB(B0, 0, 0); PG8_LDB(B1, 0, 1); PG8_SCHED; PG8_LDA(At, 0, 0); PG8_STAGE(PG8_SA(1, 1), a1 + hstepA, voffA);
            PG8_WAIT_V(8); PG8_WAIT_L(0); PG8_BAR; PG8_MMA(0, 0, At, B0); PG8_MMA(0, 1, At, B1); PG8_BAR; PG8_SCHED;
            PG8_LDA(At, 0, 1); PG8_STAGE(PG8_SB(0, 0), b2, voffB); PG8_STAGE(PG8_SB(0, 1), b2 + hstepB, voffB); PG8_STAGE(PG8_SA(0, 0), a2, voffA);
            PG8_WAIT_V(8); PG8_WAIT_L(0); PG8_BAR; PG8_MMA(1, 0, At, B0); PG8_MMA(1, 1, At, B1); PG8_BAR; PG8_SCHED;
            PG8_LDB(B0, 1, 0); PG8_LDB(B1, 1, 1); PG8_SCHED; PG8_LDA(At, 1, 0); PG8_STAGE(PG8_SA(0, 1), a2 + hstepA, voffA);
            PG8_WAIT_V(8); PG8_WAIT_L(0); PG8_BAR; PG8_MMA(0, 0, At, B0); PG8_MMA(0, 1, At, B1); PG8_BAR; PG8_SCHED;
            PG8_LDA(At, 1, 1); PG8_STAGE(PG8_SB(1, 0), b3, voffB); PG8_STAGE(PG8_SB(1, 1), b3 + hstepB, voffB); PG8_STAGE(PG8_SA(1, 0), a3, voffA);
            PG8_WAIT_V(8); PG8_WAIT_L(0); PG8_BAR; PG8_MMA(1, 0, At, B0); PG8_MMA(1, 1, At, B1); PG8_BAR; PG8_SCHED;
            } else {
            PG8_LDB(B0, 0, 0); PG8_SCHED; PG8_LDA(At, 0, 0); PG8_STAGE(PG8_SA(1, 1), a1 + hstepA, voffA);
            PG8_WAIT_L(8); PG8_BAR; PG8_WAIT_L(0); PG8_MMA(0, 0, At, B0); PG8_BAR; PG8_SCHED;
            PG8_LDB(B1, 0, 1); PG8_STAGE(PG8_SB(0, 0), b2, voffB);
            PG8_BAR; PG8_WAIT_L(0); PG8_MMA(0, 1, At, B1); PG8_BAR;
            PG8_LDA(At, 0, 1); PG8_STAGE(PG8_SA(0, 0), a2, voffA);
            PG8_BAR; PG8_WAIT_L(0); PG8_MMA(1, 0, At, B0); PG8_BAR; PG8_SCHED;
            PG8_STAGE(PG8_SB(0, 1), b2 + hstepB, voffB);
            PG8_WAIT_V(6); PG8_BAR; PG8_MMA(1, 1, At, B1); PG8_BAR;
            PG8_LDB(B0, 1, 0); PG8_SCHED; PG8_LDA(At, 1, 0); PG8_STAGE(PG8_SA(0, 1), a2 + hstepA, voffA);
            PG8_WAIT_L(8); PG8_BAR; PG8_WAIT_L(0); PG8_MMA(0, 0, At, B0); PG8_BAR; PG8_SCHED;
            PG8_LDB(B1, 1, 1); PG8_STAGE(PG8_SB(1, 0), b3, voffB);
            PG8_BAR; PG8_WAIT_L(0); PG8_MMA(0, 1, At, B1); PG8_BAR;
            PG8_LDA(At, 1, 1); PG8_STAGE(PG8_SA(1, 0), a3, voffA);
            PG8_BAR; PG8_WAIT_L(0); PG8_MMA(1, 0, At, B0); PG8_BAR; PG8_SCHED;
            PG8_STAGE(PG8_SB(1, 1), b3 + hstepB, voffB);
            PG8_WAIT_V(6); PG8_BAR; PG8_MMA(1, 1, At, B1); PG8_BAR;
            }
        }
        if constexpr (ALIGN_EPI) { if (wr == 0) PG8_BAR; }
        if constexpr (!Epi::AFTER_DRAIN) { E(acc, cur, wr, wc, fr, fq); S.done(cur); }
        if (!has_next) break;
#pragma unroll
        for (int a = 0; a < 2; ++a)
#pragma unroll
            for (int b = 0; b < 2; ++b)
#pragma unroll
                for (int m = 0; m < 4; ++m)
#pragma unroll
                    for (int n = 0; n < 2; ++n) acc[a][b][m][n] = (f32x4){0.f, 0.f, 0.f, 0.f};
        cur = nxt; cA = nA; cB = nB; ++ui;
        if constexpr (ALIGN_EPI) { if (wr == 1) PG8_BAR; }
    }
    PG8_WAIT_V(0);
    if constexpr (!ALIGN_EPI) { if (wr == 0) PG8_BAR; }
    PG8_BAR;
    if constexpr (Epi::AFTER_DRAIN) { E.fused(acc, cur, wr, wc, fr, fq, lds, wid, lane); S.done(cur); }
#undef PG8_SA
#undef PG8_SB
#undef PG8_STAGE
#undef PG8_LDA
#undef PG8_LDB
#undef PG8_MMA
#undef PG8_WAIT_V
#undef PG8_WAIT_L
#undef PG8_BAR
#undef PG8_SCHED
}
}

#ifndef MK_N_LAUNCHES
#define MK_N_LAUNCHES 1
#endif
#ifndef B_DUMMY
#define B_DUMMY 0
#endif
#ifndef DUP_PHASE
#define DUP_PHASE -1
#endif
constexpr int N_PHASES = 7;
constexpr int NWAVES = 8;
constexpr int DM = 2048, NB = 4, SEQ = 4096, CTXL = 256;
constexpr int ML = NB * SEQ, MC = NB * CTXL, MT = ML + MC;
constexpr int NIN = 6912;
constexpr int C_R = 0, C_K = 1024, C_V = 2048, C_LW = 3072, C_LA = 3200, C_ZR = 3328, C_Q = 4352, C_KA = 5376, C_VA = 5632, C_ZA = 5888;
constexpr float LOG2E = 1.4426950408889634f;
constexpr int DBG_LDS = 143360;

constexpr size_t MiB = 1u << 20;
constexpr size_t WS_CTL = 0, CTL_ZERO_BYTES = 64 * 1024;
constexpr size_t WS_MOD = 1 * MiB;
constexpr size_t WS_ROPE = 1 * MiB + 128 * 1024;
constexpr size_t WS_DBG = 1 * MiB + 192 * 1024;
constexpr size_t WS_W2T = 1 * MiB + 256 * 1024;
constexpr size_t WS_A2T = 1 * MiB + 512 * 1024;
constexpr size_t WS_WOUT = 2 * MiB;
constexpr size_t WS_P = 10 * MiB;
constexpr size_t WS_XN = 240 * MiB;
constexpr size_t WS_WIN = 308 * MiB;
constexpr size_t WS_GHQ = 240 * MiB;
constexpr size_t WS_MIX = 240 * MiB;
constexpr size_t WS_YF = 444 * MiB, WS_YB = 476 * MiB;
constexpr size_t WS_BON = 508 * MiB;
constexpr size_t WS_END = 510 * MiB;
static_assert(WS_P + (size_t)MT * NIN * 2 <= WS_XN && WS_XN + (size_t)MT * DM * 2 <= WS_WIN && WS_WIN + (size_t)NIN * DM * 2 <= WS_YF && WS_GHQ + (size_t)8704 * 24576 <= WS_YF && WS_YB + (size_t)ML * 1024 * 2 <= WS_BON, "ws map");

constexpr int CW_BAR = 1024;
constexpr int CW_TICKET = 8192;
constexpr int LDS_BYTES = 163840;
constexpr int MISC_OFF = LDS_BYTES - 256;

#define GAS __attribute__((address_space(1)))
#define LAS __attribute__((address_space(3)))
typedef unsigned short bf16;
typedef float f32x4 __attribute__((ext_vector_type(4)));
typedef float f32x16 __attribute__((ext_vector_type(16)));
typedef short bf16x8 __attribute__((ext_vector_type(8)));
typedef unsigned u32x4 __attribute__((ext_vector_type(4)));
typedef unsigned u32x2 __attribute__((ext_vector_type(2)));
typedef _Float16 h8 __attribute__((ext_vector_type(8)));
typedef _Float16 h4 __attribute__((ext_vector_type(4)));
typedef _Float16 h2 __attribute__((ext_vector_type(2)));
typedef GAS unsigned gu32;

__device__ __forceinline__ unsigned f2bf(float f) { unsigned u = __builtin_bit_cast(unsigned, f); return (u + 0x7fffu + ((u >> 16) & 1u)) >> 16; }
typedef float f32x2_t __attribute__((ext_vector_type(2))); typedef __bf16 bf16x2_t __attribute__((ext_vector_type(2)));
__device__ __forceinline__ unsigned pk2(float lo, float hi) { f32x2_t v = {lo, hi}; bf16x2_t b = __builtin_convertvector(v, bf16x2_t); return __builtin_bit_cast(unsigned, b); }
__device__ __forceinline__ float bflo(unsigned w) { return __builtin_bit_cast(float, w << 16); }
__device__ __forceinline__ float bfhi(unsigned w) { return __builtin_bit_cast(float, w & 0xffff0000u); }
__device__ __forceinline__ void unpack8(const u32x4 r, float* v) { v[0] = bflo(r.x); v[1] = bfhi(r.x); v[2] = bflo(r.y); v[3] = bfhi(r.y); v[4] = bflo(r.z); v[5] = bfhi(r.z); v[6] = bflo(r.w); v[7] = bfhi(r.w); }
__device__ __forceinline__ unsigned pkh(float a, float b) { h2 v = {(_Float16)a, (_Float16)b}; return __builtin_bit_cast(unsigned, v); }
__device__ __forceinline__ float wave_sum(float v) {
#pragma unroll
    for (int o = 1; o < 64; o <<= 1) v += __shfl_xor(v, o);
    return v;
}
__device__ __forceinline__ float fast_exp(float x) { return __builtin_amdgcn_exp2f(x * LOG2E); }
__device__ __forceinline__ float sigmoidf_(float x) { return __builtin_amdgcn_rcpf(1.0f + fast_exp(-x)); }
__device__ __forceinline__ float siluf_(float x) { return x * sigmoidf_(x); }
template <int CTRL> __device__ __forceinline__ float dpp_f(float x) { return __builtin_bit_cast(float, __builtin_amdgcn_update_dpp(0, __builtin_bit_cast(int, x), CTRL, 0xF, 0xF, false)); }

#define XB_TMO      128
#define XB_XCNT(j)  (256  + 64 * (j))
#define XB_XSUB(j)  (1280 + 64 * (j))
#define XB_XGEN(j)  (2304 + 64 * (j))
#define XB_TOP      3328
#define XB_TOPGEN   3392
#define XCD_BAR_WORDS 3456
#define XB_SPIN_CAP (1u << 18)
__device__ __forceinline__ unsigned xb_ld(unsigned* p)              { return __hip_atomic_load(p, __ATOMIC_RELAXED, __HIP_MEMORY_SCOPE_AGENT); }
__device__ __forceinline__ unsigned xb_add(unsigned* p, unsigned v) { return __hip_atomic_fetch_add(p, v, __ATOMIC_RELAXED, __HIP_MEMORY_SCOPE_AGENT); }
__device__ __forceinline__ unsigned xb_xcc_id() { return (unsigned)__builtin_amdgcn_s_getreg((3 << 11) | 20) & 0xFu; }
#define XB_SPIN(cond, bar) do { unsigned _sp = 0; while (cond) { __builtin_amdgcn_s_sleep(1); \
    if ((++_sp & 255u) == 0u) { if (xb_ld(&(bar)[XB_TMO])) break; if (_sp > XB_SPIN_CAP) { atomicAdd(&(bar)[XB_TMO], 1u); break; } } } } while (0)
struct XcdBarrier { unsigned* bar; unsigned x; volatile LAS unsigned* st; };
__device__ __forceinline__ XcdBarrier xcd_barrier_post(unsigned* bar, volatile LAS unsigned* st) {
    XcdBarrier b; b.bar = bar; b.x = xb_xcc_id(); b.st = st;
    if (threadIdx.x == 0) (void)xb_add(&bar[XB_XCNT(b.x)], 1u);
    return b;
}
__device__ __forceinline__ void xcd_barrier_complete(unsigned* bar, unsigned x, unsigned& nloc, unsigned& nx) {
    const unsigned G = gridDim.x * gridDim.y * gridDim.z;
    unsigned sum, cnt, mine, sp = 0u;
    for (;;) {
        sum = 0u; cnt = 0u; mine = 0u;
#pragma unroll
        for (unsigned j = 0; j < 16; ++j) { const unsigned c = xb_ld(&bar[XB_XCNT(j)]); sum += c; cnt += (c > 0u) ? 1u : 0u; mine = (j == x) ? c : mine; }
        if (sum == G) break;
        __builtin_amdgcn_s_sleep(1);
        if ((++sp & 255u) == 0u) { if (xb_ld(&bar[XB_TMO])) break; if (sp > XB_SPIN_CAP) { atomicAdd(&bar[XB_TMO], 1u); break; } }
    }
    nloc = mine > 0u ? mine : 1u; nx = cnt > 0u ? cnt : 1u;
}
__device__ __forceinline__ void xcd_barrier(const XcdBarrier& b) {
    asm volatile("s_waitcnt vmcnt(0)" ::: "memory");
    __syncthreads();
    if (threadIdx.x == 0) {
        unsigned* bar = b.bar;
        __builtin_amdgcn_s_waitcnt(0);
        unsigned nloc = b.st[0], nx = b.st[1];
        if (nloc == 0u) { xcd_barrier_complete(bar, b.x, nloc, nx); b.st[0] = nloc; b.st[1] = nx; }
        const unsigned old = xb_add(&bar[XB_XSUB(b.x)], 1u);
        const unsigned gen = old / nloc;
        if (old + 1u == (gen + 1u) * nloc) {
            __builtin_amdgcn_fence(__ATOMIC_RELEASE, "agent");
            asm volatile("s_waitcnt vmcnt(0)" ::: "memory");
            const unsigned og = xb_add(&bar[XB_TOP], 1u);
            const unsigned tg = og / nx;
            if (og + 1u == (tg + 1u) * nx) xb_add(&bar[XB_TOPGEN], 1u);
            else XB_SPIN(xb_ld(&bar[XB_TOPGEN]) == tg, bar);
            __builtin_amdgcn_fence(__ATOMIC_ACQUIRE, "agent");
            xb_add(&bar[XB_XGEN(b.x)], 1u);
            asm volatile("s_waitcnt vmcnt(0)" ::: "memory");
        } else {
            XB_SPIN(xb_ld(&bar[XB_XGEN(b.x)]) == gen, bar);
            __builtin_amdgcn_fence(__ATOMIC_ACQUIRE, "agent");
            asm volatile("s_waitcnt vmcnt(0)" ::: "memory");
        }
    }
    __syncthreads();
}

#define DBG_FINE (!(DBG_SEL >= 8 && DBG_SEL < 24))
#define TSTAMP(k) do { if (DBG_SEL >= 0 && (DBG_FINE || ((k) >= 8 && (k) < 24)) && F.bid == DBG_BLOCK && F.tid == 0) { volatile LAS unsigned long long* T_ = (volatile LAS unsigned long long*)(F.lds + DBG_LDS); const unsigned long long n_ = __builtin_amdgcn_s_memrealtime(); const unsigned long long m_ = __builtin_amdgcn_s_memtime(); T_[k] += n_ - T_[32]; T_[32] = n_; if ((k) < 8) { T_[24] += m_ - T_[33]; } T_[33] = m_; } } while (0)
#define TSTART() do { if (DBG_SEL >= 0 && F.bid == DBG_BLOCK && F.tid == 0) { volatile LAS unsigned long long* T_ = (volatile LAS unsigned long long*)(F.lds + DBG_LDS); T_[32] = __builtin_amdgcn_s_memrealtime(); T_[33] = __builtin_amdgcn_s_memtime(); } } while (0)
struct Frame {
    LAS unsigned char* lds;
    int tid, lane, wave, G, bid;
    const float *x, *c, *ctx, *c_ctx, *w_ada, *b_ada, *norm_g, *w_in, *mu_shift, *w0, *w2, *a0, *a2, *k_k, *k_a, *r_k, *ln_g, *ln_b, *qng, *kng, *sink, *w_out;
    float* out;
    float *MOD, *ROPE, *BON, *DBG;
    bf16 *W2T, *A2T, *WOUT, *P, *XN, *WIN, *YF, *YB, *MIX;
    unsigned char* GHQ;
};


typedef const float* cfp_t;
__device__ __forceinline__ const float* karg_f(int idx) { int off = idx * 8; asm volatile("" : "+s"(off)); const __attribute__((address_space(4))) char* kp = (const __attribute__((address_space(4))) char*)__builtin_amdgcn_kernarg_segment_ptr(); return *(const __attribute__((address_space(4))) cfp_t*)(kp + off); }
__device__ __forceinline__ void fresh(Frame& F) {
    int t_ = threadIdx.x; asm volatile("" : "+v"(t_)); F.tid = t_; F.lane = t_ & 63; F.wave = __builtin_amdgcn_readfirstlane(t_ >> 6);
    int b_ = blockIdx.x; asm volatile("" : "+s"(b_)); F.bid = b_;
    F.x = karg_f(0); F.c = karg_f(1); F.ctx = karg_f(2); F.c_ctx = karg_f(3); F.w_ada = karg_f(4); F.b_ada = karg_f(5); F.norm_g = karg_f(6); F.w_in = karg_f(7);
    F.mu_shift = karg_f(8); F.w0 = karg_f(9); F.w2 = karg_f(10); F.a0 = karg_f(11); F.a2 = karg_f(12); F.k_k = karg_f(13); F.k_a = karg_f(14); F.r_k = karg_f(15);
    F.ln_g = karg_f(16); F.ln_b = karg_f(17); F.qng = karg_f(18); F.kng = karg_f(19); F.sink = karg_f(20); F.w_out = karg_f(21);
    F.out = (float*)karg_f(22);
    unsigned char* ws = (unsigned char*)karg_f(23);
    F.MOD = (float*)(ws + WS_MOD); F.ROPE = (float*)(ws + WS_ROPE); F.BON = (float*)(ws + WS_BON); F.DBG = (float*)(ws + WS_DBG);
    F.W2T = (bf16*)(ws + WS_W2T); F.A2T = (bf16*)(ws + WS_A2T); F.WOUT = (bf16*)(ws + WS_WOUT); F.P = (bf16*)(ws + WS_P); F.XN = (bf16*)(ws + WS_XN); F.WIN = (bf16*)(ws + WS_WIN);
    F.YF = (bf16*)(ws + WS_YF); F.YB = (bf16*)(ws + WS_YB); F.MIX = (bf16*)(ws + WS_MIX); F.GHQ = ws + WS_GHQ;
}

struct Sched1 {
    int G, c;
    __device__ __forceinline__ void init(int G_, int c_) { G = G_; c = c_; }
    __device__ __forceinline__ bool next(int i, pg8::Unit& u) const {
        int grp, loc;
        if (G == 256) { if (i >= 7) return false; grp = c & 7; loc = i * 32 + (c >> 3); if (loc >= 216) { const int j = grp * 8 + (loc - 216); if (j >= 60) return false; u.pm = 64 + j / 15; const int q = j % 15; u.pn = q < 13 ? q : q + 8; return true; } }
        else { const int L = i * G + c; if (L >= 1788) return false; if (L >= 1728) { const int j = L - 1728; u.pm = 64 + j / 15; const int q = j % 15; u.pn = q < 13 ? q : q + 8; return true; } grp = L / 216; loc = L % 216; }
        u.pm = grp * 8 + (loc & 7); u.pn = loc >> 3; return true;
    }
    __device__ __forceinline__ void a_ready(const pg8::Unit&) const {}
    __device__ __forceinline__ void done(const pg8::Unit&) const {}
};

__device__ __forceinline__ void p0_transpose_item(const float* W, int K, int N, bf16* WT, LAS float* scr, int item, int lane) {
    const int nblk = N / 32, kb = item / nblk, nb = item % nblk, k0 = 64 * kb, n0 = 32 * nb;
#pragma unroll 8
    for (int i = 0; i < 32; ++i) { const int kk = 2 * i + (lane >> 5); scr[kk * 33 + (lane & 31)] = W[(size_t)(k0 + kk) * N + n0 + (lane & 31)]; }
    asm volatile("s_waitcnt lgkmcnt(0)" ::: "memory");
    const int c = lane & 7;
#pragma unroll
    for (int j = 0; j < 4; ++j) { const int n = (lane >> 3) + 8 * j; const LAS float* s = scr + (8 * c) * 33 + n;
        u32x4 o; o.x = pk2(s[0 * 33], s[1 * 33]); o.y = pk2(s[2 * 33], s[3 * 33]); o.z = pk2(s[4 * 33], s[5 * 33]); o.w = pk2(s[6 * 33], s[7 * 33]);
        *(GAS u32x4*)(WT + (size_t)(n0 + n) * K + k0 + 8 * c) = o; }
    asm volatile("s_waitcnt lgkmcnt(0)" ::: "memory");
}
__device__ __forceinline__ void p0_prologue(Frame& F) {
    const int tid = F.tid, lane = F.lane, wave = F.wave;
    if (F.bid < 192) {
        LAS float* sl = (LAS float*)F.lds;
        LAS float* red = sl + 5 * 2048;
        for (int i = tid; i < 5 * 2048; i += NWAVES * 64) { const int v = i >> 11, k = i & 2047; const float cv = v < 4 ? F.c[v * 2048 + k] : F.c_ctx[k]; sl[i] = cv / (1.0f + __expf(-cv)); }
        __syncthreads();
        const int n0 = 32 * F.bid, col = lane & 31, slot = wave * 2 + (lane >> 5);
        float acc[5] = {0.f, 0.f, 0.f, 0.f, 0.f};
        const float* wp = F.w_ada + n0 + col;
#pragma unroll 8
        for (int k = slot; k < 2048; k += 16) { const float w = wp[(size_t)k * 6144];
#pragma unroll
            for (int v = 0; v < 5; ++v) acc[v] += sl[v * 2048 + k] * w; }
#pragma unroll
        for (int v = 0; v < 5; ++v) red[(slot * 5 + v) * 32 + col] = acc[v];
        __syncthreads();
        if (tid < 160) { const int v = tid >> 5, cc = tid & 31; float s = 0.f;
#pragma unroll
            for (int q = 0; q < 16; ++q) s += red[(q * 5 + v) * 32 + cc];
            F.MOD[v * 6144 + n0 + cc] = s + F.b_ada[n0 + cc]; }
        __syncthreads();
    }
    if (F.bid == F.G - 1) {
        for (int i = tid; i < 1024; i += NWAVES * 64) { const int pos = i >> 4, f = i & 15; const float inv = exp2f(-(float)f * (13.287712379549449f / 16.0f)); const float ang = (float)pos * inv;
            F.ROPE[i] = cosf(ang); F.ROPE[1024 + i] = sinf(ang); }
    }
    LAS float* scr = (LAS float*)(F.lds + wave * 16384);
    const int gw = F.bid * NWAVES + wave, NGW = F.G * NWAVES;
    constexpr int I_IN = (DM / 64) * (NIN / 32), I_OUT = (DM / 64) * (DM / 32), I_L = 1024 / 32;
    constexpr int NITEMS = I_IN + I_OUT + 4 * I_L;
    for (int it = gw; it < NITEMS; it += NGW) {
        int r = it;
        if (r < I_IN) { p0_transpose_item(F.w_in, DM, NIN, F.WIN, scr, r, lane); continue; } r -= I_IN;
        if (r < I_OUT) { p0_transpose_item(F.w_out, DM, DM, F.WOUT, scr, r, lane); continue; } r -= I_OUT;
        const int q = r / I_L; r -= q * I_L;
        p0_transpose_item((q < 2 ? F.w2 : F.a2) + (size_t)(q & 1) * 64 * 1024, 64, 1024, (q < 2 ? F.W2T : F.A2T) + (size_t)(q & 1) * 1024 * 64, scr, r, lane);
    }
}

__device__ __forceinline__ void p1_modulate(Frame& F) {
    const int gw = F.bid * NWAVES + F.wave, NGW = F.G * NWAVES, lane = F.lane;
    const int m_lo = (int)(((long)gw * MT) / NGW), m_hi = (int)(((long)(gw + 1) * MT) / NGW);
    f32x4 gs[8], sh[8]; int cur = -1;
    for (int m = m_lo; m < m_hi; ++m) {
        const float* src = m < ML ? F.x + (size_t)m * DM : F.ctx + (size_t)(m - ML) * DM;
        const int bsel = m < ML ? (m >> 12) : 4;
        if (bsel != cur) { cur = bsel; const float* mod = F.MOD + bsel * 6144;
#pragma unroll
            for (int j = 0; j < 8; ++j) { const int d0 = (64 * j + lane) * 4; gs[j] = *(const f32x4*)(F.norm_g + d0) * (1.0f + *(const f32x4*)(mod + 2048 + d0)); sh[j] = *(const f32x4*)(mod + d0); } }
        const GAS f32x4* xr = (const GAS f32x4*)src + lane;
        f32x4 v[8]; float s = 0.f;
#pragma unroll
        for (int j = 0; j < 8; ++j) { v[j] = xr[64 * j]; s += (v[j].x * v[j].x + v[j].y * v[j].y) + (v[j].z * v[j].z + v[j].w * v[j].w); }
        const float rr = 1.0f / sqrtf(wave_sum(s) * (1.0f / DM) + 1e-6f);
        GAS u32x2* o8 = (GAS u32x2*)(F.XN + (size_t)m * DM) + lane;
#pragma unroll
        for (int j = 0; j < 8; ++j) { const f32x4 o = v[j] * rr * gs[j] + sh[j]; u32x2 w; w.x = pk2(o.x, o.y); w.y = pk2(o.z, o.w); o8[64 * j] = w; }
    }
}

__device__ __forceinline__ int seq_lo(int m) { return m < ML ? (m & ~(SEQ - 1)) : ML + ((m - ML) & ~(CTXL - 1)); }
__device__ __forceinline__ int seq_hi(int m) { return m < ML ? (m | (SEQ - 1)) : ML + ((m - ML) | (CTXL - 1)); }
__device__ __forceinline__ int scan_row(int b, int d, int blk, int tok) {
    const int j = blk < 4 ? blk * 64 + tok : (blk - 4) * 64 + tok;
    if (blk < 4) return ML + b * CTXL + (d ? (CTXL - 1 - j) : j);
    return b * SEQ + (d ? (SEQ - 1 - j) : j);
}
constexpr int CH_RS = 144, CH_MB = 64 * CH_RS;
constexpr int CB_AT = 0, CB_BT = 1, CB_KT = 2, CB_RT = 3, CB_ATT = 4, CB_BTT = 5, CB_KTT = 6, CB_VT = 7, CB_AAB = 8, CB_AABT = 9, CB_AAK = 10, CB_ARB = 11, CB_ARK = 12, CB_X1 = 13, CB_XT = 14, CB_INV = 4, CB_OY = 4, CB_OG = 5, CB_OH = 6, CB_OQ = 7;
constexpr int CH_WBUF = 8 * CH_MB, CH_ABUF = CH_WBUF + 16384;
constexpr int CH_PT = 15 * CH_MB, CH_GT = CH_PT + 1024, CH_CONST = CH_GT + 2048;
constexpr int CH_LW = 144384;
#ifndef FORCE_BF16
#define FORCE_BF16 0
#endif
constexpr size_t GHQ_ITEM = 24576;
#define LBAR() do { asm volatile("s_waitcnt lgkmcnt(0)" ::: "memory"); __builtin_amdgcn_s_barrier(); asm volatile("" ::: "memory"); } while (0)
__device__ __forceinline__ float h_lo(unsigned w) { return (float)__builtin_bit_cast(h2, w)[0]; }
__device__ __forceinline__ float h_hi(unsigned w) { return (float)__builtin_bit_cast(h2, w)[1]; }
__device__ __forceinline__ f32x4 unpack4x(bool f16, const u32x2 w) { f32x4 r;
    if (f16) { r.x = h_lo(w.x); r.y = h_hi(w.x); r.z = h_lo(w.y); r.w = h_hi(w.y); } else { r.x = bflo(w.x); r.y = bfhi(w.x); r.z = bflo(w.y); r.w = bfhi(w.y); }
    return r; }
__device__ __forceinline__ u32x4 pack8x(bool f16, const float* v) { u32x4 o;
    if (f16) { o.x = pkh(v[0], v[1]); o.y = pkh(v[2], v[3]); o.z = pkh(v[4], v[5]); o.w = pkh(v[6], v[7]); } else { o.x = pk2(v[0], v[1]); o.y = pk2(v[2], v[3]); o.z = pk2(v[4], v[5]); o.w = pk2(v[6], v[7]); }
    return o; }
__device__ __forceinline__ f32x16 mm32(bool f16, const LAS unsigned char* Aop, int mrow0, const LAS unsigned char* Blay, int nrow0, f32x16 acc, int l31, int hi) {
    const LAS unsigned char* pa = Aop + (mrow0 + l31) * CH_RS + hi * 16;
    const LAS unsigned char* pb = Blay + (nrow0 + l31) * CH_RS + hi * 16;
    bf16x8 a[4], b[4];
#pragma unroll
    for (int ks = 0; ks < 4; ++ks) { a[ks] = *(const LAS bf16x8*)(pa + ks * 32); b[ks] = *(const LAS bf16x8*)(pb + ks * 32); }
    if (f16) {
#pragma unroll
        for (int ks = 0; ks < 4; ++ks) acc = __builtin_amdgcn_mfma_f32_32x32x16_f16(__builtin_bit_cast(h8, a[ks]), __builtin_bit_cast(h8, b[ks]), acc, 0, 0, 0);
    } else {
#pragma unroll
        for (int ks = 0; ks < 4; ++ks) acc = __builtin_amdgcn_mfma_f32_32x32x16_bf16(a[ks], b[ks], acc, 0, 0, 0);
    }
    return acc;
}
__device__ __forceinline__ f32x16 mm32k(bool f16, const LAS unsigned char* Aop, int mrow0, const LAS unsigned char* Blay, int nrow0, int kb, f32x16 acc, int l31, int hi) {
    const LAS unsigned char* pa = Aop + (mrow0 + l31) * CH_RS + kb * 64 + hi * 16;
    const LAS unsigned char* pb = Blay + (nrow0 + l31) * CH_RS + kb * 64 + hi * 16;
    const bf16x8 a0 = *(const LAS bf16x8*)pa, a1 = *(const LAS bf16x8*)(pa + 32), b0 = *(const LAS bf16x8*)pb, b1 = *(const LAS bf16x8*)(pb + 32);
    if (f16) { acc = __builtin_amdgcn_mfma_f32_32x32x16_f16(__builtin_bit_cast(h8, a0), __builtin_bit_cast(h8, b0), acc, 0, 0, 0); acc = __builtin_amdgcn_mfma_f32_32x32x16_f16(__builtin_bit_cast(h8, a1), __builtin_bit_cast(h8, b1), acc, 0, 0, 0); }
    else { acc = __builtin_amdgcn_mfma_f32_32x32x16_bf16(a0, b0, acc, 0, 0, 0); acc = __builtin_amdgcn_mfma_f32_32x32x16_bf16(a1, b1, acc, 0, 0, 0); }
    return acc;
}
typedef short s16x4 __attribute__((ext_vector_type(4))); typedef short s16x8 __attribute__((ext_vector_type(8)));
__device__ __forceinline__ bf16x8 trfrag(const LAS unsigned char* Img, int j0, int c0, int lane) {
    const int g = lane >> 4, q = (lane >> 2) & 3, p = lane & 3;
    LAS unsigned char* a = (LAS unsigned char*)Img + (j0 + 8 * (g >> 1) + q) * CH_RS + (c0 + 16 * (g & 1) + 4 * p) * 2;
    const s16x4 r0 = __builtin_amdgcn_ds_read_tr16_b64_v4i16((LAS s16x4*)a), r1 = __builtin_amdgcn_ds_read_tr16_b64_v4i16((LAS s16x4*)(a + 4 * CH_RS));
    return __builtin_bit_cast(bf16x8, __builtin_shufflevector(r0, r1, 0, 1, 2, 3, 4, 5, 6, 7));
}
template<bool TA, bool TB> __device__ __forceinline__ f32x16 mm32x(bool f16, const LAS unsigned char* A, int a0, const LAS unsigned char* B, int b0, f32x16 acc, int lane) {
    const int l31 = lane & 31, hi = lane >> 5;
    bf16x8 a[4], b[4];
#pragma unroll
    for (int ks = 0; ks < 4; ++ks) {
        a[ks] = TA ? trfrag(A, 16 * ks, a0, lane) : *(const LAS bf16x8*)(A + (a0 + l31) * CH_RS + hi * 16 + ks * 32);
        b[ks] = TB ? trfrag(B, 16 * ks, b0, lane) : *(const LAS bf16x8*)(B + (b0 + l31) * CH_RS + hi * 16 + ks * 32); }
    if (f16) {
#pragma unroll
        for (int ks = 0; ks < 4; ++ks) acc = __builtin_amdgcn_mfma_f32_32x32x16_f16(__builtin_bit_cast(h8, a[ks]), __builtin_bit_cast(h8, b[ks]), acc, 0, 0, 0);
    } else {
#pragma unroll
        for (int ks = 0; ks < 4; ++ks) acc = __builtin_amdgcn_mfma_f32_32x32x16_bf16(a[ks], b[ks], acc, 0, 0, 0);
    }
    return acc;
}
__device__ __forceinline__ void st_nat(bool f16, LAS unsigned char* Out, int mrow0, int nrow0, const f32x16& acc, int l31, int hi) {
    LAS unsigned char* p = Out + (nrow0 + l31) * CH_RS + (mrow0 + 4 * hi) * 2;
    if (f16) {
#pragma unroll
        for (int rg = 0; rg < 4; ++rg) { u32x2 o; o.x = pkh(acc[4 * rg], acc[4 * rg + 1]); o.y = pkh(acc[4 * rg + 2], acc[4 * rg + 3]); *(LAS u32x2*)(p + rg * 16) = o; }
    } else {
#pragma unroll
        for (int rg = 0; rg < 4; ++rg) { u32x2 o; o.x = pk2(acc[4 * rg], acc[4 * rg + 1]); o.y = pk2(acc[4 * rg + 2], acc[4 * rg + 3]); *(LAS u32x2*)(p + rg * 16) = o; }
    }
}
__device__ __forceinline__ f32x16 zero16() { f32x16 z = {0.f, 0.f, 0.f, 0.f, 0.f, 0.f, 0.f, 0.f, 0.f, 0.f, 0.f, 0.f, 0.f, 0.f, 0.f, 0.f}; return z; }
struct ChRegs { u32x4 r, k, v, lw, la, halo; };
__device__ __forceinline__ int chunk_mlo(int b, int d, int c) { return d ? scan_row(b, d, c, 63) : scan_row(b, d, c, 0); }
__device__ __forceinline__ void ch_load(Frame& F, ChRegs& R, int b, int h, int d, int c) {
    const int tok = F.tid >> 3, ch = F.tid & 7, m = scan_row(b, d, c, tok);
    const bf16* pc = F.P + (size_t)m * NIN + 8 * ch;
    const int cr = C_R + h * 64, ck = C_K + h * 64, cv = C_V + h * 64, cw = C_LW + d * 64, ca = C_LA + d * 64;
    R.r = *(const u32x4*)(pc + cr); R.k = *(const u32x4*)(pc + ck); R.v = *(const u32x4*)(pc + cv); R.lw = *(const u32x4*)(pc + cw); R.la = *(const u32x4*)(pc + ca);
    const u32x4 z = {0u, 0u, 0u, 0u}; R.halo = z;
    if (F.tid < 80) { const int hrow = F.tid >= 40 ? 1 : 0, vec = (F.tid - 40 * hrow) >> 3, mlo = chunk_mlo(b, d, c), mh = hrow ? mlo + 64 : mlo - 1;
        const int col = vec == 0 ? cr : vec == 1 ? ck : vec == 2 ? cv : vec == 3 ? cw : ca;
        if (mh >= seq_lo(mlo) && mh <= seq_hi(mlo)) R.halo = *(const u32x4*)(F.P + (size_t)mh * NIN + col + 8 * ch); }
}
constexpr int CH_RAW3 = 0 * CH_MB, CH_RAWL = 10 * CH_MB;
__device__ __forceinline__ void ch_park(Frame& F, const ChRegs& R, int b, int d, int c) {
    LAS unsigned char* lds = F.lds; const int tok = F.tid >> 3, ch = F.tid & 7, ri = 1 + scan_row(b, d, c, tok) - chunk_mlo(b, d, c);
    LAS unsigned char* p3 = lds + CH_RAW3 + ri * 384 + ch * 16; LAS unsigned char* pl = lds + CH_RAWL + ri * 256 + ch * 16;
    *(LAS u32x4*)p3 = R.r; *(LAS u32x4*)(p3 + 128) = R.k; *(LAS u32x4*)(p3 + 256) = R.v; *(LAS u32x4*)pl = R.lw; *(LAS u32x4*)(pl + 128) = R.la;
    if (F.tid < 80) { const int hrow = F.tid >= 40 ? 1 : 0, vec = (F.tid - 40 * hrow) >> 3, rh = hrow ? 65 : 0;
        if (vec < 3) *(LAS u32x4*)(lds + CH_RAW3 + rh * 384 + vec * 128 + ch * 16) = R.halo; else *(LAS u32x4*)(lds + CH_RAWL + rh * 256 + (vec - 3) * 128 + ch * 16) = R.halo; }
}
__device__ __forceinline__ void shift8(const u32x4 c, const u32x4 p, const u32x4 n, const LAS f32x4* mu, float* o) {
    float vc[8], vp[8], vn[8]; unpack8(c, vc); unpack8(p, vp); unpack8(n, vn);
    const f32x4 m0 = mu[0], m1 = mu[1];
#pragma unroll
    for (int j = 0; j < 8; ++j) { const float mm = j < 4 ? m0[j & 3] : m1[j & 3]; o[j] = vc[j] + mm * (0.5f * (vp[j] + vn[j]) - vc[j]); }
}
template<bool F16> __device__ __forceinline__ f32x16 mf2(const u32x4 a0, const u32x4 a1, const u32x4 b0, const u32x4 b1, f32x16 acc) {
    if (F16) { acc = __builtin_amdgcn_mfma_f32_32x32x16_f16(__builtin_bit_cast(h8, a0), __builtin_bit_cast(h8, b0), acc, 0, 0, 0); acc = __builtin_amdgcn_mfma_f32_32x32x16_f16(__builtin_bit_cast(h8, a1), __builtin_bit_cast(h8, b1), acc, 0, 0, 0); }
    else { acc = __builtin_amdgcn_mfma_f32_32x32x16_bf16(__builtin_bit_cast(bf16x8, a0), __builtin_bit_cast(bf16x8, b0), acc, 0, 0, 0); acc = __builtin_amdgcn_mfma_f32_32x32x16_bf16(__builtin_bit_cast(bf16x8, a1), __builtin_bit_cast(bf16x8, b1), acc, 0, 0, 0); }
    return acc; }
template<bool F16> __device__ __forceinline__ void cv2(const f32x16& a, u32x4& s0, u32x4& s1) {
    if (F16) { s0.x = pkh(a[0], a[1]); s0.y = pkh(a[2], a[3]); s0.z = pkh(a[4], a[5]); s0.w = pkh(a[6], a[7]); s1.x = pkh(a[8], a[9]); s1.y = pkh(a[10], a[11]); s1.z = pkh(a[12], a[13]); s1.w = pkh(a[14], a[15]); }
    else { s0.x = pk2(a[0], a[1]); s0.y = pk2(a[2], a[3]); s0.z = pk2(a[4], a[5]); s0.w = pk2(a[6], a[7]); s1.x = pk2(a[8], a[9]); s1.y = pk2(a[10], a[11]); s1.z = pk2(a[12], a[13]); s1.w = pk2(a[14], a[15]); } }
template<bool F16, bool TR> __device__ __forceinline__ f32x16 inv_chain(const f32x16& ap0, const f32x16& aq0, int l31, int hi) {
    u32x4 p0, p1, q0, q1, x0, x1;
    cv2<F16>(ap0, p0, p1); cv2<F16>(aq0, q0, q1);
    f32x16 x = TR ? aq0 : ap0;
#pragma unroll
    for (int r = 0; r < 16; ++r) { const int row = (r & 3) + 8 * (r >> 2) + 4 * hi; if (row == l31) x[r] += 1.0f; }
    cv2<F16>(x, x0, x1);
#pragma unroll
    for (int k = 1; k <= 4; ++k) {
        const bool needP = (k < 4) || TR, needQ = (k < 4) || !TR;
        f32x16 ap = zero16(), aq = zero16();
        if (needP) ap = mf2<F16>(q0, q1, p0, p1, ap);
        if (needQ) aq = mf2<F16>(p0, p1, q0, q1, aq);
        if (needP) cv2<F16>(ap, p0, p1);
        if (needQ) cv2<F16>(aq, q0, q1);
        x = TR ? mf2<F16>(p0, p1, x0, x1, x) : mf2<F16>(q0, q1, x0, x1, x);
        if (k < 4) cv2<F16>(x, x0, x1);
    }
    return x;
}
template<bool F16> __device__ __forceinline__ void chain_wave(LAS unsigned char* lds, int wave, int lane, u32x4& t0, u32x4& t1) {
    const int l31 = lane & 31, hi = lane >> 5, o = wave == 2 ? 32 : 0;
    const LAS unsigned char* At = lds + CB_AT * CH_MB; const LAS unsigned char* Bt = lds + CB_BT * CH_MB;
    f32x16 aq = mm32(F16, Bt, o, At, o, zero16(), l31, hi);
    f32x16 ap = mm32(F16, At, o, Bt, o, zero16(), l31, hi);
#pragma unroll
    for (int r = 0; r < 16; ++r) { const int row = (r & 3) + 8 * (r >> 2) + 4 * hi; aq[r] = row < l31 ? aq[r] : 0.f; ap[r] = l31 < row ? ap[r] : 0.f; }
    if (wave != 3) { const f32x16 x = inv_chain<F16, true>(ap, aq, l31, hi); st_nat(F16, lds + CB_INV * CH_MB, o, o, x, l31, hi); if (wave == 2) cv2<F16>(x, t0, t1); }
    else { const f32x16 x1 = inv_chain<F16, false>(ap, aq, l31, hi);
        u32x4 b0, b1, a0, a1, u0, u1; cv2<F16>(x1, b0, b1);
        const f32x16 a21 = mm32(F16, Bt, 0, At, 32, zero16(), l31, hi);
        cv2<F16>(a21, a0, a1);
        const f32x16 u = mf2<F16>(a0, a1, b0, b1, zero16());
        cv2<F16>(u, u0, u1);
        *(LAS u32x4*)(lds + CB_AAB * CH_MB + lane * 16) = u0; *(LAS u32x4*)(lds + CB_AAB * CH_MB + 1024 + lane * 16) = u1; }
}
__device__ __forceinline__ void ch_tail(const bool f16, Frame& F, ChRegs& R, const float (&sr)[8], const float (&sk)[8], const float (&sv)[8], int b, int h, int d, int c, int chain, int ci) {
    int lane_ = F.lane; asm volatile("" : "+v"(lane_));
    const int tid = F.tid, lane = lane_, wave = F.wave, l31 = lane & 31, hi = lane >> 5;
    const int q4 = wave & 3, tb = q4 >> 1, cb = q4 & 1, tok = tid >> 3, ch = tid & 7;
    LAS unsigned char* lds = F.lds;
    const LAS f32x4* cs = (const LAS f32x4*)(lds + CH_CONST) + 2 * ch;
    const LAS float* pT = (const LAS float*)(lds + CH_PT);
#define CB(i) (lds + (i) * CH_MB)
    { const LAS f32x4* pw = (const LAS f32x4*)(lds + CH_WBUF) + tok * 16 + 2 * ch; const LAS f32x4* pab = (const LAS f32x4*)(lds + CH_ABUF) + tok * 16 + 2 * ch;
      const f32x4 p0 = pw[0], p1 = pw[1], a0v = pab[0], a1v = pab[1];
      f32x4 m0 = {1.f, 1.f, 1.f, 1.f}, m1 = m0; if (tok > 0) { m0 = pw[-16]; m1 = pw[-15]; }
      const f32x4 r0 = *(const LAS f32x4*)(pT + 64 + 8 * ch), r1 = *(const LAS f32x4*)(pT + 64 + 8 * ch + 4);
      const f32x4 kk0 = cs[80], kk1 = cs[81], ka0 = cs[96], ka1 = cs[97], rk0 = cs[112], rk1 = cs[113];
      float kk[8], ss = 0.f;
#pragma unroll
      for (int j = 0; j < 8; ++j) { kk[j] = sk[j] * (j < 4 ? kk0[j & 3] : kk1[j & 3]); ss += kk[j] * kk[j]; }
      ss += __shfl_xor(ss, 1); ss += __shfl_xor(ss, 2); ss += __shfl_xor(ss, 4);
      const float inv = __builtin_amdgcn_rsqf(fmaxf(ss, 1e-24f));
      float at[8], bt[8], kt[8], rt[8], bon = 0.f;
#pragma unroll
      for (int j = 0; j < 8; ++j) { const float P = j < 4 ? p0[j & 3] : p1[j & 3], Pm = j < 4 ? m0[j & 3] : m1[j & 3], a = j < 4 ? a0v[j & 3] : a1v[j & 3], pr = j < 4 ? r0[j & 3] : r1[j & 3];
          const float kac = j < 4 ? ka0[j & 3] : ka1[j & 3], rkc = j < 4 ? rk0[j & 3] : rk1[j & 3];
          const float kn = kk[j] * inv, kd = sk[j] * (1.0f + (a - 1.0f) * kac), ipr = __builtin_amdgcn_rcpf(pr), rp = pr * __builtin_amdgcn_rcpf(P);
          at[j] = -kn * Pm * ipr; bt[j] = kn * a * rp; kt[j] = kd * rp; rt[j] = sr[j] * P * ipr; bon += sr[j] * kd * rkc; }
      bon += __shfl_xor(bon, 1); bon += __shfl_xor(bon, 2); bon += __shfl_xor(bon, 4);
      if (ch == 0 && c >= 4) F.BON[((size_t)d * ML + scan_row(b, d, c, tok)) * 16 + h] = bon;
      *(LAS u32x4*)(CB(CB_AT) + tok * CH_RS + ch * 16) = pack8x(f16, at);
      *(LAS u32x4*)(CB(CB_BT) + tok * CH_RS + ch * 16) = pack8x(f16, bt);
      *(LAS u32x4*)(CB(CB_KT) + tok * CH_RS + ch * 16) = pack8x(f16, kt);
      *(LAS u32x4*)(CB(CB_RT) + tok * CH_RS + ch * 16) = pack8x(f16, rt);
      *(LAS u32x4*)(CB(CB_X1) + tok * CH_RS + ch * 16) = pack8x(f16, sv); }
    LBAR(); TSTAMP(3);
    const bool chainw = wave == 0 || wave == 2 || wave == 3;
    if (!chainw && ci + 1 < 34) ch_load(F, R, b, h, d, c + 1);
    u32x4 t0 = {0u, 0u, 0u, 0u}, t1 = t0;
    if (chainw) { if (f16) chain_wave<true>(lds, wave, lane, t0, t1); else chain_wave<false>(lds, wave, lane, t0, t1); }
    else { const bool mid = wave >= 4 && wave <= 6;
#pragma unroll 1
      for (int i = 0; i < 2; ++i) { if (wave == 1 && i == 1) break;
          const int pr = wave == 1 ? 1 : wave == 7 ? 2 + i : wave - 3, jb = mid ? i : 0, tbk = mid ? 1 : 0;
          const LAS unsigned char* Aop = CB((pr & 1) ? CB_KT : CB_BT); const LAS unsigned char* Blay = CB(pr < 2 ? CB_AT : CB_RT);
          LAS unsigned char* Out = CB(CB_AAB + 1 + pr);
          f32x16 a = mm32(f16, Aop, jb * 32, Blay, tbk * 32, zero16(), l31, hi);
          if (jb == tbk) { const bool incl = pr >= 2;
#pragma unroll
              for (int r = 0; r < 16; ++r) { const int j = (r & 3) + 8 * (r >> 2) + 4 * hi; const bool ok = incl ? (j <= l31) : (j < l31); a[r] = ok ? a[r] : 0.f; } }
          st_nat(f16, Out, jb * 32, tbk * 32, a, l31, hi); }
      if (wave == 1) { st_nat(f16, CB(CB_AAK), 32, 0, zero16(), l31, hi); st_nat(f16, CB(CB_INV), 32, 0, zero16(), l31, hi); }
      if (wave == 7) { st_nat(f16, CB(CB_ARB), 32, 0, zero16(), l31, hi); st_nat(f16, CB(CB_ARK), 32, 0, zero16(), l31, hi); } }
    LBAR(); TSTAMP(4);
    if ((wave == 0 || wave == 3) && ci + 1 < 34) ch_load(F, R, b, h, d, c + 1);
    if (wave == 2) { const u32x4 u0 = *(const LAS u32x4*)(CB(CB_AAB) + lane * 16), u1 = *(const LAS u32x4*)(CB(CB_AAB) + 1024 + lane * 16);
        const f32x16 y = f16 ? mf2<true>(u0, u1, t0, t1, zero16()) : mf2<false>(u0, u1, t0, t1, zero16());
        st_nat(f16, CB(CB_INV), 0, 32, y, l31, hi);
        if (ci + 1 < 34) ch_load(F, R, b, h, d, c + 1); }
    else if (wave >= 4) { const f32x16 acc = mm32x<false, true>(f16, CB(CB_AAK), tb * 32, CB(CB_X1), cb * 32, zero16(), lane); st_nat(f16, CB(CB_XT), tb * 32, cb * 32, acc, l31, hi); }
    LBAR();
    TSTAMP(5);
    { f32x16 acc = wave < 4 ? mm32x<false, true>(f16, CB(CB_INV), tb * 32, CB(CB_AT), cb * 32, zero16(), lane) : mm32(f16, CB(CB_INV), tb * 32, CB(CB_XT), cb * 32, zero16(), l31, hi);
      st_nat(f16, CB(wave < 4 ? CB_AAB : CB_AABT), tb * 32, cb * 32, acc, l31, hi); }
    LBAR(); TSTAMP(6);
    { const int om = wave >> 1, nb = wave & 1;
      int c_ = c; asm volatile("" : "+s"(c_));
#pragma unroll
      for (int mb = 0; mb < 2; ++mb) {
          if (om == 0) {
              f32x16 acc; const LAS unsigned char* p = CB(CB_RT) + (nb * 32 + l31) * CH_RS + (mb * 32 + 4 * hi) * 2;
#pragma unroll
              for (int rg = 0; rg < 4; ++rg) { const u32x2 w = *(const LAS u32x2*)(p + rg * 16); const f32x4 u = unpack4x(f16, w); acc[4 * rg] = u.x; acc[4 * rg + 1] = u.y; acc[4 * rg + 2] = u.z; acc[4 * rg + 3] = u.w; }
              acc = mm32(f16, CB(CB_AAB), mb * 32, CB(CB_ARB), nb * 32, acc, l31, hi);
              LAS unsigned char* o = CB(CB_OQ) + (nb * 32 + l31) * CH_RS + (mb * 32 + 4 * hi) * 2;
#pragma unroll
              for (int rg = 0; rg < 4; ++rg) { const f32x4 pv = *(const LAS f32x4*)(pT + 64 + mb * 32 + 8 * rg + 4 * hi);
                  u32x2 w; w.x = pkh(acc[4 * rg] * pv.x, acc[4 * rg + 1] * pv.y); w.y = pkh(acc[4 * rg + 2] * pv.z, acc[4 * rg + 3] * pv.w); *(LAS u32x2*)(o + rg * 16) = w; }
          } else if (om == 1) {
              f32x16 acc = mm32x<false, true>(f16, CB(CB_AAB), mb * 32, CB(CB_BT), nb * 32, zero16(), lane);
              const float pto = pT[nb * 32 + l31], ptk = pT[128 + nb * 32 + l31];
              LAS unsigned char* o = CB(CB_OG) + (nb * 32 + l31) * CH_RS + (mb * 32 + 4 * hi) * 2;
#pragma unroll
              for (int rg = 0; rg < 4; ++rg) { const f32x4 pv = *(const LAS f32x4*)(pT + 64 + mb * 32 + 8 * rg + 4 * hi); float g[4];
#pragma unroll
                  for (int i = 0; i < 4; ++i) { const int kp = mb * 32 + 8 * rg + 4 * hi + i; g[i] = pto * pv[i] * acc[4 * rg + i] + (kp == nb * 32 + l31 ? ptk : 0.0f); }
                  u32x2 w; w.x = pkh(g[0], g[1]); w.y = pkh(g[2], g[3]); *(LAS u32x2*)(o + rg * 16) = w; }
          } else if (om == 2) {
              f32x16 acc = mm32x<true, false>(f16, CB(CB_BT), mb * 32, CB(CB_AABT), nb * 32, zero16(), lane);
              acc = mm32x<true, true>(f16, CB(CB_KT), mb * 32, CB(CB_X1), nb * 32, acc, lane);
              LAS unsigned char* o = CB(CB_OH) + (nb * 32 + l31) * CH_RS + (mb * 32 + 4 * hi) * 2;
#pragma unroll
              for (int rg = 0; rg < 4; ++rg) { const f32x4 pv = *(const LAS f32x4*)(pT + mb * 32 + 8 * rg + 4 * hi);
                  u32x2 w; w.x = pkh(acc[4 * rg] * pv.x, acc[4 * rg + 1] * pv.y); w.y = pkh(acc[4 * rg + 2] * pv.z, acc[4 * rg + 3] * pv.w); *(LAS u32x2*)(o + rg * 16) = w; }
          } else if (c_ >= 4) {
              f32x16 acc = mm32(f16, CB(CB_AABT), mb * 32, CB(CB_ARB), nb * 32, zero16(), l31, hi);
              acc = mm32x<true, false>(f16, CB(CB_X1), mb * 32, CB(CB_ARK), nb * 32, acc, lane);
              LAS unsigned char* yp = CB(CB_OY) + (nb * 32 + l31) * CH_RS + (mb * 32 + 4 * hi) * 2;
#pragma unroll
              for (int rg = 0; rg < 4; ++rg) { u32x2 w; w.x = pkh(acc[4 * rg], acc[4 * rg + 1]); w.y = pkh(acc[4 * rg + 2], acc[4 * rg + 3]); *(LAS u32x2*)(yp + rg * 16) = w; }
          }
      } }
    LBAR();
    { int c_ = c; asm volatile("" : "+s"(c_));
      unsigned char* gq = (unsigned char*)F.GHQ + ((size_t)chain * 68 + c_) * GHQ_ITEM + tok * 128 + ch * 16; const int lo = tok * CH_RS + ch * 16;
      *(u32x4*)gq = *(const LAS u32x4*)(CB(CB_OG) + lo); *(u32x4*)(gq + 8192) = *(const LAS u32x4*)(CB(CB_OH) + lo); *(u32x4*)(gq + 16384) = *(const LAS u32x4*)(CB(CB_OQ) + lo);
      if (c_ >= 4) *(u32x4*)((unsigned char*)(d ? F.YB : F.YF) + (size_t)scan_row(b, d, c_, tok) * 2048 + h * 128 + ch * 16) = *(const LAS u32x4*)(CB(CB_OY) + lo); }
    TSTAMP(7);
#undef CB
}

__device__ __forceinline__ void p3_chunkA(Frame& F) {
    const int tid = F.tid, lane = F.lane, wave = F.wave, l31 = lane & 31, hi = lane >> 5;
    LAS unsigned char* lds = F.lds;
#define CB(i) (lds + (i) * CH_MB)
    for (int g = F.bid; g < 256; g += F.G) {
        const int chain = g >> 1, c0 = (g & 1) * 34, d = chain & 1, h = (chain >> 1) & 15, b = chain >> 5;
        { const int q = tid >> 6, n = tid & 63, c = h * 64 + n;
          const float val = q == 0 ? F.mu_shift[C_R + c] : q == 1 ? F.mu_shift[C_K + c] : q == 2 ? F.mu_shift[C_V + c] : q == 3 ? F.mu_shift[C_LW + d * 64 + n] : q == 4 ? F.mu_shift[C_LA + d * 64 + n] : q == 5 ? F.k_k[c] : q == 6 ? F.k_a[c] : F.r_k[c];
          ((LAS float*)(lds + CH_CONST))[tid] = val; }
        const int q4 = wave & 3, tb = q4 >> 1, cb = q4 & 1;
        { const int row = tid >> 3, chk = tid & 7;
          *(LAS u32x4*)(lds + CH_LW + row * CH_RS + chk * 16) = *(const u32x4*)(F.W2T + ((size_t)d * 1024 + h * 64 + row) * 64 + 8 * chk);
          *(LAS u32x4*)(lds + CH_LW + CH_MB + row * CH_RS + chk * 16) = *(const u32x4*)(F.A2T + ((size_t)d * 1024 + h * 64 + row) * 64 + 8 * chk); }
        const float lbias = (wave < 4 ? F.w0 : F.a0)[d * 1024 + h * 64 + cb * 32 + l31];
        LBAR();
        ChRegs R;
        ch_load(F, R, b, h, d, c0);
#pragma unroll 1
        for (int ci = 0; ci < 34; ++ci) {
            const int c = c0 + ci;
            const int tok = tid >> 3, ch = tid & 7;
            const LAS f32x4* cs = (const LAS f32x4*)(lds + CH_CONST) + 2 * ch;
            float sr[8], sk[8], sv[8];
            ch_park(F, R, b, d, c);
            LBAR();
            { float slw[8], sla[8];
              const int ri = 1 + scan_row(b, d, c, tok) - chunk_mlo(b, d, c);
              const LAS unsigned char* p3 = lds + CH_RAW3 + ri * 384 + ch * 16; const LAS unsigned char* pl = lds + CH_RAWL + ri * 256 + ch * 16;
              shift8(R.r, *(const LAS u32x4*)(p3 - 384), *(const LAS u32x4*)(p3 + 384), cs, sr); shift8(R.k, *(const LAS u32x4*)(p3 - 384 + 128), *(const LAS u32x4*)(p3 + 384 + 128), cs + 16, sk);
              shift8(R.v, *(const LAS u32x4*)(p3 - 384 + 256), *(const LAS u32x4*)(p3 + 384 + 256), cs + 32, sv);
              shift8(R.lw, *(const LAS u32x4*)(pl - 256), *(const LAS u32x4*)(pl + 256), cs + 48, slw); shift8(R.la, *(const LAS u32x4*)(pl - 256 + 128), *(const LAS u32x4*)(pl + 256 + 128), cs + 64, sla);
#pragma unroll
              for (int j = 0; j < 8; ++j) slw[j] = 1.0f - 2.0f * __builtin_amdgcn_rcpf(1.0f + fast_exp(2.0f * slw[j]));
              u32x4 o; o.x = pk2(slw[0], slw[1]); o.y = pk2(slw[2], slw[3]); o.z = pk2(slw[4], slw[5]); o.w = pk2(slw[6], slw[7]); *(LAS u32x4*)(CB(CB_X1) + tok * CH_RS + ch * 16) = o;
              o.x = pk2(sla[0], sla[1]); o.y = pk2(sla[2], sla[3]); o.z = pk2(sla[4], sla[5]); o.w = pk2(sla[6], sla[7]); *(LAS u32x4*)(CB(CB_XT) + tok * CH_RS + ch * 16) = o; }
            LBAR(); TSTAMP(0);
            { f32x16 acc = zero16();
              const LAS unsigned char* pa = CB(wave < 4 ? CB_X1 : CB_XT) + (tb * 32 + l31) * CH_RS + hi * 16;
              const LAS unsigned char* pw2 = lds + CH_LW + (wave < 4 ? 0 : CH_MB) + (cb * 32 + l31) * CH_RS + hi * 16;
#pragma unroll
              for (int ks = 0; ks < 4; ++ks) acc = __builtin_amdgcn_mfma_f32_32x32x16_bf16(*(const LAS bf16x8*)(pa + ks * 32), *(const LAS bf16x8*)(pw2 + ks * 32), acc, 0, 0, 0);
              LAS float* dst = (LAS float*)(lds + (wave < 4 ? CH_WBUF : CH_ABUF)) + cb * 32 + l31;
#pragma unroll
              for (int r = 0; r < 16; ++r) { const int t = tb * 32 + (r & 3) + 8 * (r >> 2) + 4 * hi; const float sg = sigmoidf_(acc[r] + lbias);
                  dst[t * 64] = wave < 4 ? fast_exp(-0.6065306597126334f * sg) : sg; } }
            LBAR(); TSTAMP(1);
            { LAS float* wb = (LAS float*)(lds + CH_WBUF) + (wave * 8) * 64 + (tid & 63); LAS float* gt = (LAS float*)(lds + CH_GT);
              float q[8]; q[0] = wb[0];
#pragma unroll
              for (int i = 1; i < 8; ++i) q[i] = q[i - 1] * wb[i * 64];
              gt[wave * 64 + (tid & 63)] = q[7];
              LBAR();
              float pre = 1.0f, p31 = 1.0f;
#pragma unroll
              for (int gg = 0; gg < 7; ++gg) { const float tv = gt[gg * 64 + (tid & 63)]; pre = gg < wave ? pre * tv : pre; p31 = gg < 4 ? p31 * tv : p31; }
#pragma unroll
              for (int i = 0; i < 8; ++i) wb[i * 64] = pre * q[i];
              if (wave == 7) { const float p63 = pre * q[7]; LAS float* pt = (LAS float*)(lds + CH_PT);
                  pt[tid & 63] = p63 / p31;
                  pt[64 + (tid & 63)] = p31;
                  pt[128 + (tid & 63)] = p63;
                  const bool ok = !FORCE_BF16 && p31 > 2.44140625e-4f && p63 > 2.44140625e-4f * p31;
                  if ((tid & 63) == 0) ((LAS unsigned*)pt)[192] = __all(ok) ? 1u : 0u; else (void)__all(ok); } }
            LBAR(); TSTAMP(2);
            { const bool f16 = __builtin_amdgcn_readfirstlane((int)((const LAS unsigned*)(lds + CH_PT))[192]) != 0;
              ch_tail(f16, F, R, sr, sk, sv, b, h, d, c, chain, ci); }
        }
    }
#undef CB
}

constexpr int BL_SLOT = 2 * CH_MB, BL_SLOTB = 4 * CH_MB, BL_YB = BL_SLOT + 2 * BL_SLOTB;
__device__ __forceinline__ void p4_chunkB(Frame& F) {
    const int lane = F.lane, wave = F.wave, l31 = lane & 31, hi = lane >> 5, srow = F.tid >> 3, sch = F.tid & 7;
    LAS unsigned char* lds = F.lds;
    for (int chain = F.bid; chain < 128; chain += F.G) {
        const int d = chain & 1, h = (chain >> 1) & 15, b = chain >> 5;
        const int q4 = wave & 3, mb = q4 >> 1, nb = q4 & 1;
        for (int i = F.tid; i < 2 * CH_MB / 4; i += NWAVES * 64) ((LAS unsigned*)lds)[i] = 0u;
        const unsigned char* gq0 = (const unsigned char*)F.GHQ + (size_t)chain * 68 * GHQ_ITEM;
        unsigned char* Yb = (unsigned char*)(d ? F.YB : F.YF) + h * 128;
        u32x4 Ra0, Ra1, Ra2, Ra3, Rb0, Rb1, Rb2, Rb3, Rc0, Rc1, Rc2, Rc3, Rd0, Rd1, Rd2, Rd3;
        { int c__ = (0); c__ = c__ < 67 ? c__ : 67; const unsigned char* gq = gq0 + (size_t)c__ * GHQ_ITEM + srow * 128 + sch * 16; const int cy = c__ < 4 ? 4 : c__;
              Ra0 = *(const u32x4*)gq; Ra1 = *(const u32x4*)(gq + 8192); Ra2 = *(const u32x4*)(gq + 16384);
              Ra3 = *(const u32x4*)(Yb + (size_t)scan_row(b, d, cy, srow) * 2048 + sch * 16); }
        { LAS unsigned char* sn = lds + BL_SLOT + srow * CH_RS + sch * 16; *(LAS u32x4*)sn = Ra0; *(LAS u32x4*)(sn + CH_MB) = Ra1; *(LAS u32x4*)(sn + 2 * CH_MB) = Ra2; *(LAS u32x4*)(sn + 3 * CH_MB) = Ra3; }
        { int c__ = (1); c__ = c__ < 67 ? c__ : 67; const unsigned char* gq = gq0 + (size_t)c__ * GHQ_ITEM + srow * 128 + sch * 16; const int cy = c__ < 4 ? 4 : c__;
              Ra0 = *(const u32x4*)gq; Ra1 = *(const u32x4*)(gq + 8192); Ra2 = *(const u32x4*)(gq + 16384);
              Ra3 = *(const u32x4*)(Yb + (size_t)scan_row(b, d, cy, srow) * 2048 + sch * 16); }
        { int c__ = (2); c__ = c__ < 67 ? c__ : 67; const unsigned char* gq = gq0 + (size_t)c__ * GHQ_ITEM + srow * 128 + sch * 16; const int cy = c__ < 4 ? 4 : c__;
              Rb0 = *(const u32x4*)gq; Rb1 = *(const u32x4*)(gq + 8192); Rb2 = *(const u32x4*)(gq + 16384);
              Rb3 = *(const u32x4*)(Yb + (size_t)scan_row(b, d, cy, srow) * 2048 + sch * 16); }
        { int c__ = (3); c__ = c__ < 67 ? c__ : 67; const unsigned char* gq = gq0 + (size_t)c__ * GHQ_ITEM + srow * 128 + sch * 16; const int cy = c__ < 4 ? 4 : c__;
              Rc0 = *(const u32x4*)gq; Rc1 = *(const u32x4*)(gq + 8192); Rc2 = *(const u32x4*)(gq + 16384);
              Rc3 = *(const u32x4*)(Yb + (size_t)scan_row(b, d, cy, srow) * 2048 + sch * 16); }
        { int c__ = (4); c__ = c__ < 67 ? c__ : 67; const unsigned char* gq = gq0 + (size_t)c__ * GHQ_ITEM + srow * 128 + sch * 16; const int cy = c__ < 4 ? 4 : c__;
              Rd0 = *(const u32x4*)gq; Rd1 = *(const u32x4*)(gq + 8192); Rd2 = *(const u32x4*)(gq + 16384);
              Rd3 = *(const u32x4*)(Yb + (size_t)scan_row(b, d, cy, srow) * 2048 + sch * 16); }
        LBAR();
#pragma unroll 1
        for (int c = 0; c < 68; c += 4) {
            { const int c_ = (c);
              LAS unsigned char* sn = lds + BL_SLOT + ((c_ + 1) & 1) * BL_SLOTB + srow * CH_RS + sch * 16;
              *(LAS u32x4*)sn = Ra0; *(LAS u32x4*)(sn + CH_MB) = Ra1; *(LAS u32x4*)(sn + 2 * CH_MB) = Ra2; *(LAS u32x4*)(sn + 3 * CH_MB) = Ra3;
              { int c__ = (c_ + 5); c__ = c__ < 67 ? c__ : 67; const unsigned char* gq = gq0 + (size_t)c__ * GHQ_ITEM + srow * 128 + sch * 16; const int cy = c__ < 4 ? 4 : c__;
              Ra0 = *(const u32x4*)gq; Ra1 = *(const u32x4*)(gq + 8192); Ra2 = *(const u32x4*)(gq + 16384);
              Ra3 = *(const u32x4*)(Yb + (size_t)scan_row(b, d, cy, srow) * 2048 + sch * 16); }
              if (c_ >= 5) { const u32x4 yv = *(const LAS u32x4*)(lds + BL_YB + ((c_ - 1) & 1) * CH_MB + srow * CH_RS + sch * 16);
                  *(u32x4*)(Yb + (size_t)scan_row(b, d, c_ - 1, srow) * 2048 + sch * 16) = yv; }
              const LAS unsigned char* sc = lds + BL_SLOT + (c_ & 1) * BL_SLOTB; const LAS unsigned char* zc = lds + (c_ & 1) * CH_MB; LAS unsigned char* zn = lds + ((c_ + 1) & 1) * CH_MB;
              if (wave < 4) {
                  f32x16 acc; const LAS unsigned char* ph = sc + CH_MB + (nb * 32 + l31) * CH_RS + (mb * 32 + 4 * hi) * 2;
#pragma unroll
                  for (int rg = 0; rg < 4; ++rg) { const u32x2 w = *(const LAS u32x2*)(ph + rg * 16); acc[4 * rg] = h_lo(w.x); acc[4 * rg + 1] = h_hi(w.x); acc[4 * rg + 2] = h_lo(w.y); acc[4 * rg + 3] = h_hi(w.y); }
                  acc = mm32(true, sc, mb * 32, zc, nb * 32, acc, l31, hi);
                  st_nat(true, zn, mb * 32, nb * 32, acc, l31, hi);
              } else if (c_ >= 4) {
                  f32x16 acc; const LAS unsigned char* py = sc + 3 * CH_MB + (nb * 32 + l31) * CH_RS + (mb * 32 + 4 * hi) * 2;
#pragma unroll
                  for (int rg = 0; rg < 4; ++rg) { const u32x2 w = *(const LAS u32x2*)(py + rg * 16); acc[4 * rg] = h_lo(w.x); acc[4 * rg + 1] = h_hi(w.x); acc[4 * rg + 2] = h_lo(w.y); acc[4 * rg + 3] = h_hi(w.y); }
                  acc = mm32(true, zc, mb * 32, sc + 2 * CH_MB, nb * 32, acc, l31, hi);
                  st_nat(true, lds + BL_YB + (c_ & 1) * CH_MB, mb * 32, nb * 32, acc, l31, hi);
              }
              LBAR(); }
            { const int c_ = (c + 1);
              LAS unsigned char* sn = lds + BL_SLOT + ((c_ + 1) & 1) * BL_SLOTB + srow * CH_RS + sch * 16;
              *(LAS u32x4*)sn = Rb0; *(LAS u32x4*)(sn + CH_MB) = Rb1; *(LAS u32x4*)(sn + 2 * CH_MB) = Rb2; *(LAS u32x4*)(sn + 3 * CH_MB) = Rb3;
              { int c__ = (c_ + 5); c__ = c__ < 67 ? c__ : 67; const unsigned char* gq = gq0 + (size_t)c__ * GHQ_ITEM + srow * 128 + sch * 16; const int cy = c__ < 4 ? 4 : c__;
              Rb0 = *(const u32x4*)gq; Rb1 = *(const u32x4*)(gq + 8192); Rb2 = *(const u32x4*)(gq + 16384);
              Rb3 = *(const u32x4*)(Yb + (size_t)scan_row(b, d, cy, srow) * 2048 + sch * 16); }
              if (c_ >= 5) { const u32x4 yv = *(const LAS u32x4*)(lds + BL_YB + ((c_ - 1) & 1) * CH_MB + srow * CH_RS + sch * 16);
                  *(u32x4*)(Yb + (size_t)scan_row(b, d, c_ - 1, srow) * 2048 + sch * 16) = yv; }
              const LAS unsigned char* sc = lds + BL_SLOT + (c_ & 1) * BL_SLOTB; const LAS unsigned char* zc = lds + (c_ & 1) * CH_MB; LAS unsigned char* zn = lds + ((c_ + 1) & 1) * CH_MB;
              if (wave < 4) {
                  f32x16 acc; const LAS unsigned char* ph = sc + CH_MB + (nb * 32 + l31) * CH_RS + (mb * 32 + 4 * hi) * 2;
#pragma unroll
                  for (int rg = 0; rg < 4; ++rg) { const u32x2 w = *(const LAS u32x2*)(ph + rg * 16); acc[4 * rg] = h_lo(w.x); acc[4 * rg + 1] = h_hi(w.x); acc[4 * rg + 2] = h_lo(w.y); acc[4 * rg + 3] = h_hi(w.y); }
                  acc = mm32(true, sc, mb * 32, zc, nb * 32, acc, l31, hi);
                  st_nat(true, zn, mb * 32, nb * 32, acc, l31, hi);
              } else if (c_ >= 4) {
                  f32x16 acc; const LAS unsigned char* py = sc + 3 * CH_MB + (nb * 32 + l31) * CH_RS + (mb * 32 + 4 * hi) * 2;
#pragma unroll
                  for (int rg = 0; rg < 4; ++rg) { const u32x2 w = *(const LAS u32x2*)(py + rg * 16); acc[4 * rg] = h_lo(w.x); acc[4 * rg + 1] = h_hi(w.x); acc[4 * rg + 2] = h_lo(w.y); acc[4 * rg + 3] = h_hi(w.y); }
                  acc = mm32(true, zc, mb * 32, sc + 2 * CH_MB, nb * 32, acc, l31, hi);
                  st_nat(true, lds + BL_YB + (c_ & 1) * CH_MB, mb * 32, nb * 32, acc, l31, hi);
              }
              LBAR(); }
            { const int c_ = (c + 2);
              LAS unsigned char* sn = lds + BL_SLOT + ((c_ + 1) & 1) * BL_SLOTB + srow * CH_RS + sch * 16;
              *(LAS u32x4*)sn = Rc0; *(LAS u32x4*)(sn + CH_MB) = Rc1; *(LAS u32x4*)(sn + 2 * CH_MB) = Rc2; *(LAS u32x4*)(sn + 3 * CH_MB) = Rc3;
              { int c__ = (c_ + 5); c__ = c__ < 67 ? c__ : 67; const unsigned char* gq = gq0 + (size_t)c__ * GHQ_ITEM + srow * 128 + sch * 16; const int cy = c__ < 4 ? 4 : c__;
              Rc0 = *(const u32x4*)gq; Rc1 = *(const u32x4*)(gq + 8192); Rc2 = *(const u32x4*)(gq + 16384);
              Rc3 = *(const u32x4*)(Yb + (size_t)scan_row(b, d, cy, srow) * 2048 + sch * 16); }
              if (c_ >= 5) { const u32x4 yv = *(const LAS u32x4*)(lds + BL_YB + ((c_ - 1) & 1) * CH_MB + srow * CH_RS + sch * 16);
                  *(u32x4*)(Yb + (size_t)scan_row(b, d, c_ - 1, srow) * 2048 + sch * 16) = yv; }
              const LAS unsigned char* sc = lds + BL_SLOT + (c_ & 1) * BL_SLOTB; const LAS unsigned char* zc = lds + (c_ & 1) * CH_MB; LAS unsigned char* zn = lds + ((c_ + 1) & 1) * CH_MB;
              if (wave < 4) {
                  f32x16 acc; const LAS unsigned char* ph = sc + CH_MB + (nb * 32 + l31) * CH_RS + (mb * 32 + 4 * hi) * 2;
#pragma unroll
                  for (int rg = 0; rg < 4; ++rg) { const u32x2 w = *(const LAS u32x2*)(ph + rg * 16); acc[4 * rg] = h_lo(w.x); acc[4 * rg + 1] = h_hi(w.x); acc[4 * rg + 2] = h_lo(w.y); acc[4 * rg + 3] = h_hi(w.y); }
                  acc = mm32(true, sc, mb * 32, zc, nb * 32, acc, l31, hi);
                  st_nat(true, zn, mb * 32, nb * 32, acc, l31, hi);
              } else if (c_ >= 4) {
                  f32x16 acc; const LAS unsigned char* py = sc + 3 * CH_MB + (nb * 32 + l31) * CH_RS + (mb * 32 + 4 * hi) * 2;
#pragma unroll
                  for (int rg = 0; rg < 4; ++rg) { const u32x2 w = *(const LAS u32x2*)(py + rg * 16); acc[4 * rg] = h_lo(w.x); acc[4 * rg + 1] = h_hi(w.x); acc[4 * rg + 2] = h_lo(w.y); acc[4 * rg + 3] = h_hi(w.y); }
                  acc = mm32(true, zc, mb * 32, sc + 2 * CH_MB, nb * 32, acc, l31, hi);
                  st_nat(true, lds + BL_YB + (c_ & 1) * CH_MB, mb * 32, nb * 32, acc, l31, hi);
              }
              LBAR(); }
            { const int c_ = (c + 3);
              LAS unsigned char* sn = lds + BL_SLOT + ((c_ + 1) & 1) * BL_SLOTB + srow * CH_RS + sch * 16;
              *(LAS u32x4*)sn = Rd0; *(LAS u32x4*)(sn + CH_MB) = Rd1; *(LAS u32x4*)(sn + 2 * CH_MB) = Rd2; *(LAS u32x4*)(sn + 3 * CH_MB) = Rd3;
              { int c__ = (c_ + 5); c__ = c__ < 67 ? c__ : 67; const unsigned char* gq = gq0 + (size_t)c__ * GHQ_ITEM + srow * 128 + sch * 16; const int cy = c__ < 4 ? 4 : c__;
              Rd0 = *(const u32x4*)gq; Rd1 = *(const u32x4*)(gq + 8192); Rd2 = *(const u32x4*)(gq + 16384);
              Rd3 = *(const u32x4*)(Yb + (size_t)scan_row(b, d, cy, srow) * 2048 + sch * 16); }
              if (c_ >= 5) { const u32x4 yv = *(const LAS u32x4*)(lds + BL_YB + ((c_ - 1) & 1) * CH_MB + srow * CH_RS + sch * 16);
                  *(u32x4*)(Yb + (size_t)scan_row(b, d, c_ - 1, srow) * 2048 + sch * 16) = yv; }
              const LAS unsigned char* sc = lds + BL_SLOT + (c_ & 1) * BL_SLOTB; const LAS unsigned char* zc = lds + (c_ & 1) * CH_MB; LAS unsigned char* zn = lds + ((c_ + 1) & 1) * CH_MB;
              if (wave < 4) {
                  f32x16 acc; const LAS unsigned char* ph = sc + CH_MB + (nb * 32 + l31) * CH_RS + (mb * 32 + 4 * hi) * 2;
#pragma unroll
                  for (int rg = 0; rg < 4; ++rg) { const u32x2 w = *(const LAS u32x2*)(ph + rg * 16); acc[4 * rg] = h_lo(w.x); acc[4 * rg + 1] = h_hi(w.x); acc[4 * rg + 2] = h_lo(w.y); acc[4 * rg + 3] = h_hi(w.y); }
                  acc = mm32(true, sc, mb * 32, zc, nb * 32, acc, l31, hi);
                  st_nat(true, zn, mb * 32, nb * 32, acc, l31, hi);
              } else if (c_ >= 4) {
                  f32x16 acc; const LAS unsigned char* py = sc + 3 * CH_MB + (nb * 32 + l31) * CH_RS + (mb * 32 + 4 * hi) * 2;
#pragma unroll
                  for (int rg = 0; rg < 4; ++rg) { const u32x2 w = *(const LAS u32x2*)(py + rg * 16); acc[4 * rg] = h_lo(w.x); acc[4 * rg + 1] = h_hi(w.x); acc[4 * rg + 2] = h_lo(w.y); acc[4 * rg + 3] = h_hi(w.y); }
                  acc = mm32(true, zc, mb * 32, sc + 2 * CH_MB, nb * 32, acc, l31, hi);
                  st_nat(true, lds + BL_YB + (c_ & 1) * CH_MB, mb * 32, nb * 32, acc, l31, hi);
              }
              LBAR(); }
        }
        { const u32x4 yv = *(const LAS u32x4*)(lds + BL_YB + CH_MB + srow * CH_RS + sch * 16); *(u32x4*)(Yb + (size_t)scan_row(b, d, 67, srow) * 2048 + sch * 16) = yv; }
        LBAR();
    }
}

constexpr int AT_K = 0, AT_V = 16384, AT_BUF = 16384 + 64 * 272;
struct KVRegs { u32x4 k1, k2, v0, v1; };
__device__ __forceinline__ void at_load(Frame& F, KVRegs& R, int mrow0, int kvh) {
    const int tid = F.tid;
    { const int key = tid >> 2, q4 = tid & 3, a = q4 >> 1, e = q4 & 1;
      const bf16* p = F.P + (size_t)(mrow0 + key) * NIN + C_KA + kvh * 64 + a * 32 + 8 * e; R.k1 = *(const u32x4*)p; R.k2 = *(const u32x4*)(p + 16); }
    { const int kp = tid >> 3, dc = tid & 7; const bf16* p = F.P + (size_t)(mrow0 + 2 * kp) * NIN + C_VA + kvh * 64 + 8 * dc; R.v0 = *(const u32x4*)p; R.v1 = *(const u32x4*)(p + NIN); }
}
__device__ __forceinline__ void qkprep_one(Frame& F, bf16* p, int a, int e, int kpos, bool rope, const float* gain, float scale) {
    float x1[8], x2[8]; unpack8(*(const u32x4*)p, x1); unpack8(*(const u32x4*)(p + 16), x2);
    float ss = 0.f;
#pragma unroll
    for (int j = 0; j < 8; ++j) ss += x1[j] * x1[j] + x2[j] * x2[j];
    ss += __shfl_xor(ss, 1); ss += __shfl_xor(ss, 2);
    const float rr = scale / sqrtf(ss * (1.0f / 64.0f) + 1e-6f);
    const int pos = a == 0 ? (kpos >> 6) : (kpos & 63);
#pragma unroll
    for (int j = 0; j < 8; ++j) { float y1 = x1[j] * rr * gain[a * 32 + 8 * e + j], y2 = x2[j] * rr * gain[a * 32 + 16 + 8 * e + j];
        if (rope) { const float c = F.ROPE[pos * 16 + 8 * e + j], sn = F.ROPE[1024 + pos * 16 + 8 * e + j]; const float t1 = y1 * c - y2 * sn, t2 = y2 * c + y1 * sn; y1 = t1; y2 = t2; }
        x1[j] = y1; x2[j] = y2; }
    u32x4 o; o.x = pk2(x1[0], x1[1]); o.y = pk2(x1[2], x1[3]); o.z = pk2(x1[4], x1[5]); o.w = pk2(x1[6], x1[7]); *(u32x4*)p = o;
    o.x = pk2(x2[0], x2[1]); o.y = pk2(x2[2], x2[3]); o.z = pk2(x2[4], x2[5]); o.w = pk2(x2[6], x2[7]); *(u32x4*)(p + 16) = o;
}
__device__ __forceinline__ void kprep(Frame& F) {
    const int total = F.G * NWAVES * 64;
    for (int idx = F.bid * NWAVES * 64 + F.tid; idx < MT * 16; idx += total) {
        const int q4 = idx & 3, kvh = (idx >> 2) & 3, m = idx >> 4, a = q4 >> 1, e = q4 & 1;
        qkprep_one(F, F.P + (size_t)m * NIN + C_KA + kvh * 64 + a * 32 + 8 * e, a, e, m & (SEQ - 1), m < ML, F.kng, 1.0f);
    }
}
__device__ __forceinline__ void at_write(Frame& F, const KVRegs& R, LAS unsigned char* buf) {
    const int tid = F.tid;
    { const int key = tid >> 2, q4 = tid & 3, a = q4 >> 1, e = q4 & 1;
      const int c1 = 4 * a + e, c2 = c1 + 2, sw = (key >> 1) & 7;
      *(LAS u32x4*)(buf + AT_K + key * 128 + ((c1 ^ sw) << 4)) = R.k1; *(LAS u32x4*)(buf + AT_K + key * 128 + ((c2 ^ sw) << 4)) = R.k2; }
    { const int kp = tid >> 3, dc = tid & 7, kq = kp >> 1;
        const int pos0 = (kq >> 2) * 16 + (kq & 1) * 8 + ((kq >> 1) & 1) * 4 + (kp & 1) * 2;
#pragma unroll
        for (int w = 0; w < 4; ++w) {
            const unsigned a0 = R.v0[w], a1 = R.v1[w];
            *(LAS unsigned*)(buf + AT_V + (8 * dc + 2 * w) * 272 + pos0 * 2) = __builtin_amdgcn_perm(a1, a0, 0x05040100u);
            *(LAS unsigned*)(buf + AT_V + (8 * dc + 2 * w + 1) * 272 + pos0 * 2) = __builtin_amdgcn_perm(a1, a0, 0x07060302u); }
    }
}
#ifndef ATTN_POOL
#define ATTN_POOL 0
#endif
#ifndef ATTN_BOUND
#define ATTN_BOUND 60.0f
#endif
template<bool NOMAX> __device__ __forceinline__ void p4_attn_t(Frame& F, int item) {
    const int n = item & 31, kvh = (item >> 5) & 3, b = item >> 7;
    const int lane = F.lane, wave = F.wave, l31 = lane & 31, hi = lane >> 5;
    const int hh = kvh * 4 + (wave >> 1), qloc = (wave & 1) * 64;
    LAS unsigned char* lds = F.lds;
    const int kfirst = n > 0 ? 0 : 1, nbnd = 3 - (n == 0 ? 1 : 0) - (n == 31 ? 1 : 0), nt = nbnd + 2;
#define TL_KIND(t) ((t) < nbnd ? kfirst + (t) : 3)
#define TL_ROW(t) ((t) < nbnd ? b * SEQ + (n - 1 + kfirst + (t)) * 128 : ML + b * CTXL + ((t) - nbnd) * 128)
#define TL_KPOS(t) ((t) < nbnd ? (n - 1 + kfirst + (t)) * 128 : 0)
    if (DBG_FINE) TSTART();
    KVRegs R;
    at_load(F, R, TL_ROW(0), kvh);
    LAS unsigned char* qbase = lds + 2 * AT_BUF + wave * 8192;
    LAS unsigned char* qlds = qbase + lane * 16;
    { const int rowl = lane >> 2, q4 = lane & 3, a = q4 >> 1, e = q4 & 1;
      const bf16* src = F.P + (size_t)(b * SEQ + n * 128 + qloc + rowl) * NIN + C_Q + hh * 64 + a * 32 + 8 * e;
      u32x4 r1[4], r2[4];
#pragma unroll
      for (int ps = 0; ps < 4; ++ps) { r1[ps] = *(const u32x4*)(src + (size_t)(16 * ps) * NIN); r2[ps] = *(const u32x4*)(src + (size_t)(16 * ps) * NIN + 16); }
      float g1[8], g2[8];
      { const f32x4 a0 = *(const f32x4*)(F.qng + a * 32 + 8 * e), a1 = *(const f32x4*)(F.qng + a * 32 + 8 * e + 4), b0 = *(const f32x4*)(F.qng + a * 32 + 16 + 8 * e), b1 = *(const f32x4*)(F.qng + a * 32 + 16 + 8 * e + 4);
#pragma unroll
        for (int j = 0; j < 4; ++j) { g1[j] = a0[j]; g1[4 + j] = a1[j]; g2[j] = b0[j]; g2[4 + j] = b1[j]; } }
#pragma unroll
      for (int ps = 0; ps < 4; ++ps) {
          const int r = 16 * ps + rowl, query = n * 128 + qloc + r, pos = a == 0 ? (query >> 6) : (query & 63);
          const f32x4 c0 = *(const f32x4*)(F.ROPE + pos * 16 + 8 * e), c1 = *(const f32x4*)(F.ROPE + pos * 16 + 8 * e + 4), s0 = *(const f32x4*)(F.ROPE + 1024 + pos * 16 + 8 * e), s1 = *(const f32x4*)(F.ROPE + 1024 + pos * 16 + 8 * e + 4);
          float x1[8], x2[8]; unpack8(r1[ps], x1); unpack8(r2[ps], x2);
          float ss = 0.f;
#pragma unroll
          for (int j = 0; j < 8; ++j) ss += x1[j] * x1[j] + x2[j] * x2[j];
          ss += __shfl_xor(ss, 1); ss += __shfl_xor(ss, 2);
          const float rr = (0.125f * LOG2E) / sqrtf(ss * (1.0f / 64.0f) + 1e-6f);
#pragma unroll
          for (int j = 0; j < 8; ++j) { const float y1 = x1[j] * rr * g1[j], y2 = x2[j] * rr * g2[j], cc = j < 4 ? c0[j & 3] : c1[j & 3], sn = j < 4 ? s0[j & 3] : s1[j & 3];
              x1[j] = y1 * cc - y2 * sn; x2[j] = y2 * cc + y1 * sn; }
          LAS unsigned char* dst = qbase + ((r >> 5) * 4 + 2 * a) * 1024 + (e * 32 + (r & 31)) * 16;
          u32x4 o; o.x = pk2(x1[0], x1[1]); o.y = pk2(x1[2], x1[3]); o.z = pk2(x1[4], x1[5]); o.w = pk2(x1[6], x1[7]); *(LAS u32x4*)dst = o;
          o.x = pk2(x2[0], x2[1]); o.y = pk2(x2[2], x2[3]); o.z = pk2(x2[4], x2[5]); o.w = pk2(x2[6], x2[7]); *(LAS u32x4*)(dst + 1024) = o;
      } }
    at_write(F, R, lds);
    LBAR(); TSTAMP(26);
    float mrun[2] = {NOMAX ? 0.f : -1e30f, NOMAX ? 0.f : -1e30f}, lrun[2] = {0.f, 0.f};
    f32x16 ot[2][2];
#pragma unroll
    for (int qb = 0; qb < 2; ++qb)
#pragma unroll
        for (int db = 0; db < 2; ++db)
#pragma unroll
            for (int r = 0; r < 16; ++r) ot[qb][db][r] = 0.f;
#pragma unroll 1
    for (int t = 0; t < nt; ++t) {
        LAS unsigned char* buf = lds + (t & 1) * AT_BUF;
        if (t + 1 < nt) at_load(F, R, TL_ROW(t + 1), kvh);
        const int kind = TL_KIND(t);
#pragma unroll 1
        for (int st = 0; st < 4; ++st) {
            int s0 = 1, s1 = 1;
            { const int dq0 = qloc >> 5, dq1 = dq0 + 1;
              if (kind == 0) { s0 = st < dq0 ? 0 : (st == dq0 ? 2 : 1); s1 = st < dq1 ? 0 : (st == dq1 ? 2 : 1); }
              else if (kind == 2) { s0 = st > dq0 ? 0 : (st == dq0 ? 2 : 1); s1 = st > dq1 ? 0 : (st == dq1 ? 2 : 1); } }
            if ((s0 | s1) == 0) continue;
            bf16x8 kf[4];
#pragma unroll
            for (int ks = 0; ks < 4; ++ks) { const int key = st * 32 + l31, ch = 2 * ks + hi; kf[ks] = *(const LAS bf16x8*)(buf + AT_K + key * 128 + ((ch ^ ((key >> 1) & 7)) << 4)); }
            f32x16 sc0 = {0.f, 0.f, 0.f, 0.f, 0.f, 0.f, 0.f, 0.f, 0.f, 0.f, 0.f, 0.f, 0.f, 0.f, 0.f, 0.f}, sc1 = sc0;
            { bf16x8 qf[4];
              if (s0) {
#pragma unroll
                  for (int ks = 0; ks < 4; ++ks) qf[ks] = *(const LAS bf16x8*)(qlds + ks * 1024);
#pragma unroll
                  for (int ks = 0; ks < 4; ++ks) sc0 = __builtin_amdgcn_mfma_f32_32x32x16_bf16(kf[ks], qf[ks], sc0, 0, 0, 0); }
              if (s1) {
#pragma unroll
                  for (int ks = 0; ks < 4; ++ks) qf[ks] = *(const LAS bf16x8*)(qlds + (4 + ks) * 1024);
#pragma unroll
                  for (int ks = 0; ks < 4; ++ks) sc1 = __builtin_amdgcn_mfma_f32_32x32x16_bf16(kf[ks], qf[ks], sc1, 0, 0, 0); } }
            bf16x8 vf[2][2];
#pragma unroll
            for (int db = 0; db < 2; ++db)
#pragma unroll
                for (int s = 0; s < 2; ++s) vf[db][s] = *(const LAS bf16x8*)(buf + AT_V + (db * 32 + l31) * 272 + ((st * 2 + s) * 16 + hi * 8) * 2);
#define AT_SOFTMAX(SC, QB, PF, DIAG) do { \
                const int qq = qloc + (QB) * 32 + l31; \
                if (DIAG) { const int th = qq - st * 32 - 4 * hi;        \
                    if (kind == 0) { _Pragma("unroll") for (int r = 0; r < 16; ++r) SC[r] = ((r & 3) + 8 * (r >> 2) >= th) ? SC[r] : -__builtin_inff(); } \
                    else { _Pragma("unroll") for (int r = 0; r < 16; ++r) SC[r] = ((r & 3) + 8 * (r >> 2) <= th) ? SC[r] : -__builtin_inff(); } } \
                if (!NOMAX) { \
                    float tm = SC[0]; \
                    _Pragma("unroll") for (int r = 1; r < 16; ++r) tm = fmaxf(tm, SC[r]); \
                    tm = fmaxf(tm, __shfl_xor(tm, 32)); \
                    if (__any(tm > mrun[QB] + 6.0f)) { \
                        const float mn = fmaxf(mrun[QB], tm), al = __builtin_amdgcn_exp2f(mrun[QB] - mn); \
                        mrun[QB] = mn; lrun[QB] *= al; \
                        _Pragma("unroll") for (int db = 0; db < 2; ++db) _Pragma("unroll") for (int r = 0; r < 16; ++r) ot[QB][db][r] *= al; } \
                    const float mm = mrun[QB]; \
                    _Pragma("unroll") for (int r = 0; r < 16; ++r) SC[r] -= mm; } \
                f32x2_t ps2 = {0.f, 0.f}; \
                _Pragma("unroll") for (int r = 0; r < 16; r += 2) { SC[r] = __builtin_amdgcn_exp2f(SC[r]); SC[r + 1] = __builtin_amdgcn_exp2f(SC[r + 1]); f32x2_t e2; e2.x = SC[r]; e2.y = SC[r + 1]; ps2 += e2; } \
                lrun[QB] += ps2.x + ps2.y; \
                _Pragma("unroll") for (int s = 0; s < 2; ++s) { u32x4 o; o.x = pk2(SC[8 * s], SC[8 * s + 1]); o.y = pk2(SC[8 * s + 2], SC[8 * s + 3]); o.z = pk2(SC[8 * s + 4], SC[8 * s + 5]); o.w = pk2(SC[8 * s + 6], SC[8 * s + 7]); PF[s] = __builtin_bit_cast(bf16x8, o); } \
            } while (0)
            bf16x8 pf0[2] = {kf[0], kf[0]}, pf1[2] = {kf[0], kf[0]};
            __builtin_amdgcn_sched_barrier(0);
            if (s0) AT_SOFTMAX(sc0, 0, pf0, s0 == 2);
            __builtin_amdgcn_sched_barrier(0);
            if (s1) AT_SOFTMAX(sc1, 1, pf1, s1 == 2);
            __builtin_amdgcn_sched_barrier(0);
#undef AT_SOFTMAX
#pragma unroll
            for (int db = 0; db < 2; ++db)
#pragma unroll
                for (int s = 0; s < 2; ++s) if (s0) ot[0][db] = __builtin_amdgcn_mfma_f32_32x32x16_bf16(vf[db][s], pf0[s], ot[0][db], 0, 0, 0);
#pragma unroll
            for (int db = 0; db < 2; ++db)
#pragma unroll
                for (int s = 0; s < 2; ++s) if (s1) ot[1][db] = __builtin_amdgcn_mfma_f32_32x32x16_bf16(vf[db][s], pf1[s], ot[1][db], 0, 0, 0);
        }
        TSTAMP(27);
        if (t + 1 < nt) at_write(F, R, lds + ((t + 1) & 1) * AT_BUF);
        LBAR(); TSTAMP(28);
    }
    constexpr int AT_ORS = 528;
    u32x4 zr[8];
    const bf16* pz = F.P + (size_t)(b * SEQ + n * 128) * NIN + kvh * 256;
#pragma unroll
    for (int i = 0; i < 8; ++i) { const int idx = F.tid + 512 * i, row = idx >> 5, c16 = idx & 31; zr[i] = *(const u32x4*)(pz + (size_t)row * NIN + C_ZA + 8 * c16); }
    const float sk2 = F.sink[hh] * LOG2E;
#pragma unroll
    for (int qb = 0; qb < 2; ++qb) {
        float l = lrun[qb]; l += __shfl_xor(l, 32); l += __builtin_amdgcn_exp2f(sk2 - mrun[qb]);
        const float il = 1.0f / l;
        LAS unsigned char* po = lds + (qloc + qb * 32 + l31) * AT_ORS + (wave >> 1) * 128 + 8 * hi;
#pragma unroll
        for (int db = 0; db < 2; ++db)
#pragma unroll
            for (int rg = 0; rg < 4; ++rg) { u32x2 o; o.x = pkh(ot[qb][db][4 * rg] * il, ot[qb][db][4 * rg + 1] * il); o.y = pkh(ot[qb][db][4 * rg + 2] * il, ot[qb][db][4 * rg + 3] * il);
                *(LAS u32x2*)(po + (db * 32 + 8 * rg) * 2) = o; }
    }
    LBAR();
#pragma unroll
    for (int i = 0; i < 8; ++i) { const int idx = F.tid + 512 * i, row = idx >> 5, c16 = idx & 31;
        const u32x4 ov = *(const LAS u32x4*)(lds + row * AT_ORS + c16 * 16);
        float z[8]; unpack8(zr[i], z);
        u32x4 w; w.x = pk2(h_lo(ov.x) * siluf_(z[0]), h_hi(ov.x) * siluf_(z[1])); w.y = pk2(h_lo(ov.y) * siluf_(z[2]), h_hi(ov.y) * siluf_(z[3]));
        w.z = pk2(h_lo(ov.z) * siluf_(z[4]), h_hi(ov.z) * siluf_(z[5])); w.w = pk2(h_lo(ov.w) * siluf_(z[6]), h_hi(ov.w) * siluf_(z[7]));
        *(u32x4*)(F.P + (size_t)(b * SEQ + n * 128 + row) * NIN + 1024 + kvh * 256 + 8 * c16) = w; }
    TSTAMP(29);
#undef TL_KIND
#undef TL_ROW
#undef TL_KPOS
}
__device__ __forceinline__ bool attn_nomax(Frame& F) {
    float gq = fabsf(F.qng[F.lane]), gk = fabsf(F.kng[F.lane]);
#pragma unroll
    for (int o = 1; o < 64; o <<= 1) { gq = fmaxf(gq, __shfl_xor(gq, o)); gk = fmaxf(gk, __shfl_xor(gk, o)); }
    const float bound = 8.0f * LOG2E * gq * gk;
    return __builtin_amdgcn_readfirstlane(bound <= ATTN_BOUND ? 1 : 0) != 0;
}

__device__ __forceinline__ void p5_mix(Frame& F) {
    const int total = F.G * NWAVES * 64, rstep = total >> 7, gi = F.bid * NWAVES * 64 + F.tid;
    const int ch = gi & 7, h = (gi >> 3) & 15, c0 = h * 64 + 8 * ch;
    float mus[8], lg[8], lb[8];
    { const f32x4 a0 = *(const f32x4*)(F.mu_shift + C_V + c0), a1 = *(const f32x4*)(F.mu_shift + C_V + c0 + 4), g0 = *(const f32x4*)(F.ln_g + c0), g1 = *(const f32x4*)(F.ln_g + c0 + 4), b0 = *(const f32x4*)(F.ln_b + c0), b1 = *(const f32x4*)(F.ln_b + c0 + 4);
#pragma unroll
      for (int j = 0; j < 4; ++j) { mus[j] = a0[j]; mus[4 + j] = a1[j]; lg[j] = g0[j]; lg[4 + j] = g1[j]; lb[j] = b0[j]; lb[4 + j] = b1[j]; } }
    const u32x4 z = {0u, 0u, 0u, 0u};
#pragma unroll 1
    for (int m0 = gi >> 7; m0 < ML; m0 += 4 * rstep) {
        u32x4 ryf[4], ryb[4], rvc[4], rvp[4], rvn[4], rzr[4]; float bon[4];
#pragma unroll
        for (int k = 0; k < 4; ++k) { const int m = m0 + k * rstep, mm = m < ML ? m : m0, t = mm & (SEQ - 1);
            const bf16* pc = F.P + (size_t)mm * NIN;
            ryf[k] = *(const u32x4*)(F.YF + (size_t)mm * 1024 + c0); ryb[k] = *(const u32x4*)(F.YB + (size_t)mm * 1024 + c0);
            rvc[k] = *(const u32x4*)(pc + C_V + c0); rvp[k] = *(const u32x4*)(pc - (t > 0 ? NIN : 0) + C_V + c0); rvn[k] = *(const u32x4*)(pc + (t < SEQ - 1 ? NIN : 0) + C_V + c0);
            rzr[k] = *(const u32x4*)(pc + C_ZR + c0);
            bon[k] = F.BON[(size_t)mm * 16 + h] + F.BON[(size_t)(ML + mm) * 16 + h]; }
#pragma unroll
        for (int k = 0; k < 4; ++k) { const int m = m0 + k * rstep; if (m >= ML) break;
            float y[8];
            { const h8 hf = __builtin_bit_cast(h8, ryf[k]), hb = __builtin_bit_cast(h8, ryb[k]);
#pragma unroll
              for (int j = 0; j < 8; ++j) y[j] = (float)hf[j] + (float)hb[j]; }
            float s = 0.f;
#pragma unroll
            for (int j = 0; j < 8; ++j) s += y[j];
            s += __shfl_xor(s, 1); s += __shfl_xor(s, 2); s += __shfl_xor(s, 4);
            const float mu = s * (1.0f / 64.0f); float q = 0.f;
#pragma unroll
            for (int j = 0; j < 8; ++j) { y[j] -= mu; q += y[j] * y[j]; }
            q += __shfl_xor(q, 1); q += __shfl_xor(q, 2); q += __shfl_xor(q, 4);
            const float rs = 1.0f / sqrtf(q * (1.0f / 64.0f) + 64e-5f);
            float vc[8], vp[8], vn[8], zr[8];
            const int t = m & (SEQ - 1);
            unpack8(rvc[k], vc); unpack8(t > 0 ? rvp[k] : z, vp); unpack8(t < SEQ - 1 ? rvn[k] : z, vn); unpack8(rzr[k], zr);
            float o[8];
#pragma unroll
            for (int j = 0; j < 8; ++j) { const float sv = vc[j] + mus[j] * (0.5f * (vp[j] + vn[j]) - vc[j]);
                const float yn = y[j] * rs * lg[j] + lb[j];
                o[j] = (yn + bon[k] * sv) * siluf_(zr[j]); }
            u32x4 w; w.x = pk2(o[0], o[1]); w.y = pk2(o[2], o[3]); w.z = pk2(o[4], o[5]); w.w = pk2(o[6], o[7]);
            *(u32x4*)(F.P + (size_t)m * NIN + c0) = w; }
    }
}

struct Args { const float* in[22]; float* out; unsigned char* ws; int ph_lo, ph_hi; };
__global__ void __launch_bounds__(NWAVES * 64, 2) hymba_fwd(Args args) {
    extern __shared__ __attribute__((aligned(16))) unsigned char lds_raw[];
    Frame F;
    F.lds = (LAS unsigned char*)lds_raw;
    F.tid = threadIdx.x; F.G = gridDim.x;
    unsigned char* ws = args.ws;
    volatile LAS unsigned* MISC = (volatile LAS unsigned*)(F.lds + MISC_OFF);
    for (int u = F.tid; u < 64; u += NWAVES * 64) MISC[u] = 0u;
    if (DBG_SEL >= 0) for (int u = F.tid; u < 72; u += NWAVES * 64) ((volatile LAS unsigned*)(F.lds + DBG_LDS))[u] = 0u;
    __syncthreads();
    const int lo = args.ph_lo, hi = args.ph_hi;
    XcdBarrier bar; bar.bar = (unsigned*)(ws + WS_CTL) + CW_BAR; bar.x = 0; bar.st = nullptr;
    if (hi - lo > 1) bar = xcd_barrier_post((unsigned*)(ws + WS_CTL) + CW_BAR, MISC + 8);
#define IN(k) (lo <= (k) && (k) < hi)
#define SEAM(k) do { if (IN(k) && IN((k) + 1)) xcd_barrier(bar); } while (0)
    fresh(F); TSTART();
    if (DBG_SEL >= 0 && F.bid == DBG_BLOCK && F.tid == 0) { volatile LAS unsigned long long* T_ = (volatile LAS unsigned long long*)(F.lds + DBG_LDS); T_[34] = T_[32]; }
    if (IN(0)) { fresh(F); p0_prologue(F); if (DUP_PHASE == 0) { fresh(F); p0_prologue(F); } } TSTAMP(8); SEAM(0); TSTAMP(9);
    if (IN(1)) { fresh(F); p1_modulate(F); if (DUP_PHASE == 1) { fresh(F); p1_modulate(F); } } TSTAMP(10); SEAM(1); TSTAMP(11);
    if (IN(2)) {
        fresh(F);
        pg8::Gemm g{F.XN, F.WIN, MT, NIN, DM, DM}; Sched1 S; S.init(F.G, F.bid);
        pg8::EpiBf16<0> E{F.P, NIN, nullptr, 0, 0, 1.f};
        pg8::gemm_phase<pg8::EpiBf16<0>, Sched1, true, true>(F.lds, g, S, E);
        if (DUP_PHASE == 2) { __syncthreads(); pg8::gemm_phase<pg8::EpiBf16<0>, Sched1, true, true>(F.lds, g, S, E); }
    } TSTAMP(12); SEAM(2); TSTAMP(13);
    if (IN(3)) { fresh(F); p3_chunkA(F); fresh(F); kprep(F); TSTAMP(14); if (DUP_PHASE == 3) { fresh(F); p3_chunkA(F); } } SEAM(3); TSTAMP(15);
    if (IN(4)) {
        fresh(F);
        { const bool g256 = F.G == 256; const int xg = F.bid & 7;
          int li0 = 3 * ((F.bid - 128) >> 3), cnt = 3;
          if (!g256 || F.bid < 128) { p4_chunkB(F); TSTAMP(30); LBAR(); fresh(F); li0 = 48 + (F.bid >> 3); cnt = 1; }
          if (!g256) cnt = (512 - F.bid + F.G - 1) / F.G;
          unsigned* tq = (unsigned*)((unsigned char*)F.MOD - WS_MOD + WS_CTL) + CW_TICKET + 64 * xg;
          volatile LAS unsigned* tk = (volatile LAS unsigned*)(F.lds + MISC_OFF) + 40;
          const bool pool = g256 && ATTN_POOL;
          unsigned nxt = 0u; if (pool && F.tid == 0) nxt = __hip_atomic_fetch_add(tq, 1u, __ATOMIC_RELAXED, __HIP_MEMORY_SCOPE_AGENT);
#define ATTN_ITEMS(NM) \
          for (int j = 0; ; ++j) { int li = li0 + j; \
              if (!pool) { if (j >= cnt) break; } \
              else { if (F.tid == 0) tk[0] = nxt; \
                  LBAR(); const unsigned q = tk[0]; LBAR(); if (q >= 64u) break; li = (int)q; \
                  if (F.tid == 0) nxt = __hip_atomic_fetch_add(tq, 1u, __ATOMIC_RELAXED, __HIP_MEMORY_SCOPE_AGENT); } \
              fresh(F); p4_attn_t<NM>(F, g256 ? (2 * xg + (li >> 5)) * 32 + (li & 31) : F.bid + j * F.G); LBAR(); }
          if (attn_nomax(F)) {
#pragma unroll 1
              ATTN_ITEMS(true)
          } else {
#pragma unroll 1
              ATTN_ITEMS(false)
          }
#undef ATTN_ITEMS
        }
        TSTAMP(16);
    } SEAM(4); TSTAMP(17);
    if (IN(5)) { fresh(F); p5_mix(F); TSTAMP(18);
        if (DBG_SEL >= 0 && F.bid == DBG_BLOCK && F.tid == 0) { volatile LAS unsigned long long* T_ = (volatile LAS unsigned long long*)(F.lds + DBG_LDS);
            F.DBG[0] = (float)(DBG_SEL == 99 ? (T_[0] + T_[1] + T_[2] + T_[3] + T_[4] + T_[5] + T_[6] + T_[7]) : T_[DBG_SEL]) * (DBG_FINE ? 1e-6f : 2.5e-7f); F.DBG[1] = (DBG_SEL2 == 24 ? (float)T_[24] * 1e-7f : (float)T_[DBG_SEL2] * 1e-4f); }
    } SEAM(5);
    if (IN(6)) {
        fresh(F);
        pg8::Gemm g{F.P, F.WOUT, ML, DM, DM, NIN};
        pg8::StaticOrder S; S.init(ML, DM, F.G, F.bid);
        pg8::EpiGate E{F.x, F.out, F.MOD + 4096, DM, DBG_SEL >= 0 ? F.DBG[0] : 0.f, DBG_SEL >= 0 ? F.DBG[1] : 0.f};
        pg8::gemm_phase<pg8::EpiGate, pg8::StaticOrder, true, true>(F.lds, g, S, E);
        if (DUP_PHASE == 6) { __syncthreads(); pg8::gemm_phase<pg8::EpiGate, pg8::StaticOrder, true, true>(F.lds, g, S, E); }
        if (DBG_SEL >= 0 && DBG_END > 0 && blockIdx.x == 0 && threadIdx.x == 0) { volatile LAS unsigned long long* T_ = (volatile LAS unsigned long long*)(F.lds + DBG_LDS);
            const unsigned long long n_ = __builtin_amdgcn_s_memrealtime(); asm volatile("s_waitcnt vmcnt(0)" ::: "memory");
            F.out[0] += (float)(DBG_END == 1 ? n_ - T_[34] : n_ - T_[32]) * 1e-5f; }
    }
#undef IN
#undef SEAM
}

extern "C" void kernel_launch(void* const* d_in, const int* in_sizes, int n_in, void* d_out, int out_size, void* d_ws, size_t ws_size, hipStream_t stream) {
    static int grid = 0;
    if (grid == 0) {
        if (n_in != 22 || out_size != ML * DM || ws_size < WS_END) { fprintf(stderr, "kernel_launch: unexpected problem shape (n_in %d, out %d, ws %zu)\n", n_in, out_size, ws_size); grid = -1; return; }
        int dev = 0, cus = 0;
        if (hipGetDevice(&dev) != hipSuccess || hipDeviceGetAttribute(&cus, hipDeviceAttributeMultiprocessorCount, dev) != hipSuccess) { grid = -1; return; }
        if (hipFuncSetAttribute((const void*)hymba_fwd, hipFuncAttributeMaxDynamicSharedMemorySize, LDS_BYTES) != hipSuccess) { fprintf(stderr, "kernel_launch: hipFuncSetAttribute failed\n"); grid = -1; return; }
        (void)hipGetLastError();
        grid = cus;
    }
    if (grid < 0) return;
    (void)hipMemsetAsync((char*)d_ws + WS_CTL, 0, CTL_ZERO_BYTES, stream);
    Args a{};
    for (int i = 0; i < 22; ++i) a.in[i] = (const float*)d_in[i];
    a.out = (float*)d_out; a.ws = (unsigned char*)d_ws;
    if (MK_N_LAUNCHES == 1) { a.ph_lo = 0; a.ph_hi = N_PHASES; hipLaunchKernelGGL(hymba_fwd, dim3(grid), dim3(NWAVES * 64), LDS_BYTES, stream, a); }
    else for (int p = 0; p < N_PHASES; ++p) { a.ph_lo = p; a.ph_hi = p + 1; hipLaunchKernelGGL(hymba_fwd, dim3(grid), dim3(NWAVES * 64), LDS_BYTES, stream, a); }
}
```

```cpp
#include <hip/hip_runtime.h>
#include <cstdio>
#include <cstdint>
#ifndef DBG_SEL
#define DBG_SEL -1
#endif
#ifndef DBG_SEL2
#define DBG_SEL2 0
#endif
#ifndef DBG_BLOCK
#define DBG_BLOCK 0
#endif
#ifndef DBG_END
#define DBG_END 0
#endif
namespace pg8 {
#define PG8_LAS __attribute__((address_space(3)))
typedef unsigned short bf16_t;
typedef short bf16x8 __attribute__((ext_vector_type(8)));
typedef float f32x4 __attribute__((ext_vector_type(4)));
typedef unsigned u32x4 __attribute__((ext_vector_type(4)));
constexpr int BM = 256, BK = 64, HALF = 128, HTB = HALF * BK * 2  , STAGE_BYTES = 8 * HTB, NXCD = 8, WGM = 8;

__host__ __device__ __forceinline__ int lds_byte(int r, int c) { const int st = (r >> 4) * 2 + (c >> 5), rr = r & 15, cc = c & 31, ob = rr * 64 + cc * 2; return st * 1024 + (ob ^ (((ob >> 9) & 1) << 5)); }
__host__ __device__ __forceinline__ void stage_rc(int b, int& R, int& C) { const int st = b / 1024, sb = b % 1024, swz = sb ^ (((sb >> 9) & 1) << 5); R = (st >> 1) * 16 + swz / 64; C = (st & 1) * 32 + (swz % 64) / 2; }
__host__ __device__ __forceinline__ int perm32(int rho) { const int n = rho >> 4, i = rho & 15; return 8 * (i >> 2) + 4 * n + (i & 3); }

struct Unit { int pm, pn; };
struct Gemm { const bf16_t* A; const bf16_t* Bt; int M, N, K, lda; };

struct StaticOrder {
    int nM, nN, nwg, G, c;
    __host__ __device__ void init(int M, int N, int G_, int c_) { nM = M / BM; nN = N / BM; nwg = nM * nN; G = G_; c = c_; }
    __host__ __device__ bool next(int i, Unit& u) const {
        const long L = (long)i * G + c; if (L >= nwg) return false;
        int wgid = (int)L; { const int q = nwg / NXCD, r = nwg % NXCD, xcd = wgid % NXCD, off = wgid / NXCD; wgid = (xcd < r ? xcd * (q + 1) : r * (q + 1) + (xcd - r) * q) + off; }
        const int nig = WGM * nN, gid = wgid / nig, fm = gid * WGM, gsz = (nM - fm) < WGM ? (nM - fm) : WGM;
        u.pm = fm + ((wgid % nig) % gsz); u.pn = (wgid % nig) / gsz; return true;
    }
    __device__ __forceinline__ void a_ready(const Unit&) const {}
    __device__ __forceinline__ void done(const Unit&) const {}
};

__device__ __forceinline__ unsigned cvt_pk_bf16(float lo, float hi) { unsigned r; asm volatile("v_cvt_pk_bf16_f32 %0, %1, %2" : "=v"(r) : "v"(lo), "v"(hi)); return r; }
typedef float f32x2 __attribute__((ext_vector_type(2)));
__device__ __forceinline__ f32x2 gelu_pk(f32x2 v) {
    const f32x2 av = __builtin_elementwise_abs(v), d = av * 0.2316418882f + 1.0f;
    f32x2 t; t.x = __builtin_amdgcn_rcpf(d.x); t.y = __builtin_amdgcn_rcpf(d.y);
    f32x2 q = t * 0.5307027145f + (-0.7265760135f); q = q * t + 0.7107068705f; q = q * t + (-0.142248368f); q = q * t + 0.127414796f; q = q * t;
    const f32x2 s = (v * v) * (-0.72134752044f);
    f32x2 e; e.x = __builtin_amdgcn_exp2f(s.x); e.y = __builtin_amdgcn_exp2f(s.y);
    const f32x2 m = v * (q * e), r = v - m;
    f32x2 o; o.x = v.x < 0.f ? m.x : r.x; o.y = v.y < 0.f ? m.y : r.y; return o;
}

template <int ACT  > struct EpiBf16 {
    static constexpr bool PERM = true, AFTER_DRAIN = false; static_assert(ACT == 0 || ACT == 1, "EpiBf16: ACT is 0 (none) or 1 (gelu_pk)");
    bf16_t* O; int ldc; const float* bias; int split_cols; size_t split_stride; float scale0;
    __device__ __forceinline__ void operator()(const f32x4 (&acc)[2][2][4][2], const Unit& u, int wr, int wc, int fr, int fq) const {
        const int row0 = u.pm * BM + wr * 64 + fr; int colt = u.pn * BM; bf16_t* base = O;
        float sc = 1.f; if (split_cols) { const int t = colt / split_cols; base += (size_t)t * split_stride; colt -= t * split_cols; if (t == 0) sc = scale0; }
        const int col0 = colt + wc * 32 + 8 * fq, bcol0 = u.pn * BM + wc * 32 + 8 * fq;
        f32x4 bv[2][2];
#pragma unroll
        for (int bj = 0; bj < 2; ++bj)
#pragma unroll
            for (int n = 0; n < 2; ++n) bv[bj][n] = bias ? *(const f32x4*)(bias + bcol0 + bj * HALF + 4 * n) : (f32x4){0.f, 0.f, 0.f, 0.f};
#pragma unroll
        for (int ai = 0; ai < 2; ++ai)
#pragma unroll
            for (int m = 0; m < 4; ++m) { bf16_t* rowp = base + (size_t)(row0 + ai * HALF + m * 16) * ldc + col0;
#pragma unroll
                for (int bj = 0; bj < 2; ++bj) { f32x4 v0 = acc[ai][bj][m][0] + bv[bj][0], v1 = acc[ai][bj][m][1] + bv[bj][1];
                    if (ACT == 1) { f32x2 a = gelu_pk((f32x2){v0[0], v0[1]}), b = gelu_pk((f32x2){v0[2], v0[3]}), c = gelu_pk((f32x2){v1[0], v1[1]}), d = gelu_pk((f32x2){v1[2], v1[3]});
                        v0 = (f32x4){a.x, a.y, b.x, b.y}; v1 = (f32x4){c.x, c.y, d.x, d.y}; }
                    v0 = v0 * sc; v1 = v1 * sc; u32x4 w; w.x = cvt_pk_bf16(v0[0], v0[1]); w.y = cvt_pk_bf16(v0[2], v0[3]); w.z = cvt_pk_bf16(v1[0], v1[1]); w.w = cvt_pk_bf16(v1[2], v1[3]);
                    *(u32x4*)(rowp + bj * HALF) = w; } }
    }
};


struct EpiGate {
    static constexpr bool PERM = false, AFTER_DRAIN = false;
    const float* x; float* out; const float* gate; int ldc; float dbg0, dbg1;
    __device__ __forceinline__ void operator()(const f32x4 (&acc)[2][2][4][2], const Unit& u, int wr, int wc, int fr, int fq) const {
        const int col0 = u.pn * BM + wc * 32 + 4 * fq;
        const int b = (u.pm * BM) >> 12;
        f32x4 gv[2][2];
#pragma unroll
        for (int bj = 0; bj < 2; ++bj)
#pragma unroll
            for (int n = 0; n < 2; ++n) gv[bj][n] = *(const f32x4*)(gate + (size_t)b * 6144 + col0 + bj * HALF + n * 16);
#pragma unroll
        for (int ai = 0; ai < 2; ++ai)
#pragma unroll
            for (int m = 0; m < 4; ++m) { const size_t off = (size_t)(u.pm * BM + ai * HALF + wr * 64 + m * 16 + fr) * ldc + col0;
#pragma unroll
                for (int bj = 0; bj < 2; ++bj)
#pragma unroll
                    for (int n = 0; n < 2; ++n) { const f32x4 xv = *(const f32x4*)(x + off + bj * HALF + n * 16);
                        f32x4 o = xv + gv[bj][n] * acc[ai][bj][m][n];
                        if (DBG_SEL >= 0) { o = o + dbg0; if (off + bj * HALF + n * 16 == 0) o.x += dbg1; }
                        *(f32x4*)(out + off + bj * HALF + n * 16) = o; }
                if (m & 1) asm volatile("" ::: "memory"); }
    }
};
template <class Epi, class Sched, bool ALIGN_EPI = false, bool SP2 = false>
__device__ __forceinline__ void gemm_phase(PG8_LAS unsigned char* lds, const Gemm g, const Sched& S, const Epi& E) {
    const int tid = threadIdx.x, wid = __builtin_amdgcn_readfirstlane(tid >> 6), lane = tid & 63, wr = wid >> 2, wc = wid & 3, fr = lane & 15, fq = lane >> 4;
    const int K = g.K, nt = K / BK, lda = g.lda;
    unsigned voffA[2], voffB[2];
#pragma unroll
    for (int i = 0; i < 2; ++i) { int R, C; stage_rc(tid * 16 + i * 8192, R, C); const int Rb = Epi::PERM ? ((R & ~31) + perm32(R & 31)) : R;
        voffA[i] = (unsigned)(R * lda + C) * 2u; voffB[i] = (unsigned)(Rb * K + C) * 2u; }
    const size_t kstep = (size_t)(BK * 2);
    const size_t hstepA = (size_t)HALF * lda * 2, hstepB = (size_t)HALF * K * 2;
    const size_t tstepA = 2 * hstepA, tstepB = 2 * hstepB;
    const unsigned ldsw = (unsigned)wid * 1024u;
    const int aoff = lds_byte(wr * 64 + fr, fq * 8), boff = lds_byte(wc * 32 + fr, fq * 8);
#define PG8_SA(b, h) (((b) * 2 + (h)) * HTB)
#define PG8_SB(b, h) ((4 + (b) * 2 + (h)) * HTB)
#define PG8_STAGE(bufoff, gbase, voff) do { _Pragma("unroll") for (int _i = 0; _i < 2; ++_i) \
        __builtin_amdgcn_global_load_lds((const unsigned*)((const char*)(gbase) + (voff)[_i]), (PG8_LAS unsigned*)(lds + (bufoff) + ldsw + _i * 8192), 16, 0, 0); } while (0)
#define PG8_LDA(dst, b, h) do { _Pragma("unroll") for (int m = 0; m < 4; ++m) _Pragma("unroll") for (int k = 0; k < 2; ++k) dst[m][k] = *(const PG8_LAS bf16x8*)(lds + PG8_SA(b, h) + aoff + m * 2048 + k * 1024); } while (0)
#define PG8_LDB(dst, b, h) do { _Pragma("unroll") for (int n = 0; n < 2; ++n) _Pragma("unroll") for (int k = 0; k < 2; ++k) dst[n][k] = *(const PG8_LAS bf16x8*)(lds + PG8_SB(b, h) + boff + n * 2048 + k * 1024); } while (0)
#define PG8_MMA(ai, bj, At, Bt) do { __builtin_amdgcn_s_setprio(1); _Pragma("unroll") for (int m = 0; m < 4; ++m) _Pragma("unroll") for (int n = 0; n < 2; ++n) _Pragma("unroll") for (int k = 0; k < 2; ++k) \
        acc[ai][bj][m][n] = __builtin_amdgcn_mfma_f32_16x16x32_bf16(Bt[n][k], At[m][k], acc[ai][bj][m][n], 0, 0, 0); __builtin_amdgcn_s_setprio(0); } while (0)
#define PG8_WAIT_V(n) asm volatile("s_waitcnt vmcnt(" #n ")" ::: "memory")
#define PG8_WAIT_L(n) asm volatile("s_waitcnt lgkmcnt(" #n ")" ::: "memory")
#define PG8_BAR __builtin_amdgcn_s_barrier()
#define PG8_SCHED __builtin_amdgcn_sched_barrier(0)
    Unit cur, nxt; int ui = 0;
    if (!S.next(0, cur)) return;
    f32x4 acc[2][2][4][2];
#pragma unroll
    for (int a = 0; a < 2; ++a)
#pragma unroll
        for (int b = 0; b < 2; ++b)
#pragma unroll
            for (int m = 0; m < 4; ++m)
#pragma unroll
                for (int n = 0; n < 2; ++n) acc[a][b][m][n] = (f32x4){0.f, 0.f, 0.f, 0.f};
    bf16x8 At[4][2], B0[2][2], B1[2][2];
    const char* cA = (const char*)g.A + (size_t)cur.pm * tstepA; const char* cB = (const char*)g.Bt + (size_t)cur.pn * tstepB;
    S.a_ready(cur);
    if constexpr (SP2) {
        PG8_STAGE(PG8_SB(0, 0), cB, voffB); PG8_STAGE(PG8_SB(0, 1), cB + hstepB, voffB); PG8_STAGE(PG8_SA(0, 0), cA, voffA); PG8_STAGE(PG8_SA(0, 1), cA + hstepA, voffA);
        if (wr == 1) PG8_BAR;
        PG8_WAIT_V(2); PG8_BAR;
        PG8_STAGE(PG8_SB(1, 0), cB + kstep, voffB); PG8_STAGE(PG8_SA(1, 0), cA + kstep, voffA); PG8_STAGE(PG8_SB(1, 1), cB + hstepB + kstep, voffB);
        PG8_WAIT_V(6); PG8_BAR;
    } else {
        PG8_STAGE(PG8_SB(0, 0), cB, voffB); PG8_STAGE(PG8_SA(0, 0), cA, voffA); PG8_STAGE(PG8_SB(0, 1), cB + hstepB, voffB); PG8_STAGE(PG8_SA(0, 1), cA + hstepA, voffA);
        if (wr == 1) PG8_BAR;
        PG8_WAIT_V(4); PG8_BAR;
        PG8_STAGE(PG8_SB(1, 0), cB + kstep, voffB); PG8_STAGE(PG8_SA(1, 0), cA + kstep, voffA); PG8_STAGE(PG8_SB(1, 1), cB + hstepB + kstep, voffB);
        PG8_WAIT_V(6); PG8_BAR;
    }
    for (;;) {
        const bool has_next = S.next(ui + 1, nxt);
        const char* nA = has_next ? (const char*)g.A + (size_t)nxt.pm * tstepA : cA; const char* nB = has_next ? (const char*)g.Bt + (size_t)nxt.pn * tstepB : cB;
        for (int t = 0; t < nt; t += 2) {
            const bool last = (t == nt - 2);
            const char* a1 = cA + (size_t)(t + 1) * kstep;
            const char* a2 = last ? nA : cA + (size_t)(t + 2) * kstep; const char* b2 = last ? nB : cB + (size_t)(t + 2) * kstep;
            const char* a3 = a2 + kstep; const char* b3 = b2 + kstep;
            if (last && has_next) S.a_ready(nxt);
            if constexpr (SP2) {
            PG8_LDB(B0, 0, 0); PG8_LDB(B1, 0, 1); PG8_SCHED; PG8_LDA(At, 0, 0); PG8_STAGE(PG8_SA(1, 1), a1 + hstepA, voffA);
            PG8_WAIT_V(8); PG8_WAIT_L(0); PG8_BAR; PG8_MMA(0, 0, At, B0); PG8_MMA(0, 1, At, B1); PG8_BAR; PG8_SCHED;
            PG8_LDA(At, 0, 1); PG8_STAGE(PG8_SB(0, 0), b2, voffB); PG8_STAGE(PG8_SB(0, 1), b2 + hstepB, voffB); PG8_STAGE(PG8_SA(0, 0), a2, voffA);
            PG8_WAIT_V(8); PG8_WAIT_L(0); PG8_BAR; PG8_MMA(1, 0, At, B0); PG8_MMA(1, 1, At, B1); PG8_BAR; PG8_SCHED;
            PG8_LDB(B0, 1, 0); PG8_LDB(B1, 1, 1); PG8_SCHED; PG8_LDA(At, 1, 0); PG8_STAGE(PG8_SA(0, 1), a2 + hstepA, voffA);
            PG8_WAIT_V(8); PG8_WAIT_L(0); PG8_BAR; PG8_MMA(0, 0, At, B0); PG8_MMA(0, 1, At, B1); PG8_BAR; PG8_SCHED;
            PG8_LDA(At, 1, 1); PG8_STAGE(PG8_SB(1, 0), b3, voffB); PG8_STAGE(PG8_SB(1, 1), b3 + hstepB, voffB); PG8_STAGE(PG8_SA(1, 0), a3, voffA);
            PG8_WAIT_V(8); PG8_WAIT_L(0); PG8_BAR; PG8_MMA(1, 0, At, B0); PG8_MMA(1, 1, At, B1); PG8_BAR; PG8_SCHED;
            } else {
            PG8_LDB(B0, 0, 0); PG8_SCHED; PG8_LDA(At, 0, 0); PG8_STAGE(PG8_SA(1, 1), a1 + hstepA, voffA);
            PG8_WAIT_L(8); PG8_BAR; PG8_WAIT_L(0); PG8_MMA(0, 0, At, B0); PG8_BAR; PG8_SCHED;
            PG8_LDB(B1, 0, 1); PG8_STAGE(PG8_SB(0, 0), b2, voffB);
            PG8_BAR; PG8_WAIT_L(0); PG8_MMA(0, 1, At, B1); PG8_BAR;
            PG8_LDA(At, 0, 1); PG8_STAGE(PG8_SA(0, 0), a2, voffA);
            PG8_BAR; PG8_WAIT_L(0); PG8_MMA(1, 0, At, B0); PG8_BAR; PG8_SCHED;
            PG8_STAGE(PG8_SB(0, 1), b2 + hstepB, voffB);
            PG8_WAIT_V(6); PG8_BAR; PG8_MMA(1, 1, At, B1); PG8_BAR;
            PG8_LDB(B0, 1, 0); PG8_SCHED; PG8_LDA(At, 1, 0); PG8_STAGE(PG8_SA(0, 1), a2 + hstepA, voffA);
            PG8_WAIT_L(8); PG8_BAR; PG8_WAIT_L(0); PG8_MMA(0, 0, At, B0); PG8_BAR; PG8_SCHED;
            PG8_LDB(B1, 1, 1); PG8_STAGE(PG8_SB(1, 0), b3, voffB);
            PG8_BAR; PG8_WAIT_L(0); PG8_MMA(0, 1, At, B1); PG8_BAR;
            PG8_LDA(At, 1, 1); PG8_STAGE(PG8_SA(1, 0), a3, voffA);
            PG8_BAR; PG8_WAIT_L(0); PG8_MMA(1, 0, At, B0); PG8_BAR; PG8_SCHED;
            PG8_STAGE(PG8_SB(1, 1), b3 + hstepB, voffB);
            PG8_WAIT_V(6); PG8_BAR; PG8_MMA(1, 1, At, B1); PG8_BAR;
            }
        }
        if constexpr (ALIGN_EPI) { if (wr == 0) PG8_BAR; }
        if constexpr (!Epi::AFTER_DRAIN) { E(acc, cur, wr, wc, fr, fq); S.done(cur); }
        if (!has_next) break;
#pragma unroll
        for (int a = 0; a < 2; ++a)
#pragma unroll
            for (int b = 0; b < 2; ++b)
#pragma unroll
                for (int m = 0; m < 4; ++m)
#pragma unroll
                    for (int n = 0; n < 2; ++n) acc[a][b][m][n] = (f32x4){0.f, 0.f, 0.f, 0.f};
        cur = nxt; cA = nA; cB = nB; ++ui;
        if constexpr (ALIGN_EPI) { if (wr == 1) PG8_BAR; }
    }
    PG8_WAIT_V(0);
    if constexpr (!ALIGN_EPI) { if (wr == 0) PG8_BAR; }
    PG8_BAR;
    if constexpr (Epi::AFTER_DRAIN) { E.fused(acc, cur, wr, wc, fr, fq, lds, wid, lane); S.done(cur); }
#undef PG8_SA
#undef PG8_SB
#undef PG8_STAGE
#undef PG8_LDA
#undef PG8_LDB
#undef PG8_MMA
#undef PG8_WAIT_V
#undef PG8_WAIT_L
#undef PG8_BAR
#undef PG8_SCHED
}
}

#ifndef MK_N_LAUNCHES
#define MK_N_LAUNCHES 1
#endif
#ifndef B_DUMMY
#define B_DUMMY 0
#endif
#ifndef DUP_PHASE
#define DUP_PHASE -1
#endif
constexpr int N_PHASES = 7;
constexpr int NWAVES = 8;
constexpr int DM = 2048, NB = 4, SEQ = 4096, CTXL = 256;
constexpr int ML = NB * SEQ, MC = NB * CTXL, MT = ML + MC;
constexpr int NIN = 6912;
constexpr int C_R = 0, C_K = 1024, C_V = 2048, C_LW = 3072, C_LA = 3200, C_ZR = 3328, C_Q = 4352, C_KA = 5376, C_VA = 5632, C_ZA = 5888;
constexpr float LOG2E = 1.4426950408889634f;
constexpr int DBG_LDS = 143360;

constexpr size_t MiB = 1u << 20;
constexpr size_t WS_CTL = 0, CTL_ZERO_BYTES = 64 * 1024;
constexpr size_t WS_MOD = 1 * MiB;
constexpr size_t WS_ROPE = 1 * MiB + 128 * 1024;
constexpr size_t WS_DBG = 1 * MiB + 192 * 1024;
constexpr size_t WS_W2T = 1 * MiB + 256 * 1024;
constexpr size_t WS_A2T = 1 * MiB + 512 * 1024;
constexpr size_t WS_WOUT = 2 * MiB;
constexpr size_t WS_P = 10 * MiB;
constexpr size_t WS_XN = 240 * MiB;
constexpr size_t WS_WIN = 308 * MiB;
constexpr size_t WS_GHQ = 240 * MiB;
constexpr size_t WS_MIX = 240 * MiB;
constexpr size_t WS_YF = 444 * MiB, WS_YB = 476 * MiB;
constexpr size_t WS_BON = 508 * MiB;
constexpr size_t WS_END = 510 * MiB;
static_assert(WS_P + (size_t)MT * NIN * 2 <= WS_XN && WS_XN + (size_t)MT * DM * 2 <= WS_WIN && WS_WIN + (size_t)NIN * DM * 2 <= WS_YF && WS_GHQ + (size_t)8704 * 24576 <= WS_YF && WS_YB + (size_t)ML * 1024 * 2 <= WS_BON, "ws map");

constexpr int CW_BAR = 1024;
constexpr int CW_TICKET = 8192;
constexpr int LDS_BYTES = 163840;
constexpr int MISC_OFF = LDS_BYTES - 256;

#define GAS __attribute__((address_space(1)))
#define LAS __attribute__((address_space(3)))
typedef unsigned short bf16;
typedef float f32x4 __attribute__((ext_vector_type(4)));
typedef float f32x16 __attribute__((ext_vector_type(16)));
typedef short bf16x8 __attribute__((ext_vector_type(8)));
typedef unsigned u32x4 __attribute__((ext_vector_type(4)));
typedef unsigned u32x2 __attribute__((ext_vector_type(2)));
typedef _Float16 h8 __attribute__((ext_vector_type(8)));
typedef _Float16 h4 __attribute__((ext_vector_type(4)));
typedef _Float16 h2 __attribute__((ext_vector_type(2)));
typedef GAS unsigned gu32;

__device__ __forceinline__ unsigned f2bf(float f) { unsigned u = __builtin_bit_cast(unsigned, f); return (u + 0x7fffu + ((u >> 16) & 1u)) >> 16; }
typedef float f32x2_t __attribute__((ext_vector_type(2))); typedef __bf16 bf16x2_t __attribute__((ext_vector_type(2)));
__device__ __forceinline__ unsigned pk2(float lo, float hi) { f32x2_t v = {lo, hi}; bf16x2_t b = __builtin_convertvector(v, bf16x2_t); return __builtin_bit_cast(unsigned, b); }
__device__ __forceinline__ float bflo(unsigned w) { return __builtin_bit_cast(float, w << 16); }
__device__ __forceinline__ float bfhi(unsigned w) { return __builtin_bit_cast(float, w & 0xffff0000u); }
__device__ __forceinline__ void unpack8(const u32x4 r, float* v) { v[0] = bflo(r.x); v[1] = bfhi(r.x); v[2] = bflo(r.y); v[3] = bfhi(r.y); v[4] = bflo(r.z); v[5] = bfhi(r.z); v[6] = bflo(r.w); v[7] = bfhi(r.w); }
__device__ __forceinline__ unsigned pkh(float a, float b) { h2 v = {(_Float16)a, (_Float16)b}; return __builtin_bit_cast(unsigned, v); }
__device__ __forceinline__ float wave_sum(float v) {
#pragma unroll
    for (int o = 1; o < 64; o <<= 1) v += __shfl_xor(v, o);
    return v;
}
__device__ __forceinline__ float fast_exp(float x) { return __builtin_amdgcn_exp2f(x * LOG2E); }
__device__ __forceinline__ float sigmoidf_(float x) { return __builtin_amdgcn_rcpf(1.0f + fast_exp(-x)); }
__device__ __forceinline__ float siluf_(float x) { return x * sigmoidf_(x); }
template <int CTRL> __device__ __forceinline__ float dpp_f(float x) { return __builtin_bit_cast(float, __builtin_amdgcn_update_dpp(0, __builtin_bit_cast(int, x), CTRL, 0xF, 0xF, false)); }

#define XB_TMO      128
#define XB_XCNT(j)  (256  + 64 * (j))
#define XB_XSUB(j)  (1280 + 64 * (j))
#define XB_XGEN(j)  (2304 + 64 * (j))
#define XB_TOP      3328
#define XB_TOPGEN   3392
#define XCD_BAR_WORDS 3456
#define XB_SPIN_CAP (1u << 18)
__device__ __forceinline__ unsigned xb_ld(unsigned* p)              { return __hip_atomic_load(p, __ATOMIC_RELAXED, __HIP_MEMORY_SCOPE_AGENT); }
__device__ __forceinline__ unsigned xb_add(unsigned* p, unsigned v) { return __hip_atomic_fetch_add(p, v, __ATOMIC_RELAXED, __HIP_MEMORY_SCOPE_AGENT); }
__device__ __forceinline__ unsigned xb_xcc_id() { return (unsigned)__builtin_amdgcn_s_getreg((3 << 11) | 20) & 0xFu; }
#define XB_SPIN(cond, bar) do { unsigned _sp = 0; while (cond) { __builtin_amdgcn_s_sleep(1); \
    if ((++_sp & 255u) == 0u) { if (xb_ld(&(bar)[XB_TMO])) break; if (_sp > XB_SPIN_CAP) { atomicAdd(&(bar)[XB_TMO], 1u); break; } } } } while (0)
struct XcdBarrier { unsigned* bar; unsigned x; volatile LAS unsigned* st; };
__device__ __forceinline__ XcdBarrier xcd_barrier_post(unsigned* bar, volatile LAS unsigned* st) {
    XcdBarrier b; b.bar = bar; b.x = xb_xcc_id(); b.st = st;
    if (threadIdx.x == 0) (void)xb_add(&bar[XB_XCNT(b.x)], 1u);
    return b;
}
__device__ __forceinline__ void xcd_barrier_complete(unsigned* bar, unsigned x, unsigned& nloc, unsigned& nx) {
    const unsigned G = gridDim.x * gridDim.y * gridDim.z;
    unsigned sum, cnt, mine, sp = 0u;
    for (;;) {
        sum = 0u; cnt = 0u; mine = 0u;
#pragma unroll
        for (unsigned j = 0; j < 16; ++j) { const unsigned c = xb_ld(&bar[XB_XCNT(j)]); sum += c; cnt += (c > 0u) ? 1u : 0u; mine = (j == x) ? c : mine; }
        if (sum == G) break;
        __builtin_amdgcn_s_sleep(1);
        if ((++sp & 255u) == 0u) { if (xb_ld(&bar[XB_TMO])) break; if (sp > XB_SPIN_CAP) { atomicAdd(&bar[XB_TMO], 1u); break; } }
    }
    nloc = mine > 0u ? mine : 1u; nx = cnt > 0u ? cnt : 1u;
}
__device__ __forceinline__ void xcd_barrier(const XcdBarrier& b) {
    asm volatile("s_waitcnt vmcnt(0)" ::: "memory");
    __syncthreads();
    if (threadIdx.x == 0) {
        unsigned* bar = b.bar;
        __builtin_amdgcn_s_waitcnt(0);
        unsigned nloc = b.st[0], nx = b.st[1];
        if (nloc == 0u) { xcd_barrier_complete(bar, b.x, nloc, nx); b.st[0] = nloc; b.st[1] = nx; }
        const unsigned old = xb_add(&bar[XB_XSUB(b.x)], 1u);
        const unsigned gen = old / nloc;
        if (old + 1u == (gen + 1u) * nloc) {
            __builtin_amdgcn_fence(__ATOMIC_RELEASE, "agent");
            asm volatile("s_waitcnt vmcnt(0)" ::: "memory");
            const unsigned og = xb_add(&bar[XB_TOP], 1u);
            const unsigned tg = og / nx;
            if (og + 1u == (tg + 1u) * nx) xb_add(&bar[XB_TOPGEN], 1u);
            else XB_SPIN(xb_ld(&bar[XB_TOPGEN]) == tg, bar);
            __builtin_amdgcn_fence(__ATOMIC_ACQUIRE, "agent");
            xb_add(&bar[XB_XGEN(b.x)], 1u);
            asm volatile("s_waitcnt vmcnt(0)" ::: "memory");
        } else {
            XB_SPIN(xb_ld(&bar[XB_XGEN(b.x)]) == gen, bar);
            __builtin_amdgcn_fence(__ATOMIC_ACQUIRE, "agent");
            asm volatile("s_waitcnt vmcnt(0)" ::: "memory");
        }
    }
    __syncthreads();
}

#define DBG_FINE (!(DBG_SEL >= 8 && DBG_SEL < 24))
#define TSTAMP(k) do { if (DBG_SEL >= 0 && (DBG_FINE || ((k) >= 8 && (k) < 24)) && F.bid == DBG_BLOCK && F.tid == 0) { volatile LAS unsigned long long* T_ = (volatile LAS unsigned long long*)(F.lds + DBG_LDS); const unsigned long long n_ = __builtin_amdgcn_s_memrealtime(); const unsigned long long m_ = __builtin_amdgcn_s_memtime(); T_[k] += n_ - T_[32]; T_[32] = n_; if ((k) < 8) { T_[24] += m_ - T_[33]; } T_[33] = m_; } } while (0)
#define TSTART() do { if (DBG_SEL >= 0 && F.bid == DBG_BLOCK && F.tid == 0) { volatile LAS unsigned long long* T_ = (volatile LAS unsigned long long*)(F.lds + DBG_LDS); T_[32] = __builtin_amdgcn_s_memrealtime(); T_[33] = __builtin_amdgcn_s_memtime(); } } while (0)
struct Frame {
    LAS unsigned char* lds;
    int tid, lane, wave, G, bid;
    const float *x, *c, *ctx, *c_ctx, *w_ada, *b_ada, *norm_g, *w_in, *mu_shift, *w0, *w2, *a0, *a2, *k_k, *k_a, *r_k, *ln_g, *ln_b, *qng, *kng, *sink, *w_out;
    float* out;
    float *MOD, *ROPE, *BON, *DBG;
    bf16 *W2T, *A2T, *WOUT, *P, *XN, *WIN, *YF, *YB, *MIX;
    unsigned char* GHQ;
};


typedef const float* cfp_t;
__device__ __forceinline__ const float* karg_f(int idx) { int off = idx * 8; asm volatile("" : "+s"(off)); const __attribute__((address_space(4))) char* kp = (const __attribute__((address_space(4))) char*)__builtin_amdgcn_kernarg_segment_ptr(); return *(const __attribute__((address_space(4))) cfp_t*)(kp + off); }
__device__ __forceinline__ void fresh(Frame& F) {
    int t_ = threadIdx.x; asm volatile("" : "+v"(t_)); F.tid = t_; F.lane = t_ & 63; F.wave = __builtin_amdgcn_readfirstlane(t_ >> 6);
    int b_ = blockIdx.x; asm volatile("" : "+s"(b_)); F.bid = b_;
    F.x = karg_f(0); F.c = karg_f(1); F.ctx = karg_f(2); F.c_ctx = karg_f(3); F.w_ada = karg_f(4); F.b_ada = karg_f(5); F.norm_g = karg_f(6); F.w_in = karg_f(7);
    F.mu_shift = karg_f(8); F.w0 = karg_f(9); F.w2 = karg_f(10); F.a0 = karg_f(11); F.a2 = karg_f(12); F.k_k = karg_f(13); F.k_a = karg_f(14); F.r_k = karg_f(15);
    F.ln_g = karg_f(16); F.ln_b = karg_f(17); F.qng = karg_f(18); F.kng = karg_f(19); F.sink = karg_f(20); F.w_out = karg_f(21);
    F.out = (float*)karg_f(22);
    unsigned char* ws = (unsigned char*)karg_f(23);
    F.MOD = (float*)(ws + WS_MOD); F.ROPE = (float*)(ws + WS_ROPE); F.BON = (float*)(ws + WS_BON); F.DBG = (float*)(ws + WS_DBG);
    F.W2T = (bf16*)(ws + WS_W2T); F.A2T = (bf16*)(ws + WS_A2T); F.WOUT = (bf16*)(ws + WS_WOUT); F.P = (bf16*)(ws + WS_P); F.XN = (bf16*)(ws + WS_XN); F.WIN = (bf16*)(ws + WS_WIN);
    F.YF = (bf16*)(ws + WS_YF); F.YB = (bf16*)(ws + WS_YB); F.MIX = (bf16*)(ws + WS_MIX); F.GHQ = ws + WS_GHQ;
}

struct Sched1 {
    int G, c;
    __device__ __forceinline__ void init(int G_, int c_) { G = G_; c = c_; }
    __device__ __forceinline__ bool next(int i, pg8::Unit& u) const {
        int grp, loc;
        if (G == 256) { if (i >= 7) return false; grp = c & 7; loc = i * 32 + (c >> 3); if (loc >= 216) { const int j = grp * 8 + (loc - 216); if (j >= 60) return false; u.pm = 64 + j / 15; const int q = j % 15; u.pn = q < 13 ? q : q + 8; return true; } }
        else { const int L = i * G + c; if (L >= 1788) return false; if (L >= 1728) { const int j = L - 1728; u.pm = 64 + j / 15; const int q = j % 15; u.pn = q < 13 ? q : q + 8; return true; } grp = L / 216; loc = L % 216; }
        u.pm = grp * 8 + (loc & 7); u.pn = loc >> 3; return true;
    }
    __device__ __forceinline__ void a_ready(const pg8::Unit&) const {}
    __device__ __forceinline__ void done(const pg8::Unit&) const {}
};

__device__ __forceinline__ void p0_transpose_item(const float* W, int K, int N, bf16* WT, LAS float* scr, int item, int lane) {
    const int nblk = N / 32, kb = item / nblk, nb = item % nblk, k0 = 64 * kb, n0 = 32 * nb;
#pragma unroll 8
    for (int i = 0; i < 32; ++i) { const int kk = 2 * i + (lane >> 5); scr[kk * 33 + (lane & 31)] = W[(size_t)(k0 + kk) * N + n0 + (lane & 31)]; }
    asm volatile("s_waitcnt lgkmcnt(0)" ::: "memory");
    const int c = lane & 7;
#pragma unroll
    for (int j = 0; j < 4; ++j) { const int n = (lane >> 3) + 8 * j; const LAS float* s = scr + (8 * c) * 33 + n;
        u32x4 o; o.x = pk2(s[0 * 33], s[1 * 33]); o.y = pk2(s[2 * 33], s[3 * 33]); o.z = pk2(s[4 * 33], s[5 * 33]); o.w = pk2(s[6 * 33], s[7 * 33]);
        *(GAS u32x4*)(WT + (size_t)(n0 + n) * K + k0 + 8 * c) = o; }
    asm volatile("s_waitcnt lgkmcnt(0)" ::: "memory");
}
__device__ __forceinline__ void p0_prologue(Frame& F) {
    const int tid = F.tid, lane = F.lane, wave = F.wave;
    if (F.bid < 192) {
        LAS float* sl = (LAS float*)F.lds;
        LAS float* red = sl + 5 * 2048;
        for (int i = tid; i < 5 * 2048; i += NWAVES * 64) { const int v = i >> 11, k = i & 2047; const float cv = v < 4 ? F.c[v * 2048 + k] : F.c_ctx[k]; sl[i] = cv / (1.0f + __expf(-cv)); }
        __syncthreads();
        const int n0 = 32 * F.bid, col = lane & 31, slot = wave * 2 + (lane >> 5);
        float acc[5] = {0.f, 0.f, 0.f, 0.f, 0.f};
        const float* wp = F.w_ada + n0 + col;
#pragma unroll 8
        for (int k = slot; k < 2048; k += 16) { const float w = wp[(size_t)k * 6144];
#pragma unroll
            for (int v = 0; v < 5; ++v) acc[v] += sl[v * 2048 + k] * w; }
#pragma unroll
        for (int v = 0; v < 5; ++v) red[(slot * 5 + v) * 32 + col] = acc[v];
        __syncthreads();
        if (tid < 160) { const int v = tid >> 5, cc = tid & 31; float s = 0.f;
#pragma unroll
            for (int q = 0; q < 16; ++q) s += red[(q * 5 + v) * 32 + cc];
            F.MOD[v * 6144 + n0 + cc] = s + F.b_ada[n0 + cc]; }
        __syncthreads();
    }
    if (F.bid == F.G - 1) {
        for (int i = tid; i < 1024; i += NWAVES * 64) { const int pos = i >> 4, f = i & 15; const float inv = exp2f(-(float)f * (13.287712379549449f / 16.0f)); const float ang = (float)pos * inv;
            F.ROPE[i] = cosf(ang); F.ROPE[1024 + i] = sinf(ang); }
    }
    LAS float* scr = (LAS float*)(F.lds + wave * 16384);
    const int gw = F.bid * NWAVES + wave, NGW = F.G * NWAVES;
    constexpr int I_IN = (DM / 64) * (NIN / 32), I_OUT = (DM / 64) * (DM / 32), I_L = 1024 / 32;
    constexpr int NITEMS = I_IN + I_OUT + 4 * I_L;
    for (int it = gw; it < NITEMS; it += NGW) {
        int r = it;
        if (r < I_IN) { p0_transpose_item(F.w_in, DM, NIN, F.WIN, scr, r, lane); continue; } r -= I_IN;
        if (r < I_OUT) { p0_transpose_item(F.w_out, DM, DM, F.WOUT, scr, r, lane); continue; } r -= I_OUT;
        const int q = r / I_L; r -= q * I_L;
        p0_transpose_item((q < 2 ? F.w2 : F.a2) + (size_t)(q & 1) * 64 * 1024, 64, 1024, (q < 2 ? F.W2T : F.A2T) + (size_t)(q & 1) * 1024 * 64, scr, r, lane);
    }
}

__device__ __forceinline__ void p1_modulate(Frame& F) {
    const int gw = F.bid * NWAVES + F.wave, NGW = F.G * NWAVES, lane = F.lane;
    const int m_lo = (int)(((long)gw * MT) / NGW), m_hi = (int)(((long)(gw + 1) * MT) / NGW);
    f32x4 gs[8], sh[8]; int cur = -1;
    for (int m = m_lo; m < m_hi; ++m) {
        const float* src = m < ML ? F.x + (size_t)m * DM : F.ctx + (size_t)(m - ML) * DM;
        const int bsel = m < ML ? (m >> 12) : 4;
        if (bsel != cur) { cur = bsel; const float* mod = F.MOD + bsel * 6144;
#pragma unroll
            for (int j = 0; j < 8; ++j) { const int d0 = (64 * j + lane) * 4; gs[j] = *(const f32x4*)(F.norm_g + d0) * (1.0f + *(const f32x4*)(mod + 2048 + d0)); sh[j] = *(const f32x4*)(mod + d0); } }
        const GAS f32x4* xr = (const GAS f32x4*)src + lane;
        f32x4 v[8]; float s = 0.f;
#pragma unroll
        for (int j = 0; j < 8; ++j) { v[j] = xr[64 * j]; s += (v[j].x * v[j].x + v[j].y * v[j].y) + (v[j].z * v[j].z + v[j].w * v[j].w); }
        const float rr = 1.0f / sqrtf(wave_sum(s) * (1.0f / DM) + 1e-6f);
        GAS u32x2* o8 = (GAS u32x2*)(F.XN + (size_t)m * DM) + lane;
#pragma unroll
        for (int j = 0; j < 8; ++j) { const f32x4 o = v[j] * rr * gs[j] + sh[j]; u32x2 w; w.x = pk2(o.x, o.y); w.y = pk2(o.z, o.w); o8[64 * j] = w; }
    }
}

__device__ __forceinline__ int seq_lo(int m) { return m < ML ? (m & ~(SEQ - 1)) : ML + ((m - ML) & ~(CTXL - 1)); }
__device__ __forceinline__ int seq_hi(int m) { return m < ML ? (m | (SEQ - 1)) : ML + ((m - ML) | (CTXL - 1)); }
__device__ __forceinline__ int scan_row(int b, int d, int blk, int tok) {
    const int j = blk < 4 ? blk * 64 + tok : (blk - 4) * 64 + tok;
    if (blk < 4) return ML + b * CTXL + (d ? (CTXL - 1 - j) : j);
    return b * SEQ + (d ? (SEQ - 1 - j) : j);
}
constexpr int CH_RS = 144, CH_MB = 64 * CH_RS;
constexpr int CB_AT = 0, CB_BT = 1, CB_KT = 2, CB_RT = 3, CB_ATT = 4, CB_BTT = 5, CB_KTT = 6, CB_VT = 7, CB_AAB = 8, CB_AABT = 9, CB_AAK = 10, CB_ARB = 11, CB_ARK = 12, CB_X1 = 13, CB_XT = 14, CB_INV = 4, CB_OY = 4, CB_OG = 5, CB_OH = 6, CB_OQ = 7;
constexpr int CH_WBUF = 8 * CH_MB, CH_ABUF = CH_WBUF + 16384;
constexpr int CH_PT = 15 * CH_MB, CH_GT = CH_PT + 1024, CH_CONST = CH_GT + 2048;
constexpr int CH_LW = 144384;
#ifndef FORCE_BF16
#define FORCE_BF16 0
#endif
constexpr size_t GHQ_ITEM = 24576;
#define LBAR() do { asm volatile("s_waitcnt lgkmcnt(0)" ::: "memory"); __builtin_amdgcn_s_barrier(); asm volatile("" ::: "memory"); } while (0)
__device__ __forceinline__ float h_lo(unsigned w) { return (float)__builtin_bit_cast(h2, w)[0]; }
__device__ __forceinline__ float h_hi(unsigned w) { return (float)__builtin_bit_cast(h2, w)[1]; }
__device__ __forceinline__ f32x4 unpack4x(bool f16, const u32x2 w) { f32x4 r;
    if (f16) { r.x = h_lo(w.x); r.y = h_hi(w.x); r.z = h_lo(w.y); r.w = h_hi(w.y); } else { r.x = bflo(w.x); r.y = bfhi(w.x); r.z = bflo(w.y); r.w = bfhi(w.y); }
    return r; }
__device__ __forceinline__ u32x4 pack8x(bool f16, const float* v) { u32x4 o;
    if (f16) { o.x = pkh(v[0], v[1]); o.y = pkh(v[2], v[3]); o.z = pkh(v[4], v[5]); o.w = pkh(v[6], v[7]); } else { o.x = pk2(v[0], v[1]); o.y = pk2(v[2], v[3]); o.z = pk2(v[4], v[5]); o.w = pk2(v[6], v[7]); }
    return o; }
__device__ __forceinline__ f32x16 mm32(bool f16, const LAS unsigned char* Aop, int mrow0, const LAS unsigned char* Blay, int nrow0, f32x16 acc, int l31, int hi) {
    const LAS unsigned char* pa = Aop + (mrow0 + l31) * CH_RS + hi * 16;
    const LAS unsigned char* pb = Blay + (nrow0 + l31) * CH_RS + hi * 16;
    bf16x8 a[4], b[4];
#pragma unroll
    for (int ks = 0; ks < 4; ++ks) { a[ks] = *(const LAS bf16x8*)(pa + ks * 32); b[ks] = *(const LAS bf16x8*)(pb + ks * 32); }
    if (f16) {
#pragma unroll
        for (int ks = 0; ks < 4; ++ks) acc = __builtin_amdgcn_mfma_f32_32x32x16_f16(__builtin_bit_cast(h8, a[ks]), __builtin_bit_cast(h8, b[ks]), acc, 0, 0, 0);
    } else {
#pragma unroll
        for (int ks = 0; ks < 4; ++ks) acc = __builtin_amdgcn_mfma_f32_32x32x16_bf16(a[ks], b[ks], acc, 0, 0, 0);
    }
    return acc;
}
__device__ __forceinline__ f32x16 mm32k(bool f16, const LAS unsigned char* Aop, int mrow0, const LAS unsigned char* Blay, int nrow0, int kb, f32x16 acc, int l31, int hi) {
    const LAS unsigned char* pa = Aop + (mrow0 + l31) * CH_RS + kb * 64 + hi * 16;
    const LAS unsigned char* pb = Blay + (nrow0 + l31) * CH_RS + kb * 64 + hi * 16;
    const bf16x8 a0 = *(const LAS bf16x8*)pa, a1 = *(const LAS bf16x8*)(pa + 32), b0 = *(const LAS bf16x8*)pb, b1 = *(const LAS bf16x8*)(pb + 32);
    if (f16) { acc = __builtin_amdgcn_mfma_f32_32x32x16_f16(__builtin_bit_cast(h8, a0), __builtin_bit_cast(h8, b0), acc, 0, 0, 0); acc = __builtin_amdgcn_mfma_f32_32x32x16_f16(__builtin_bit_cast(h8, a1), __builtin_bit_cast(h8, b1), acc, 0, 0, 0); }
    else { acc = __builtin_amdgcn_mfma_f32_32x32x16_bf16(a0, b0, acc, 0, 0, 0); acc = __builtin_amdgcn_mfma_f32_32x32x16_bf16(a1, b1, acc, 0, 0, 0); }
    return acc;
}
typedef short s16x4 __attribute__((ext_vector_type(4))); typedef short s16x8 __attribute__((ext_vector_type(8)));
__device__ __forceinline__ bf16x8 trfrag(const LAS unsigned char* Img, int j0, int c0, int lane) {
    const int g = lane >> 4, q = (lane >> 2) & 3, p = lane & 3;
    LAS unsigned char* a = (LAS unsigned char*)Img + (j0 + 8 * (g >> 1) + q) * CH_RS + (c0 + 16 * (g & 1) + 4 * p) * 2;
    const s16x4 r0 = __builtin_amdgcn_ds_read_tr16_b64_v4i16((LAS s16x4*)a), r1 = __builtin_amdgcn_ds_read_tr16_b64_v4i16((LAS s16x4*)(a + 4 * CH_RS));
    return __builtin_bit_cast(bf16x8, __builtin_shufflevector(r0, r1, 0, 1, 2, 3, 4, 5, 6, 7));
}
template<bool TA, bool TB> __device__ __forceinline__ f32x16 mm32x(bool f16, const LAS unsigned char* A, int a0, const LAS unsigned char* B, int b0, f32x16 acc, int lane) {
    const int l31 = lane & 31, hi = lane >> 5;
    bf16x8 a[4], b[4];
#pragma unroll
    for (int ks = 0; ks < 4; ++ks) {
        a[ks] = TA ? trfrag(A, 16 * ks, a0, lane) : *(const LAS bf16x8*)(A + (a0 + l31) * CH_RS + hi * 16 + ks * 32);
        b[ks] = TB ? trfrag(B, 16 * ks, b0, lane) : *(const LAS bf16x8*)(B + (b0 + l31) * CH_RS + hi * 16 + ks * 32); }
    if (f16) {
#pragma unroll
        for (int ks = 0; ks < 4; ++ks) acc = __builtin_amdgcn_mfma_f32_32x32x16_f16(__builtin_bit_cast(h8, a[ks]), __builtin_bit_cast(h8, b[ks]), acc, 0, 0, 0);
    } else {
#pragma unroll
        for (int ks = 0; ks < 4; ++ks) acc = __builtin_amdgcn_mfma_f32_32x32x16_bf16(a[ks], b[ks], acc, 0, 0, 0);
    }
    return acc;
}
__device__ __forceinline__ void st_nat(bool f16, LAS unsigned char* Out, int mrow0, int nrow0, const f32x16& acc, int l31, int hi) {
    LAS unsigned char* p = Out + (nrow0 + l31) * CH_RS + (mrow0 + 4 * hi) * 2;
    if (f16) {
#pragma unroll
        for (int rg = 0; rg < 4; ++rg) { u32x2 o; o.x = pkh(acc[4 * rg], acc[4 * rg + 1]); o.y = pkh(acc[4 * rg + 2], acc[4 * rg + 3]); *(LAS u32x2*)(p + rg * 16) = o; }
    } else {
#pragma unroll
        for (int rg = 0; rg < 4; ++rg) { u32x2 o; o.x = pk2(acc[4 * rg], acc[4 * rg + 1]); o.y = pk2(acc[4 * rg + 2], acc[4 * rg + 3]); *(LAS u32x2*)(p + rg * 16) = o; }
    }
}
__device__ __forceinline__ f32x16 zero16() { f32x16 z = {0.f, 0.f, 0.f, 0.f, 0.f, 0.f, 0.f, 0.f, 0.f, 0.f, 0.f, 0.f, 0.f, 0.f, 0.f, 0.f}; return z; }
struct ChRegs { u32x4 r, k, v, lw, la, halo; };
__device__ __forceinline__ int chunk_mlo(int b, int d, int c) { return d ? scan_row(b, d, c, 63) : scan_row(b, d, c, 0); }
__device__ __forceinline__ void ch_load(Frame& F, ChRegs& R, int b, int h, int d, int c) {
    const int tok = F.tid >> 3, ch = F.tid & 7, m = scan_row(b, d, c, tok);
    const bf16* pc = F.P + (size_t)m * NIN + 8 * ch;
    const int cr = C_R + h * 64, ck = C_K + h * 64, cv = C_V + h * 64, cw = C_LW + d * 64, ca = C_LA + d * 64;
    R.r = *(const u32x4*)(pc + cr); R.k = *(const u32x4*)(pc + ck); R.v = *(const u32x4*)(pc + cv); R.lw = *(const u32x4*)(pc + cw); R.la = *(const u32x4*)(pc + ca);
    const u32x4 z = {0u, 0u, 0u, 0u}; R.halo = z;
    if (F.tid < 80) { const int hrow = F.tid >= 40 ? 1 : 0, vec = (F.tid - 40 * hrow) >> 3, mlo = chunk_mlo(b, d, c), mh = hrow ? mlo + 64 : mlo - 1;
        const int col = vec == 0 ? cr : vec == 1 ? ck : vec == 2 ? cv : vec == 3 ? cw : ca;
        if (mh >= seq_lo(mlo) && mh <= seq_hi(mlo)) R.halo = *(const u32x4*)(F.P + (size_t)mh * NIN + col + 8 * ch); }
}
constexpr int CH_RAW3 = 0 * CH_MB, CH_RAWL = 10 * CH_MB;
__device__ __forceinline__ void ch_park(Frame& F, const ChRegs& R, int b, int d, int c) {
    LAS unsigned char* lds = F.lds; const int tok = F.tid >> 3, ch = F.tid & 7, ri = 1 + scan_row(b, d, c, tok) - chunk_mlo(b, d, c);
    LAS unsigned char* p3 = lds + CH_RAW3 + ri * 384 + ch * 16; LAS unsigned char* pl = lds + CH_RAWL + ri * 256 + ch * 16;
    *(LAS u32x4*)p3 = R.r; *(LAS u32x4*)(p3 + 128) = R.k; *(LAS u32x4*)(p3 + 256) = R.v; *(LAS u32x4*)pl = R.lw; *(LAS u32x4*)(pl + 128) = R.la;
    if (F.tid < 80) { const int hrow = F.tid >= 40 ? 1 : 0, vec = (F.tid - 40 * hrow) >> 3, rh = hrow ? 65 : 0;
        if (vec < 3) *(LAS u32x4*)(lds + CH_RAW3 + rh * 384 + vec * 128 + ch * 16) = R.halo; else *(LAS u32x4*)(lds + CH_RAWL + rh * 256 + (vec - 3) * 128 + ch * 16) = R.halo; }
}
__device__ __forceinline__ void shift8(const u32x4 c, const u32x4 p, const u32x4 n, const LAS f32x4* mu, float* o) {
    float vc[8], vp[8], vn[8]; unpack8(c, vc); unpack8(p, vp); unpack8(n, vn);
    const f32x4 m0 = mu[0], m1 = mu[1];
#pragma unroll
    for (int j = 0; j < 8; ++j) { const float mm = j < 4 ? m0[j & 3] : m1[j & 3]; o[j] = vc[j] + mm * (0.5f * (vp[j] + vn[j]) - vc[j]); }
}
template<bool F16> __device__ __forceinline__ f32x16 mf2(const u32x4 a0, const u32x4 a1, const u32x4 b0, const u32x4 b1, f32x16 acc) {
    if (F16) { acc = __builtin_amdgcn_mfma_f32_32x32x16_f16(__builtin_bit_cast(h8, a0), __builtin_bit_cast(h8, b0), acc, 0, 0, 0); acc = __builtin_amdgcn_mfma_f32_32x32x16_f16(__builtin_bit_cast(h8, a1), __builtin_bit_cast(h8, b1), acc, 0, 0, 0); }
    else { acc = __builtin_amdgcn_mfma_f32_32x32x16_bf16(__builtin_bit_cast(bf16x8, a0), __builtin_bit_cast(bf16x8, b0), acc, 0, 0, 0); acc = __builtin_amdgcn_mfma_f32_32x32x16_bf16(__builtin_bit_cast(bf16x8, a1), __builtin_bit_cast(bf16x8, b1), acc, 0, 0, 0); }
    return acc; }
template<bool F16> __device__ __forceinline__ void cv2(const f32x16& a, u32x4& s0, u32x4& s1) {
    if (F16) { s0.x = pkh(a[0], a[1]); s0.y = pkh(a[2], a[3]); s0.z = pkh(a[4], a[5]); s0.w = pkh(a[6], a[7]); s1.x = pkh(a[8], a[9]); s1.y = pkh(a[10], a[11]); s1.z = pkh(a[12], a[13]); s1.w = pkh(a[14], a[15]); }
    else { s0.x = pk2(a[0], a[1]); s0.y = pk2(a[2], a[3]); s0.z = pk2(a[4], a[5]); s0.w = pk2(a[6], a[7]); s1.x = pk2(a[8], a[9]); s1.y = pk2(a[10], a[11]); s1.z = pk2(a[12], a[13]); s1.w = pk2(a[14], a[15]); } }
template<bool F16, bool TR> __device__ __forceinline__ f32x16 inv_chain(const f32x16& ap0, const f32x16& aq0, int l31, int hi) {
    u32x4 p0, p1, q0, q1, x0, x1;
    cv2<F16>(ap0, p0, p1); cv2<F16>(aq0, q0, q1);
    f32x16 x = TR ? aq0 : ap0;
#pragma unroll
    for (int r = 0; r < 16; ++r) { const int row = (r & 3) + 8 * (r >> 2) + 4 * hi; if (row == l31) x[r] += 1.0f; }
    cv2<F16>(x, x0, x1);
#pragma unroll
    for (int k = 1; k <= 4; ++k) {
        const bool needP = (k < 4) || TR, needQ = (k < 4) || !TR;
        f32x16 ap = zero16(), aq = zero16();
        if (needP) ap = mf2<F16>(q0, q1, p0, p1, ap);
        if (needQ) aq = mf2<F16>(p0, p1, q0, q1, aq);
        if (needP) cv2<F16>(ap, p0, p1);
        if (needQ) cv2<F16>(aq, q0, q1);
        x = TR ? mf2<F16>(p0, p1, x0, x1, x) : mf2<F16>(q0, q1, x0, x1, x);
        if (k < 4) cv2<F16>(x, x0, x1);
    }
    return x;
}
template<bool F16> __device__ __forceinline__ void chain_wave(LAS unsigned char* lds, int wave, int lane, u32x4& t0, u32x4& t1) {
    const int l31 = lane & 31, hi = lane >> 5, o = wave == 2 ? 32 : 0;
    const LAS unsigned char* At = lds + CB_AT * CH_MB; const LAS unsigned char* Bt = lds + CB_BT * CH_MB;
    f32x16 aq = mm32(F16, Bt, o, At, o, zero16(), l31, hi);
    f32x16 ap = mm32(F16, At, o, Bt, o, zero16(), l31, hi);
#pragma unroll
    for (int r = 0; r < 16; ++r) { const int row = (r & 3) + 8 * (r >> 2) + 4 * hi; aq[r] = row < l31 ? aq[r] : 0.f; ap[r] = l31 < row ? ap[r] : 0.f; }
    if (wave != 3) { const f32x16 x = inv_chain<F16, true>(ap, aq, l31, hi); st_nat(F16, lds + CB_INV * CH_MB, o, o, x, l31, hi); if (wave == 2) cv2<F16>(x, t0, t1); }
    else { const f32x16 x1 = inv_chain<F16, false>(ap, aq, l31, hi);
        u32x4 b0, b1, a0, a1, u0, u1; cv2<F16>(x1, b0, b1);
        const f32x16 a21 = mm32(F16, Bt, 0, At, 32, zero16(), l31, hi);
        cv2<F16>(a21, a0, a1);
        const f32x16 u = mf2<F16>(a0, a1, b0, b1, zero16());
        cv2<F16>(u, u0, u1);
        *(LAS u32x4*)(lds + CB_AAB * CH_MB + lane * 16) = u0; *(LAS u32x4*)(lds + CB_AAB * CH_MB + 1024 + lane * 16) = u1; }
}
__device__ __forceinline__ void ch_tail(const bool f16, Frame& F, ChRegs& R, const float (&sr)[8], const float (&sk)[8], const float (&sv)[8], int b, int h, int d, int c, int chain, int ci) {
    int lane_ = F.lane; asm volatile("" : "+v"(lane_));
    const int tid = F.tid, lane = lane_, wave = F.wave, l31 = lane & 31, hi = lane >> 5;
    const int q4 = wave & 3, tb = q4 >> 1, cb = q4 & 1, tok = tid >> 3, ch = tid & 7;
    LAS unsigned char* lds = F.lds;
    const LAS f32x4* cs = (const LAS f32x4*)(lds + CH_CONST) + 2 * ch;
    const LAS float* pT = (const LAS float*)(lds + CH_PT);
#define CB(i) (lds + (i) * CH_MB)
    { const LAS f32x4* pw = (const LAS f32x4*)(lds + CH_WBUF) + tok * 16 + 2 * ch; const LAS f32x4* pab = (const LAS f32x4*)(lds + CH_ABUF) + tok * 16 + 2 * ch;
      const f32x4 p0 = pw[0], p1 = pw[1], a0v = pab[0], a1v = pab[1];
      f32x4 m0 = {1.f, 1.f, 1.f, 1.f}, m1 = m0; if (tok > 0) { m0 = pw[-16]; m1 = pw[-15]; }
      const f32x4 r0 = *(const LAS f32x4*)(pT + 64 + 8 * ch), r1 = *(const LAS f32x4*)(pT + 64 + 8 * ch + 4);
      const f32x4 kk0 = cs[80], kk1 = cs[81], ka0 = cs[96], ka1 = cs[97], rk0 = cs[112], rk1 = cs[113];
      float kk[8], ss = 0.f;
#pragma unroll
      for (int j = 0; j < 8; ++j) { kk[j] = sk[j] * (j < 4 ? kk0[j & 3] : kk1[j & 3]); ss += kk[j] * kk[j]; }
      ss += __shfl_xor(ss, 1); ss += __shfl_xor(ss, 2); ss += __shfl_xor(ss, 4);
      const float inv = __builtin_amdgcn_rsqf(fmaxf(ss, 1e-24f));
      float at[8], bt[8], kt[8], rt[8], bon = 0.f;
#pragma unroll
      for (int j = 0; j < 8; ++j) { const float P = j < 4 ? p0[j & 3] : p1[j & 3], Pm = j < 4 ? m0[j & 3] : m1[j & 3], a = j < 4 ? a0v[j & 3] : a1v[j & 3], pr = j < 4 ? r0[j & 3] : r1[j & 3];
          const float kac = j < 4 ? ka0[j & 3] : ka1[j & 3], rkc = j < 4 ? rk0[j & 3] : rk1[j & 3];
          const float kn = kk[j] * inv, kd = sk[j] * (1.0f + (a - 1.0f) * kac), ipr = __builtin_amdgcn_rcpf(pr), rp = pr * __builtin_amdgcn_rcpf(P);
          at[j] = -kn * Pm * ipr; bt[j] = kn * a * rp; kt[j] = kd * rp; rt[j] = sr[j] * P * ipr; bon += sr[j] * kd * rkc; }
      bon += __shfl_xor(bon, 1); bon += __shfl_xor(bon, 2); bon += __shfl_xor(bon, 4);
      if (ch == 0 && c >= 4) F.BON[((size_t)d * ML + scan_row(b, d, c, tok)) * 16 + h] = bon;
      *(LAS u32x4*)(CB(CB_AT) + tok * CH_RS + ch * 16) = pack8x(f16, at);
      *(LAS u32x4*)(CB(CB_BT) + tok * CH_RS + ch * 16) = pack8x(f16, bt);
      *(LAS u32x4*)(CB(CB_KT) + tok * CH_RS + ch * 16) = pack8x(f16, kt);
      *(LAS u32x4*)(CB(CB_RT) + tok * CH_RS + ch * 16) = pack8x(f16, rt);
      *(LAS u32x4*)(CB(CB_X1) + tok * CH_RS + ch * 16) = pack8x(f16, sv); }
    LBAR(); TSTAMP(3);
    const bool chainw = wave == 0 || wave == 2 || wave == 3;
    if (!chainw && ci + 1 < 34) ch_load(F, R, b, h, d, c - 1);
    u32x4 t0 = {0u, 0u, 0u, 0u}, t1 = t0;
    if (chainw) { if (f16) chain_wave<true>(lds, wave, lane, t0, t1); else chain_wave<false>(lds, wave, lane, t0, t1); }
    else { const bool mid = wave >= 4 && wave <= 6;
#pragma unroll 1
      for (int i = 0; i < 2; ++i) { if (wave == 1 && i == 1) break;
          const int pr = wave == 1 ? 1 : wave == 7 ? 2 + i : wave - 3, jb = mid ? i : 0, tbk = mid ? 1 : 0;
          const LAS unsigned char* Aop = CB((pr & 1) ? CB_KT : CB_BT); const LAS unsigned char* Blay = CB(pr < 2 ? CB_AT : CB_RT);
          LAS unsigned char* Out = CB(CB_AAB + 1 + pr);
          f32x16 a = mm32(f16, Aop, jb * 32, Blay, tbk * 32, zero16(), l31, hi);
          if (jb == tbk) { const bool incl = pr >= 2;
#pragma unroll
              for (int r = 0; r < 16; ++r) { const int j = (r & 3) + 8 * (r >> 2) + 4 * hi; const bool ok = incl ? (j <= l31) : (j < l31); a[r] = ok ? a[r] : 0.f; } }
          st_nat(f16, Out, jb * 32, tbk * 32, a, l31, hi); }
      if (wave == 1) { st_nat(f16, CB(CB_AAK), 32, 0, zero16(), l31, hi); st_nat(f16, CB(CB_INV), 32, 0, zero16(), l31, hi); }
      if (wave == 7) { st_nat(f16, CB(CB_ARB), 32, 0, zero16(), l31, hi); st_nat(f16, CB(CB_ARK), 32, 0, zero16(), l31, hi); } }
    LBAR(); TSTAMP(4);
    if ((wave == 0 || wave == 3) && ci + 1 < 34) ch_load(F, R, b, h, d, c - 1);
    if (wave == 2) { const u32x4 u0 = *(const LAS u32x4*)(CB(CB_AAB) + lane * 16), u1 = *(const LAS u32x4*)(CB(CB_AAB) + 1024 + lane * 16);
        const f32x16 y = f16 ? mf2<true>(u0, u1, t0, t1, zero16()) : mf2<false>(u0, u1, t0, t1, zero16());
        st_nat(f16, CB(CB_INV), 0, 32, y, l31, hi);
        if (ci + 1 < 34) ch_load(F, R, b, h, d, c - 1); }
    else if (wave >= 4) { const f32x16 acc = mm32x<false, true>(f16, CB(CB_AAK), tb * 32, CB(CB_X1), cb * 32, zero16(), lane); st_nat(f16, CB(CB_XT), tb * 32, cb * 32, acc, l31, hi); }
    LBAR();
    TSTAMP(5);
    { f32x16 acc = wave < 4 ? mm32x<false, true>(f16, CB(CB_INV), tb * 32, CB(CB_AT), cb * 32, zero16(), lane) : mm32(f16, CB(CB_INV), tb * 32, CB(CB_XT), cb * 32, zero16(), l31, hi);
      st_nat(f16, CB(wave < 4 ? CB_AAB : CB_AABT), tb * 32, cb * 32, acc, l31, hi); }
    LBAR(); TSTAMP(6);
    { const int om = wave >> 1, nb = wave & 1;
      int c_ = c; asm volatile("" : "+s"(c_));
#pragma unroll
      for (int mb = 0; mb < 2; ++mb) {
          if (om == 0) {
              f32x16 acc; const LAS unsigned char* p = CB(CB_RT) + (nb * 32 + l31) * CH_RS + (mb * 32 + 4 * hi) * 2;
#pragma unroll
              for (int rg = 0; rg < 4; ++rg) { const u32x2 w = *(const LAS u32x2*)(p + rg * 16); const f32x4 u = unpack4x(f16, w); acc[4 * rg] = u.x; acc[4 * rg + 1] = u.y; acc[4 * rg + 2] = u.z; acc[4 * rg + 3] = u.w; }
              acc = mm32(f16, CB(CB_AAB), mb * 32, CB(CB_ARB), nb * 32, acc, l31, hi);
              LAS unsigned char* o = CB(CB_OQ) + (nb * 32 + l31) * CH_RS + (mb * 32 + 4 * hi) * 2;
#pragma unroll
              for (int rg = 0; rg < 4; ++rg) { const f32x4 pv = *(const LAS f32x4*)(pT + 64 + mb * 32 + 8 * rg + 4 * hi);
                  u32x2 w; w.x = pkh(acc[4 * rg] * pv.x, acc[4 * rg + 1] * pv.y); w.y = pkh(acc[4 * rg + 2] * pv.z, acc[4 * rg + 3] * pv.w); *(LAS u32x2*)(o + rg * 16) = w; }
          } else if (om == 1) {
              f32x16 acc = mm32x<false, true>(f16, CB(CB_AAB), mb * 32, CB(CB_BT), nb * 32, zero16(), lane);
              const float pto = pT[nb * 32 + l31], ptk = pT[128 + nb * 32 + l31];
              LAS unsigned char* o = CB(CB_OG) + (nb * 32 + l31) * CH_RS + (mb * 32 + 4 * hi) * 2;
#pragma unroll
              for (int rg = 0; rg < 4; ++rg) { const f32x4 pv = *(const LAS f32x4*)(pT + 64 + mb * 32 + 8 * rg + 4 * hi); float g[4];
#pragma unroll
                  for (int i = 0; i < 4; ++i) { const int kp = mb * 32 + 8 * rg + 4 * hi + i; g[i] = pto * pv[i] * acc[4 * rg + i] + (kp == nb * 32 + l31 ? ptk : 0.0f); }
                  u32x2 w; w.x = pkh(g[0], g[1]); w.y = pkh(g[2], g[3]); *(LAS u32x2*)(o + rg * 16) = w; }
          } else if (om == 2) {
              f32x16 acc = mm32x<true, false>(f16, CB(CB_BT), mb * 32, CB(CB_AABT), nb * 32, zero16(), lane);
              acc = mm32x<true, true>(f16, CB(CB_KT), mb * 32, CB(CB_X1), nb * 32, acc, lane);
              LAS unsigned char* o = CB(CB_OH) + (nb * 32 + l31) * CH_RS + (mb * 32 + 4 * hi) * 2;
#pragma unroll
              for (int rg = 0; rg < 4; ++rg) { const f32x4 pv = *(const LAS f32x4*)(pT + mb * 32 + 8 * rg + 4 * hi);
                  u32x2 w; w.x = pkh(acc[4 * rg] * pv.x, acc[4 * rg + 1] * pv.y); w.y = pkh(acc[4 * rg + 2] * pv.z, acc[4 * rg + 3] * pv.w); *(LAS u32x2*)(o + rg * 16) = w; }
          } else if (c_ >= 4) {
              f32x16 acc = mm32(f16, CB(CB_AABT), mb * 32, CB(CB_ARB), nb * 32, zero16(), l31, hi);
              acc = mm32x<true, false>(f16, CB(CB_X1), mb * 32, CB(CB_ARK), nb * 32, acc, lane);
              LAS unsigned char* yp = CB(CB_OY) + (nb * 32 + l31) * CH_RS + (mb * 32 + 4 * hi) * 2;
#pragma unroll
              for (int rg = 0; rg < 4; ++rg) { u32x2 w; w.x = pkh(acc[4 * rg], acc[4 * rg + 1]); w.y = pkh(acc[4 * rg + 2], acc[4 * rg + 3]); *(LAS u32x2*)(yp + rg * 16) = w; }
          }
      } }
    LBAR();
    { int c_ = c; asm volatile("" : "+s"(c_));
      unsigned char* gq = (unsigned char*)F.GHQ + ((size_t)chain * 68 + c_) * GHQ_ITEM + tok * 128 + ch * 16; const int lo = tok * CH_RS + ch * 16;
      *(u32x4*)gq = *(const LAS u32x4*)(CB(CB_OG) + lo); *(u32x4*)(gq + 8192) = *(const LAS u32x4*)(CB(CB_OH) + lo); *(u32x4*)(gq + 16384) = *(const LAS u32x4*)(CB(CB_OQ) + lo);
      if (c_ >= 4) *(u32x4*)((unsigned char*)(d ? F.YB : F.YF) + (size_t)scan_row(b, d, c_, tok) * 2048 + h * 128 + ch * 16) = *(const LAS u32x4*)(CB(CB_OY) + lo); }
    TSTAMP(7);
#undef CB
}

__device__ __forceinline__ void p3_chunkA(Frame& F) {
    const int tid = F.tid, lane = F.lane, wave = F.wave, l31 = lane & 31, hi = lane >> 5;
    LAS unsigned char* lds = F.lds;
#define CB(i) (lds + (i) * CH_MB)
    for (int g = F.bid; g < 256; g += F.G) {
        const int chain = g >> 1, c0 = (g & 1) * 34, d = chain & 1, h = (chain >> 1) & 15, b = chain >> 5;
        { const int q = tid >> 6, n = tid & 63, c = h * 64 + n;
          const float val = q == 0 ? F.mu_shift[C_R + c] : q == 1 ? F.mu_shift[C_K + c] : q == 2 ? F.mu_shift[C_V + c] : q == 3 ? F.mu_shift[C_LW + d * 64 + n] : q == 4 ? F.mu_shift[C_LA + d * 64 + n] : q == 5 ? F.k_k[c] : q == 6 ? F.k_a[c] : F.r_k[c];
          ((LAS float*)(lds + CH_CONST))[tid] = val; }
        const int q4 = wave & 3, tb = q4 >> 1, cb = q4 & 1;
        { const int row = tid >> 3, chk = tid & 7;
          *(LAS u32x4*)(lds + CH_LW + row * CH_RS + chk * 16) = *(const u32x4*)(F.W2T + ((size_t)d * 1024 + h * 64 + row) * 64 + 8 * chk);
          *(LAS u32x4*)(lds + CH_LW + CH_MB + row * CH_RS + chk * 16) = *(const u32x4*)(F.A2T + ((size_t)d * 1024 + h * 64 + row) * 64 + 8 * chk); }
        const float lbias = (wave < 4 ? F.w0 : F.a0)[d * 1024 + h * 64 + cb * 32 + l31];
        LBAR();
        ChRegs R;
        ch_load(F, R, b, h, d, c0 + 33);
#pragma unroll 1
        for (int ci = 0; ci < 34; ++ci) {
            const int c = c0 + 33 - ci;
            const int tok = tid >> 3, ch = tid & 7;
            const LAS f32x4* cs = (const LAS f32x4*)(lds + CH_CONST) + 2 * ch;
            float sr[8], sk[8], sv[8];
            ch_park(F, R, b, d, c);
            LBAR();
            { float slw[8], sla[8];
              const int ri = 1 + scan_row(b, d, c, tok) - chunk_mlo(b, d, c);
              const LAS unsigned char* p3 = lds + CH_RAW3 + ri * 384 + ch * 16; const LAS unsigned char* pl = lds + CH_RAWL + ri * 256 + ch * 16;
              shift8(R.r, *(const LAS u32x4*)(p3 - 384), *(const LAS u32x4*)(p3 + 384), cs, sr); shift8(R.k, *(const LAS u32x4*)(p3 - 384 + 128), *(const LAS u32x4*)(p3 + 384 + 128), cs + 16, sk);
              shift8(R.v, *(const LAS u32x4*)(p3 - 384 + 256), *(const LAS u32x4*)(p3 + 384 + 256), cs + 32, sv);
              shift8(R.lw, *(const LAS u32x4*)(pl - 256), *(const LAS u32x4*)(pl + 256), cs + 48, slw); shift8(R.la, *(const LAS u32x4*)(pl - 256 + 128), *(const LAS u32x4*)(pl + 256 + 128), cs + 64, sla);
#pragma unroll
              for (int j = 0; j < 8; ++j) slw[j] = 1.0f - 2.0f * __builtin_amdgcn_rcpf(1.0f + fast_exp(2.0f * slw[j]));
              u32x4 o; o.x = pk2(slw[0], slw[1]); o.y = pk2(slw[2], slw[3]); o.z = pk2(slw[4], slw[5]); o.w = pk2(slw[6], slw[7]); *(LAS u32x4*)(CB(CB_X1) + tok * CH_RS + ch * 16) = o;
              o.x = pk2(sla[0], sla[1]); o.y = pk2(sla[2], sla[3]); o.z = pk2(sla[4], sla[5]); o.w = pk2(sla[6], sla[7]); *(LAS u32x4*)(CB(CB_XT) + tok * CH_RS + ch * 16) = o; }
            LBAR(); TSTAMP(0);
            { f32x16 acc = zero16();
              const LAS unsigned char* pa = CB(wave < 4 ? CB_X1 : CB_XT) + (tb * 32 + l31) * CH_RS + hi * 16;
              const LAS unsigned char* pw2 = lds + CH_LW + (wave < 4 ? 0 : CH_MB) + (cb * 32 + l31) * CH_RS + hi * 16;
#pragma unroll
              for (int ks = 0; ks < 4; ++ks) acc = __builtin_amdgcn_mfma_f32_32x32x16_bf16(*(const LAS bf16x8*)(pa + ks * 32), *(const LAS bf16x8*)(pw2 + ks * 32), acc, 0, 0, 0);
              LAS float* dst = (LAS float*)(lds + (wave < 4 ? CH_WBUF : CH_ABUF)) + cb * 32 + l31;
#pragma unroll
              for (int r = 0; r < 16; ++r) { const int t = tb * 32 + (r & 3) + 8 * (r >> 2) + 4 * hi; const float sg = sigmoidf_(acc[r] + lbias);
                  dst[t * 64] = wave < 4 ? fast_exp(-0.6065306597126334f * sg) : sg; } }
            LBAR(); TSTAMP(1);
            { LAS float* wb = (LAS float*)(lds + CH_WBUF) + (wave * 8) * 64 + (tid & 63); LAS float* gt = (LAS float*)(lds + CH_GT);
              float q[8]; q[0] = wb[0];
#pragma unroll
              for (int i = 1; i < 8; ++i) q[i] = q[i - 1] * wb[i * 64];
              gt[wave * 64 + (tid & 63)] = q[7];
              LBAR();
              float pre = 1.0f, p31 = 1.0f;
#pragma unroll
              for (int gg = 0; gg < 7; ++gg) { const float tv = gt[gg * 64 + (tid & 63)]; pre = gg < wave ? pre * tv : pre; p31 = gg < 4 ? p31 * tv : p31; }
#pragma unroll
              for (int i = 0; i < 8; ++i) wb[i * 64] = pre * q[i];
              if (wave == 7) { const float p63 = pre * q[7]; LAS float* pt = (LAS float*)(lds + CH_PT);
                  pt[tid & 63] = p63 / p31;
                  pt[64 + (tid & 63)] = p31;
                  pt[128 + (tid & 63)] = p63;
                  const bool ok = !FORCE_BF16 && p31 > 2.44140625e-4f && p63 > 2.44140625e-4f * p31;
                  if ((tid & 63) == 0) ((LAS unsigned*)pt)[192] = __all(ok) ? 1u : 0u; else (void)__all(ok); } }
            LBAR(); TSTAMP(2);
            { const bool f16 = __builtin_amdgcn_readfirstlane((int)((const LAS unsigned*)(lds + CH_PT))[192]) != 0;
              ch_tail(f16, F, R, sr, sk, sv, b, h, d, c, chain, ci); }
        }
    }
#undef CB
}

constexpr int BL_SLOT = 2 * CH_MB, BL_SLOTB = 4 * CH_MB, BL_YB = BL_SLOT + 2 * BL_SLOTB;
__device__ __forceinline__ void p4_chunkB(Frame& F) {
    const int lane = F.lane, wave = F.wave, l31 = lane & 31, hi = lane >> 5, srow = F.tid >> 3, sch = F.tid & 7;
    LAS unsigned char* lds = F.lds;
    for (int chain = F.bid; chain < 128; chain += F.G) {
        const int d = chain & 1, h = (chain >> 1) & 15, b = chain >> 5;
        const int q4 = wave & 3, mb = q4 >> 1, nb = q4 & 1;
        for (int i = F.tid; i < 2 * CH_MB / 4; i += NWAVES * 64) ((LAS unsigned*)lds)[i] = 0u;
        const unsigned char* gq0 = (const unsigned char*)F.GHQ + (size_t)chain * 68 * GHQ_ITEM;
        unsigned char* Yb = (unsigned char*)(d ? F.YB : F.YF) + h * 128;
        u32x4 Ra0, Ra1, Ra2, Ra3, Rb0, Rb1, Rb2, Rb3;
        { int c__ = (0); c__ = c__ < 67 ? c__ : 67; const unsigned char* gq = gq0 + (size_t)c__ * GHQ_ITEM + srow * 128 + sch * 16; const int cy = c__ < 4 ? 4 : c__;
              Ra0 = *(const u32x4*)gq; Ra1 = *(const u32x4*)(gq + 8192); Ra2 = *(const u32x4*)(gq + 16384);
              Ra3 = *(const u32x4*)(Yb + (size_t)scan_row(b, d, cy, srow) * 2048 + sch * 16); }
        { LAS unsigned char* sn = lds + BL_SLOT + srow * CH_RS + sch * 16; *(LAS u32x4*)sn = Ra0; *(LAS u32x4*)(sn + CH_MB) = Ra1; *(LAS u32x4*)(sn + 2 * CH_MB) = Ra2; *(LAS u32x4*)(sn + 3 * CH_MB) = Ra3; }
        { int c__ = (1); c__ = c__ < 67 ? c__ : 67; const unsigned char* gq = gq0 + (size_t)c__ * GHQ_ITEM + srow * 128 + sch * 16; const int cy = c__ < 4 ? 4 : c__;
              Ra0 = *(const u32x4*)gq; Ra1 = *(const u32x4*)(gq + 8192); Ra2 = *(const u32x4*)(gq + 16384);
              Ra3 = *(const u32x4*)(Yb + (size_t)scan_row(b, d, cy, srow) * 2048 + sch * 16); }
        { int c__ = (2); c__ = c__ < 67 ? c__ : 67; const unsigned char* gq = gq0 + (size_t)c__ * GHQ_ITEM + srow * 128 + sch * 16; const int cy = c__ < 4 ? 4 : c__;
              Rb0 = *(const u32x4*)gq; Rb1 = *(const u32x4*)(gq + 8192); Rb2 = *(const u32x4*)(gq + 16384);
              Rb3 = *(const u32x4*)(Yb + (size_t)scan_row(b, d, cy, srow) * 2048 + sch * 16); }
        LBAR();
#pragma unroll 1
        for (int c = 0; c < 68; c += 4) {
            { const int c_ = (c);
              LAS unsigned char* sn = lds + BL_SLOT + ((c_ + 1) & 1) * BL_SLOTB + srow * CH_RS + sch * 16;
              *(LAS u32x4*)sn = Ra0; *(LAS u32x4*)(sn + CH_MB) = Ra1; *(LAS u32x4*)(sn + 2 * CH_MB) = Ra2; *(LAS u32x4*)(sn + 3 * CH_MB) = Ra3;
              { int c__ = (c_ + 3); c__ = c__ < 67 ? c__ : 67; const unsigned char* gq = gq0 + (size_t)c__ * GHQ_ITEM + srow * 128 + sch * 16; const int cy = c__ < 4 ? 4 : c__;
              Ra0 = *(const u32x4*)gq; Ra1 = *(const u32x4*)(gq + 8192); Ra2 = *(const u32x4*)(gq + 16384);
              Ra3 = *(const u32x4*)(Yb + (size_t)scan_row(b, d, cy, srow) * 2048 + sch * 16); }
              if (c_ >= 5) { const u32x4 yv = *(const LAS u32x4*)(lds + BL_YB + ((c_ - 1) & 1) * CH_MB + srow * CH_RS + sch * 16);
                  *(u32x4*)(Yb + (size_t)scan_row(b, d, c_ - 1, srow) * 2048 + sch * 16) = yv; }
              const LAS unsigned char* sc = lds + BL_SLOT + (c_ & 1) * BL_SLOTB; const LAS unsigned char* zc = lds + (c_ & 1) * CH_MB; LAS unsigned char* zn = lds + ((c_ + 1) & 1) * CH_MB;
              if (wave < 4) {
                  f32x16 acc; const LAS unsigned char* ph = sc + CH_MB + (nb * 32 + l31) * CH_RS + (mb * 32 + 4 * hi) * 2;
#pragma unroll
                  for (int rg = 0; rg < 4; ++rg) { const u32x2 w = *(const LAS u32x2*)(ph + rg * 16); acc[4 * rg] = h_lo(w.x); acc[4 * rg + 1] = h_hi(w.x); acc[4 * rg + 2] = h_lo(w.y); acc[4 * rg + 3] = h_hi(w.y); }
                  acc = mm32(true, sc, mb * 32, zc, nb * 32, acc, l31, hi);
                  st_nat(true, zn, mb * 32, nb * 32, acc, l31, hi);
              } else if (c_ >= 4) {
                  f32x16 acc; const LAS unsigned char* py = sc + 3 * CH_MB + (nb * 32 + l31) * CH_RS + (mb * 32 + 4 * hi) * 2;
#pragma unroll
                  for (int rg = 0; rg < 4; ++rg) { const u32x2 w = *(const LAS u32x2*)(py + rg * 16); acc[4 * rg] = h_lo(w.x); acc[4 * rg + 1] = h_hi(w.x); acc[4 * rg + 2] = h_lo(w.y); acc[4 * rg + 3] = h_hi(w.y); }
                  acc = mm32(true, zc, mb * 32, sc + 2 * CH_MB, nb * 32, acc, l31, hi);
                  st_nat(true, lds + BL_YB + (c_ & 1) * CH_MB, mb * 32, nb * 32, acc, l31, hi);
              }
              LBAR(); }
            { const int c_ = (c + 1);
              LAS unsigned char* sn = lds + BL_SLOT + ((c_ + 1) & 1) * BL_SLOTB + srow * CH_RS + sch * 16;
              *(LAS u32x4*)sn = Rb0; *(LAS u32x4*)(sn + CH_MB) = Rb1; *(LAS u32x4*)(sn + 2 * CH_MB) = Rb2; *(LAS u32x4*)(sn + 3 * CH_MB) = Rb3;
              { int c__ = (c_ + 3); c__ = c__ < 67 ? c__ : 67; const unsigned char* gq = gq0 + (size_t)c__ * GHQ_ITEM + srow * 128 + sch * 16; const int cy = c__ < 4 ? 4 : c__;
              Rb0 = *(const u32x4*)gq; Rb1 = *(const u32x4*)(gq + 8192); Rb2 = *(const u32x4*)(gq + 16384);
              Rb3 = *(const u32x4*)(Yb + (size_t)scan_row(b, d, cy, srow) * 2048 + sch * 16); }
              if (c_ >= 5) { const u32x4 yv = *(const LAS u32x4*)(lds + BL_YB + ((c_ - 1) & 1) * CH_MB + srow * CH_RS + sch * 16);
                  *(u32x4*)(Yb + (size_t)scan_row(b, d, c_ - 1, srow) * 2048 + sch * 16) = yv; }
              const LAS unsigned char* sc = lds + BL_SLOT + (c_ & 1) * BL_SLOTB; const LAS unsigned char* zc = lds + (c_ & 1) * CH_MB; LAS unsigned char* zn = lds + ((c_ + 1) & 1) * CH_MB;
              if (wave < 4) {
                  f32x16 acc; const LAS unsigned char* ph = sc + CH_MB + (nb * 32 + l31) * CH_RS + (mb * 32 + 4 * hi) * 2;
#pragma unroll
                  for (int rg = 0; rg < 4; ++rg) { const u32x2 w = *(const LAS u32x2*)(ph + rg * 16); acc[4 * rg] = h_lo(w.x); acc[4 * rg + 1] = h_hi(w.x); acc[4 * rg + 2] = h_lo(w.y); acc[4 * rg + 3] = h_hi(w.y); }
                  acc = mm32(true, sc, mb * 32, zc, nb * 32, acc, l31, hi);
                  st_nat(true, zn, mb * 32, nb * 32, acc, l31, hi);
              } else if (c_ >= 4) {
                  f32x16 acc; const LAS unsigned char* py = sc + 3 * CH_MB + (nb * 32 + l31) * CH_RS + (mb * 32 + 4 * hi) * 2;
#pragma unroll
                  for (int rg = 0; rg < 4; ++rg) { const u32x2 w = *(const LAS u32x2*)(py + rg * 16); acc[4 * rg] = h_lo(w.x); acc[4 * rg + 1] = h_hi(w.x); acc[4 * rg + 2] = h_lo(w.y); acc[4 * rg + 3] = h_hi(w.y); }
                  acc = mm32(true, zc, mb * 32, sc + 2 * CH_MB, nb * 32, acc, l31, hi);
                  st_nat(true, lds + BL_YB + (c_ & 1) * CH_MB, mb * 32, nb * 32, acc, l31, hi);
              }
              LBAR(); }
            { const int c_ = (c + 2);
              LAS unsigned char* sn = lds + BL_SLOT + ((c_ + 1) & 1) * BL_SLOTB + srow * CH_RS + sch * 16;
              *(LAS u32x4*)sn = Ra0; *(LAS u32x4*)(sn + CH_MB) = Ra1; *(LAS u32x4*)(sn + 2 * CH_MB) = Ra2; *(LAS u32x4*)(sn + 3 * CH_MB) = Ra3;
              { int c__ = (c_ + 3); c__ = c__ < 67 ? c__ : 67; const unsigned char* gq = gq0 + (size_t)c__ * GHQ_ITEM + srow * 128 + sch * 16; const int cy = c__ < 4 ? 4 : c__;
              Ra0 = *(const u32x4*)gq; Ra1 = *(const u32x4*)(gq + 8192); Ra2 = *(const u32x4*)(gq + 16384);
              Ra3 = *(const u32x4*)(Yb + (size_t)scan_row(b, d, cy, srow) * 2048 + sch * 16); }
              if (c_ >= 5) { const u32x4 yv = *(const LAS u32x4*)(lds + BL_YB + ((c_ - 1) & 1) * CH_MB + srow * CH_RS + sch * 16);
                  *(u32x4*)(Yb + (size_t)scan_row(b, d, c_ - 1, srow) * 2048 + sch * 16) = yv; }
              const LAS unsigned char* sc = lds + BL_SLOT + (c_ & 1) * BL_SLOTB; const LAS unsigned char* zc = lds + (c_ & 1) * CH_MB; LAS unsigned char* zn = lds + ((c_ + 1) & 1) * CH_MB;
              if (wave < 4) {
                  f32x16 acc; const LAS unsigned char* ph = sc + CH_MB + (nb * 32 + l31) * CH_RS + (mb * 32 + 4 * hi) * 2;
#pragma unroll
                  for (int rg = 0; rg < 4; ++rg) { const u32x2 w = *(const LAS u32x2*)(ph + rg * 16); acc[4 * rg] = h_lo(w.x); acc[4 * rg + 1] = h_hi(w.x); acc[4 * rg + 2] = h_lo(w.y); acc[4 * rg + 3] = h_hi(w.y); }
                  acc = mm32(true, sc, mb * 32, zc, nb * 32, acc, l31, hi);
                  st_nat(true, zn, mb * 32, nb * 32, acc, l31, hi);
              } else if (c_ >= 4) {
                  f32x16 acc; const LAS unsigned char* py = sc + 3 * CH_MB + (nb * 32 + l31) * CH_RS + (mb * 32 + 4 * hi) * 2;
#pragma unroll
                  for (int rg = 0; rg < 4; ++rg) { const u32x2 w = *(const LAS u32x2*)(py + rg * 16); acc[4 * rg] = h_lo(w.x); acc[4 * rg + 1] = h_hi(w.x); acc[4 * rg + 2] = h_lo(w.y); acc[4 * rg + 3] = h_hi(w.y); }
                  acc = mm32(true, zc, mb * 32, sc + 2 * CH_MB, nb * 32, acc, l31, hi);
                  st_nat(true, lds + BL_YB + (c_ & 1) * CH_MB, mb * 32, nb * 32, acc, l31, hi);
              }
              LBAR(); }
            { const int c_ = (c + 3);
              LAS unsigned char* sn = lds + BL_SLOT + ((c_ + 1) & 1) * BL_SLOTB + srow * CH_RS + sch * 16;
              *(LAS u32x4*)sn = Rb0; *(LAS u32x4*)(sn + CH_MB) = Rb1; *(LAS u32x4*)(sn + 2 * CH_MB) = Rb2; *(LAS u32x4*)(sn + 3 * CH_MB) = Rb3;
              { int c__ = (c_ + 3); c__ = c__ < 67 ? c__ : 67; const unsigned char* gq = gq0 + (size_t)c__ * GHQ_ITEM + srow * 128 + sch * 16; const int cy = c__ < 4 ? 4 : c__;
              Rb0 = *(const u32x4*)gq; Rb1 = *(const u32x4*)(gq + 8192); Rb2 = *(const u32x4*)(gq + 16384);
              Rb3 = *(const u32x4*)(Yb + (size_t)scan_row(b, d, cy, srow) * 2048 + sch * 16); }
              if (c_ >= 5) { const u32x4 yv = *(const LAS u32x4*)(lds + BL_YB + ((c_ - 1) & 1) * CH_MB + srow * CH_RS + sch * 16);
                  *(u32x4*)(Yb + (size_t)scan_row(b, d, c_ - 1, srow) * 2048 + sch * 16) = yv; }
              const LAS unsigned char* sc = lds + BL_SLOT + (c_ & 1) * BL_SLOTB; const LAS unsigned char* zc = lds + (c_ & 1) * CH_MB; LAS unsigned char* zn = lds + ((c_ + 1) & 1) * CH_MB;
              if (wave < 4) {
                  f32x16 acc; const LAS unsigned char* ph = sc + CH_MB + (nb * 32 + l31) * CH_RS + (mb * 32 + 4 * hi) * 2;
#pragma unroll
                  for (int rg = 0; rg < 4; ++rg) { const u32x2 w = *(const LAS u32x2*)(ph + rg * 16); acc[4 * rg] = h_lo(w.x); acc[4 * rg + 1] = h_hi(w.x); acc[4 * rg + 2] = h_lo(w.y); acc[4 * rg + 3] = h_hi(w.y); }
                  acc = mm32(true, sc, mb * 32, zc, nb * 32, acc, l31, hi);
                  st_nat(true, zn, mb * 32, nb * 32, acc, l31, hi);
              } else if (c_ >= 4) {
                  f32x16 acc; const LAS unsigned char* py = sc + 3 * CH_MB + (nb * 32 + l31) * CH_RS + (mb * 32 + 4 * hi) * 2;
#pragma unroll
                  for (int rg = 0; rg < 4; ++rg) { const u32x2 w = *(const LAS u32x2*)(py + rg * 16); acc[4 * rg] = h_lo(w.x); acc[4 * rg + 1] = h_hi(w.x); acc[4 * rg + 2] = h_lo(w.y); acc[4 * rg + 3] = h_hi(w.y); }
                  acc = mm32(true, zc, mb * 32, sc + 2 * CH_MB, nb * 32, acc, l31, hi);
                  st_nat(true, lds + BL_YB + (c_ & 1) * CH_MB, mb * 32, nb * 32, acc, l31, hi);
              }
              LBAR(); }
        }
        { const u32x4 yv = *(const LAS u32x4*)(lds + BL_YB + CH_MB + srow * CH_RS + sch * 16); *(u32x4*)(Yb + (size_t)scan_row(b, d, 67, srow) * 2048 + sch * 16) = yv; }
        LBAR();
    }
}

constexpr int AT_K = 0, AT_V = 16384, AT_BUF = 16384 + 64 * 272;
struct KVRegs { u32x4 k1, k2, v0, v1; };
__device__ __forceinline__ void at_load(Frame& F, KVRegs& R, int mrow0, int kvh) {
    const int tid = F.tid;
    { const int key = tid >> 2, q4 = tid & 3, a = q4 >> 1, e = q4 & 1;
      const bf16* p = F.P + (size_t)(mrow0 + key) * NIN + C_KA + kvh * 64 + a * 32 + 8 * e; R.k1 = *(const u32x4*)p; R.k2 = *(const u32x4*)(p + 16); }
    { const int kp = tid >> 3, dc = tid & 7; const bf16* p = F.P + (size_t)(mrow0 + 2 * kp) * NIN + C_VA + kvh * 64 + 8 * dc; R.v0 = *(const u32x4*)p; R.v1 = *(const u32x4*)(p + NIN); }
}
__device__ __forceinline__ void qkprep_one(Frame& F, bf16* p, int a, int e, int kpos, bool rope, const float* gain, float scale) {
    float x1[8], x2[8]; unpack8(*(const u32x4*)p, x1); unpack8(*(const u32x4*)(p + 16), x2);
    float ss = 0.f;
#pragma unroll
    for (int j = 0; j < 8; ++j) ss += x1[j] * x1[j] + x2[j] * x2[j];
    ss += __shfl_xor(ss, 1); ss += __shfl_xor(ss, 2);
    const float rr = scale / sqrtf(ss * (1.0f / 64.0f) + 1e-6f);
    const int pos = a == 0 ? (kpos >> 6) : (kpos & 63);
#pragma unroll
    for (int j = 0; j < 8; ++j) { float y1 = x1[j] * rr * gain[a * 32 + 8 * e + j], y2 = x2[j] * rr * gain[a * 32 + 16 + 8 * e + j];
        if (rope) { const float c = F.ROPE[pos * 16 + 8 * e + j], sn = F.ROPE[1024 + pos * 16 + 8 * e + j]; const float t1 = y1 * c - y2 * sn, t2 = y2 * c + y1 * sn; y1 = t1; y2 = t2; }
        x1[j] = y1; x2[j] = y2; }
    u32x4 o; o.x = pk2(x1[0], x1[1]); o.y = pk2(x1[2], x1[3]); o.z = pk2(x1[4], x1[5]); o.w = pk2(x1[6], x1[7]); *(u32x4*)p = o;
    o.x = pk2(x2[0], x2[1]); o.y = pk2(x2[2], x2[3]); o.z = pk2(x2[4], x2[5]); o.w = pk2(x2[6], x2[7]); *(u32x4*)(p + 16) = o;
}
__device__ __forceinline__ void kprep(Frame& F) {
    const int total = F.G * NWAVES * 64;
    for (int idx = F.bid * NWAVES * 64 + F.tid; idx < MT * 16; idx += total) {
        const int q4 = idx & 3, kvh = (idx >> 2) & 3, m = idx >> 4, a = q4 >> 1, e = q4 & 1;
        qkprep_one(F, F.P + (size_t)m * NIN + C_KA + kvh * 64 + a * 32 + 8 * e, a, e, m & (SEQ - 1), m < ML, F.kng, 1.0f);
    }
}
__device__ __forceinline__ void at_write(Frame& F, const KVRegs& R, LAS unsigned char* buf) {
    const int tid = F.tid;
    { const int key = tid >> 2, q4 = tid & 3, a = q4 >> 1, e = q4 & 1;
      const int c1 = 4 * a + e, c2 = c1 + 2, sw = (key >> 1) & 7;
      *(LAS u32x4*)(buf + AT_K + key * 128 + ((c1 ^ sw) << 4)) = R.k1; *(LAS u32x4*)(buf + AT_K + key * 128 + ((c2 ^ sw) << 4)) = R.k2; }
    { const int kp = tid >> 3, dc = tid & 7, kq = kp >> 1;
        const int pos0 = (kq >> 2) * 16 + (kq & 1) * 8 + ((kq >> 1) & 1) * 4 + (kp & 1) * 2;
#pragma unroll
        for (int w = 0; w < 4; ++w) {
            const unsigned a0 = R.v0[w], a1 = R.v1[w];
            *(LAS unsigned*)(buf + AT_V + (8 * dc + 2 * w) * 272 + pos0 * 2) = __builtin_amdgcn_perm(a1, a0, 0x05040100u);
            *(LAS unsigned*)(buf + AT_V + (8 * dc + 2 * w + 1) * 272 + pos0 * 2) = __builtin_amdgcn_perm(a1, a0, 0x07060302u); }
    }
}
#ifndef ATTN_POOL
#define ATTN_POOL 0
#endif
#ifndef ATTN_BOUND
#define ATTN_BOUND 60.0f
#endif
template<bool NOMAX> __device__ __forceinline__ void p4_attn_t(Frame& F, int item) {
    const int n = item & 31, kvh = (item >> 5) & 3, b = item >> 7;
    const int lane = F.lane, wave = F.wave, l31 = lane & 31, hi = lane >> 5;
    const int hh = kvh * 4 + (wave >> 1), qloc = (wave & 1) * 64;
    LAS unsigned char* lds = F.lds;
    const int kfirst = n > 0 ? 0 : 1, nbnd = 3 - (n == 0 ? 1 : 0) - (n == 31 ? 1 : 0), nt = nbnd + 2;
#define TL_KIND(t) ((t) < nbnd ? kfirst + (t) : 3)
#define TL_ROW(t) ((t) < nbnd ? b * SEQ + (n - 1 + kfirst + (t)) * 128 : ML + b * CTXL + ((t) - nbnd) * 128)
#define TL_KPOS(t) ((t) < nbnd ? (n - 1 + kfirst + (t)) * 128 : 0)
    if (DBG_FINE) TSTART();
    KVRegs R;
    at_load(F, R, TL_ROW(0), kvh);
    LAS unsigned char* qbase = lds + 2 * AT_BUF + wave * 8192;
    LAS unsigned char* qlds = qbase + lane * 16;
    { const int rowl = lane >> 2, q4 = lane & 3, a = q4 >> 1, e = q4 & 1;
      const bf16* src = F.P + (size_t)(b * SEQ + n * 128 + qloc + rowl) * NIN + C_Q + hh * 64 + a * 32 + 8 * e;
      u32x4 r1[4], r2[4];
#pragma unroll
      for (int ps = 0; ps < 4; ++ps) { r1[ps] = *(const u32x4*)(src + (size_t)(16 * ps) * NIN); r2[ps] = *(const u32x4*)(src + (size_t)(16 * ps) * NIN + 16); }
      float g1[8], g2[8];
      { const f32x4 a0 = *(const f32x4*)(F.qng + a * 32 + 8 * e), a1 = *(const f32x4*)(F.qng + a * 32 + 8 * e + 4), b0 = *(const f32x4*)(F.qng + a * 32 + 16 + 8 * e), b1 = *(const f32x4*)(F.qng + a * 32 + 16 + 8 * e + 4);
#pragma unroll
        for (int j = 0; j < 4; ++j) { g1[j] = a0[j]; g1[4 + j] = a1[j]; g2[j] = b0[j]; g2[4 + j] = b1[j]; } }
#pragma unroll
      for (int ps = 0; ps < 4; ++ps) {
          const int r = 16 * ps + rowl, query = n * 128 + qloc + r, pos = a == 0 ? (query >> 6) : (query & 63);
          const f32x4 c0 = *(const f32x4*)(F.ROPE + pos * 16 + 8 * e), c1 = *(const f32x4*)(F.ROPE + pos * 16 + 8 * e + 4), s0 = *(const f32x4*)(F.ROPE + 1024 + pos * 16 + 8 * e), s1 = *(const f32x4*)(F.ROPE + 1024 + pos * 16 + 8 * e + 4);
          float x1[8], x2[8]; unpack8(r1[ps], x1); unpack8(r2[ps], x2);
          float ss = 0.f;
#pragma unroll
          for (int j = 0; j < 8; ++j) ss += x1[j] * x1[j] + x2[j] * x2[j];
          ss += __shfl_xor(ss, 1); ss += __shfl_xor(ss, 2);
          const float rr = (0.125f * LOG2E) / sqrtf(ss * (1.0f / 64.0f) + 1e-6f);
#pragma unroll
          for (int j = 0; j < 8; ++j) { const float y1 = x1[j] * rr * g1[j], y2 = x2[j] * rr * g2[j], cc = j < 4 ? c0[j & 3] : c1[j & 3], sn = j < 4 ? s0[j & 3] : s1[j & 3];
              x1[j] = y1 * cc - y2 * sn; x2[j] = y2 * cc + y1 * sn; }
          LAS unsigned char* dst = qbase + ((r >> 5) * 4 + 2 * a) * 1024 + (e * 32 + (r & 31)) * 16;
          u32x4 o; o.x = pk2(x1[0], x1[1]); o.y = pk2(x1[2], x1[3]); o.z = pk2(x1[4], x1[5]); o.w = pk2(x1[6], x1[7]); *(LAS u32x4*)dst = o;
          o.x = pk2(x2[0], x2[1]); o.y = pk2(x2[2], x2[3]); o.z = pk2(x2[4], x2[5]); o.w = pk2(x2[6], x2[7]); *(LAS u32x4*)(dst + 1024) = o;
      } }
    at_write(F, R, lds);
    LBAR(); TSTAMP(26);
    float mrun[2] = {NOMAX ? 0.f : -1e30f, NOMAX ? 0.f : -1e30f}, lrun[2] = {0.f, 0.f};
    f32x16 ot[2][2];
#pragma unroll
    for (int qb = 0; qb < 2; ++qb)
#pragma unroll
        for (int db = 0; db < 2; ++db)
#pragma unroll
            for (int r = 0; r < 16; ++r) ot[qb][db][r] = 0.f;
#pragma unroll 1
    for (int t = 0; t < nt; ++t) {
        LAS unsigned char* buf = lds + (t & 1) * AT_BUF;
        if (t + 1 < nt) at_load(F, R, TL_ROW(t + 1), kvh);
        const int kind = TL_KIND(t);
#pragma unroll 1
        for (int st = 0; st < 4; ++st) {
            int s0 = 1, s1 = 1;
            { const int dq0 = qloc >> 5, dq1 = dq0 + 1;
              if (kind == 0) { s0 = st < dq0 ? 0 : (st == dq0 ? 2 : 1); s1 = st < dq1 ? 0 : (st == dq1 ? 2 : 1); }
              else if (kind == 2) { s0 = st > dq0 ? 0 : (st == dq0 ? 2 : 1); s1 = st > dq1 ? 0 : (st == dq1 ? 2 : 1); } }
            if ((s0 | s1) == 0) continue;
            bf16x8 kf[4];
#pragma unroll
            for (int ks = 0; ks < 4; ++ks) { const int key = st * 32 + l31, ch = 2 * ks + hi; kf[ks] = *(const LAS bf16x8*)(buf + AT_K + key * 128 + ((ch ^ ((key >> 1) & 7)) << 4)); }
            f32x16 sc0 = {0.f, 0.f, 0.f, 0.f, 0.f, 0.f, 0.f, 0.f, 0.f, 0.f, 0.f, 0.f, 0.f, 0.f, 0.f, 0.f}, sc1 = sc0;
            { bf16x8 qf[4];
              if (s0) {
#pragma unroll
                  for (int ks = 0; ks < 4; ++ks) qf[ks] = *(const LAS bf16x8*)(qlds + ks * 1024);
#pragma unroll
                  for (int ks = 0; ks < 4; ++ks) sc0 = __builtin_amdgcn_mfma_f32_32x32x16_bf16(kf[ks], qf[ks], sc0, 0, 0, 0); }
              if (s1) {
#pragma unroll
                  for (int ks = 0; ks < 4; ++ks) qf[ks] = *(const LAS bf16x8*)(qlds + (4 + ks) * 1024);
#pragma unroll
                  for (int ks = 0; ks < 4; ++ks) sc1 = __builtin_amdgcn_mfma_f32_32x32x16_bf16(kf[ks], qf[ks], sc1, 0, 0, 0); } }
            bf16x8 vf[2][2];
#pragma unroll
            for (int db = 0; db < 2; ++db)
#pragma unroll
                for (int s = 0; s < 2; ++s) vf[db][s] = *(const LAS bf16x8*)(buf + AT_V + (db * 32 + l31) * 272 + ((st * 2 + s) * 16 + hi * 8) * 2);
#define AT_SOFTMAX(SC, QB, PF, DIAG) do { \
                const int qq = qloc + (QB) * 32 + l31; \
                if (DIAG) { const int th = qq - st * 32 - 4 * hi;        \
                    if (kind == 0) { _Pragma("unroll") for (int r = 0; r < 16; ++r) SC[r] = ((r & 3) + 8 * (r >> 2) >= th) ? SC[r] : -__builtin_inff(); } \
                    else { _Pragma("unroll") for (int r = 0; r < 16; ++r) SC[r] = ((r & 3) + 8 * (r >> 2) <= th) ? SC[r] : -__builtin_inff(); } } \
                if (!NOMAX) { \
                    float tm = SC[0]; \
                    _Pragma("unroll") for (int r = 1; r < 16; ++r) tm = fmaxf(tm, SC[r]); \
                    tm = fmaxf(tm, __shfl_xor(tm, 32)); \
                    if (__any(tm > mrun[QB] + 6.0f)) { \
                        const float mn = fmaxf(mrun[QB], tm), al = __builtin_amdgcn_exp2f(mrun[QB] - mn); \
                        mrun[QB] = mn; lrun[QB] *= al; \
                        _Pragma("unroll") for (int db = 0; db < 2; ++db) _Pragma("unroll") for (int r = 0; r < 16; ++r) ot[QB][db][r] *= al; } \
                    const float mm = mrun[QB]; \
                    _Pragma("unroll") for (int r = 0; r < 16; ++r) SC[r] -= mm; } \
                f32x2_t ps2 = {0.f, 0.f}; \
                _Pragma("unroll") for (int r = 0; r < 16; r += 2) { SC[r] = __builtin_amdgcn_exp2f(SC[r]); SC[r + 1] = __builtin_amdgcn_exp2f(SC[r + 1]); f32x2_t e2; e2.x = SC[r]; e2.y = SC[r + 1]; ps2 += e2; } \
                lrun[QB] += ps2.x + ps2.y; \
                _Pragma("unroll") for (int s = 0; s < 2; ++s) { u32x4 o; o.x = pk2(SC[8 * s], SC[8 * s + 1]); o.y = pk2(SC[8 * s + 2], SC[8 * s + 3]); o.z = pk2(SC[8 * s + 4], SC[8 * s + 5]); o.w = pk2(SC[8 * s + 6], SC[8 * s + 7]); PF[s] = __builtin_bit_cast(bf16x8, o); } \
            } while (0)
            bf16x8 pf0[2] = {kf[0], kf[0]}, pf1[2] = {kf[0], kf[0]};
            __builtin_amdgcn_sched_barrier(0);
            if (s0) AT_SOFTMAX(sc0, 0, pf0, s0 == 2);
            __builtin_amdgcn_sched_barrier(0);
            if (s1) AT_SOFTMAX(sc1, 1, pf1, s1 == 2);
            __builtin_amdgcn_sched_barrier(0);
#undef AT_SOFTMAX
#pragma unroll
            for (int db = 0; db < 2; ++db)
#pragma unroll
                for (int s = 0; s < 2; ++s) if (s0) ot[0][db] = __builtin_amdgcn_mfma_f32_32x32x16_bf16(vf[db][s], pf0[s], ot[0][db], 0, 0, 0);
#pragma unroll
            for (int db = 0; db < 2; ++db)
#pragma unroll
                for (int s = 0; s < 2; ++s) if (s1) ot[1][db] = __builtin_amdgcn_mfma_f32_32x32x16_bf16(vf[db][s], pf1[s], ot[1][db], 0, 0, 0);
        }
        TSTAMP(27);
        if (t + 1 < nt) at_write(F, R, lds + ((t + 1) & 1) * AT_BUF);
        LBAR(); TSTAMP(28);
    }
    constexpr int AT_ORS = 528;
    u32x4 zr[8];
    const bf16* pz = F.P + (size_t)(b * SEQ + n * 128) * NIN + kvh * 256;
#pragma unroll
    for (int i = 0; i < 8; ++i) { const int idx = F.tid + 512 * i, row = idx >> 5, c16 = idx & 31; zr[i] = *(const u32x4*)(pz + (size_t)row * NIN + C_ZA + 8 * c16); }
    const float sk2 = F.sink[hh] * LOG2E;
#pragma unroll
    for (int qb = 0; qb < 2; ++qb) {
        float l = lrun[qb]; l += __shfl_xor(l, 32); l += __builtin_amdgcn_exp2f(sk2 - mrun[qb]);
        const float il = 1.0f / l;
        LAS unsigned char* po = lds + (qloc + qb * 32 + l31) * AT_ORS + (wave >> 1) * 128 + 8 * hi;
#pragma unroll
        for (int db = 0; db < 2; ++db)
#pragma unroll
            for (int rg = 0; rg < 4; ++rg) { u32x2 o; o.x = pkh(ot[qb][db][4 * rg] * il, ot[qb][db][4 * rg + 1] * il); o.y = pkh(ot[qb][db][4 * rg + 2] * il, ot[qb][db][4 * rg + 3] * il);
                *(LAS u32x2*)(po + (db * 32 + 8 * rg) * 2) = o; }
    }
    LBAR();
#pragma unroll
    for (int i = 0; i < 8; ++i) { const int idx = F.tid + 512 * i, row = idx >> 5, c16 = idx & 31;
        const u32x4 ov = *(const LAS u32x4*)(lds + row * AT_ORS + c16 * 16);
        float z[8]; unpack8(zr[i], z);
        u32x4 w; w.x = pk2(h_lo(ov.x) * siluf_(z[0]), h_hi(ov.x) * siluf_(z[1])); w.y = pk2(h_lo(ov.y) * siluf_(z[2]), h_hi(ov.y) * siluf_(z[3]));
        w.z = pk2(h_lo(ov.z) * siluf_(z[4]), h_hi(ov.z) * siluf_(z[5])); w.w = pk2(h_lo(ov.w) * siluf_(z[6]), h_hi(ov.w) * siluf_(z[7]));
        *(u32x4*)(F.P + (size_t)(b * SEQ + n * 128 + row) * NIN + 1024 + kvh * 256 + 8 * c16) = w; }
    TSTAMP(29);
#undef TL_KIND
#undef TL_ROW
#undef TL_KPOS
}
__device__ __forceinline__ bool attn_nomax(Frame& F) {
    float gq = fabsf(F.qng[F.lane]), gk = fabsf(F.kng[F.lane]);
#pragma unroll
    for (int o = 1; o < 64; o <<= 1) { gq = fmaxf(gq, __shfl_xor(gq, o)); gk = fmaxf(gk, __shfl_xor(gk, o)); }
    const float bound = 8.0f * LOG2E * gq * gk;
    return __builtin_amdgcn_readfirstlane(bound <= ATTN_BOUND ? 1 : 0) != 0;
}

__device__ __forceinline__ void p5_mix(Frame& F) {
    const int total = F.G * NWAVES * 64, rstep = total >> 7, gi = F.bid * NWAVES * 64 + F.tid;
    const int ch = gi & 7, h = (gi >> 3) & 15, c0 = h * 64 + 8 * ch;
    float mus[8], lg[8], lb[8];
    { const f32x4 a0 = *(const f32x4*)(F.mu_shift + C_V + c0), a1 = *(const f32x4*)(F.mu_shift + C_V + c0 + 4), g0 = *(const f32x4*)(F.ln_g + c0), g1 = *(const f32x4*)(F.ln_g + c0 + 4), b0 = *(const f32x4*)(F.ln_b + c0), b1 = *(const f32x4*)(F.ln_b + c0 + 4);
#pragma unroll
      for (int j = 0; j < 4; ++j) { mus[j] = a0[j]; mus[4 + j] = a1[j]; lg[j] = g0[j]; lg[4 + j] = g1[j]; lb[j] = b0[j]; lb[4 + j] = b1[j]; } }
    const u32x4 z = {0u, 0u, 0u, 0u};
#pragma unroll 1
    for (int m0 = gi >> 7; m0 < ML; m0 += 4 * rstep) {
        u32x4 ryf[4], ryb[4], rvc[4], rvp[4], rvn[4], rzr[4]; float bon[4];
#pragma unroll
        for (int k = 0; k < 4; ++k) { const int m = m0 + k * rstep, mm = m < ML ? m : m0, t = mm & (SEQ - 1);
            const bf16* pc = F.P + (size_t)mm * NIN;
            ryf[k] = *(const u32x4*)(F.YF + (size_t)mm * 1024 + c0); ryb[k] = *(const u32x4*)(F.YB + (size_t)mm * 1024 + c0);
            rvc[k] = *(const u32x4*)(pc + C_V + c0); rvp[k] = *(const u32x4*)(pc - (t > 0 ? NIN : 0) + C_V + c0); rvn[k] = *(const u32x4*)(pc + (t < SEQ - 1 ? NIN : 0) + C_V + c0);
            rzr[k] = *(const u32x4*)(pc + C_ZR + c0);
            bon[k] = F.BON[(size_t)mm * 16 + h] + F.BON[(size_t)(ML + mm) * 16 + h]; }
#pragma unroll
        for (int k = 0; k < 4; ++k) { const int m = m0 + k * rstep; if (m >= ML) break;
            float y[8];
            { const h8 hf = __builtin_bit_cast(h8, ryf[k]), hb = __builtin_bit_cast(h8, ryb[k]);
#pragma unroll
              for (int j = 0; j < 8; ++j) y[j] = (float)hf[j] + (float)hb[j]; }
            float s = 0.f;
#pragma unroll
            for (int j = 0; j < 8; ++j) s += y[j];
            s += __shfl_xor(s, 1); s += __shfl_xor(s, 2); s += __shfl_xor(s, 4);
            const float mu = s * (1.0f / 64.0f); float q = 0.f;
#pragma unroll
            for (int j = 0; j < 8; ++j) { y[j] -= mu; q += y[j] * y[j]; }
            q += __shfl_xor(q, 1); q += __shfl_xor(q, 2); q += __shfl_xor(q, 4);
            const float rs = 1.0f / sqrtf(q * (1.0f / 64.0f) + 64e-5f);
            float vc[8], vp[8], vn[8], zr[8];
            const int t = m & (SEQ - 1);
            unpack8(rvc[k], vc); unpack8(t > 0 ? rvp[k] : z, vp); unpack8(t < SEQ - 1 ? rvn[k] : z, vn); unpack8(rzr[k], zr);
            float o[8];
#pragma unroll
            for (int j = 0; j < 8; ++j) { const float sv = vc[j] + mus[j] * (0.5f * (vp[j] + vn[j]) - vc[j]);
                const float yn = y[j] * rs * lg[j] + lb[j];
                o[j] = (yn + bon[k] * sv) * siluf_(zr[j]); }
            u32x4 w; w.x = pk2(o[0], o[1]); w.y = pk2(o[2], o[3]); w.z = pk2(o[4], o[5]); w.w = pk2(o[6], o[7]);
            *(u32x4*)(F.P + (size_t)m * NIN + c0) = w; }
    }
}

struct Args { const float* in[22]; float* out; unsigned char* ws; int ph_lo, ph_hi; };
__global__ void __launch_bounds__(NWAVES * 64, 2) hymba_fwd(Args args) {
    extern __shared__ __attribute__((aligned(16))) unsigned char lds_raw[];
    Frame F;
    F.lds = (LAS unsigned char*)lds_raw;
    F.tid = threadIdx.x; F.G = gridDim.x;
    unsigned char* ws = args.ws;
    volatile LAS unsigned* MISC = (volatile LAS unsigned*)(F.lds + MISC_OFF);
    for (int u = F.tid; u < 64; u += NWAVES * 64) MISC[u] = 0u;
    if (DBG_SEL >= 0) for (int u = F.tid; u < 72; u += NWAVES * 64) ((volatile LAS unsigned*)(F.lds + DBG_LDS))[u] = 0u;
    __syncthreads();
    const int lo = args.ph_lo, hi = args.ph_hi;
    XcdBarrier bar; bar.bar = (unsigned*)(ws + WS_CTL) + CW_BAR; bar.x = 0; bar.st = nullptr;
    if (hi - lo > 1) bar = xcd_barrier_post((unsigned*)(ws + WS_CTL) + CW_BAR, MISC + 8);
#define IN(k) (lo <= (k) && (k) < hi)
#define SEAM(k) do { if (IN(k) && IN((k) + 1)) xcd_barrier(bar); } while (0)
    fresh(F); TSTART();
    if (DBG_SEL >= 0 && F.bid == DBG_BLOCK && F.tid == 0) { volatile LAS unsigned long long* T_ = (volatile LAS unsigned long long*)(F.lds + DBG_LDS); T_[34] = T_[32]; }
    if (IN(0)) { fresh(F); p0_prologue(F); if (DUP_PHASE == 0) { fresh(F); p0_prologue(F); } } TSTAMP(8); SEAM(0); TSTAMP(9);
    if (IN(1)) { fresh(F); p1_modulate(F); if (DUP_PHASE == 1) { fresh(F); p1_modulate(F); } } TSTAMP(10); SEAM(1); TSTAMP(11);
    if (IN(2)) {
        fresh(F);
        pg8::Gemm g{F.XN, F.WIN, MT, NIN, DM, DM}; Sched1 S; S.init(F.G, F.bid);
        pg8::EpiBf16<0> E{F.P, NIN, nullptr, 0, 0, 1.f};
        pg8::gemm_phase<pg8::EpiBf16<0>, Sched1, true, true>(F.lds, g, S, E);
        if (DUP_PHASE == 2) { __syncthreads(); pg8::gemm_phase<pg8::EpiBf16<0>, Sched1, true, true>(F.lds, g, S, E); }
    } TSTAMP(12); SEAM(2); TSTAMP(13);
    if (IN(3)) { fresh(F); p3_chunkA(F); fresh(F); kprep(F); TSTAMP(14); if (DUP_PHASE == 3) { fresh(F); p3_chunkA(F); } } SEAM(3); TSTAMP(15);
    if (IN(4)) {
        fresh(F);
        { const bool g256 = F.G == 256; const int xg = F.bid & 7;
          int li0 = 3 * ((F.bid - 128) >> 3), cnt = 3;
          if (!g256 || F.bid < 128) { p4_chunkB(F); TSTAMP(30); LBAR(); fresh(F); li0 = 48 + (F.bid >> 3); cnt = 1; }
          if (!g256) cnt = (512 - F.bid + F.G - 1) / F.G;
          unsigned* tq = (unsigned*)((unsigned char*)F.MOD - WS_MOD + WS_CTL) + CW_TICKET + 64 * xg;
          volatile LAS unsigned* tk = (volatile LAS unsigned*)(F.lds + MISC_OFF) + 40;
          const bool pool = g256 && ATTN_POOL;
          unsigned nxt = 0u; if (pool && F.tid == 0) nxt = __hip_atomic_fetch_add(tq, 1u, __ATOMIC_RELAXED, __HIP_MEMORY_SCOPE_AGENT);
#define ATTN_ITEMS(NM) \
          for (int j = 0; ; ++j) { int li = li0 + j; \
              if (!pool) { if (j >= cnt) break; } \
              else { if (F.tid == 0) tk[0] = nxt; \
                  LBAR(); const unsigned q = tk[0]; LBAR(); if (q >= 64u) break; li = (int)q; \
                  if (F.tid == 0) nxt = __hip_atomic_fetch_add(tq, 1u, __ATOMIC_RELAXED, __HIP_MEMORY_SCOPE_AGENT); } \
              fresh(F); p4_attn_t<NM>(F, g256 ? (2 * xg + (li >> 5)) * 32 + (li & 31) : F.bid + j * F.G); LBAR(); }
          if (attn_nomax(F)) {
#pragma unroll 1
              ATTN_ITEMS(true)
          } else {
#pragma unroll 1
              ATTN_ITEMS(false)
          }
#undef ATTN_ITEMS
        }
        TSTAMP(16);
    } SEAM(4); TSTAMP(17);
    if (IN(5)) { fresh(F); p5_mix(F); TSTAMP(18);
        if (DBG_SEL >= 0 && F.bid == DBG_BLOCK && F.tid == 0) { volatile LAS unsigned long long* T_ = (volatile LAS unsigned long long*)(F.lds + DBG_LDS);
            F.DBG[0] = (float)(DBG_SEL == 99 ? (T_[0] + T_[1] + T_[2] + T_[3] + T_[4] + T_[5] + T_[6] + T_[7]) : T_[DBG_SEL]) * (DBG_FINE ? 1e-6f : 2.5e-7f); F.DBG[1] = (DBG_SEL2 == 24 ? (float)T_[24] * 1e-7f : (float)T_[DBG_SEL2] * 1e-4f); }
    } SEAM(5);
    if (IN(6)) {
        fresh(F);
        pg8::Gemm g{F.P, F.WOUT, ML, DM, DM, NIN};
        pg8::StaticOrder S; S.init(ML, DM, F.G, F.bid);
        pg8::EpiGate E{F.x, F.out, F.MOD + 4096, DM, DBG_SEL >= 0 ? F.DBG[0] : 0.f, DBG_SEL >= 0 ? F.DBG[1] : 0.f};
        pg8::gemm_phase<pg8::EpiGate, pg8::StaticOrder, true, true>(F.lds, g, S, E);
        if (DUP_PHASE == 6) { __syncthreads(); pg8::gemm_phase<pg8::EpiGate, pg8::StaticOrder, true, true>(F.lds, g, S, E); }
        if (DBG_SEL >= 0 && DBG_END > 0 && blockIdx.x == 0 && threadIdx.x == 0) { volatile LAS unsigned long long* T_ = (volatile LAS unsigned long long*)(F.lds + DBG_LDS);
            const unsigned long long n_ = __builtin_amdgcn_s_memrealtime(); asm volatile("s_waitcnt vmcnt(0)" ::: "memory");
            F.out[0] += (float)(DBG_END == 1 ? n_ - T_[34] : n_ - T_[32]) * 1e-5f; }
    }
#undef IN
#undef SEAM
}

extern "C" void kernel_launch(void* const* d_in, const int* in_sizes, int n_in, void* d_out, int out_size, void* d_ws, size_t ws_size, hipStream_t stream) {
    static int grid = 0;
    if (grid == 0) {
        if (n_in != 22 || out_size != ML * DM || ws_size < WS_END) { fprintf(stderr, "kernel_launch: unexpected problem shape (n_in %d, out %d, ws %zu)\n", n_in, out_size, ws_size); grid = -1; return; }
        int dev = 0, cus = 0;
        if (hipGetDevice(&dev) != hipSuccess || hipDeviceGetAttribute(&cus, hipDeviceAttributeMultiprocessorCount, dev) != hipSuccess) { grid = -1; return; }
        if (hipFuncSetAttribute((const void*)hymba_fwd, hipFuncAttributeMaxDynamicSharedMemorySize, LDS_BYTES) != hipSuccess) { fprintf(stderr, "kernel_launch: hipFuncSetAttribute failed\n"); grid = -1; return; }
        (void)hipGetLastError();
        grid = cus;
    }
    if (grid < 0) return;
    (void)hipMemsetAsync((char*)d_ws + WS_CTL, 0, CTL_ZERO_BYTES, stream);
    Args a{};
    for (int i = 0; i < 22; ++i) a.in[i] = (const float*)d_in[i];
    a.out = (float*)d_out; a.ws = (unsigned char*)d_ws;
    if (MK_N_LAUNCHES == 1) { a.ph_lo = 0; a.ph_hi = N_PHASES; hipLaunchKernelGGL(hymba_fwd, dim3(grid), dim3(NWAVES * 64), LDS_BYTES, stream, a); }
    else for (int p = 0; p < N_PHASES; ++p) { a.ph_lo = p; a.ph_hi = p + 1; hipLaunchKernelGGL(hymba_fwd, dim3(grid), dim3(NWAVES * 64), LDS_BYTES, stream, a); }
}
```

```cpp
#include <hip/hip_runtime.h>
#include <cstdio>
#include <cstdint>
#ifndef DBG_SEL
#define DBG_SEL -1
#endif
#ifndef DBG_SEL2
#define DBG_SEL2 0
#endif
#ifndef DBG_BLOCK
#define DBG_BLOCK 0
#endif
#ifndef DBG_END
#define DBG_END 0
#endif
namespace pg8 {
#define PG8_LAS __attribute__((address_space(3)))
typedef unsigned short bf16_t;
typedef short bf16x8 __attribute__((ext_vector_type(8)));
typedef float f32x4 __attribute__((ext_vector_type(4)));
typedef unsigned u32x4 __attribute__((ext_vector_type(4)));
constexpr int BM = 256, BK = 64, HALF = 128, HTB = HALF * BK * 2  , STAGE_BYTES = 8 * HTB, NXCD = 8, WGM = 8;

__host__ __device__ __forceinline__ int lds_byte(int r, int c) { const int st = (r >> 4) * 2 + (c >> 5), rr = r & 15, cc = c & 31, ob = rr * 64 + cc * 2; return st * 1024 + (ob ^ (((ob >> 9) & 1) << 5)); }
__host__ __device__ __forceinline__ void stage_rc(int b, int& R, int& C) { const int st = b / 1024, sb = b % 1024, swz = sb ^ (((sb >> 9) & 1) << 5); R = (st >> 1) * 16 + swz / 64; C = (st & 1) * 32 + (swz % 64) / 2; }
__host__ __device__ __forceinline__ int perm32(int rho) { const int n = rho >> 4, i = rho & 15; return 8 * (i >> 2) + 4 * n + (i & 3); }

struct Unit { int pm, pn; };
struct Gemm { const bf16_t* A; const bf16_t* Bt; int M, N, K, lda; };

struct StaticOrder {
    int nM, nN, nwg, G, c;
    __host__ __device__ void init(int M, int N, int G_, int c_) { nM = M / BM; nN = N / BM; nwg = nM * nN; G = G_; c = c_; }
    __host__ __device__ bool next(int i, Unit& u) const {
        const long L = (long)i * G + c; if (L >= nwg) return false;
        int wgid = (int)L; { const int q = nwg / NXCD, r = nwg % NXCD, xcd = wgid % NXCD, off = wgid / NXCD; wgid = (xcd < r ? xcd * (q + 1) : r * (q + 1) + (xcd - r) * q) + off; }
        const int nig = WGM * nN, gid = wgid / nig, fm = gid * WGM, gsz = (nM - fm) < WGM ? (nM - fm) : WGM;
        u.pm = fm + ((wgid % nig) % gsz); u.pn = (wgid % nig) / gsz; return true;
    }
    __device__ __forceinline__ void a_ready(const Unit&) const {}
    __device__ __forceinline__ void done(const Unit&) const {}
};

__device__ __forceinline__ unsigned cvt_pk_bf16(float lo, float hi) { unsigned r; asm volatile("v_cvt_pk_bf16_f32 %0, %1, %2" : "=v"(r) : "v"(lo), "v"(hi)); return r; }
typedef float f32x2 __attribute__((ext_vector_type(2)));
__device__ __forceinline__ f32x2 gelu_pk(f32x2 v) {
    const f32x2 av = __builtin_elementwise_abs(v), d = av * 0.2316418882f + 1.0f;
    f32x2 t; t.x = __builtin_amdgcn_rcpf(d.x); t.y = __builtin_amdgcn_rcpf(d.y);
    f32x2 q = t * 0.5307027145f + (-0.7265760135f); q = q * t + 0.7107068705f; q = q * t + (-0.142248368f); q = q * t + 0.127414796f; q = q * t;
    const f32x2 s = (v * v) * (-0.72134752044f);
    f32x2 e; e.x = __builtin_amdgcn_exp2f(s.x); e.y = __builtin_amdgcn_exp2f(s.y);
    const f32x2 m = v * (q * e), r = v - m;
    f32x2 o; o.x = v.x < 0.f ? m.x : r.x; o.y = v.y < 0.f ? m.y : r.y; return o;
}

template <int ACT  > struct EpiBf16 {
    static constexpr bool PERM = true, AFTER_DRAIN = false; static_assert(ACT == 0 || ACT == 1, "EpiBf16: ACT is 0 (none) or 1 (gelu_pk)");
    bf16_t* O; int ldc; const float* bias; int split_cols; size_t split_stride; float scale0;
    __device__ __forceinline__ void operator()(const f32x4 (&acc)[2][2][4][2], const Unit& u, int wr, int wc, int fr, int fq) const {
        const int row0 = u.pm * BM + wr * 64 + fr; int colt = u.pn * BM; bf16_t* base = O;
        float sc = 1.f; if (split_cols) { const int t = colt / split_cols; base += (size_t)t * split_stride; colt -= t * split_cols; if (t == 0) sc = scale0; }
        const int col0 = colt + wc * 32 + 8 * fq, bcol0 = u.pn * BM + wc * 32 + 8 * fq;
        f32x4 bv[2][2];
#pragma unroll
        for (int bj = 0; bj < 2; ++bj)
#pragma unroll
            for (int n = 0; n < 2; ++n) bv[bj][n] = bias ? *(const f32x4*)(bias + bcol0 + bj * HALF + 4 * n) : (f32x4){0.f, 0.f, 0.f, 0.f};
#pragma unroll
        for (int ai = 0; ai < 2; ++ai)
#pragma unroll
            for (int m = 0; m < 4; ++m) { bf16_t* rowp = base + (size_t)(row0 + ai * HALF + m * 16) * ldc + col0;
#pragma unroll
                for (int bj = 0; bj < 2; ++bj) { f32x4 v0 = acc[ai][bj][m][0] + bv[bj][0], v1 = acc[ai][bj][m][1] + bv[bj][1];
                    if (ACT == 1) { f32x2 a = gelu_pk((f32x2){v0[0], v0[1]}), b = gelu_pk((f32x2){v0[2], v0[3]}), c = gelu_pk((f32x2){v1[0], v1[1]}), d = gelu_pk((f32x2){v1[2], v1[3]});
                        v0 = (f32x4){a.x, a.y, b.x, b.y}; v1 = (f32x4){c.x, c.y, d.x, d.y}; }
                    v0 = v0 * sc; v1 = v1 * sc; u32x4 w; w.x = cvt_pk_bf16(v0[0], v0[1]); w.y = cvt_pk_bf16(v0[2], v0[3]); w.z = cvt_pk_bf16(v1[0], v1[1]); w.w = cvt_pk_bf16(v1[2], v1[3]);
                    *(u32x4*)(rowp + bj * HALF) = w; } }
    }
};


struct EpiGate {
    static constexpr bool PERM = false, AFTER_DRAIN = false;
    const float* x; float* out; const float* gate; int ldc; float dbg0, dbg1;
    __device__ __forceinline__ void operator()(const f32x4 (&acc)[2][2][4][2], const Unit& u, int wr, int wc, int fr, int fq) const {
        const int col0 = u.pn * BM + wc * 32 + 4 * fq;
        const int b = (u.pm * BM) >> 12;
        f32x4 gv[2][2];
#pragma unroll
        for (int bj = 0; bj < 2; ++bj)
#pragma unroll
            for (int n = 0; n < 2; ++n) gv[bj][n] = *(const f32x4*)(gate + (size_t)b * 6144 + col0 + bj * HALF + n * 16);
#pragma unroll
        for (int ai = 0; ai < 2; ++ai)
#pragma unroll
            for (int mp = 0; mp < 2; ++mp) {
                f32x4 xv[2][2][2];
#pragma unroll
                for (int mm = 0; mm < 2; ++mm) { const size_t off = (size_t)(u.pm * BM + ai * HALF + wr * 64 + (2 * mp + mm) * 16 + fr) * ldc + col0;
#pragma unroll
                    for (int bj = 0; bj < 2; ++bj)
#pragma unroll
                        for (int n = 0; n < 2; ++n) xv[mm][bj][n] = *(const f32x4*)(x + off + bj * HALF + n * 16); }
                asm volatile("" ::: "memory");
#pragma unroll
                for (int mm = 0; mm < 2; ++mm) { const int m = 2 * mp + mm; const size_t off = (size_t)(u.pm * BM + ai * HALF + wr * 64 + m * 16 + fr) * ldc + col0;
#pragma unroll
                    for (int bj = 0; bj < 2; ++bj)
#pragma unroll
                        for (int n = 0; n < 2; ++n) { f32x4 o = xv[mm][bj][n] + gv[bj][n] * acc[ai][bj][m][n];
                            if (DBG_SEL >= 0) { o = o + dbg0; if (off + bj * HALF + n * 16 == 0) o.x += dbg1; }
                            *(f32x4*)(out + off + bj * HALF + n * 16) = o; } }
                asm volatile("" ::: "memory"); }
    }
};
template <class Epi, class Sched, bool ALIGN_EPI = false, bool SP2 = false>
__device__ __forceinline__ void gemm_phase(PG8_LAS unsigned char* lds, const Gemm g, const Sched& S, const Epi& E) {
    const int tid = threadIdx.x, wid = __builtin_amdgcn_readfirstlane(tid >> 6), lane = tid & 63, wr = wid >> 2, wc = wid & 3, fr = lane & 15, fq = lane >> 4;
    const int K = g.K, nt = K / BK, lda = g.lda;
    unsigned voffA[2], voffB[2];
#pragma unroll
    for (int i = 0; i < 2; ++i) { int R, C; stage_rc(tid * 16 + i * 8192, R, C); const int Rb = Epi::PERM ? ((R & ~31) + perm32(R & 31)) : R;
        voffA[i] = (unsigned)(R * lda + C) * 2u; voffB[i] = (unsigned)(Rb * K + C) * 2u; }
    const size_t kstep = (size_t)(BK * 2);
    const size_t hstepA = (size_t)HALF * lda * 2, hstepB = (size_t)HALF * K * 2;
    const size_t tstepA = 2 * hstepA, tstepB = 2 * hstepB;
    const unsigned ldsw = (unsigned)wid * 1024u;
    const int aoff = lds_byte(wr * 64 + fr, fq * 8), boff = lds_byte(wc * 32 + fr, fq * 8);
#define PG8_SA(b, h) (((b) * 2 + (h)) * HTB)
#define PG8_SB(b, h) ((4 + (b) * 2 + (h)) * HTB)
#define PG8_STAGE(bufoff, gbase, voff) do { _Pragma("unroll") for (int _i = 0; _i < 2; ++_i) \
        __builtin_amdgcn_global_load_lds((const unsigned*)((const char*)(gbase) + (voff)[_i]), (PG8_LAS unsigned*)(lds + (bufoff) + ldsw + _i * 8192), 16, 0, 0); } while (0)
#define PG8_LDA(dst, b, h) do { _Pragma("unroll") for (int m = 0; m < 4; ++m) _Pragma("unroll") for (int k = 0; k < 2; ++k) dst[m][k] = *(const PG8_LAS bf16x8*)(lds + PG8_SA(b, h) + aoff + m * 2048 + k * 1024); } while (0)
#define PG8_LDB(dst, b, h) do { _Pragma("unroll") for (int n = 0; n < 2; ++n) _Pragma("unroll") for (int k = 0; k < 2; ++k) dst[n][k] = *(const PG8_LAS bf16x8*)(lds + PG8_SB(b, h) + boff + n * 2048 + k * 1024); } while (0)
#define PG8_MMA(ai, bj, At, Bt) do { __builtin_amdgcn_s_setprio(1); _Pragma("unroll") for (int m = 0; m < 4; ++m) _Pragma("unroll") for (int n = 0; n < 2; ++n) _Pragma("unroll") for (int k = 0; k < 2; ++k) \
        acc[ai][bj][m][n] = __builtin_amdgcn_mfma_f32_16x16x32_bf16(Bt[n][k], At[m][k], acc[ai][bj][m][n], 0, 0, 0); __builtin_amdgcn_s_setprio(0); } while (0)
#define PG8_WAIT_V(n) asm volatile("s_waitcnt vmcnt(" #n ")" ::: "memory")
#define PG8_WAIT_L(n) asm volatile("s_waitcnt lgkmcnt(" #n ")" ::: "memory")
#define PG8_BAR __builtin_amdgcn_s_barrier()
#define PG8_SCHED __builtin_amdgcn_sched_barrier(0)
    Unit cur, nxt; int ui = 0;
    if (!S.next(0, cur)) return;
    f32x4 acc[2][2][4][2];
#pragma unroll
    for (int a = 0; a < 2; ++a)
#pragma unroll
        for (int b = 0; b < 2; ++b)
#pragma unroll
            for (int m = 0; m < 4; ++m)
#pragma unroll
                for (int n = 0; n < 2; ++n) acc[a][b][m][n] = (f32x4){0.f, 0.f, 0.f, 0.f};
    bf16x8 At[4][2], B0[2][2], B1[2][2];
    const char* cA = (const char*)g.A + (size_t)cur.pm * tstepA; const char* cB = (const char*)g.Bt + (size_t)cur.pn * tstepB;
    S.a_ready(cur);
    if constexpr (SP2) {
        PG8_STAGE(PG8_SB(0, 0), cB, voffB); PG8_STAGE(PG8_SB(0, 1), cB + hstepB, voffB); PG8_STAGE(PG8_SA(0, 0), cA, voffA); PG8_STAGE(PG8_SA(0, 1), cA + hstepA, voffA);
        if (wr == 1) PG8_BAR;
        PG8_WAIT_V(2); PG8_BAR;
        PG8_STAGE(PG8_SB(1, 0), cB + kstep, voffB); PG8_STAGE(PG8_SA(1, 0), cA + kstep, voffA); PG8_STAGE(PG8_SB(1, 1), cB + hstepB + kstep, voffB);
        PG8_WAIT_V(6); PG8_BAR;
    } else {
        PG8_STAGE(PG8_SB(0, 0), cB, voffB); PG8_STAGE(PG8_SA(0, 0), cA, voffA); PG8_STAGE(PG8_SB(0, 1), cB + hstepB, voffB); PG8_STAGE(PG8_SA(0, 1), cA + hstepA, voffA);
        if (wr == 1) PG8_BAR;
        PG8_WAIT_V(4); PG8_BAR;
        PG8_STAGE(PG8_SB(1, 0), cB + kstep, voffB); PG8_STAGE(PG8_SA(1, 0), cA + kstep, voffA); PG8_STAGE(PG8_SB(1, 1), cB + hstepB + kstep, voffB);
        PG8_WAIT_V(6); PG8_BAR;
    }
    for (;;) {
        const bool has_next = S.next(ui + 1, nxt);
        const char* nA = has_next ? (const char*)g.A + (size_t)nxt.pm * tstepA : cA; const char* nB = has_next ? (const char*)g.Bt + (size_t)nxt.pn * tstepB : cB;
        for (int t = 0; t < nt; t += 2) {
            const bool last = (t == nt - 2);
            const char* a1 = cA + (size_t)(t + 1) * kstep;
            const char* a2 = last ? nA : cA + (size_t)(t + 2) * kstep; const char* b2 = last ? nB : cB + (size_t)(t + 2) * kstep;
            const char* a3 = a2 + kstep; const char* b3 = b2 + kstep;
            if (last && has_next) S.a_ready(nxt);
            if constexpr (SP2) {
            PG8_LDB(B0, 0, 0); PG8_LDB(B1, 0, 1); PG8_SCHED; PG8_LDA(At, 0, 0); PG8_STAGE(PG8_SA(1, 1), a1 + hstepA, voffA);
            PG8_WAIT_V(8); PG8_WAIT_L(0); PG8_BAR; PG8_MMA(0, 0, At, B0); PG8_MMA(0, 1, At, B1); PG8_BAR; PG8_SCHED;
            PG8_LDA(At, 0, 1); PG8_STAGE(PG8_SB(0, 0), b2, voffB); PG8_STAGE(PG8_SB(0, 1), b2 + hstepB, voffB); PG8_STAGE(PG8_SA(0, 0), a2, voffA);
            PG8_WAIT_V(8); PG8_WAIT_L(0); PG8_BAR; PG8_MMA(1, 0, At, B0); PG8_MMA(1, 1, At, B1); PG8_BAR; PG8_SCHED;
            PG8_LDB(B0, 1, 0); PG8_LDB(B1, 1, 1); PG8_SCHED; PG8_LDA(At, 1, 0); PG8_STAGE(PG8_SA(0, 1), a2 + hstepA, voffA);
            PG8_WAIT_V(8); PG8_WAIT_L(0); PG8_BAR; PG8_MMA(0, 0, At, B0); PG8_MMA(0, 1, At, B1); PG8_BAR; PG8_SCHED;
            PG8_LDA(At, 1, 1); PG8_STAGE(PG8_SB(1, 0), b3, voffB); PG8_STAGE(PG8_SB(1, 1), b3 + hstepB, voffB); PG8_STAGE(PG8_SA(1, 0), a3, voffA);
            PG8_WAIT_V(8); PG8_WAIT_L(0); PG8_BAR; PG8_MMA(1, 0, At, B0); PG8_MMA(1, 1, At, B1); PG8_BAR; PG8_SCHED;
            } else {
            PG8_LDB(B0, 0, 0); PG8_SCHED; PG8_LDA(At, 0, 0); PG8_STAGE(PG8_SA(1, 1), a1 + hstepA, voffA);
            PG8_WAIT_L(8); PG8_BAR; PG8_WAIT_L(0); PG8_MMA(0, 0, At, B0); PG8_BAR; PG8_SCHED;
            PG8_LDB(B1, 0, 1); PG8_STAGE(PG8_SB(0, 0), b2, voffB);
            PG8_BAR; PG8_WAIT_L(0); PG8_MMA(0, 1, At, B1); PG8_BAR;
            PG8_LDA(At, 0, 1); PG8_STAGE(PG8_SA(0, 0), a2, voffA);
            PG8_BAR; PG8_WAIT_L(0); PG8_MMA(1, 0, At, B0); PG8_BAR; PG8_SCHED;
            PG8_STAGE(PG8_SB(0, 1), b2 + hstepB, voffB);
            PG8_WAIT_V(6); PG8_BAR; PG8_MMA(1, 1, At, B1); PG8_BAR;
            PG8_LDB(B0, 1, 0); PG8_SCHED; PG8_LDA(At, 1, 0); PG8_STAGE(PG8_SA(0, 1), a2 + hstepA, voffA);
            PG8_WAIT_L(8); PG8_BAR; PG8_WAIT_L(0); PG8_MMA(0, 0, At, B0); PG8_BAR; PG8_SCHED;
            PG8_LDB(B1, 1, 1); PG8_STAGE(PG8_SB(1, 0), b3, voffB);
            PG8_BAR; PG8_WAIT_L(0); PG8_MMA(0, 1, At, B1); PG8_BAR;
            PG8_LDA(At, 1, 1); PG8_STAGE(PG8_SA(1, 0), a3, voffA);
            PG8_BAR; PG8_WAIT_L(0); PG8_MMA(1, 0, At, B0); PG8_BAR; PG8_SCHED;
            PG8_STAGE(PG8_SB(1, 1), b3 + hstepB, voffB);
            PG8_WAIT_V(6); PG8_BAR; PG8_MMA(1, 1, At, B1); PG8_BAR;
            }
        }
        if constexpr (ALIGN_EPI) { if (wr == 0) PG8_BAR; }
        if constexpr (!Epi::AFTER_DRAIN) { E(acc, cur, wr, wc, fr, fq); S.done(cur); }
        if (!has_next) break;
#pragma unroll
        for (int a = 0; a < 2; ++a)
#pragma unroll
            for (int b = 0; b < 2; ++b)
#pragma unroll
                for (int m = 0; m < 4; ++m)
#pragma unroll
                    for (int n = 0; n < 2; ++n) acc[a][b][m][n] = (f32x4){0.f, 0.f, 0.f, 0.f};
        cur = nxt; cA = nA; cB = nB; ++ui;
        if constexpr (ALIGN_EPI) { if (wr == 1) PG8_BAR; }
    }
    PG8_WAIT_V(0);
    if constexpr (!ALIGN_EPI) { if (wr == 0) PG8_BAR; }
    PG8_BAR;
    if constexpr (Epi::AFTER_DRAIN) { E.fused(acc, cur, wr, wc, fr, fq, lds, wid, lane); S.done(cur); }
#undef PG8_SA
#undef PG8_SB
#undef PG8_STAGE
#undef PG8_LDA
#undef PG8_LDB
#undef PG8_MMA
#undef PG8_WAIT_V
#undef PG8_WAIT_L
#undef PG8_BAR
#undef PG8_SCHED
}
}

#ifndef MK_N_LAUNCHES
#define MK_N_LAUNCHES 1
#endif
#ifndef B_DUMMY
#define B_DUMMY 0
#endif
#ifndef DUP_PHASE
#define DUP_PHASE -1
#endif
constexpr int N_PHASES = 7;
constexpr int NWAVES = 8;
constexpr int DM = 2048, NB = 4, SEQ = 4096, CTXL = 256;
constexpr int ML = NB * SEQ, MC = NB * CTXL, MT = ML + MC;
constexpr int NIN = 6912;
constexpr int C_R = 0, C_K = 1024, C_V = 2048, C_LW = 3072, C_LA = 3200, C_ZR = 3328, C_Q = 4352, C_KA = 5376, C_VA = 5632, C_ZA = 5888;
constexpr float LOG2E = 1.4426950408889634f;
constexpr int DBG_LDS = 143360;

constexpr size_t MiB = 1u << 20;
constexpr size_t WS_CTL = 0, CTL_ZERO_BYTES = 64 * 1024;
constexpr size_t WS_MOD = 1 * MiB;
constexpr size_t WS_ROPE = 1 * MiB + 128 * 1024;
constexpr size_t WS_DBG = 1 * MiB + 192 * 1024;
constexpr size_t WS_W2T = 1 * MiB + 256 * 1024;
constexpr size_t WS_A2T = 1 * MiB + 512 * 1024;
constexpr size_t WS_WOUT = 2 * MiB;
constexpr size_t WS_P = 10 * MiB;
constexpr size_t WS_XN = 240 * MiB;
constexpr size_t WS_WIN = 308 * MiB;
constexpr size_t WS_GHQ = 240 * MiB;
constexpr size_t WS_MIX = 240 * MiB;
constexpr size_t WS_YF = 444 * MiB, WS_YB = 476 * MiB;
constexpr size_t WS_BON = 508 * MiB;
constexpr size_t WS_END = 510 * MiB;
static_assert(WS_P + (size_t)MT * NIN * 2 <= WS_XN && WS_XN + (size_t)MT * DM * 2 <= WS_WIN && WS_WIN + (size_t)NIN * DM * 2 <= WS_YF && WS_GHQ + (size_t)8704 * 24576 <= WS_YF && WS_YB + (size_t)ML * 1024 * 2 <= WS_BON, "ws map");

constexpr int CW_BAR = 1024;
constexpr int CW_TICKET = 8192;
constexpr int LDS_BYTES = 163840;
constexpr int MISC_OFF = LDS_BYTES - 256;

#define GAS __attribute__((address_space(1)))
#define LAS __attribute__((address_space(3)))
typedef unsigned short bf16;
typedef float f32x4 __attribute__((ext_vector_type(4)));
typedef float f32x16 __attribute__((ext_vector_type(16)));
typedef short bf16x8 __attribute__((ext_vector_type(8)));
typedef unsigned u32x4 __attribute__((ext_vector_type(4)));
typedef unsigned u32x2 __attribute__((ext_vector_type(2)));
typedef _Float16 h8 __attribute__((ext_vector_type(8)));
typedef _Float16 h4 __attribute__((ext_vector_type(4)));
typedef _Float16 h2 __attribute__((ext_vector_type(2)));
typedef GAS unsigned gu32;

__device__ __forceinline__ unsigned f2bf(float f) { unsigned u = __builtin_bit_cast(unsigned, f); return (u + 0x7fffu + ((u >> 16) & 1u)) >> 16; }
typedef float f32x2_t __attribute__((ext_vector_type(2))); typedef __bf16 bf16x2_t __attribute__((ext_vector_type(2)));
__device__ __forceinline__ unsigned pk2(float lo, float hi) { f32x2_t v = {lo, hi}; bf16x2_t b = __builtin_convertvector(v, bf16x2_t); return __builtin_bit_cast(unsigned, b); }
__device__ __forceinline__ float bflo(unsigned w) { return __builtin_bit_cast(float, w << 16); }
__device__ __forceinline__ float bfhi(unsigned w) { return __builtin_bit_cast(float, w & 0xffff0000u); }
__device__ __forceinline__ void unpack8(const u32x4 r, float* v) { v[0] = bflo(r.x); v[1] = bfhi(r.x); v[2] = bflo(r.y); v[3] = bfhi(r.y); v[4] = bflo(r.z); v[5] = bfhi(r.z); v[6] = bflo(r.w); v[7] = bfhi(r.w); }
__device__ __forceinline__ unsigned pkh(float a, float b) { h2 v = {(_Float16)a, (_Float16)b}; return __builtin_bit_cast(unsigned, v); }
__device__ __forceinline__ float wave_sum(float v) {
#pragma unroll
    for (int o = 1; o < 64; o <<= 1) v += __shfl_xor(v, o);
    return v;
}
__device__ __forceinline__ float fast_exp(float x) { return __builtin_amdgcn_exp2f(x * LOG2E); }
__device__ __forceinline__ float sigmoidf_(float x) { return __builtin_amdgcn_rcpf(1.0f + fast_exp(-x)); }
__device__ __forceinline__ float siluf_(float x) { return x * sigmoidf_(x); }
template <int CTRL> __device__ __forceinline__ float dpp_f(float x) { return __builtin_bit_cast(float, __builtin_amdgcn_update_dpp(0, __builtin_bit_cast(int, x), CTRL, 0xF, 0xF, false)); }

#define XB_TMO      128
#define XB_XCNT(j)  (256  + 64 * (j))
#define XB_XSUB(j)  (1280 + 64 * (j))
#define XB_XGEN(j)  (2304 + 64 * (j))
#define XB_TOP      3328
#define XB_TOPGEN   3392
#define XCD_BAR_WORDS 3456
#define XB_SPIN_CAP (1u << 18)
__device__ __forceinline__ unsigned xb_ld(unsigned* p)              { return __hip_atomic_load(p, __ATOMIC_RELAXED, __HIP_MEMORY_SCOPE_AGENT); }
__device__ __forceinline__ unsigned xb_add(unsigned* p, unsigned v) { return __hip_atomic_fetch_add(p, v, __ATOMIC_RELAXED, __HIP_MEMORY_SCOPE_AGENT); }
__device__ __forceinline__ unsigned xb_xcc_id() { return (unsigned)__builtin_amdgcn_s_getreg((3 << 11) | 20) & 0xFu; }
#define XB_SPIN(cond, bar) do { unsigned _sp = 0; while (cond) { __builtin_amdgcn_s_sleep(1); \
    if ((++_sp & 255u) == 0u) { if (xb_ld(&(bar)[XB_TMO])) break; if (_sp > XB_SPIN_CAP) { atomicAdd(&(bar)[XB_TMO], 1u); break; } } } } while (0)
struct XcdBarrier { unsigned* bar; unsigned x; volatile LAS unsigned* st; };
__device__ __forceinline__ XcdBarrier xcd_barrier_post(unsigned* bar, volatile LAS unsigned* st) {
    XcdBarrier b; b.bar = bar; b.x = xb_xcc_id(); b.st = st;
    if (threadIdx.x == 0) (void)xb_add(&bar[XB_XCNT(b.x)], 1u);
    return b;
}
__device__ __forceinline__ void xcd_barrier_complete(unsigned* bar, unsigned x, unsigned& nloc, unsigned& nx) {
    const unsigned G = gridDim.x * gridDim.y * gridDim.z;
    unsigned sum, cnt, mine, sp = 0u;
    for (;;) {
        sum = 0u; cnt = 0u; mine = 0u;
#pragma unroll
        for (unsigned j = 0; j < 16; ++j) { const unsigned c = xb_ld(&bar[XB_XCNT(j)]); sum += c; cnt += (c > 0u) ? 1u : 0u; mine = (j == x) ? c : mine; }
        if (sum == G) break;
        __builtin_amdgcn_s_sleep(1);
        if ((++sp & 255u) == 0u) { if (xb_ld(&bar[XB_TMO])) break; if (sp > XB_SPIN_CAP) { atomicAdd(&bar[XB_TMO], 1u); break; } }
    }
    nloc = mine > 0u ? mine : 1u; nx = cnt > 0u ? cnt : 1u;
}
__device__ __forceinline__ void xcd_barrier(const XcdBarrier& b) {
    asm volatile("s_waitcnt vmcnt(0)" ::: "memory");
    __syncthreads();
    if (threadIdx.x == 0) {
        unsigned* bar = b.bar;
        __builtin_amdgcn_s_waitcnt(0);
        unsigned nloc = b.st[0], nx = b.st[1];
        if (nloc == 0u) { xcd_barrier_complete(bar, b.x, nloc, nx); b.st[0] = nloc; b.st[1] = nx; }
        const unsigned old = xb_add(&bar[XB_XSUB(b.x)], 1u);
        const unsigned gen = old / nloc;
        if (old + 1u == (gen + 1u) * nloc) {
            __builtin_amdgcn_fence(__ATOMIC_RELEASE, "agent");
            asm volatile("s_waitcnt vmcnt(0)" ::: "memory");
            const unsigned og = xb_add(&bar[XB_TOP], 1u);
            const unsigned tg = og / nx;
            if (og + 1u == (tg + 1u) * nx) xb_add(&bar[XB_TOPGEN], 1u);
            else XB_SPIN(xb_ld(&bar[XB_TOPGEN]) == tg, bar);
            __builtin_amdgcn_fence(__ATOMIC_ACQUIRE, "agent");
            xb_add(&bar[XB_XGEN(b.x)], 1u);
            asm volatile("s_waitcnt vmcnt(0)" ::: "memory");
        } else {
            XB_SPIN(xb_ld(&bar[XB_XGEN(b.x)]) == gen, bar);
            __builtin_amdgcn_fence(__ATOMIC_ACQUIRE, "agent");
            asm volatile("s_waitcnt vmcnt(0)" ::: "memory");
        }
    }
    __syncthreads();
}

#define DBG_FINE (!(DBG_SEL >= 8 && DBG_SEL < 24))
#define TSTAMP(k) do { if (DBG_SEL >= 0 && (DBG_FINE || ((k) >= 8 && (k) < 24)) && F.bid == DBG_BLOCK && F.tid == 0) { volatile LAS unsigned long long* T_ = (volatile LAS unsigned long long*)(F.lds + DBG_LDS); const unsigned long long n_ = __builtin_amdgcn_s_memrealtime(); const unsigned long long m_ = __builtin_amdgcn_s_memtime(); T_[k] += n_ - T_[32]; T_[32] = n_; if ((k) < 8) { T_[24] += m_ - T_[33]; } T_[33] = m_; } } while (0)
#define TSTART() do { if (DBG_SEL >= 0 && F.bid == DBG_BLOCK && F.tid == 0) { volatile LAS unsigned long long* T_ = (volatile LAS unsigned long long*)(F.lds + DBG_LDS); T_[32] = __builtin_amdgcn_s_memrealtime(); T_[33] = __builtin_amdgcn_s_memtime(); } } while (0)
struct Frame {
    LAS unsigned char* lds;
    int tid, lane, wave, G, bid;
    const float *x, *c, *ctx, *c_ctx, *w_ada, *b_ada, *norm_g, *w_in, *mu_shift, *w0, *w2, *a0, *a2, *k_k, *k_a, *r_k, *ln_g, *ln_b, *qng, *kng, *sink, *w_out;
    float* out;
    float *MOD, *ROPE, *BON, *DBG;
    bf16 *W2T, *A2T, *WOUT, *P, *XN, *WIN, *YF, *YB, *MIX;
    unsigned char* GHQ;
};


typedef const float* cfp_t;
__device__ __forceinline__ const float* karg_f(int idx) { int off = idx * 8; asm volatile("" : "+s"(off)); const __attribute__((address_space(4))) char* kp = (const __attribute__((address_space(4))) char*)__builtin_amdgcn_kernarg_segment_ptr(); return *(const __attribute__((address_space(4))) cfp_t*)(kp + off); }
__device__ __forceinline__ void fresh(Frame& F) {
    int t_ = threadIdx.x; asm volatile("" : "+v"(t_)); F.tid = t_; F.lane = t_ & 63; F.wave = __builtin_amdgcn_readfirstlane(t_ >> 6);
    int b_ = blockIdx.x; asm volatile("" : "+s"(b_)); F.bid = b_;
    F.x = karg_f(0); F.c = karg_f(1); F.ctx = karg_f(2); F.c_ctx = karg_f(3); F.w_ada = karg_f(4); F.b_ada = karg_f(5); F.norm_g = karg_f(6); F.w_in = karg_f(7);
    F.mu_shift = karg_f(8); F.w0 = karg_f(9); F.w2 = karg_f(10); F.a0 = karg_f(11); F.a2 = karg_f(12); F.k_k = karg_f(13); F.k_a = karg_f(14); F.r_k = karg_f(15);
    F.ln_g = karg_f(16); F.ln_b = karg_f(17); F.qng = karg_f(18); F.kng = karg_f(19); F.sink = karg_f(20); F.w_out = karg_f(21);
    F.out = (float*)karg_f(22);
    unsigned char* ws = (unsigned char*)karg_f(23);
    F.MOD = (float*)(ws + WS_MOD); F.ROPE = (float*)(ws + WS_ROPE); F.BON = (float*)(ws + WS_BON); F.DBG = (float*)(ws + WS_DBG);
    F.W2T = (bf16*)(ws + WS_W2T); F.A2T = (bf16*)(ws + WS_A2T); F.WOUT = (bf16*)(ws + WS_WOUT); F.P = (bf16*)(ws + WS_P); F.XN = (bf16*)(ws + WS_XN); F.WIN = (bf16*)(ws + WS_WIN);
    F.YF = (bf16*)(ws + WS_YF); F.YB = (bf16*)(ws + WS_YB); F.MIX = (bf16*)(ws + WS_MIX); F.GHQ = ws + WS_GHQ;
}

struct Sched1 {
    int G, c;
    __device__ __forceinline__ void init(int G_, int c_) { G = G_; c = c_; }
    __device__ __forceinline__ bool next(int i, pg8::Unit& u) const {
        int grp, loc;
        if (G == 256) { if (i >= 7) return false; grp = c & 7; loc = i * 32 + (c >> 3); if (loc >= 216) { const int j = grp * 8 + (loc - 216); if (j >= 60) return false; u.pm = 64 + j / 15; const int q = j % 15; u.pn = q < 13 ? q : q + 8; return true; } }
        else { const int L = i * G + c; if (L >= 1788) return false; if (L >= 1728) { const int j = L - 1728; u.pm = 64 + j / 15; const int q = j % 15; u.pn = q < 13 ? q : q + 8; return true; } grp = L / 216; loc = L % 216; }
        u.pm = grp * 8 + (loc & 7); u.pn = loc >> 3; return true;
    }
    __device__ __forceinline__ void a_ready(const pg8::Unit&) const {}
    __device__ __forceinline__ void done(const pg8::Unit&) const {}
};

__device__ __forceinline__ void p0_transpose_item(const float* W, int K, int N, bf16* WT, LAS float* scr, int item, int lane) {
    const int nblk = N / 32, kb = item / nblk, nb = item % nblk, k0 = 64 * kb, n0 = 32 * nb;
#pragma unroll 8
    for (int i = 0; i < 32; ++i) { const int kk = 2 * i + (lane >> 5); scr[kk * 33 + (lane & 31)] = W[(size_t)(k0 + kk) * N + n0 + (lane & 31)]; }
    asm volatile("s_waitcnt lgkmcnt(0)" ::: "memory");
    const int c = lane & 7;
#pragma unroll
    for (int j = 0; j < 4; ++j) { const int n = (lane >> 3) + 8 * j; const LAS float* s = scr + (8 * c) * 33 + n;
        u32x4 o; o.x = pk2(s[0 * 33], s[1 * 33]); o.y = pk2(s[2 * 33], s[3 * 33]); o.z = pk2(s[4 * 33], s[5 * 33]); o.w = pk2(s[6 * 33], s[7 * 33]);
        *(GAS u32x4*)(WT + (size_t)(n0 + n) * K + k0 + 8 * c) = o; }
    asm volatile("s_waitcnt lgkmcnt(0)" ::: "memory");
}
__device__ __forceinline__ void p0_prologue(Frame& F) {
    const int tid = F.tid, lane = F.lane, wave = F.wave;
    if (F.bid < 192) {
        LAS float* sl = (LAS float*)F.lds;
        LAS float* red = sl + 5 * 2048;
        for (int i = tid; i < 5 * 2048; i += NWAVES * 64) { const int v = i >> 11, k = i & 2047; const float cv = v < 4 ? F.c[v * 2048 + k] : F.c_ctx[k]; sl[i] = cv / (1.0f + __expf(-cv)); }
        __syncthreads();
        const int n0 = 32 * F.bid, col = lane & 31, slot = wave * 2 + (lane >> 5);
        float acc[5] = {0.f, 0.f, 0.f, 0.f, 0.f};
        const float* wp = F.w_ada + n0 + col;
#pragma unroll 8
        for (int k = slot; k < 2048; k += 16) { const float w = wp[(size_t)k * 6144];
#pragma unroll
            for (int v = 0; v < 5; ++v) acc[v] += sl[v * 2048 + k] * w; }
#pragma unroll
        for (int v = 0; v < 5; ++v) red[(slot * 5 + v) * 32 + col] = acc[v];
        __syncthreads();
        if (tid < 160) { const int v = tid >> 5, cc = tid & 31; float s = 0.f;
#pragma unroll
            for (int q = 0; q < 16; ++q) s += red[(q * 5 + v) * 32 + cc];
            F.MOD[v * 6144 + n0 + cc] = s + F.b_ada[n0 + cc]; }
        __syncthreads();
    }
    if (F.bid == F.G - 1) {
        for (int i = tid; i < 1024; i += NWAVES * 64) { const int pos = i >> 4, f = i & 15; const float inv = exp2f(-(float)f * (13.287712379549449f / 16.0f)); const float ang = (float)pos * inv;
            F.ROPE[i] = cosf(ang); F.ROPE[1024 + i] = sinf(ang); }
    }
    LAS float* scr = (LAS float*)(F.lds + wave * 16384);
    const int gw = F.bid * NWAVES + wave, NGW = F.G * NWAVES;
    constexpr int I_IN = (DM / 64) * (NIN / 32), I_OUT = (DM / 64) * (DM / 32), I_L = 1024 / 32;
    constexpr int NITEMS = I_IN + I_OUT + 4 * I_L;
    for (int it = gw; it < NITEMS; it += NGW) {
        int r = it;
        if (r < I_IN) { p0_transpose_item(F.w_in, DM, NIN, F.WIN, scr, r, lane); continue; } r -= I_IN;
        if (r < I_OUT) { p0_transpose_item(F.w_out, DM, DM, F.WOUT, scr, r, lane); continue; } r -= I_OUT;
        const int q = r / I_L; r -= q * I_L;
        p0_transpose_item((q < 2 ? F.w2 : F.a2) + (size_t)(q & 1) * 64 * 1024, 64, 1024, (q < 2 ? F.W2T : F.A2T) + (size_t)(q & 1) * 1024 * 64, scr, r, lane);
    }
}

__device__ __forceinline__ void p1_modulate(Frame& F) {
    const int gw = F.bid * NWAVES + F.wave, NGW = F.G * NWAVES, lane = F.lane;
    const int m_lo = (int)(((long)gw * MT) / NGW), m_hi = (int)(((long)(gw + 1) * MT) / NGW);
    f32x4 gs[8], sh[8]; int cur = -1;
    for (int m = m_lo; m < m_hi; ++m) {
        const float* src = m < ML ? F.x + (size_t)m * DM : F.ctx + (size_t)(m - ML) * DM;
        const int bsel = m < ML ? (m >> 12) : 4;
        if (bsel != cur) { cur = bsel; const float* mod = F.MOD + bsel * 6144;
#pragma unroll
            for (int j = 0; j < 8; ++j) { const int d0 = (64 * j + lane) * 4; gs[j] = *(const f32x4*)(F.norm_g + d0) * (1.0f + *(const f32x4*)(mod + 2048 + d0)); sh[j] = *(const f32x4*)(mod + d0); } }
        const GAS f32x4* xr = (const GAS f32x4*)src + lane;
        f32x4 v[8]; float s = 0.f;
#pragma unroll
        for (int j = 0; j < 8; ++j) { v[j] = xr[64 * j]; s += (v[j].x * v[j].x + v[j].y * v[j].y) + (v[j].z * v[j].z + v[j].w * v[j].w); }
        const float rr = 1.0f / sqrtf(wave_sum(s) * (1.0f / DM) + 1e-6f);
        GAS u32x2* o8 = (GAS u32x2*)(F.XN + (size_t)m * DM) + lane;
#pragma unroll
        for (int j = 0; j < 8; ++j) { const f32x4 o = v[j] * rr * gs[j] + sh[j]; u32x2 w; w.x = pk2(o.x, o.y); w.y = pk2(o.z, o.w); o8[64 * j] = w; }
    }
}

__device__ __forceinline__ int seq_lo(int m) { return m < ML ? (m & ~(SEQ - 1)) : ML + ((m - ML) & ~(CTXL - 1)); }
__device__ __forceinline__ int seq_hi(int m) { return m < ML ? (m | (SEQ - 1)) : ML + ((m - ML) | (CTXL - 1)); }
__device__ __forceinline__ int scan_row(int b, int d, int blk, int tok) {
    const int j = blk < 4 ? blk * 64 + tok : (blk - 4) * 64 + tok;
    if (blk < 4) return ML + b * CTXL + (d ? (CTXL - 1 - j) : j);
    return b * SEQ + (d ? (SEQ - 1 - j) : j);
}
constexpr int CH_RS = 144, CH_MB = 64 * CH_RS;
constexpr int CB_AT = 0, CB_BT = 1, CB_KT = 2, CB_RT = 3, CB_ATT = 4, CB_BTT = 5, CB_KTT = 6, CB_VT = 7, CB_AAB = 8, CB_AABT = 9, CB_AAK = 10, CB_ARB = 11, CB_ARK = 12, CB_X1 = 13, CB_XT = 14, CB_INV = 4, CB_OY = 4, CB_OG = 5, CB_OH = 6, CB_OQ = 7;
constexpr int CH_WBUF = 8 * CH_MB, CH_ABUF = CH_WBUF + 16384;
constexpr int CH_PT = 15 * CH_MB, CH_GT = CH_PT + 1024, CH_CONST = CH_GT + 2048;
constexpr int CH_LW = 144384;
#ifndef FORCE_BF16
#define FORCE_BF16 0
#endif
constexpr size_t GHQ_ITEM = 24576;
#define LBAR() do { asm volatile("s_waitcnt lgkmcnt(0)" ::: "memory"); __builtin_amdgcn_s_barrier(); asm volatile("" ::: "memory"); } while (0)
__device__ __forceinline__ float h_lo(unsigned w) { return (float)__builtin_bit_cast(h2, w)[0]; }
__device__ __forceinline__ float h_hi(unsigned w) { return (float)__builtin_bit_cast(h2, w)[1]; }
__device__ __forceinline__ f32x4 unpack4x(bool f16, const u32x2 w) { f32x4 r;
    if (f16) { r.x = h_lo(w.x); r.y = h_hi(w.x); r.z = h_lo(w.y); r.w = h_hi(w.y); } else { r.x = bflo(w.x); r.y = bfhi(w.x); r.z = bflo(w.y); r.w = bfhi(w.y); }
    return r; }
__device__ __forceinline__ u32x4 pack8x(bool f16, const float* v) { u32x4 o;
    if (f16) { o.x = pkh(v[0], v[1]); o.y = pkh(v[2], v[3]); o.z = pkh(v[4], v[5]); o.w = pkh(v[6], v[7]); } else { o.x = pk2(v[0], v[1]); o.y = pk2(v[2], v[3]); o.z = pk2(v[4], v[5]); o.w = pk2(v[6], v[7]); }
    return o; }
__device__ __forceinline__ f32x16 mm32(bool f16, const LAS unsigned char* Aop, int mrow0, const LAS unsigned char* Blay, int nrow0, f32x16 acc, int l31, int hi) {
    const LAS unsigned char* pa = Aop + (mrow0 + l31) * CH_RS + hi * 16;
    const LAS unsigned char* pb = Blay + (nrow0 + l31) * CH_RS + hi * 16;
    bf16x8 a[4], b[4];
#pragma unroll
    for (int ks = 0; ks < 4; ++ks) { a[ks] = *(const LAS bf16x8*)(pa + ks * 32); b[ks] = *(const LAS bf16x8*)(pb + ks * 32); }
    if (f16) {
#pragma unroll
        for (int ks = 0; ks < 4; ++ks) acc = __builtin_amdgcn_mfma_f32_32x32x16_f16(__builtin_bit_cast(h8, a[ks]), __builtin_bit_cast(h8, b[ks]), acc, 0, 0, 0);
    } else {
#pragma unroll
        for (int ks = 0; ks < 4; ++ks) acc = __builtin_amdgcn_mfma_f32_32x32x16_bf16(a[ks], b[ks], acc, 0, 0, 0);
    }
    return acc;
}
__device__ __forceinline__ f32x16 mm32k(bool f16, const LAS unsigned char* Aop, int mrow0, const LAS unsigned char* Blay, int nrow0, int kb, f32x16 acc, int l31, int hi) {
    const LAS unsigned char* pa = Aop + (mrow0 + l31) * CH_RS + kb * 64 + hi * 16;
    const LAS unsigned char* pb = Blay + (nrow0 + l31) * CH_RS + kb * 64 + hi * 16;
    const bf16x8 a0 = *(const LAS bf16x8*)pa, a1 = *(const LAS bf16x8*)(pa + 32), b0 = *(const LAS bf16x8*)pb, b1 = *(const LAS bf16x8*)(pb + 32);
    if (f16) { acc = __builtin_amdgcn_mfma_f32_32x32x16_f16(__builtin_bit_cast(h8, a0), __builtin_bit_cast(h8, b0), acc, 0, 0, 0); acc = __builtin_amdgcn_mfma_f32_32x32x16_f16(__builtin_bit_cast(h8, a1), __builtin_bit_cast(h8, b1), acc, 0, 0, 0); }
    else { acc = __builtin_amdgcn_mfma_f32_32x32x16_bf16(a0, b0, acc, 0, 0, 0); acc = __builtin_amdgcn_mfma_f32_32x32x16_bf16(a1, b1, acc, 0, 0, 0); }
    return acc;
}
typedef short s16x4 __attribute__((ext_vector_type(4))); typedef short s16x8 __attribute__((ext_vector_type(8)));
__device__ __forceinline__ bf16x8 trfrag(const LAS unsigned char* Img, int j0, int c0, int lane) {
    const int g = lane >> 4, q = (lane >> 2) & 3, p = lane & 3;
    LAS unsigned char* a = (LAS unsigned char*)Img + (j0 + 8 * (g >> 1) + q) * CH_RS + (c0 + 16 * (g & 1) + 4 * p) * 2;
    const s16x4 r0 = __builtin_amdgcn_ds_read_tr16_b64_v4i16((LAS s16x4*)a), r1 = __builtin_amdgcn_ds_read_tr16_b64_v4i16((LAS s16x4*)(a + 4 * CH_RS));
    return __builtin_bit_cast(bf16x8, __builtin_shufflevector(r0, r1, 0, 1, 2, 3, 4, 5, 6, 7));
}
template<bool TA, bool TB> __device__ __forceinline__ f32x16 mm32x(bool f16, const LAS unsigned char* A, int a0, const LAS unsigned char* B, int b0, f32x16 acc, int lane) {
    const int l31 = lane & 31, hi = lane >> 5;
    bf16x8 a[4], b[4];
#pragma unroll
    for (int ks = 0; ks < 4; ++ks) {
        a[ks] = TA ? trfrag(A, 16 * ks, a0, lane) : *(const LAS bf16x8*)(A + (a0 + l31) * CH_RS + hi * 16 + ks * 32);
        b[ks] = TB ? trfrag(B, 16 * ks, b0, lane) : *(const LAS bf16x8*)(B + (b0 + l31) * CH_RS + hi * 16 + ks * 32); }
    if (f16) {
#pragma unroll
        for (int ks = 0; ks < 4; ++ks) acc = __builtin_amdgcn_mfma_f32_32x32x16_f16(__builtin_bit_cast(h8, a[ks]), __builtin_bit_cast(h8, b[ks]), acc, 0, 0, 0);
    } else {
#pragma unroll
        for (int ks = 0; ks < 4; ++ks) acc = __builtin_amdgcn_mfma_f32_32x32x16_bf16(a[ks], b[ks], acc, 0, 0, 0);
    }
    return acc;
}
__device__ __forceinline__ void st_nat(bool f16, LAS unsigned char* Out, int mrow0, int nrow0, const f32x16& acc, int l31, int hi) {
    LAS unsigned char* p = Out + (nrow0 + l31) * CH_RS + (mrow0 + 4 * hi) * 2;
    if (f16) {
#pragma unroll
        for (int rg = 0; rg < 4; ++rg) { u32x2 o; o.x = pkh(acc[4 * rg], acc[4 * rg + 1]); o.y = pkh(acc[4 * rg + 2], acc[4 * rg + 3]); *(LAS u32x2*)(p + rg * 16) = o; }
    } else {
#pragma unroll
        for (int rg = 0; rg < 4; ++rg) { u32x2 o; o.x = pk2(acc[4 * rg], acc[4 * rg + 1]); o.y = pk2(acc[4 * rg + 2], acc[4 * rg + 3]); *(LAS u32x2*)(p + rg * 16) = o; }
    }
}
__device__ __forceinline__ f32x16 zero16() { f32x16 z = {0.f, 0.f, 0.f, 0.f, 0.f, 0.f, 0.f, 0.f, 0.f, 0.f, 0.f, 0.f, 0.f, 0.f, 0.f, 0.f}; return z; }
struct ChRegs { u32x4 r, k, v, lw, la, halo; };
__device__ __forceinline__ int chunk_mlo(int b, int d, int c) { return d ? scan_row(b, d, c, 63) : scan_row(b, d, c, 0); }
__device__ __forceinline__ void ch_load(Frame& F, ChRegs& R, int b, int h, int d, int c) {
    const int tok = F.tid >> 3, ch = F.tid & 7, m = scan_row(b, d, c, tok);
    const bf16* pc = F.P + (size_t)m * NIN + 8 * ch;
    const int cr = C_R + h * 64, ck = C_K + h * 64, cv = C_V + h * 64, cw = C_LW + d * 64, ca = C_LA + d * 64;
    R.r = *(const u32x4*)(pc + cr); R.k = *(const u32x4*)(pc + ck); R.v = *(const u32x4*)(pc + cv); R.lw = *(const u32x4*)(pc + cw); R.la = *(const u32x4*)(pc + ca);
    const u32x4 z = {0u, 0u, 0u, 0u}; R.halo = z;
    if (F.tid < 80) { const int hrow = F.tid >= 40 ? 1 : 0, vec = (F.tid - 40 * hrow) >> 3, mlo = chunk_mlo(b, d, c), mh = hrow ? mlo + 64 : mlo - 1;
        const int col = vec == 0 ? cr : vec == 1 ? ck : vec == 2 ? cv : vec == 3 ? cw : ca;
        if (mh >= seq_lo(mlo) && mh <= seq_hi(mlo)) R.halo = *(const u32x4*)(F.P + (size_t)mh * NIN + col + 8 * ch); }
}
constexpr int CH_RAW3 = 0 * CH_MB, CH_RAWL = 10 * CH_MB;
__device__ __forceinline__ void ch_park(Frame& F, const ChRegs& R, int b, int d, int c) {
    LAS unsigned char* lds = F.lds; const int tok = F.tid >> 3, ch = F.tid & 7, ri = 1 + scan_row(b, d, c, tok) - chunk_mlo(b, d, c);
    LAS unsigned char* p3 = lds + CH_RAW3 + ri * 384 + ch * 16; LAS unsigned char* pl = lds + CH_RAWL + ri * 256 + ch * 16;
    *(LAS u32x4*)p3 = R.r; *(LAS u32x4*)(p3 + 128) = R.k; *(LAS u32x4*)(p3 + 256) = R.v; *(LAS u32x4*)pl = R.lw; *(LAS u32x4*)(pl + 128) = R.la;
    if (F.tid < 80) { const int hrow = F.tid >= 40 ? 1 : 0, vec = (F.tid - 40 * hrow) >> 3, rh = hrow ? 65 : 0;
        if (vec < 3) *(LAS u32x4*)(lds + CH_RAW3 + rh * 384 + vec * 128 + ch * 16) = R.halo; else *(LAS u32x4*)(lds + CH_RAWL + rh * 256 + (vec - 3) * 128 + ch * 16) = R.halo; }
}
__device__ __forceinline__ void shift8(const u32x4 c, const u32x4 p, const u32x4 n, const LAS f32x4* mu, float* o) {
    float vc[8], vp[8], vn[8]; unpack8(c, vc); unpack8(p, vp); unpack8(n, vn);
    const f32x4 m0 = mu[0], m1 = mu[1];
#pragma unroll
    for (int j = 0; j < 8; ++j) { const float mm = j < 4 ? m0[j & 3] : m1[j & 3]; o[j] = vc[j] + mm * (0.5f * (vp[j] + vn[j]) - vc[j]); }
}
template<bool F16> __device__ __forceinline__ f32x16 mf2(const u32x4 a0, const u32x4 a1, const u32x4 b0, const u32x4 b1, f32x16 acc) {
    if (F16) { acc = __builtin_amdgcn_mfma_f32_32x32x16_f16(__builtin_bit_cast(h8, a0), __builtin_bit_cast(h8, b0), acc, 0, 0, 0); acc = __builtin_amdgcn_mfma_f32_32x32x16_f16(__builtin_bit_cast(h8, a1), __builtin_bit_cast(h8, b1), acc, 0, 0, 0); }
    else { acc = __builtin_amdgcn_mfma_f32_32x32x16_bf16(__builtin_bit_cast(bf16x8, a0), __builtin_bit_cast(bf16x8, b0), acc, 0, 0, 0); acc = __builtin_amdgcn_mfma_f32_32x32x16_bf16(__builtin_bit_cast(bf16x8, a1), __builtin_bit_cast(bf16x8, b1), acc, 0, 0, 0); }
    return acc; }
template<bool F16> __device__ __forceinline__ void cv2(const f32x16& a, u32x4& s0, u32x4& s1) {
    if (F16) { s0.x = pkh(a[0], a[1]); s0.y = pkh(a[2], a[3]); s0.z = pkh(a[4], a[5]); s0.w = pkh(a[6], a[7]); s1.x = pkh(a[8], a[9]); s1.y = pkh(a[10], a[11]); s1.z = pkh(a[12], a[13]); s1.w = pkh(a[14], a[15]); }
    else { s0.x = pk2(a[0], a[1]); s0.y = pk2(a[2], a[3]); s0.z = pk2(a[4], a[5]); s0.w = pk2(a[6], a[7]); s1.x = pk2(a[8], a[9]); s1.y = pk2(a[10], a[11]); s1.z = pk2(a[12], a[13]); s1.w = pk2(a[14], a[15]); } }
template<bool F16, bool TR> __device__ __forceinline__ f32x16 inv_chain(const f32x16& ap0, const f32x16& aq0, int l31, int hi) {
    u32x4 p0, p1, q0, q1, x0, x1;
    cv2<F16>(ap0, p0, p1); cv2<F16>(aq0, q0, q1);
    f32x16 x = TR ? aq0 : ap0;
#pragma unroll
    for (int r = 0; r < 16; ++r) { const int row = (r & 3) + 8 * (r >> 2) + 4 * hi; if (row == l31) x[r] += 1.0f; }
    cv2<F16>(x, x0, x1);
#pragma unroll
    for (int k = 1; k <= 4; ++k) {
        const bool needP = (k < 4) || TR, needQ = (k < 4) || !TR;
        f32x16 ap = zero16(), aq = zero16();
        if (needP) ap = mf2<F16>(q0, q1, p0, p1, ap);
        if (needQ) aq = mf2<F16>(p0, p1, q0, q1, aq);
        if (needP) cv2<F16>(ap, p0, p1);
        if (needQ) cv2<F16>(aq, q0, q1);
        x = TR ? mf2<F16>(p0, p1, x0, x1, x) : mf2<F16>(q0, q1, x0, x1, x);
        if (k < 4) cv2<F16>(x, x0, x1);
    }
    return x;
}
template<bool F16> __device__ __forceinline__ void chain_wave(LAS unsigned char* lds, int wave, int lane, u32x4& t0, u32x4& t1) {
    const int l31 = lane & 31, hi = lane >> 5, o = wave == 2 ? 32 : 0;
    const LAS unsigned char* At = lds + CB_AT * CH_MB; const LAS unsigned char* Bt = lds + CB_BT * CH_MB;
    f32x16 aq = mm32(F16, Bt, o, At, o, zero16(), l31, hi);
    f32x16 ap = mm32(F16, At, o, Bt, o, zero16(), l31, hi);
#pragma unroll
    for (int r = 0; r < 16; ++r) { const int row = (r & 3) + 8 * (r >> 2) + 4 * hi; aq[r] = row < l31 ? aq[r] : 0.f; ap[r] = l31 < row ? ap[r] : 0.f; }
    if (wave != 3) { const f32x16 x = inv_chain<F16, true>(ap, aq, l31, hi); st_nat(F16, lds + CB_INV * CH_MB, o, o, x, l31, hi); if (wave == 2) cv2<F16>(x, t0, t1); }
    else { const f32x16 x1 = inv_chain<F16, false>(ap, aq, l31, hi);
        u32x4 b0, b1, a0, a1, u0, u1; cv2<F16>(x1, b0, b1);
        const f32x16 a21 = mm32(F16, Bt, 0, At, 32, zero16(), l31, hi);
        cv2<F16>(a21, a0, a1);
        const f32x16 u = mf2<F16>(a0, a1, b0, b1, zero16());
        cv2<F16>(u, u0, u1);
        *(LAS u32x4*)(lds + CB_AAB * CH_MB + lane * 16) = u0; *(LAS u32x4*)(lds + CB_AAB * CH_MB + 1024 + lane * 16) = u1; }
}
__device__ __forceinline__ void ch_tail(const bool f16, Frame& F, ChRegs& R, const float (&sr)[8], const float (&sk)[8], const float (&sv)[8], int b, int h, int d, int c, int chain, int ci) {
    int lane_ = F.lane; asm volatile("" : "+v"(lane_));
    const int tid = F.tid, lane = lane_, wave = F.wave, l31 = lane & 31, hi = lane >> 5;
    const int q4 = wave & 3, tb = q4 >> 1, cb = q4 & 1, tok = tid >> 3, ch = tid & 7;
    LAS unsigned char* lds = F.lds;
    const LAS f32x4* cs = (const LAS f32x4*)(lds + CH_CONST) + 2 * ch;
    const LAS float* pT = (const LAS float*)(lds + CH_PT);
#define CB(i) (lds + (i) * CH_MB)
    { const LAS f32x4* pw = (const LAS f32x4*)(lds + CH_WBUF) + tok * 16 + 2 * ch; const LAS f32x4* pab = (const LAS f32x4*)(lds + CH_ABUF) + tok * 16 + 2 * ch;
      const f32x4 p0 = pw[0], p1 = pw[1], a0v = pab[0], a1v = pab[1];
      f32x4 m0 = {1.f, 1.f, 1.f, 1.f}, m1 = m0; if (tok > 0) { m0 = pw[-16]; m1 = pw[-15]; }
      const f32x4 r0 = *(const LAS f32x4*)(pT + 64 + 8 * ch), r1 = *(const LAS f32x4*)(pT + 64 + 8 * ch + 4);
      const f32x4 kk0 = cs[80], kk1 = cs[81], ka0 = cs[96], ka1 = cs[97], rk0 = cs[112], rk1 = cs[113];
      float kk[8], ss = 0.f;
#pragma unroll
      for (int j = 0; j < 8; ++j) { kk[j] = sk[j] * (j < 4 ? kk0[j & 3] : kk1[j & 3]); ss += kk[j] * kk[j]; }
      ss += __shfl_xor(ss, 1); ss += __shfl_xor(ss, 2); ss += __shfl_xor(ss, 4);
      const float inv = __builtin_amdgcn_rsqf(fmaxf(ss, 1e-24f));
      float at[8], bt[8], kt[8], rt[8], bon = 0.f;
#pragma unroll
      for (int j = 0; j < 8; ++j) { const float P = j < 4 ? p0[j & 3] : p1[j & 3], Pm = j < 4 ? m0[j & 3] : m1[j & 3], a = j < 4 ? a0v[j & 3] : a1v[j & 3], pr = j < 4 ? r0[j & 3] : r1[j & 3];
          const float kac = j < 4 ? ka0[j & 3] : ka1[j & 3], rkc = j < 4 ? rk0[j & 3] : rk1[j & 3];
          const float kn = kk[j] * inv, kd = sk[j] * (1.0f + (a - 1.0f) * kac), ipr = __builtin_amdgcn_rcpf(pr), rp = pr * __builtin_amdgcn_rcpf(P);
          at[j] = -kn * Pm * ipr; bt[j] = kn * a * rp; kt[j] = kd * rp; rt[j] = sr[j] * P * ipr; bon += sr[j] * kd * rkc; }
      bon += __shfl_xor(bon, 1); bon += __shfl_xor(bon, 2); bon += __shfl_xor(bon, 4);
      if (ch == 0 && c >= 4) F.BON[((size_t)d * ML + scan_row(b, d, c, tok)) * 16 + h] = bon;
      *(LAS u32x4*)(CB(CB_AT) + tok * CH_RS + ch * 16) = pack8x(f16, at);
      *(LAS u32x4*)(CB(CB_BT) + tok * CH_RS + ch * 16) = pack8x(f16, bt);
      *(LAS u32x4*)(CB(CB_KT) + tok * CH_RS + ch * 16) = pack8x(f16, kt);
      *(LAS u32x4*)(CB(CB_RT) + tok * CH_RS + ch * 16) = pack8x(f16, rt);
      *(LAS u32x4*)(CB(CB_X1) + tok * CH_RS + ch * 16) = pack8x(f16, sv); }
    LBAR(); TSTAMP(3);
    const bool chainw = wave == 0 || wave == 2 || wave == 3;
    if (!chainw && ci + 1 < 34) ch_load(F, R, b, h, d, c - 1);
    u32x4 t0 = {0u, 0u, 0u, 0u}, t1 = t0;
    if (chainw) { if (f16) chain_wave<true>(lds, wave, lane, t0, t1); else chain_wave<false>(lds, wave, lane, t0, t1); }
    else { const bool mid = wave >= 4 && wave <= 6;
#pragma unroll 1
      for (int i = 0; i < 2; ++i) { if (wave == 1 && i == 1) break;
          const int pr = wave == 1 ? 1 : wave == 7 ? 2 + i : wave - 3, jb = mid ? i : 0, tbk = mid ? 1 : 0;
          const LAS unsigned char* Aop = CB((pr & 1) ? CB_KT : CB_BT); const LAS unsigned char* Blay = CB(pr < 2 ? CB_AT : CB_RT);
          LAS unsigned char* Out = CB(CB_AAB + 1 + pr);
          f32x16 a = mm32(f16, Aop, jb * 32, Blay, tbk * 32, zero16(), l31, hi);
          if (jb == tbk) { const bool incl = pr >= 2;
#pragma unroll
              for (int r = 0; r < 16; ++r) { const int j = (r & 3) + 8 * (r >> 2) + 4 * hi; const bool ok = incl ? (j <= l31) : (j < l31); a[r] = ok ? a[r] : 0.f; } }
          st_nat(f16, Out, jb * 32, tbk * 32, a, l31, hi); }
      if (wave == 1) { st_nat(f16, CB(CB_AAK), 32, 0, zero16(), l31, hi); st_nat(f16, CB(CB_INV), 32, 0, zero16(), l31, hi); }
      if (wave == 7) { st_nat(f16, CB(CB_ARB), 32, 0, zero16(), l31, hi); st_nat(f16, CB(CB_ARK), 32, 0, zero16(), l31, hi); } }
    LBAR(); TSTAMP(4);
    if ((wave == 0 || wave == 3) && ci + 1 < 34) ch_load(F, R, b, h, d, c - 1);
    if (wave == 2) { const u32x4 u0 = *(const LAS u32x4*)(CB(CB_AAB) + lane * 16), u1 = *(const LAS u32x4*)(CB(CB_AAB) + 1024 + lane * 16);
        const f32x16 y = f16 ? mf2<true>(u0, u1, t0, t1, zero16()) : mf2<false>(u0, u1, t0, t1, zero16());
        st_nat(f16, CB(CB_INV), 0, 32, y, l31, hi);
        if (ci + 1 < 34) ch_load(F, R, b, h, d, c - 1); }
    else if (wave >= 4) { const f32x16 acc = mm32x<false, true>(f16, CB(CB_AAK), tb * 32, CB(CB_X1), cb * 32, zero16(), lane); st_nat(f16, CB(CB_XT), tb * 32, cb * 32, acc, l31, hi); }
    LBAR();
    TSTAMP(5);
    { f32x16 acc = wave < 4 ? mm32x<false, true>(f16, CB(CB_INV), tb * 32, CB(CB_AT), cb * 32, zero16(), lane) : mm32(f16, CB(CB_INV), tb * 32, CB(CB_XT), cb * 32, zero16(), l31, hi);
      st_nat(f16, CB(wave < 4 ? CB_AAB : CB_AABT), tb * 32, cb * 32, acc, l31, hi); }
    LBAR(); TSTAMP(6);
    { const int om = wave >> 1, nb = wave & 1;
      int c_ = c; asm volatile("" : "+s"(c_));
#pragma unroll
      for (int mb = 0; mb < 2; ++mb) {
          if (om == 0) {
              f32x16 acc; const LAS unsigned char* p = CB(CB_RT) + (nb * 32 + l31) * CH_RS + (mb * 32 + 4 * hi) * 2;
#pragma unroll
              for (int rg = 0; rg < 4; ++rg) { const u32x2 w = *(const LAS u32x2*)(p + rg * 16); const f32x4 u = unpack4x(f16, w); acc[4 * rg] = u.x; acc[4 * rg + 1] = u.y; acc[4 * rg + 2] = u.z; acc[4 * rg + 3] = u.w; }
              acc = mm32(f16, CB(CB_AAB), mb * 32, CB(CB_ARB), nb * 32, acc, l31, hi);
              LAS unsigned char* o = CB(CB_OQ) + (nb * 32 + l31) * CH_RS + (mb * 32 + 4 * hi) * 2;
#pragma unroll
              for (int rg = 0; rg < 4; ++rg) { const f32x4 pv = *(const LAS f32x4*)(pT + 64 + mb * 32 + 8 * rg + 4 * hi);
                  u32x2 w; w.x = pkh(acc[4 * rg] * pv.x, acc[4 * rg + 1] * pv.y); w.y = pkh(acc[4 * rg + 2] * pv.z, acc[4 * rg + 3] * pv.w); *(LAS u32x2*)(o + rg * 16) = w; }
          } else if (om == 1) {
              f32x16 acc = mm32x<false, true>(f16, CB(CB_AAB), mb * 32, CB(CB_BT), nb * 32, zero16(), lane);
              const float pto = pT[nb * 32 + l31], ptk = pT[128 + nb * 32 + l31];
              LAS unsigned char* o = CB(CB_OG) + (nb * 32 + l31) * CH_RS + (mb * 32 + 4 * hi) * 2;
#pragma unroll
              for (int rg = 0; rg < 4; ++rg) { const f32x4 pv = *(const LAS f32x4*)(pT + 64 + mb * 32 + 8 * rg + 4 * hi); float g[4];
#pragma unroll
                  for (int i = 0; i < 4; ++i) { const int kp = mb * 32 + 8 * rg + 4 * hi + i; g[i] = pto * pv[i] * acc[4 * rg + i] + (kp == nb * 32 + l31 ? ptk : 0.0f); }
                  u32x2 w; w.x = pkh(g[0], g[1]); w.y = pkh(g[2], g[3]); *(LAS u32x2*)(o + rg * 16) = w; }
          } else if (om == 2) {
              f32x16 acc = mm32x<true, false>(f16, CB(CB_BT), mb * 32, CB(CB_AABT), nb * 32, zero16(), lane);
              acc = mm32x<true, true>(f16, CB(CB_KT), mb * 32, CB(CB_X1), nb * 32, acc, lane);
              LAS unsigned char* o = CB(CB_OH) + (nb * 32 + l31) * CH_RS + (mb * 32 + 4 * hi) * 2;
#pragma unroll
              for (int rg = 0; rg < 4; ++rg) { const f32x4 pv = *(const LAS f32x4*)(pT + mb * 32 + 8 * rg + 4 * hi);
                  u32x2 w; w.x = pkh(acc[4 * rg] * pv.x, acc[4 * rg + 1] * pv.y); w.y = pkh(acc[4 * rg + 2] * pv.z, acc[4 * rg + 3] * pv.w); *(LAS u32x2*)(o + rg * 16) = w; }
          } else if (c_ >= 4) {
              f32x16 acc = mm32(f16, CB(CB_AABT), mb * 32, CB(CB_ARB), nb * 32, zero16(), l31, hi);
              acc = mm32x<true, false>(f16, CB(CB_X1), mb * 32, CB(CB_ARK), nb * 32, acc, lane);
              LAS unsigned char* yp = CB(CB_OY) + (nb * 32 + l31) * CH_RS + (mb * 32 + 4 * hi) * 2;
#pragma unroll
              for (int rg = 0; rg < 4; ++rg) { u32x2 w; w.x = pkh(acc[4 * rg], acc[4 * rg + 1]); w.y = pkh(acc[4 * rg + 2], acc[4 * rg + 3]); *(LAS u32x2*)(yp + rg * 16) = w; }
          }
      } }
    LBAR();
    { int c_ = c; asm volatile("" : "+s"(c_));
      unsigned char* gq = (unsigned char*)F.GHQ + ((size_t)chain * 68 + c_) * GHQ_ITEM + tok * 128 + ch * 16; const int lo = tok * CH_RS + ch * 16;
      *(u32x4*)gq = *(const LAS u32x4*)(CB(CB_OG) + lo); *(u32x4*)(gq + 8192) = *(const LAS u32x4*)(CB(CB_OH) + lo); *(u32x4*)(gq + 16384) = *(const LAS u32x4*)(CB(CB_OQ) + lo);
      if (c_ >= 4) *(u32x4*)((unsigned char*)(d ? F.YB : F.YF) + (size_t)scan_row(b, d, c_, tok) * 2048 + h * 128 + ch * 16) = *(const LAS u32x4*)(CB(CB_OY) + lo); }
    TSTAMP(7);
#undef CB
}

__device__ __forceinline__ void p3_chunkA(Frame& F) {
    const int tid = F.tid, lane = F.lane, wave = F.wave, l31 = lane & 31, hi = lane >> 5;
    LAS unsigned char* lds = F.lds;
#define CB(i) (lds + (i) * CH_MB)
    for (int g = F.bid; g < 256; g += F.G) {
        const int chain = g >> 1, c0 = (g & 1) * 34, d = chain & 1, h = (chain >> 1) & 15, b = chain >> 5;
        { const int q = tid >> 6, n = tid & 63, c = h * 64 + n;
          const float val = q == 0 ? F.mu_shift[C_R + c] : q == 1 ? F.mu_shift[C_K + c] : q == 2 ? F.mu_shift[C_V + c] : q == 3 ? F.mu_shift[C_LW + d * 64 + n] : q == 4 ? F.mu_shift[C_LA + d * 64 + n] : q == 5 ? F.k_k[c] : q == 6 ? F.k_a[c] : F.r_k[c];
          ((LAS float*)(lds + CH_CONST))[tid] = val; }
        const int q4 = wave & 3, tb = q4 >> 1, cb = q4 & 1;
        { const int row = tid >> 3, chk = tid & 7;
          *(LAS u32x4*)(lds + CH_LW + row * CH_RS + chk * 16) = *(const u32x4*)(F.W2T + ((size_t)d * 1024 + h * 64 + row) * 64 + 8 * chk);
          *(LAS u32x4*)(lds + CH_LW + CH_MB + row * CH_RS + chk * 16) = *(const u32x4*)(F.A2T + ((size_t)d * 1024 + h * 64 + row) * 64 + 8 * chk); }
        const float lbias = (wave < 4 ? F.w0 : F.a0)[d * 1024 + h * 64 + cb * 32 + l31];
        LBAR();
        ChRegs R;
        ch_load(F, R, b, h, d, c0 + 33);
#pragma unroll 1
        for (int ci = 0; ci < 34; ++ci) {
            const int c = c0 + 33 - ci;
            const int tok = tid >> 3, ch = tid & 7;
            const LAS f32x4* cs = (const LAS f32x4*)(lds + CH_CONST) + 2 * ch;
            float sr[8], sk[8], sv[8];
            ch_park(F, R, b, d, c);
            LBAR();
            { float slw[8], sla[8];
              const int ri = 1 + scan_row(b, d, c, tok) - chunk_mlo(b, d, c);
              const LAS unsigned char* p3 = lds + CH_RAW3 + ri * 384 + ch * 16; const LAS unsigned char* pl = lds + CH_RAWL + ri * 256 + ch * 16;
              shift8(R.r, *(const LAS u32x4*)(p3 - 384), *(const LAS u32x4*)(p3 + 384), cs, sr); shift8(R.k, *(const LAS u32x4*)(p3 - 384 + 128), *(const LAS u32x4*)(p3 + 384 + 128), cs + 16, sk);
              shift8(R.v, *(const LAS u32x4*)(p3 - 384 + 256), *(const LAS u32x4*)(p3 + 384 + 256), cs + 32, sv);
              shift8(R.lw, *(const LAS u32x4*)(pl - 256), *(const LAS u32x4*)(pl + 256), cs + 48, slw); shift8(R.la, *(const LAS u32x4*)(pl - 256 + 128), *(const LAS u32x4*)(pl + 256 + 128), cs + 64, sla);
#pragma unroll
              for (int j = 0; j < 8; ++j) slw[j] = 1.0f - 2.0f * __builtin_amdgcn_rcpf(1.0f + fast_exp(2.0f * slw[j]));
              u32x4 o; o.x = pk2(slw[0], slw[1]); o.y = pk2(slw[2], slw[3]); o.z = pk2(slw[4], slw[5]); o.w = pk2(slw[6], slw[7]); *(LAS u32x4*)(CB(CB_X1) + tok * CH_RS + ch * 16) = o;
              o.x = pk2(sla[0], sla[1]); o.y = pk2(sla[2], sla[3]); o.z = pk2(sla[4], sla[5]); o.w = pk2(sla[6], sla[7]); *(LAS u32x4*)(CB(CB_XT) + tok * CH_RS + ch * 16) = o; }
            LBAR(); TSTAMP(0);
            { f32x16 acc = zero16();
              const LAS unsigned char* pa = CB(wave < 4 ? CB_X1 : CB_XT) + (tb * 32 + l31) * CH_RS + hi * 16;
              const LAS unsigned char* pw2 = lds + CH_LW + (wave < 4 ? 0 : CH_MB) + (cb * 32 + l31) * CH_RS + hi * 16;
#pragma unroll
              for (int ks = 0; ks < 4; ++ks) acc = __builtin_amdgcn_mfma_f32_32x32x16_bf16(*(const LAS bf16x8*)(pa + ks * 32), *(const LAS bf16x8*)(pw2 + ks * 32), acc, 0, 0, 0);
              LAS float* dst = (LAS float*)(lds + (wave < 4 ? CH_WBUF : CH_ABUF)) + cb * 32 + l31;
#pragma unroll
              for (int r = 0; r < 16; ++r) { const int t = tb * 32 + (r & 3) + 8 * (r >> 2) + 4 * hi; const float sg = sigmoidf_(acc[r] + lbias);
                  dst[t * 64] = wave < 4 ? fast_exp(-0.6065306597126334f * sg) : sg; } }
            LBAR(); TSTAMP(1);
            { LAS float* wb = (LAS float*)(lds + CH_WBUF) + (wave * 8) * 64 + (tid & 63); LAS float* gt = (LAS float*)(lds + CH_GT);
              float q[8]; q[0] = wb[0];
#pragma unroll
              for (int i = 1; i < 8; ++i) q[i] = q[i - 1] * wb[i * 64];
              gt[wave * 64 + (tid & 63)] = q[7];
              LBAR();
              float pre = 1.0f, p31 = 1.0f;
#pragma unroll
              for (int gg = 0; gg < 7; ++gg) { const float tv = gt[gg * 64 + (tid & 63)]; pre = gg < wave ? pre * tv : pre; p31 = gg < 4 ? p31 * tv : p31; }
#pragma unroll
              for (int i = 0; i < 8; ++i) wb[i * 64] = pre * q[i];
              if (wave == 7) { const float p63 = pre * q[7]; LAS float* pt = (LAS float*)(lds + CH_PT);
                  pt[tid & 63] = p63 / p31;
                  pt[64 + (tid & 63)] = p31;
                  pt[128 + (tid & 63)] = p63;
                  const bool ok = !FORCE_BF16 && p31 > 2.44140625e-4f && p63 > 2.44140625e-4f * p31;
                  if ((tid & 63) == 0) ((LAS unsigned*)pt)[192] = __all(ok) ? 1u : 0u; else (void)__all(ok); } }
            LBAR(); TSTAMP(2);
            { const bool f16 = __builtin_amdgcn_readfirstlane((int)((const LAS unsigned*)(lds + CH_PT))[192]) != 0;
              ch_tail(f16, F, R, sr, sk, sv, b, h, d, c, chain, ci); }
        }
    }
#undef CB
}

constexpr int BL_SLOT = 2 * CH_MB, BL_SLOTB = 4 * CH_MB, BL_YB = BL_SLOT + 2 * BL_SLOTB;
__device__ __forceinline__ void p4_chunkB(Frame& F) {
    const int lane = F.lane, wave = F.wave, l31 = lane & 31, hi = lane >> 5, srow = F.tid >> 3, sch = F.tid & 7;
    LAS unsigned char* lds = F.lds;
    for (int chain = F.bid; chain < 128; chain += F.G) {
        const int d = chain & 1, h = (chain >> 1) & 15, b = chain >> 5;
        const int q4 = wave & 3, mb = q4 >> 1, nb = q4 & 1;
        for (int i = F.tid; i < 2 * CH_MB / 4; i += NWAVES * 64) ((LAS unsigned*)lds)[i] = 0u;
        const unsigned char* gq0 = (const unsigned char*)F.GHQ + (size_t)chain * 68 * GHQ_ITEM;
        unsigned char* Yb = (unsigned char*)(d ? F.YB : F.YF) + h * 128;
        u32x4 Ra0, Ra1, Ra2, Ra3, Rb0, Rb1, Rb2, Rb3;
        { int c__ = (0); c__ = c__ < 67 ? c__ : 67; const unsigned char* gq = gq0 + (size_t)c__ * GHQ_ITEM + srow * 128 + sch * 16; const int cy = c__ < 4 ? 4 : c__;
              Ra0 = *(const u32x4*)gq; Ra1 = *(const u32x4*)(gq + 8192); Ra2 = *(const u32x4*)(gq + 16384);
              Ra3 = *(const u32x4*)(Yb + (size_t)scan_row(b, d, cy, srow) * 2048 + sch * 16); }
        { LAS unsigned char* sn = lds + BL_SLOT + srow * CH_RS + sch * 16; *(LAS u32x4*)sn = Ra0; *(LAS u32x4*)(sn + CH_MB) = Ra1; *(LAS u32x4*)(sn + 2 * CH_MB) = Ra2; *(LAS u32x4*)(sn + 3 * CH_MB) = Ra3; }
        { int c__ = (1); c__ = c__ < 67 ? c__ : 67; const unsigned char* gq = gq0 + (size_t)c__ * GHQ_ITEM + srow * 128 + sch * 16; const int cy = c__ < 4 ? 4 : c__;
              Ra0 = *(const u32x4*)gq; Ra1 = *(const u32x4*)(gq + 8192); Ra2 = *(const u32x4*)(gq + 16384);
              Ra3 = *(const u32x4*)(Yb + (size_t)scan_row(b, d, cy, srow) * 2048 + sch * 16); }
        { int c__ = (2); c__ = c__ < 67 ? c__ : 67; const unsigned char* gq = gq0 + (size_t)c__ * GHQ_ITEM + srow * 128 + sch * 16; const int cy = c__ < 4 ? 4 : c__;
              Rb0 = *(const u32x4*)gq; Rb1 = *(const u32x4*)(gq + 8192); Rb2 = *(const u32x4*)(gq + 16384);
              Rb3 = *(const u32x4*)(Yb + (size_t)scan_row(b, d, cy, srow) * 2048 + sch * 16); }
        LBAR();
#pragma unroll 1
        for (int c = 0; c < 68; c += 4) {
            { const int c_ = (c);
              LAS unsigned char* sn = lds + BL_SLOT + ((c_ + 1) & 1) * BL_SLOTB + srow * CH_RS + sch * 16;
              *(LAS u32x4*)sn = Ra0; *(LAS u32x4*)(sn + CH_MB) = Ra1; *(LAS u32x4*)(sn + 2 * CH_MB) = Ra2; *(LAS u32x4*)(sn + 3 * CH_MB) = Ra3;
              { int c__ = (c_ + 3); c__ = c__ < 67 ? c__ : 67; const unsigned char* gq = gq0 + (size_t)c__ * GHQ_ITEM + srow * 128 + sch * 16; const int cy = c__ < 4 ? 4 : c__;
              Ra0 = *(const u32x4*)gq; Ra1 = *(const u32x4*)(gq + 8192); Ra2 = *(const u32x4*)(gq + 16384);
              Ra3 = *(const u32x4*)(Yb + (size_t)scan_row(b, d, cy, srow) * 2048 + sch * 16); }
              if (c_ >= 5) { const u32x4 yv = *(const LAS u32x4*)(lds + BL_YB + ((c_ - 1) & 1) * CH_MB + srow * CH_RS + sch * 16);
                  *(u32x4*)(Yb + (size_t)scan_row(b, d, c_ - 1, srow) * 2048 + sch * 16) = yv; }
              const LAS unsigned char* sc = lds + BL_SLOT + (c_ & 1) * BL_SLOTB; const LAS unsigned char* zc = lds + (c_ & 1) * CH_MB; LAS unsigned char* zn = lds + ((c_ + 1) & 1) * CH_MB;
              if (wave < 4) {
                  f32x16 acc; const LAS unsigned char* ph = sc + CH_MB + (nb * 32 + l31) * CH_RS + (mb * 32 + 4 * hi) * 2;
#pragma unroll
                  for (int rg = 0; rg < 4; ++rg) { const u32x2 w = *(const LAS u32x2*)(ph + rg * 16); acc[4 * rg] = h_lo(w.x); acc[4 * rg + 1] = h_hi(w.x); acc[4 * rg + 2] = h_lo(w.y); acc[4 * rg + 3] = h_hi(w.y); }
                  acc = mm32(true, sc, mb * 32, zc, nb * 32, acc, l31, hi);
                  st_nat(true, zn, mb * 32, nb * 32, acc, l31, hi);
              } else if (c_ >= 4) {
                  f32x16 acc; const LAS unsigned char* py = sc + 3 * CH_MB + (nb * 32 + l31) * CH_RS + (mb * 32 + 4 * hi) * 2;
#pragma unroll
                  for (int rg = 0; rg < 4; ++rg) { const u32x2 w = *(const LAS u32x2*)(py + rg * 16); acc[4 * rg] = h_lo(w.x); acc[4 * rg + 1] = h_hi(w.x); acc[4 * rg + 2] = h_lo(w.y); acc[4 * rg + 3] = h_hi(w.y); }
                  acc = mm32(true, zc, mb * 32, sc + 2 * CH_MB, nb * 32, acc, l31, hi);
                  st_nat(true, lds + BL_YB + (c_ & 1) * CH_MB, mb * 32, nb * 32, acc, l31, hi);
              }
              LBAR(); }
            { const int c_ = (c + 1);
              LAS unsigned char* sn = lds + BL_SLOT + ((c_ + 1) & 1) * BL_SLOTB + srow * CH_RS + sch * 16;
              *(LAS u32x4*)sn = Rb0; *(LAS u32x4*)(sn + CH_MB) = Rb1; *(LAS u32x4*)(sn + 2 * CH_MB) = Rb2; *(LAS u32x4*)(sn + 3 * CH_MB) = Rb3;
              { int c__ = (c_ + 3); c__ = c__ < 67 ? c__ : 67; const unsigned char* gq = gq0 + (size_t)c__ * GHQ_ITEM + srow * 128 + sch * 16; const int cy = c__ < 4 ? 4 : c__;
              Rb0 = *(const u32x4*)gq; Rb1 = *(const u32x4*)(gq + 8192); Rb2 = *(const u32x4*)(gq + 16384);
              Rb3 = *(const u32x4*)(Yb + (size_t)scan_row(b, d, cy, srow) * 2048 + sch * 16); }
              if (c_ >= 5) { const u32x4 yv = *(const LAS u32x4*)(lds + BL_YB + ((c_ - 1) & 1) * CH_MB + srow * CH_RS + sch * 16);
                  *(u32x4*)(Yb + (size_t)scan_row(b, d, c_ - 1, srow) * 2048 + sch * 16) = yv; }
              const LAS unsigned char* sc = lds + BL_SLOT + (c_ & 1) * BL_SLOTB; const LAS unsigned char* zc = lds + (c_ & 1) * CH_MB; LAS unsigned char* zn = lds + ((c_ + 1) & 1) * CH_MB;
              if (wave < 4) {
                  f32x16 acc; const LAS unsigned char* ph = sc + CH_MB + (nb * 32 + l31) * CH_RS + (mb * 32 + 4 * hi) * 2;
#pragma unroll
                  for (int rg = 0; rg < 4; ++rg) { const u32x2 w = *(const LAS u32x2*)(ph + rg * 16); acc[4 * rg] = h_lo(w.x); acc[4 * rg + 1] = h_hi(w.x); acc[4 * rg + 2] = h_lo(w.y); acc[4 * rg + 3] = h_hi(w.y); }
                  acc = mm32(true, sc, mb * 32, zc, nb * 32, acc, l31, hi);
                  st_nat(true, zn, mb * 32, nb * 32, acc, l31, hi);
              } else if (c_ >= 4) {
                  f32x16 acc; const LAS unsigned char* py = sc + 3 * CH_MB + (nb * 32 + l31) * CH_RS + (mb * 32 + 4 * hi) * 2;
#pragma unroll
                  for (int rg = 0; rg < 4; ++rg) { const u32x2 w = *(const LAS u32x2*)(py + rg * 16); acc[4 * rg] = h_lo(w.x); acc[4 * rg + 1] = h_hi(w.x); acc[4 * rg + 2] = h_lo(w.y); acc[4 * rg + 3] = h_hi(w.y); }
                  acc = mm32(true, zc, mb * 32, sc + 2 * CH_MB, nb * 32, acc, l31, hi);
                  st_nat(true, lds + BL_YB + (c_ & 1) * CH_MB, mb * 32, nb * 32, acc, l31, hi);
              }
              LBAR(); }
            { const int c_ = (c + 2);
              LAS unsigned char* sn = lds + BL_SLOT + ((c_ + 1) & 1) * BL_SLOTB + srow * CH_RS + sch * 16;
              *(LAS u32x4*)sn = Ra0; *(LAS u32x4*)(sn + CH_MB) = Ra1; *(LAS u32x4*)(sn + 2 * CH_MB) = Ra2; *(LAS u32x4*)(sn + 3 * CH_MB) = Ra3;
              { int c__ = (c_ + 3); c__ = c__ < 67 ? c__ : 67; const unsigned char* gq = gq0 + (size_t)c__ * GHQ_ITEM + srow * 128 + sch * 16; const int cy = c__ < 4 ? 4 : c__;
              Ra0 = *(const u32x4*)gq; Ra1 = *(const u32x4*)(gq + 8192); Ra2 = *(const u32x4*)(gq + 16384);
              Ra3 = *(const u32x4*)(Yb + (size_t)scan_row(b, d, cy, srow) * 2048 + sch * 16); }
              if (c_ >= 5) { const u32x4 yv = *(const LAS u32x4*)(lds + BL_YB + ((c_ - 1) & 1) * CH_MB + srow * CH_RS + sch * 16);
                  *(u32x4*)(Yb + (size_t)scan_row(b, d, c_ - 1, srow) * 2048 + sch * 16) = yv; }
              const LAS unsigned char* sc = lds + BL_SLOT + (c_ & 1) * BL_SLOTB; const LAS unsigned char* zc = lds + (c_ & 1) * CH_MB; LAS unsigned char* zn = lds + ((c_ + 1) & 1) * CH_MB;
              if (wave < 4) {
                  f32x16 acc; const LAS unsigned char* ph = sc + CH_MB + (nb * 32 + l31) * CH_RS + (mb * 32 + 4 * hi) * 2;
#pragma unroll
                  for (int rg = 0; rg < 4; ++rg) { const u32x2 w = *(const LAS u32x2*)(ph + rg * 16); acc[4 * rg] = h_lo(w.x); acc[4 * rg + 1] = h_hi(w.x); acc[4 * rg + 2] = h_lo(w.y); acc[4 * rg + 3] = h_hi(w.y); }
                  acc = mm32(true, sc, mb * 32, zc, nb * 32, acc, l31, hi);
                  st_nat(true, zn, mb * 32, nb * 32, acc, l31, hi);
              } else if (c_ >= 4) {
                  f32x16 acc; const LAS unsigned char* py = sc + 3 * CH_MB + (nb * 32 + l31) * CH_RS + (mb * 32 + 4 * hi) * 2;
#pragma unroll
                  for (int rg = 0; rg < 4; ++rg) { const u32x2 w = *(const LAS u32x2*)(py + rg * 16); acc[4 * rg] = h_lo(w.x); acc[4 * rg + 1] = h_hi(w.x); acc[4 * rg + 2] = h_lo(w.y); acc[4 * rg + 3] = h_hi(w.y); }
                  acc = mm32(true, zc, mb * 32, sc + 2 * CH_MB, nb * 32, acc, l31, hi);
                  st_nat(true, lds + BL_YB + (c_ & 1) * CH_MB, mb * 32, nb * 32, acc, l31, hi);
              }
              LBAR(); }
            { const int c_ = (c + 3);
              LAS unsigned char* sn = lds + BL_SLOT + ((c_ + 1) & 1) * BL_SLOTB + srow * CH_RS + sch * 16;
              *(LAS u32x4*)sn = Rb0; *(LAS u32x4*)(sn + CH_MB) = Rb1; *(LAS u32x4*)(sn + 2 * CH_MB) = Rb2; *(LAS u32x4*)(sn + 3 * CH_MB) = Rb3;
              { int c__ = (c_ + 3); c__ = c__ < 67 ? c__ : 67; const unsigned char* gq = gq0 + (size_t)c__ * GHQ_ITEM + srow * 128 + sch * 16; const int cy = c__ < 4 ? 4 : c__;
              Rb0 = *(const u32x4*)gq; Rb1 = *(const u32x4*)(gq + 8192); Rb2 = *(const u32x4*)(gq + 16384);
              Rb3 = *(const u32x4*)(Yb + (size_t)scan_row(b, d, cy, srow) * 2048 + sch * 16); }
              if (c_ >= 5) { const u32x4 yv = *(const LAS u32x4*)(lds + BL_YB + ((c_ - 1) & 1) * CH_MB + srow * CH_RS + sch * 16);
                  *(u32x4*)(Yb + (size_t)scan_row(b, d, c_ - 1, srow) * 2048 + sch * 16) = yv; }
              const LAS unsigned char* sc = lds + BL_SLOT + (c_ & 1) * BL_SLOTB; const LAS unsigned char* zc = lds + (c_ & 1) * CH_MB; LAS unsigned char* zn = lds + ((c_ + 1) & 1) * CH_MB;
              if (wave < 4) {
                  f32x16 acc; const LAS unsigned char* ph = sc + CH_MB + (nb * 32 + l31) * CH_RS + (mb * 32 + 4 * hi) * 2;
#pragma unroll
                  for (int rg = 0; rg < 4; ++rg) { const u32x2 w = *(const LAS u32x2*)(ph + rg * 16); acc[4 * rg] = h_lo(w.x); acc[4 * rg + 1] = h_hi(w.x); acc[4 * rg + 2] = h_lo(w.y); acc[4 * rg + 3] = h_hi(w.y); }
                  acc = mm32(true, sc, mb * 32, zc, nb * 32, acc, l31, hi);
                  st_nat(true, zn, mb * 32, nb * 32, acc, l31, hi);
              } else if (c_ >= 4) {
                  f32x16 acc; const LAS unsigned char* py = sc + 3 * CH_MB + (nb * 32 + l31) * CH_RS + (mb * 32 + 4 * hi) * 2;
#pragma unroll
                  for (int rg = 0; rg < 4; ++rg) { const u32x2 w = *(const LAS u32x2*)(py + rg * 16); acc[4 * rg] = h_lo(w.x); acc[4 * rg + 1] = h_hi(w.x); acc[4 * rg + 2] = h_lo(w.y); acc[4 * rg + 3] = h_hi(w.y); }
                  acc = mm32(true, zc, mb * 32, sc + 2 * CH_MB, nb * 32, acc, l31, hi);
                  st_nat(true, lds + BL_YB + (c_ & 1) * CH_MB, mb * 32, nb * 32, acc, l31, hi);
              }
              LBAR(); }
        }
        { const u32x4 yv = *(const LAS u32x4*)(lds + BL_YB + CH_MB + srow * CH_RS + sch * 16); *(u32x4*)(Yb + (size_t)scan_row(b, d, 67, srow) * 2048 + sch * 16) = yv; }
        LBAR();
    }
}

constexpr int AT_K = 0, AT_V = 16384, AT_BUF = 16384 + 64 * 272;
struct KVRegs { u32x4 k1, k2, v0, v1; };
__device__ __forceinline__ void at_load(Frame& F, KVRegs& R, int mrow0, int kvh) {
    const int tid = F.tid;
    { const int key = tid >> 2, q4 = tid & 3, a = q4 >> 1, e = q4 & 1;
      const bf16* p = F.P + (size_t)(mrow0 + key) * NIN + C_KA + kvh * 64 + a * 32 + 8 * e; R.k1 = *(const u32x4*)p; R.k2 = *(const u32x4*)(p + 16); }
    { const int kp = tid >> 3, dc = tid & 7; const bf16* p = F.P + (size_t)(mrow0 + 2 * kp) * NIN + C_VA + kvh * 64 + 8 * dc; R.v0 = *(const u32x4*)p; R.v1 = *(const u32x4*)(p + NIN); }
}
__device__ __forceinline__ void qkprep_one(Frame& F, bf16* p, int a, int e, int kpos, bool rope, const float* gain, float scale) {
    float x1[8], x2[8]; unpack8(*(const u32x4*)p, x1); unpack8(*(const u32x4*)(p + 16), x2);
    float ss = 0.f;
#pragma unroll
    for (int j = 0; j < 8; ++j) ss += x1[j] * x1[j] + x2[j] * x2[j];
    ss += __shfl_xor(ss, 1); ss += __shfl_xor(ss, 2);
    const float rr = scale / sqrtf(ss * (1.0f / 64.0f) + 1e-6f);
    const int pos = a == 0 ? (kpos >> 6) : (kpos & 63);
#pragma unroll
    for (int j = 0; j < 8; ++j) { float y1 = x1[j] * rr * gain[a * 32 + 8 * e + j], y2 = x2[j] * rr * gain[a * 32 + 16 + 8 * e + j];
        if (rope) { const float c = F.ROPE[pos * 16 + 8 * e + j], sn = F.ROPE[1024 + pos * 16 + 8 * e + j]; const float t1 = y1 * c - y2 * sn, t2 = y2 * c + y1 * sn; y1 = t1; y2 = t2; }
        x1[j] = y1; x2[j] = y2; }
    u32x4 o; o.x = pk2(x1[0], x1[1]); o.y = pk2(x1[2], x1[3]); o.z = pk2(x1[4], x1[5]); o.w = pk2(x1[6], x1[7]); *(u32x4*)p = o;
    o.x = pk2(x2[0], x2[1]); o.y = pk2(x2[2], x2[3]); o.z = pk2(x2[4], x2[5]); o.w = pk2(x2[6], x2[7]); *(u32x4*)(p + 16) = o;
}
__device__ __forceinline__ void kprep(Frame& F) {
    const int total = F.G * NWAVES * 64;
    for (int idx = F.bid * NWAVES * 64 + F.tid; idx < MT * 16; idx += total) {
        const int q4 = idx & 3, kvh = (idx >> 2) & 3, m = idx >> 4, a = q4 >> 1, e = q4 & 1;
        qkprep_one(F, F.P + (size_t)m * NIN + C_KA + kvh * 64 + a * 32 + 8 * e, a, e, m & (SEQ - 1), m < ML, F.kng, 1.0f);
    }
}
__device__ __forceinline__ void at_write(Frame& F, const KVRegs& R, LAS unsigned char* buf) {
    const int tid = F.tid;
    { const int key = tid >> 2, q4 = tid & 3, a = q4 >> 1, e = q4 & 1;
      const int c1 = 4 * a + e, c2 = c1 + 2, sw = (key >> 1) & 7;
      *(LAS u32x4*)(buf + AT_K + key * 128 + ((c1 ^ sw) << 4)) = R.k1; *(LAS u32x4*)(buf + AT_K + key * 128 + ((c2 ^ sw) << 4)) = R.k2; }
    { const int kp = tid >> 3, dc = tid & 7, kq = kp >> 1;
        const int pos0 = (kq >> 2) * 16 + (kq & 1) * 8 + ((kq >> 1) & 1) * 4 + (kp & 1) * 2;
#pragma unroll
        for (int w = 0; w < 4; ++w) {
            const unsigned a0 = R.v0[w], a1 = R.v1[w];
            *(LAS unsigned*)(buf + AT_V + (8 * dc + 2 * w) * 272 + pos0 * 2) = __builtin_amdgcn_perm(a1, a0, 0x05040100u);
            *(LAS unsigned*)(buf + AT_V + (8 * dc + 2 * w + 1) * 272 + pos0 * 2) = __builtin_amdgcn_perm(a1, a0, 0x07060302u); }
    }
}
#ifndef ATTN_POOL
#define ATTN_POOL 0
#endif
#ifndef ATTN_BOUND
#define ATTN_BOUND 60.0f
#endif
template<bool NOMAX> __device__ __forceinline__ void p4_attn_t(Frame& F, int item) {
    const int n = item & 31, kvh = (item >> 5) & 3, b = item >> 7;
    const int lane = F.lane, wave = F.wave, l31 = lane & 31, hi = lane >> 5;
    const int hh = kvh * 4 + (wave >> 1), qloc = (wave & 1) * 64;
    LAS unsigned char* lds = F.lds;
    const int kfirst = n > 0 ? 0 : 1, nbnd = 3 - (n == 0 ? 1 : 0) - (n == 31 ? 1 : 0), nt = nbnd + 2;
#define TL_KIND(t) ((t) < nbnd ? kfirst + (t) : 3)
#define TL_ROW(t) ((t) < nbnd ? b * SEQ + (n - 1 + kfirst + (t)) * 128 : ML + b * CTXL + ((t) - nbnd) * 128)
#define TL_KPOS(t) ((t) < nbnd ? (n - 1 + kfirst + (t)) * 128 : 0)
    if (DBG_FINE) TSTART();
    KVRegs R;
    at_load(F, R, TL_ROW(0), kvh);
    LAS unsigned char* qbase = lds + 2 * AT_BUF + wave * 8192;
    LAS unsigned char* qlds = qbase + lane * 16;
    { const int rowl = lane >> 2, q4 = lane & 3, a = q4 >> 1, e = q4 & 1;
      const bf16* src = F.P + (size_t)(b * SEQ + n * 128 + qloc + rowl) * NIN + C_Q + hh * 64 + a * 32 + 8 * e;
      u32x4 r1[4], r2[4];
#pragma unroll
      for (int ps = 0; ps < 4; ++ps) { r1[ps] = *(const u32x4*)(src + (size_t)(16 * ps) * NIN); r2[ps] = *(const u32x4*)(src + (size_t)(16 * ps) * NIN + 16); }
      float g1[8], g2[8];
      { const f32x4 a0 = *(const f32x4*)(F.qng + a * 32 + 8 * e), a1 = *(const f32x4*)(F.qng + a * 32 + 8 * e + 4), b0 = *(const f32x4*)(F.qng + a * 32 + 16 + 8 * e), b1 = *(const f32x4*)(F.qng + a * 32 + 16 + 8 * e + 4);
#pragma unroll
        for (int j = 0; j < 4; ++j) { g1[j] = a0[j]; g1[4 + j] = a1[j]; g2[j] = b0[j]; g2[4 + j] = b1[j]; } }
#pragma unroll
      for (int ps = 0; ps < 4; ++ps) {
          const int r = 16 * ps + rowl, query = n * 128 + qloc + r, pos = a == 0 ? (query >> 6) : (query & 63);
          const f32x4 c0 = *(const f32x4*)(F.ROPE + pos * 16 + 8 * e), c1 = *(const f32x4*)(F.ROPE + pos * 16 + 8 * e + 4), s0 = *(const f32x4*)(F.ROPE + 1024 + pos * 16 + 8 * e), s1 = *(const f32x4*)(F.ROPE + 1024 + pos * 16 + 8 * e + 4);
          float x1[8], x2[8]; unpack8(r1[ps], x1); unpack8(r2[ps], x2);
          float ss = 0.f;
#pragma unroll
          for (int j = 0; j < 8; ++j) ss += x1[j] * x1[j] + x2[j] * x2[j];
          ss += __shfl_xor(ss, 1); ss += __shfl_xor(ss, 2);
          const float rr = (0.125f * LOG2E) / sqrtf(ss * (1.0f / 64.0f) + 1e-6f);
#pragma unroll
          for (int j = 0; j < 8; ++j) { const float y1 = x1[j] * rr * g1[j], y2 = x2[j] * rr * g2[j], cc = j < 4 ? c0[j & 3] : c1[j & 3], sn = j < 4 ? s0[j & 3] : s1[j & 3];
              x1[j] = y1 * cc - y2 * sn; x2[j] = y2 * cc + y1 * sn; }
          LAS unsigned char* dst = qbase + ((r >> 5) * 4 + 2 * a) * 1024 + (e * 32 + (r & 31)) * 16;
          u32x4 o; o.x = pk2(x1[0], x1[1]); o.y = pk2(x1[2], x1[3]); o.z = pk2(x1[4], x1[5]); o.w = pk2(x1[6], x1[7]); *(LAS u32x4*)dst = o;
          o.x = pk2(x2[0], x2[1]); o.y = pk2(x2[2], x2[3]); o.z = pk2(x2[4], x2[5]); o.w = pk2(x2[6], x2[7]); *(LAS u32x4*)(dst + 1024) = o;
      } }
    at_write(F, R, lds);
    LBAR(); TSTAMP(26);
    float mrun[2] = {NOMAX ? 0.f : -1e30f, NOMAX ? 0.f : -1e30f}, lrun[2] = {0.f, 0.f};
    f32x16 ot[2][2];
#pragma unroll
    for (int qb = 0; qb < 2; ++qb)
#pragma unroll
        for (int db = 0; db < 2; ++db)
#pragma unroll
            for (int r = 0; r < 16; ++r) ot[qb][db][r] = 0.f;
#pragma unroll 1
    for (int t = 0; t < nt; ++t) {
        LAS unsigned char* buf = lds + (t & 1) * AT_BUF;
        if (t + 1 < nt) at_load(F, R, TL_ROW(t + 1), kvh);
        const int kind = TL_KIND(t);
#pragma unroll 1
        for (int st = 0; st < 4; ++st) {
            int s0 = 1, s1 = 1;
            { const int dq0 = qloc >> 5, dq1 = dq0 + 1;
              if (kind == 0) { s0 = st < dq0 ? 0 : (st == dq0 ? 2 : 1); s1 = st < dq1 ? 0 : (st == dq1 ? 2 : 1); }
              else if (kind == 2) { s0 = st > dq0 ? 0 : (st == dq0 ? 2 : 1); s1 = st > dq1 ? 0 : (st == dq1 ? 2 : 1); } }
            if ((s0 | s1) == 0) continue;
            bf16x8 kf[4];
#pragma unroll
            for (int ks = 0; ks < 4; ++ks) { const int key = st * 32 + l31, ch = 2 * ks + hi; kf[ks] = *(const LAS bf16x8*)(buf + AT_K + key * 128 + ((ch ^ ((key >> 1) & 7)) << 4)); }
            f32x16 sc0 = {0.f, 0.f, 0.f, 0.f, 0.f, 0.f, 0.f, 0.f, 0.f, 0.f, 0.f, 0.f, 0.f, 0.f, 0.f, 0.f}, sc1 = sc0;
            { bf16x8 qf[4];
              if (s0) {
#pragma unroll
                  for (int ks = 0; ks < 4; ++ks) qf[ks] = *(const LAS bf16x8*)(qlds + ks * 1024);
#pragma unroll
                  for (int ks = 0; ks < 4; ++ks) sc0 = __builtin_amdgcn_mfma_f32_32x32x16_bf16(kf[ks], qf[ks], sc0, 0, 0, 0); }
              if (s1) {
#pragma unroll
                  for (int ks = 0; ks < 4; ++ks) qf[ks] = *(const LAS bf16x8*)(qlds + (4 + ks) * 1024);
#pragma unroll
                  for (int ks = 0; ks < 4; ++ks) sc1 = __builtin_amdgcn_mfma_f32_32x32x16_bf16(kf[ks], qf[ks], sc1, 0, 0, 0); } }
            bf16x8 vf[2][2];
#pragma unroll
            for (int db = 0; db < 2; ++db)
#pragma unroll
                for (int s = 0; s < 2; ++s) vf[db][s] = *(const LAS bf16x8*)(buf + AT_V + (db * 32 + l31) * 272 + ((st * 2 + s) * 16 + hi * 8) * 2);
#define AT_SOFTMAX(SC, QB, PF, DIAG) do { \
                const int qq = qloc + (QB) * 32 + l31; \
                if (DIAG) { const int th = qq - st * 32 - 4 * hi;        \
                    if (kind == 0) { _Pragma("unroll") for (int r = 0; r < 16; ++r) SC[r] = ((r & 3) + 8 * (r >> 2) >= th) ? SC[r] : -__builtin_inff(); } \
                    else { _Pragma("unroll") for (int r = 0; r < 16; ++r) SC[r] = ((r & 3) + 8 * (r >> 2) <= th) ? SC[r] : -__builtin_inff(); } } \
                if (!NOMAX) { \
                    float tm = SC[0]; \
                    _Pragma("unroll") for (int r = 1; r < 16; ++r) tm = fmaxf(tm, SC[r]); \
                    tm = fmaxf(tm, __shfl_xor(tm, 32)); \
                    if (__any(tm > mrun[QB] + 6.0f)) { \
                        const float mn = fmaxf(mrun[QB], tm), al = __builtin_amdgcn_exp2f(mrun[QB] - mn); \
                        mrun[QB] = mn; lrun[QB] *= al; \
                        _Pragma("unroll") for (int db = 0; db < 2; ++db) _Pragma("unroll") for (int r = 0; r < 16; ++r) ot[QB][db][r] *= al; } \
                    const float mm = mrun[QB]; \
                    _Pragma("unroll") for (int r = 0; r < 16; ++r) SC[r] -= mm; } \
                f32x2_t ps2 = {0.f, 0.f}; \
                _Pragma("unroll") for (int r = 0; r < 16; r += 2) { SC[r] = __builtin_amdgcn_exp2f(SC[r]); SC[r + 1] = __builtin_amdgcn_exp2f(SC[r + 1]); f32x2_t e2; e2.x = SC[r]; e2.y = SC[r + 1]; ps2 += e2; } \
                lrun[QB] += ps2.x + ps2.y; \
                _Pragma("unroll") for (int s = 0; s < 2; ++s) { u32x4 o; o.x = pk2(SC[8 * s], SC[8 * s + 1]); o.y = pk2(SC[8 * s + 2], SC[8 * s + 3]); o.z = pk2(SC[8 * s + 4], SC[8 * s + 5]); o.w = pk2(SC[8 * s + 6], SC[8 * s + 7]); PF[s] = __builtin_bit_cast(bf16x8, o); } \
            } while (0)
            bf16x8 pf0[2] = {kf[0], kf[0]}, pf1[2] = {kf[0], kf[0]};
            __builtin_amdgcn_sched_barrier(0);
            if (s0) AT_SOFTMAX(sc0, 0, pf0, s0 == 2);
            __builtin_amdgcn_sched_barrier(0);
            if (s1) AT_SOFTMAX(sc1, 1, pf1, s1 == 2);
            __builtin_amdgcn_sched_barrier(0);
#undef AT_SOFTMAX
#pragma unroll
            for (int db = 0; db < 2; ++db)
#pragma unroll
                for (int s = 0; s < 2; ++s) if (s0) ot[0][db] = __builtin_amdgcn_mfma_f32_32x32x16_bf16(vf[db][s], pf0[s], ot[0][db], 0, 0, 0);
#pragma unroll
            for (int db = 0; db < 2; ++db)
#pragma unroll
                for (int s = 0; s < 2; ++s) if (s1) ot[1][db] = __builtin_amdgcn_mfma_f32_32x32x16_bf16(vf[db][s], pf1[s], ot[1][db], 0, 0, 0);
        }
        TSTAMP(27);
        if (t + 1 < nt) at_write(F, R, lds + ((t + 1) & 1) * AT_BUF);
        LBAR(); TSTAMP(28);
    }
    constexpr int AT_ORS = 528;
    u32x4 zr[8];
    const bf16* pz = F.P + (size_t)(b * SEQ + n * 128) * NIN + kvh * 256;
#pragma unroll
    for (int i = 0; i < 8; ++i) { const int idx = F.tid + 512 * i, row = idx >> 5, c16 = idx & 31; zr[i] = *(const u32x4*)(pz + (size_t)row * NIN + C_ZA + 8 * c16); }
    const float sk2 = F.sink[hh] * LOG2E;
#pragma unroll
    for (int qb = 0; qb < 2; ++qb) {
        float l = lrun[qb]; l += __shfl_xor(l, 32); l += __builtin_amdgcn_exp2f(sk2 - mrun[qb]);
        const float il = 1.0f / l;
        LAS unsigned char* po = lds + (qloc + qb * 32 + l31) * AT_ORS + (wave >> 1) * 128 + 8 * hi;
#pragma unroll
        for (int db = 0; db < 2; ++db)
#pragma unroll
            for (int rg = 0; rg < 4; ++rg) { u32x2 o; o.x = pkh(ot[qb][db][4 * rg] * il, ot[qb][db][4 * rg + 1] * il); o.y = pkh(ot[qb][db][4 * rg + 2] * il, ot[qb][db][4 * rg + 3] * il);
                *(LAS u32x2*)(po + (db * 32 + 8 * rg) * 2) = o; }
    }
    LBAR();
#pragma unroll
    for (int i = 0; i < 8; ++i) { const int idx = F.tid + 512 * i, row = idx >> 5, c16 = idx & 31;
        const u32x4 ov = *(const LAS u32x4*)(lds + row * AT_ORS + c16 * 16);
        float z[8]; unpack8(zr[i], z);
        u32x4 w; w.x = pk2(h_lo(ov.x) * siluf_(z[0]), h_hi(ov.x) * siluf_(z[1])); w.y = pk2(h_lo(ov.y) * siluf_(z[2]), h_hi(ov.y) * siluf_(z[3]));
        w.z = pk2(h_lo(ov.z) * siluf_(z[4]), h_hi(ov.z) * siluf_(z[5])); w.w = pk2(h_lo(ov.w) * siluf_(z[6]), h_hi(ov.w) * siluf_(z[7]));
        *(u32x4*)(F.P + (size_t)(b * SEQ + n * 128 + row) * NIN + 1024 + kvh * 256 + 8 * c16) = w; }
    TSTAMP(29);
#undef TL_KIND
#undef TL_ROW
#undef TL_KPOS
}
__device__ __forceinline__ bool attn_nomax(Frame& F) {
    float gq = fabsf(F.qng[F.lane]), gk = fabsf(F.kng[F.lane]);
#pragma unroll
    for (int o = 1; o < 64; o <<= 1) { gq = fmaxf(gq, __shfl_xor(gq, o)); gk = fmaxf(gk, __shfl_xor(gk, o)); }
    const float bound = 8.0f * LOG2E * gq * gk;
    return __builtin_amdgcn_readfirstlane(bound <= ATTN_BOUND ? 1 : 0) != 0;
}

__device__ __forceinline__ void p5_mix(Frame& F) {
    const int total = F.G * NWAVES * 64, rstep = total >> 7, gi = F.bid * NWAVES * 64 + F.tid;
    const int ch = gi & 7, h = (gi >> 3) & 15, c0 = h * 64 + 8 * ch;
    float mus[8], lg[8], lb[8];
    { const f32x4 a0 = *(const f32x4*)(F.mu_shift + C_V + c0), a1 = *(const f32x4*)(F.mu_shift + C_V + c0 + 4), g0 = *(const f32x4*)(F.ln_g + c0), g1 = *(const f32x4*)(F.ln_g + c0 + 4), b0 = *(const f32x4*)(F.ln_b + c0), b1 = *(const f32x4*)(F.ln_b + c0 + 4);
#pragma unroll
      for (int j = 0; j < 4; ++j) { mus[j] = a0[j]; mus[4 + j] = a1[j]; lg[j] = g0[j]; lg[4 + j] = g1[j]; lb[j] = b0[j]; lb[4 + j] = b1[j]; } }
    const u32x4 z = {0u, 0u, 0u, 0u};
#pragma unroll 1
    for (int m0 = gi >> 7; m0 < ML; m0 += 4 * rstep) {
        u32x4 ryf[4], ryb[4], rvc[4], rvp[4], rvn[4], rzr[4]; float bon[4];
#pragma unroll
        for (int k = 0; k < 4; ++k) { const int m = m0 + k * rstep, mm = m < ML ? m : m0, t = mm & (SEQ - 1);
            const bf16* pc = F.P + (size_t)mm * NIN;
            ryf[k] = *(const u32x4*)(F.YF + (size_t)mm * 1024 + c0); ryb[k] = *(const u32x4*)(F.YB + (size_t)mm * 1024 + c0);
            rvc[k] = *(const u32x4*)(pc + C_V + c0); rvp[k] = *(const u32x4*)(pc - (t > 0 ? NIN : 0) + C_V + c0); rvn[k] = *(const u32x4*)(pc + (t < SEQ - 1 ? NIN : 0) + C_V + c0);
            rzr[k] = *(const u32x4*)(pc + C_ZR + c0);
            bon[k] = F.BON[(size_t)mm * 16 + h] + F.BON[(size_t)(ML + mm) * 16 + h]; }
#pragma unroll
        for (int k = 0; k < 4; ++k) { const int m = m0 + k * rstep; if (m >= ML) break;
            float y[8];
            { const h8 hf = __builtin_bit_cast(h8, ryf[k]), hb = __builtin_bit_cast(h8, ryb[k]);
#pragma unroll
              for (int j = 0; j < 8; ++j) y[j] = (float)hf[j] + (float)hb[j]; }
            float s = 0.f;
#pragma unroll
            for (int j = 0; j < 8; ++j) s += y[j];
            s += __shfl_xor(s, 1); s += __shfl_xor(s, 2); s += __shfl_xor(s, 4);
            const float mu = s * (1.0f / 64.0f); float q = 0.f;
#pragma unroll
            for (int j = 0; j < 8; ++j) { y[j] -= mu; q += y[j] * y[j]; }
            q += __shfl_xor(q, 1); q += __shfl_xor(q, 2); q += __shfl_xor(q, 4);
            const float rs = 1.0f / sqrtf(q * (1.0f / 64.0f) + 64e-5f);
            float vc[8], vp[8], vn[8], zr[8];
            const int t = m & (SEQ - 1);
            unpack8(rvc[k], vc); unpack8(t > 0 ? rvp[k] : z, vp); unpack8(t < SEQ - 1 ? rvn[k] : z, vn); unpack8(rzr[k], zr);
            float o[8];
#pragma unroll
            for (int j = 0; j < 8; ++j) { const float sv = vc[j] + mus[j] * (0.5f * (vp[j] + vn[j]) - vc[j]);
                const float yn = y[j] * rs * lg[j] + lb[j];
                o[j] = (yn + bon[k] * sv) * siluf_(zr[j]); }
            u32x4 w; w.x = pk2(o[0], o[1]); w.y = pk2(o[2], o[3]); w.z = pk2(o[4], o[5]); w.w = pk2(o[6], o[7]);
            *(u32x4*)(F.P + (size_t)m * NIN + c0) = w; }
    }
}

struct Args { const float* in[22]; float* out; unsigned char* ws; int ph_lo, ph_hi; };
__global__ void __launch_bounds__(NWAVES * 64, 2) hymba_fwd(Args args) {
    extern __shared__ __attribute__((aligned(16))) unsigned char lds_raw[];
    Frame F;
    F.lds = (LAS unsigned char*)lds_raw;
    F.tid = threadIdx.x; F.G = gridDim.x;
    unsigned char* ws = args.ws;
    volatile LAS unsigned* MISC = (volatile LAS unsigned*)(F.lds + MISC_OFF);
    for (int u = F.tid; u < 64; u += NWAVES * 64) MISC[u] = 0u;
    if (DBG_SEL >= 0) for (int u = F.tid; u < 72; u += NWAVES * 64) ((volatile LAS unsigned*)(F.lds + DBG_LDS))[u] = 0u;
    __syncthreads();
    const int lo = args.ph_lo, hi = args.ph_hi;
    XcdBarrier bar; bar.bar = (unsigned*)(ws + WS_CTL) + CW_BAR; bar.x = 0; bar.st = nullptr;
    if (hi - lo > 1) bar = xcd_barrier_post((unsigned*)(ws + WS_CTL) + CW_BAR, MISC + 8);
#define IN(k) (lo <= (k) && (k) < hi)
#define SEAM(k) do { if (IN(k) && IN((k) + 1)) xcd_barrier(bar); } while (0)
    fresh(F); TSTART();
    if (DBG_SEL >= 0 && F.bid == DBG_BLOCK && F.tid == 0) { volatile LAS unsigned long long* T_ = (volatile LAS unsigned long long*)(F.lds + DBG_LDS); T_[34] = T_[32]; }
    if (IN(0)) { fresh(F); p0_prologue(F); if (DUP_PHASE == 0) { fresh(F); p0_prologue(F); } } TSTAMP(8); SEAM(0); TSTAMP(9);
    if (IN(1)) { fresh(F); p1_modulate(F); if (DUP_PHASE == 1) { fresh(F); p1_modulate(F); } } TSTAMP(10); SEAM(1); TSTAMP(11);
    if (IN(2)) {
        fresh(F);
        pg8::Gemm g{F.XN, F.WIN, MT, NIN, DM, DM}; Sched1 S; S.init(F.G, F.bid);
        pg8::EpiBf16<0> E{F.P, NIN, nullptr, 0, 0, 1.f};
        pg8::gemm_phase<pg8::EpiBf16<0>, Sched1, true, true>(F.lds, g, S, E);
        if (DUP_PHASE == 2) { __syncthreads(); pg8::gemm_phase<pg8::EpiBf16<0>, Sched1, true, true>(F.lds, g, S, E); }
    } TSTAMP(12); SEAM(2); TSTAMP(13);
    if (IN(3)) { fresh(F); p3_chunkA(F); fresh(F); kprep(F); TSTAMP(14); if (DUP_PHASE == 3) { fresh(F); p3_chunkA(F); } } SEAM(3); TSTAMP(15);
    if (IN(4)) {
        fresh(F);
        { const bool g256 = F.G == 256; const int xg = F.bid & 7;
          int li0 = 3 * ((F.bid - 128) >> 3), cnt = 3;
          if (!g256 || F.bid < 128) { p4_chunkB(F); TSTAMP(30); LBAR(); fresh(F); li0 = 48 + (F.bid >> 3); cnt = 1; }
          if (!g256) cnt = (512 - F.bid + F.G - 1) / F.G;
          unsigned* tq = (unsigned*)((unsigned char*)F.MOD - WS_MOD + WS_CTL) + CW_TICKET + 64 * xg;
          volatile LAS unsigned* tk = (volatile LAS unsigned*)(F.lds + MISC_OFF) + 40;
          const bool pool = g256 && ATTN_POOL;
          unsigned nxt = 0u; if (pool && F.tid == 0) nxt = __hip_atomic_fetch_add(tq, 1u, __ATOMIC_RELAXED, __HIP_MEMORY_SCOPE_AGENT);
#define ATTN_ITEMS(NM) \
          for (int j = 0; ; ++j) { int li = li0 + j; \
              if (!pool) { if (j >= cnt) break; } \
              else { if (F.tid == 0) tk[0] = nxt; \
                  LBAR(); const unsigned q = tk[0]; LBAR(); if (q >= 64u) break; li = (int)q; \
                  if (F.tid == 0) nxt = __hip_atomic_fetch_add(tq, 1u, __ATOMIC_RELAXED, __HIP_MEMORY_SCOPE_AGENT); } \
              fresh(F); p4_attn_t<NM>(F, g256 ? (2 * xg + (li >> 5)) * 32 + (li & 31) : F.bid + j * F.G); LBAR(); }
          if (attn_nomax(F)) {
#pragma unroll 1
              ATTN_ITEMS(true)
          } else {
#pragma unroll 1
              ATTN_ITEMS(false)
          }
#undef ATTN_ITEMS
        }
        TSTAMP(16);
    } SEAM(4); TSTAMP(17);
    if (IN(5)) { fresh(F); p5_mix(F); TSTAMP(18);
        if (DBG_SEL >= 0 && F.bid == DBG_BLOCK && F.tid == 0) { volatile LAS unsigned long long* T_ = (volatile LAS unsigned long long*)(F.lds + DBG_LDS);
            F.DBG[0] = (float)(DBG_SEL == 99 ? (T_[0] + T_[1] + T_[2] + T_[3] + T_[4] + T_[5] + T_[6] + T_[7]) : T_[DBG_SEL]) * (DBG_FINE ? 1e-6f : 2.5e-7f); F.DBG[1] = (DBG_SEL2 == 24 ? (float)T_[24] * 1e-7f : (float)T_[DBG_SEL2] * 1e-4f); }
    } SEAM(5);
    if (IN(6)) {
        fresh(F);
        pg8::Gemm g{F.P, F.WOUT, ML, DM, DM, NIN};
        pg8::StaticOrder S; S.init(ML, DM, F.G, F.bid);
        pg8::EpiGate E{F.x, F.out, F.MOD + 4096, DM, DBG_SEL >= 0 ? F.DBG[0] : 0.f, DBG_SEL >= 0 ? F.DBG[1] : 0.f};
        pg8::gemm_phase<pg8::EpiGate, pg8::StaticOrder, true, true>(F.lds, g, S, E);
        if (DUP_PHASE == 6) { __syncthreads(); pg8::gemm_phase<pg8::EpiGate, pg8::StaticOrder, true, true>(F.lds, g, S, E); }
        if (DBG_SEL >= 0 && DBG_END > 0 && blockIdx.x == 0 && threadIdx.x == 0) { volatile LAS unsigned long long* T_ = (volatile LAS unsigned long long*)(F.lds + DBG_LDS);
            const unsigned long long n_ = __builtin_amdgcn_s_memrealtime(); asm volatile("s_waitcnt vmcnt(0)" ::: "memory");
            F.out[0] += (float)(DBG_END == 1 ? n_ - T_[34] : n_ - T_[32]) * 1e-5f; }
    }
#undef IN
#undef SEAM
}

extern "C" void kernel_launch(void* const* d_in, const int* in_sizes, int n_in, void* d_out, int out_size, void* d_ws, size_t ws_size, hipStream_t stream) {
    static int grid = 0;
    if (grid == 0) {
        if (n_in != 22 || out_size != ML * DM || ws_size < WS_END) { fprintf(stderr, "kernel_launch: unexpected problem shape (n_in %d, out %d, ws %zu)\n", n_in, out_size, ws_size); grid = -1; return; }
        int dev = 0, cus = 0;
        if (hipGetDevice(&dev) != hipSuccess || hipDeviceGetAttribute(&cus, hipDeviceAttributeMultiprocessorCount, dev) != hipSuccess) { grid = -1; return; }
        if (hipFuncSetAttribute((const void*)hymba_fwd, hipFuncAttributeMaxDynamicSharedMemorySize, LDS_BYTES) != hipSuccess) { fprintf(stderr, "kernel_launch: hipFuncSetAttribute failed\n"); grid = -1; return; }
        (void)hipGetLastError();
        grid = cus;
    }
    if (grid < 0) return;
    (void)hipMemsetAsync((char*)d_ws + WS_CTL, 0, CTL_ZERO_BYTES, stream);
    Args a{};
    for (int i = 0; i < 22; ++i) a.in[i] = (const float*)d_in[i];
    a.out = (float*)d_out; a.ws = (unsigned char*)d_ws;
    if (MK_N_LAUNCHES == 1) { a.ph_lo = 0; a.ph_hi = N_PHASES; hipLaunchKernelGGL(hymba_fwd, dim3(grid), dim3(NWAVES * 64), LDS_BYTES, stream, a); }
    else for (int p = 0; p < N_PHASES; ++p) { a.ph_lo = p; a.ph_hi = p + 1; hipLaunchKernelGGL(hymba_fwd, dim3(grid), dim3(NWAVES * 64), LDS_BYTES, stream, a); }
}
```

```cpp
#include <hip/hip_runtime.h>
#include <cstdio>
#include <cstdint>
#ifndef DBG_SEL
#define DBG_SEL -1
#endif
#ifndef DBG_SEL2
#define DBG_SEL2 0
#endif
#ifndef DBG_BLOCK
#define DBG_BLOCK 0
#endif
#ifndef DBG_END
#define DBG_END 0
#endif
namespace pg8 {
#define PG8_LAS __attribute__((address_space(3)))
typedef unsigned short bf16_t;
typedef short bf16x8 __attribute__((ext_vector_type(8)));
typedef float f32x4 __attribute__((ext_vector_type(4)));
typedef unsigned u32x4 __attribute__((ext_vector_type(4)));
constexpr int BM = 256, BK = 64, HALF = 128, HTB = HALF * BK * 2  , STAGE_BYTES = 8 * HTB, NXCD = 8, WGM = 8;

__host__ __device__ __forceinline__ int lds_byte(int r, int c) { const int st = (r >> 4) * 2 + (c >> 5), rr = r & 15, cc = c & 31, ob = rr * 64 + cc * 2; return st * 1024 + (ob ^ (((ob >> 9) & 1) << 5)); }
__host__ __device__ __forceinline__ void stage_rc(int b, int& R, int& C) { const int st = b / 1024, sb = b % 1024, swz = sb ^ (((sb >> 9) & 1) << 5); R = (st >> 1) * 16 + swz / 64; C = (st & 1) * 32 + (swz % 64) / 2; }
__host__ __device__ __forceinline__ int perm32(int rho) { const int n = rho >> 4, i = rho & 15; return 8 * (i >> 2) + 4 * n + (i & 3); }

struct Unit { int pm, pn; };
struct Gemm { const bf16_t* A; const bf16_t* Bt; int M, N, K, lda; };

struct StaticOrder {
    int nM, nN, nwg, G, c;
    __host__ __device__ void init(int M, int N, int G_, int c_) { nM = M / BM; nN = N / BM; nwg = nM * nN; G = G_; c = c_; }
    __host__ __device__ bool next(int i, Unit& u) const {
        const long L = (long)i * G + c; if (L >= nwg) return false;
        int wgid = (int)L; { const int q = nwg / NXCD, r = nwg % NXCD, xcd = wgid % NXCD, off = wgid / NXCD; wgid = (xcd < r ? xcd * (q + 1) : r * (q + 1) + (xcd - r) * q) + off; }
        const int nig = WGM * nN, gid = wgid / nig, fm = gid * WGM, gsz = (nM - fm) < WGM ? (nM - fm) : WGM;
        u.pm = fm + ((wgid % nig) % gsz); u.pn = (wgid % nig) / gsz; return true;
    }
    __device__ __forceinline__ void a_ready(const Unit&) const {}
    __device__ __forceinline__ void done(const Unit&) const {}
};

__device__ __forceinline__ unsigned cvt_pk_bf16(float lo, float hi) { unsigned r; asm volatile("v_cvt_pk_bf16_f32 %0, %1, %2" : "=v"(r) : "v"(lo), "v"(hi)); return r; }
typedef float f32x2 __attribute__((ext_vector_type(2)));
__device__ __forceinline__ f32x2 gelu_pk(f32x2 v) {
    const f32x2 av = __builtin_elementwise_abs(v), d = av * 0.2316418882f + 1.0f;
    f32x2 t; t.x = __builtin_amdgcn_rcpf(d.x); t.y = __builtin_amdgcn_rcpf(d.y);
    f32x2 q = t * 0.5307027145f + (-0.7265760135f); q = q * t + 0.7107068705f; q = q * t + (-0.142248368f); q = q * t + 0.127414796f; q = q * t;
    const f32x2 s = (v * v) * (-0.72134752044f);
    f32x2 e; e.x = __builtin_amdgcn_exp2f(s.x); e.y = __builtin_amdgcn_exp2f(s.y);
    const f32x2 m = v * (q * e), r = v - m;
    f32x2 o; o.x = v.x < 0.f ? m.x : r.x; o.y = v.y < 0.f ? m.y : r.y; return o;
}

template <int ACT  > struct EpiBf16 {
    static constexpr bool PERM = true, AFTER_DRAIN = false; static_assert(ACT == 0 || ACT == 1, "EpiBf16: ACT is 0 (none) or 1 (gelu_pk)");
    bf16_t* O; int ldc; const float* bias; int split_cols; size_t split_stride; float scale0;
    __device__ __forceinline__ void operator()(const f32x4 (&acc)[2][2][4][2], const Unit& u, int wr, int wc, int fr, int fq) const {
        const int row0 = u.pm * BM + wr * 64 + fr; int colt = u.pn * BM; bf16_t* base = O;
        float sc = 1.f; if (split_cols) { const int t = colt / split_cols; base += (size_t)t * split_stride; colt -= t * split_cols; if (t == 0) sc = scale0; }
        const int col0 = colt + wc * 32 + 8 * fq, bcol0 = u.pn * BM + wc * 32 + 8 * fq;
        f32x4 bv[2][2];
#pragma unroll
        for (int bj = 0; bj < 2; ++bj)
#pragma unroll
            for (int n = 0; n < 2; ++n) bv[bj][n] = bias ? *(const f32x4*)(bias + bcol0 + bj * HALF + 4 * n) : (f32x4){0.f, 0.f, 0.f, 0.f};
#pragma unroll
        for (int ai = 0; ai < 2; ++ai)
#pragma unroll
            for (int m = 0; m < 4; ++m) { bf16_t* rowp = base + (size_t)(row0 + ai * HALF + m * 16) * ldc + col0;
#pragma unroll
                for (int bj = 0; bj < 2; ++bj) { f32x4 v0 = acc[ai][bj][m][0] + bv[bj][0], v1 = acc[ai][bj][m][1] + bv[bj][1];
                    if (ACT == 1) { f32x2 a = gelu_pk((f32x2){v0[0], v0[1]}), b = gelu_pk((f32x2){v0[2], v0[3]}), c = gelu_pk((f32x2){v1[0], v1[1]}), d = gelu_pk((f32x2){v1[2], v1[3]});
                        v0 = (f32x4){a.x, a.y, b.x, b.y}; v1 = (f32x4){c.x, c.y, d.x, d.y}; }
                    v0 = v0 * sc; v1 = v1 * sc; u32x4 w; w.x = cvt_pk_bf16(v0[0], v0[1]); w.y = cvt_pk_bf16(v0[2], v0[3]); w.z = cvt_pk_bf16(v1[0], v1[1]); w.w = cvt_pk_bf16(v1[2], v1[3]);
                    *(u32x4*)(rowp + bj * HALF) = w; } }
    }
};


struct EpiGate {
    static constexpr bool PERM = false, AFTER_DRAIN = false;
    const float* x; float* out; const float* gate; int ldc; float dbg0, dbg1;
    __device__ __forceinline__ void operator()(const f32x4 (&acc)[2][2][4][2], const Unit& u, int wr, int wc, int fr, int fq) const {
        const int col0 = u.pn * BM + wc * 32 + 4 * fq;
        const int b = (u.pm * BM) >> 12;
        f32x4 gv[2][2];
#pragma unroll
        for (int bj = 0; bj < 2; ++bj)
#pragma unroll
            for (int n = 0; n < 2; ++n) gv[bj][n] = *(const f32x4*)(gate + (size_t)b * 6144 + col0 + bj * HALF + n * 16);
#pragma unroll
        for (int ai = 0; ai < 2; ++ai)
#pragma unroll
            for (int mp = 0; mp < 2; ++mp) {
                f32x4 xv[2][2][2];
#pragma unroll
                for (int mm = 0; mm < 2; ++mm) { const size_t off = (size_t)(u.pm * BM + ai * HALF + wr * 64 + (2 * mp + mm) * 16 + fr) * ldc + col0;
#pragma unroll
                    for (int bj = 0; bj < 2; ++bj)
#pragma unroll
                        for (int n = 0; n < 2; ++n) xv[mm][bj][n] = *(const f32x4*)(x + off + bj * HALF + n * 16); }
                asm volatile("" ::: "memory");
#pragma unroll
                for (int mm = 0; mm < 2; ++mm) { const int m = 2 * mp + mm; const size_t off = (size_t)(u.pm * BM + ai * HALF + wr * 64 + m * 16 + fr) * ldc + col0;
#pragma unroll
                    for (int bj = 0; bj < 2; ++bj)
#pragma unroll
                        for (int n = 0; n < 2; ++n) { f32x4 o = xv[mm][bj][n] + gv[bj][n] * acc[ai][bj][m][n];
                            if (DBG_SEL >= 0) { o = o + dbg0; if (off + bj * HALF + n * 16 == 0) o.x += dbg1; }
                            *(f32x4*)(out + off + bj * HALF + n * 16) = o; } }
                asm volatile("" ::: "memory"); }
    }
};
template <class Epi, class Sched, bool ALIGN_EPI = false, bool SP2 = false>
__device__ __forceinline__ void gemm_phase(PG8_LAS unsigned char* lds, const Gemm g, const Sched& S, const Epi& E) {
    const int tid = threadIdx.x, wid = __builtin_amdgcn_readfirstlane(tid >> 6), lane = tid & 63, wr = wid >> 2, wc = wid & 3, fr = lane & 15, fq = lane >> 4;
    const int K = g.K, nt = K / BK, lda = g.lda;
    unsigned voffA[2], voffB[2];
#pragma unroll
    for (int i = 0; i < 2; ++i) { int R, C; stage_rc(tid * 16 + i * 8192, R, C); const int Rb = Epi::PERM ? ((R & ~31) + perm32(R & 31)) : R;
        voffA[i] = (unsigned)(R * lda + C) * 2u; voffB[i] = (unsigned)(Rb * K + C) * 2u; }
    const size_t kstep = (size_t)(BK * 2);
    const size_t hstepA = (size_t)HALF * lda * 2, hstepB = (size_t)HALF * K * 2;
    const size_t tstepA = 2 * hstepA, tstepB = 2 * hstepB;
    const unsigned ldsw = (unsigned)wid * 1024u;
    const int aoff = lds_byte(wr * 64 + fr, fq * 8), boff = lds_byte(wc * 32 + fr, fq * 8);
#define PG8_SA(b, h) (((b) * 2 + (h)) * HTB)
#define PG8_SB(b, h) ((4 + (b) * 2 + (h)) * HTB)
#define PG8_STAGE(bufoff, gbase, voff) do { _Pragma("unroll") for (int _i = 0; _i < 2; ++_i) \
        __builtin_amdgcn_global_load_lds((const unsigned*)((const char*)(gbase) + (voff)[_i]), (PG8_LAS unsigned*)(lds + (bufoff) + ldsw + _i * 8192), 16, 0, 0); } while (0)
#define PG8_LDA(dst, b, h) do { _Pragma("unroll") for (int m = 0; m < 4; ++m) _Pragma("unroll") for (int k = 0; k < 2; ++k) dst[m][k] = *(const PG8_LAS bf16x8*)(lds + PG8_SA(b, h) + aoff + m * 2048 + k * 1024); } while (0)
#define PG8_LDB(dst, b, h) do { _Pragma("unroll") for (int n = 0; n < 2; ++n) _Pragma("unroll") for (int k = 0; k < 2; ++k) dst[n][k] = *(const PG8_LAS bf16x8*)(lds + PG8_SB(b, h) + boff + n * 2048 + k * 1024); } while (0)
#define PG8_MMA(ai, bj, At, Bt) do { __builtin_amdgcn_s_setprio(1); _Pragma("unroll") for (int m = 0; m < 4; ++m) _Pragma("unroll") for (int n = 0; n < 2; ++n) _Pragma("unroll") for (int k = 0; k < 2; ++k) \
        acc[ai][bj][m][n] = __builtin_amdgcn_mfma_f32_16x16x32_bf16(Bt[n][k], At[m][k], acc[ai][bj][m][n], 0, 0, 0); __builtin_amdgcn_s_setprio(0); } while (0)
#define PG8_WAIT_V(n) asm volatile("s_waitcnt vmcnt(" #n ")" ::: "memory")
#define PG8_WAIT_L(n) asm volatile("s_waitcnt lgkmcnt(" #n ")" ::: "memory")
#define PG8_BAR __builtin_amdgcn_s_barrier()
#define PG8_SCHED __builtin_amdgcn_sched_barrier(0)
    Unit cur, nxt; int ui = 0;
    if (!S.next(0, cur)) return;
    f32x4 acc[2][2][4][2];
#pragma unroll
    for (int a = 0; a < 2; ++a)
#pragma unroll
        for (int b = 0; b < 2; ++b)
#pragma unroll
            for (int m = 0; m < 4; ++m)
#pragma unroll
                for (int n = 0; n < 2; ++n) acc[a][b][m][n] = (f32x4){0.f, 0.f, 0.f, 0.f};
    bf16x8 At[4][2], B0[2][2], B1[2][2];
    const char* cA = (const char*)g.A + (size_t)cur.pm * tstepA; const char* cB = (const char*)g.Bt + (size_t)cur.pn * tstepB;
    S.a_ready(cur);
    if constexpr (SP2) {
        PG8_STAGE(PG8_SB(0, 0), cB, voffB); PG8_STAGE(PG8_SB(0, 1), cB + hstepB, voffB); PG8_STAGE(PG8_SA(0, 0), cA, voffA); PG8_STAGE(PG8_SA(0, 1), cA + hstepA, voffA);
        if (wr == 1) PG8_BAR;
        PG8_WAIT_V(2); PG8_BAR;
        PG8_STAGE(PG8_SB(1, 0), cB + kstep, voffB); PG8_STAGE(PG8_SA(1, 0), cA + kstep, voffA); PG8_STAGE(PG8_SB(1, 1), cB + hstepB + kstep, voffB);
        PG8_WAIT_V(6); PG8_BAR;
    } else {
        PG8_STAGE(PG8_SB(0, 0), cB, voffB); PG8_STAGE(PG8_SA(0, 0), cA, voffA); PG8_STAGE(PG8_SB(0, 1), cB + hstepB, voffB); PG8_STAGE(PG8_SA(0, 1), cA + hstepA, voffA);
        if (wr == 1) PG8_BAR;
        PG8_WAIT_V(4); PG8_BAR;
        PG8_STAGE(PG8_SB(1, 0), cB + kstep, voffB); PG8_STAGE(PG8_SA(1, 0), cA + kstep, voffA); PG8_STAGE(PG8_SB(1, 1), cB + hstepB + kstep, voffB);
        PG8_WAIT_V(6); PG8_BAR;
    }
    for (;;) {
        const bool has_next = S.next(ui + 1, nxt);
        const char* nA = has_next ? (const char*)g.A + (size_t)nxt.pm * tstepA : cA; const char* nB = has_next ? (const char*)g.Bt + (size_t)nxt.pn * tstepB : cB;
        for (int t = 0; t < nt; t += 2) {
            const bool last = (t == nt - 2);
            const char* a1 = cA + (size_t)(t + 1) * kstep;
            const char* a2 = last ? nA : cA + (size_t)(t + 2) * kstep; const char* b2 = last ? nB : cB + (size_t)(t + 2) * kstep;
            const char* a3 = a2 + kstep; const char* b3 = b2 + kstep;
            if (last && has_next) S.a_ready(nxt);
            if constexpr (SP2) {
            PG8_LDB(B0, 0, 0); PG8_LDB(B1, 0, 1); PG8_SCHED; PG8_LDA(At, 0, 0); PG8_STAGE(PG8_SA(1, 1), a1 + hstepA, voffA);
            PG8_WAIT_V(8); PG8_WAIT_L(0); PG8_BAR; PG8_MMA(0, 0, At, B0); PG8_MMA(0, 1, At, B1); PG8_BAR; PG8_SCHED;
            PG8_LDA(At, 0, 1); PG8_STAGE(PG8_SB(0, 0), b2, voffB); PG8_STAGE(PG8_SB(0, 1), b2 + hstepB, voffB); PG8_STAGE(PG8_SA(0, 0), a2, voffA);
            PG8_WAIT_V(8); PG8_WAIT_L(0); PG8_BAR; PG8_MMA(1, 0, At, B0); PG8_MMA(1, 1, At, B1); PG8_BAR; PG8_SCHED;
            PG8_LDB(B0, 1, 0); PG8_LDB(B1, 1, 1); PG8_SCHED; PG8_LDA(At, 1, 0); PG8_STAGE(PG8_SA(0, 1), a2 + hstepA, voffA);
            PG8_WAIT_V(8); PG8_WAIT_L(0); PG8_BAR; PG8_MMA(0, 0, At, B0); PG8_MMA(0, 1, At, B1); PG8_BAR; PG8_SCHED;
            PG8_LDA(At, 1, 1); PG8_STAGE(PG8_SB(1, 0), b3, voffB); PG8_STAGE(PG8_SB(1, 1), b3 + hstepB, voffB); PG8_STAGE(PG8_SA(1, 0), a3, voffA);
            PG8_WAIT_V(8); PG8_WAIT_L(0); PG8_BAR; PG8_MMA(1, 0, At, B0); PG8_MMA(1, 1, At, B1); PG8_BAR; PG8_SCHED;
            } else {
            PG8_LDB(B0, 0, 0); PG8_SCHED; PG8_LDA(At, 0, 0); PG8_STAGE(PG8_SA(1, 1), a1 + hstepA, voffA);
            PG8_WAIT_L(8); PG8_BAR; PG8_WAIT_L(0); PG8_MMA(0, 0, At, B0); PG8_BAR; PG8_SCHED;
            PG8_LDB(B1, 0, 1); PG8_STAGE(PG8_SB(0, 0), b2, voffB);
            PG8_BAR; PG8_WAIT_L(0); PG8_MMA(0, 1, At, B1); PG8_BAR;
            PG8_LDA(At, 0, 1); PG8_STAGE(PG8_SA(0, 0), a2, voffA);
            PG8_BAR; PG8_WAIT_L(0); PG8_MMA(1, 0, At, B0); PG8_BAR; PG8_SCHED;
            PG8_STAGE(PG8_SB(0, 1), b2 + hstepB, voffB);
            PG8_WAIT_V(6); PG8_BAR; PG8_MMA(1, 1, At, B1); PG8_BAR;
            PG8_LDB(B0, 1, 0); PG8_SCHED; PG8_LDA(At, 1, 0); PG8_STAGE(PG8_SA(0, 1), a2 + hstepA, voffA);
            PG8_WAIT_L(8); PG8_BAR; PG8_WAIT_L(0); PG8_MMA(0, 0, At, B0); PG8_BAR; PG8_SCHED;
            PG8_LDB(B1, 1, 1); PG8_STAGE(PG8_SB(1, 0), b3, voffB);
            PG8_BAR; PG8_WAIT_L(0); PG8_MMA(0, 1, At, B1); PG8_BAR;
            PG8_LDA(At, 1, 1); PG8_STAGE(PG8_SA(1, 0), a3, voffA);
            PG8_BAR; PG8_WAIT_L(0); PG8_MMA(1, 0, At, B0); PG8_BAR; PG8_SCHED;
            PG8_STAGE(PG8_SB(1, 1), b3 + hstepB, voffB);
            PG8_WAIT_V(6); PG8_BAR; PG8_MMA(1, 1, At, B1); PG8_BAR;
            }
        }
        if constexpr (ALIGN_EPI) { if (wr == 0) PG8_BAR; }
        if constexpr (!Epi::AFTER_DRAIN) { E(acc, cur, wr, wc, fr, fq); S.done(cur); }
        if (!has_next) break;
#pragma unroll
        for (int a = 0; a < 2; ++a)
#pragma unroll
            for (int b = 0; b < 2; ++b)
#pragma unroll
                for (int m = 0; m < 4; ++m)
#pragma unroll
                    for (int n = 0; n < 2; ++n) acc[a][b][m][n] = (f32x4){0.f, 0.f, 0.f, 0.f};
        cur = nxt; cA = nA; cB = nB; ++ui;
        if constexpr (ALIGN_EPI) { if (wr == 1) PG8_BAR; }
    }
    PG8_WAIT_V(0);
    if constexpr (!ALIGN_EPI) { if (wr == 0) PG8_BAR; }
    PG8_BAR;
    if constexpr (Epi::AFTER_DRAIN) { E.fused(acc, cur, wr, wc, fr, fq, lds, wid, lane); S.done(cur); }
#undef PG8_SA
#undef PG8_SB
#undef PG8_STAGE
#undef PG8_LDA
#undef PG8_LDB
#undef PG8_MMA
#undef PG8_WAIT_V
#undef PG8_WAIT_L
#undef PG8_BAR
#undef PG8_SCHED
}
}

#ifndef MK_N_LAUNCHES
#define MK_N_LAUNCHES 1
#endif
#ifndef B_DUMMY
#define B_DUMMY 0
#endif
#ifndef DUP_PHASE
#define DUP_PHASE -1
#endif
constexpr int N_PHASES = 7;
constexpr int NWAVES = 8;
constexpr int DM = 2048, NB = 4, SEQ = 4096, CTXL = 256;
constexpr int ML = NB * SEQ, MC = NB * CTXL, MT = ML + MC;
constexpr int NIN = 6912;
constexpr int C_R = 0, C_K = 1024, C_V = 2048, C_LW = 3072, C_LA = 3200, C_ZR = 3328, C_Q = 4352, C_KA = 5376, C_VA = 5632, C_ZA = 5888;
constexpr float LOG2E = 1.4426950408889634f;
constexpr int DBG_LDS = 143360;

constexpr size_t MiB = 1u << 20;
constexpr size_t WS_CTL = 0, CTL_ZERO_BYTES = 64 * 1024;
constexpr size_t WS_MOD = 1 * MiB;
constexpr size_t WS_ROPE = 1 * MiB + 128 * 1024;
constexpr size_t WS_DBG = 1 * MiB + 192 * 1024;
constexpr size_t WS_W2T = 1 * MiB + 256 * 1024;
constexpr size_t WS_A2T = 1 * MiB + 512 * 1024;
constexpr size_t WS_WOUT = 2 * MiB;
constexpr size_t WS_P = 10 * MiB;
constexpr size_t WS_XN = 240 * MiB;
constexpr size_t WS_WIN = 308 * MiB;
constexpr size_t WS_GHQ = 240 * MiB;
constexpr size_t WS_MIX = 240 * MiB;
constexpr size_t WS_YF = 444 * MiB, WS_YB = 476 * MiB;
constexpr size_t WS_BON = 508 * MiB;
constexpr size_t WS_END = 510 * MiB;
static_assert(WS_P + (size_t)MT * NIN * 2 <= WS_XN && WS_XN + (size_t)MT * DM * 2 <= WS_WIN && WS_WIN + (size_t)NIN * DM * 2 <= WS_YF && WS_GHQ + (size_t)8704 * 24576 <= WS_YF && WS_YB + (size_t)ML * 1024 * 2 <= WS_BON, "ws map");

constexpr int CW_BAR = 1024;
constexpr int CW_TICKET = 8192;
constexpr int LDS_BYTES = 163840;
constexpr int MISC_OFF = LDS_BYTES - 256;

#define GAS __attribute__((address_space(1)))
#define LAS __attribute__((address_space(3)))
typedef unsigned short bf16;
typedef float f32x4 __attribute__((ext_vector_type(4)));
typedef float f32x16 __attribute__((ext_vector_type(16)));
typedef short bf16x8 __attribute__((ext_vector_type(8)));
typedef unsigned u32x4 __attribute__((ext_vector_type(4)));
typedef unsigned u32x2 __attribute__((ext_vector_type(2)));
typedef _Float16 h8 __attribute__((ext_vector_type(8)));
typedef _Float16 h4 __attribute__((ext_vector_type(4)));
typedef _Float16 h2 __attribute__((ext_vector_type(2)));
typedef GAS unsigned gu32;

__device__ __forceinline__ unsigned f2bf(float f) { unsigned u = __builtin_bit_cast(unsigned, f); return (u + 0x7fffu + ((u >> 16) & 1u)) >> 16; }
typedef float f32x2_t __attribute__((ext_vector_type(2))); typedef __bf16 bf16x2_t __attribute__((ext_vector_type(2)));
__device__ __forceinline__ unsigned pk2(float lo, float hi) { f32x2_t v = {lo, hi}; bf16x2_t b = __builtin_convertvector(v, bf16x2_t); return __builtin_bit_cast(unsigned, b); }
__device__ __forceinline__ float bflo(unsigned w) { return __builtin_bit_cast(float, w << 16); }
__device__ __forceinline__ float bfhi(unsigned w) { return __builtin_bit_cast(float, w & 0xffff0000u); }
__device__ __forceinline__ void unpack8(const u32x4 r, float* v) { v[0] = bflo(r.x); v[1] = bfhi(r.x); v[2] = bflo(r.y); v[3] = bfhi(r.y); v[4] = bflo(r.z); v[5] = bfhi(r.z); v[6] = bflo(r.w); v[7] = bfhi(r.w); }
__device__ __forceinline__ unsigned pkh(float a, float b) { h2 v = {(_Float16)a, (_Float16)b}; return __builtin_bit_cast(unsigned, v); }
__device__ __forceinline__ float wave_sum(float v) {
#pragma unroll
    for (int o = 1; o < 64; o <<= 1) v += __shfl_xor(v, o);
    return v;
}
__device__ __forceinline__ float fast_exp(float x) { return __builtin_amdgcn_exp2f(x * LOG2E); }
__device__ __forceinline__ float sigmoidf_(float x) { return __builtin_amdgcn_rcpf(1.0f + fast_exp(-x)); }
__device__ __forceinline__ float siluf_(float x) { return x * sigmoidf_(x); }
template <int CTRL> __device__ __forceinline__ float dpp_f(float x) { return __builtin_bit_cast(float, __builtin_amdgcn_update_dpp(0, __builtin_bit_cast(int, x), CTRL, 0xF, 0xF, false)); }

#define XB_TMO      128
#define XB_XCNT(j)  (256  + 64 * (j))
#define XB_XSUB(j)  (1280 + 64 * (j))
#define XB_XGEN(j)  (2304 + 64 * (j))
#define XB_TOP      3328
#define XB_TOPGEN   3392
#define XCD_BAR_WORDS 3456
#define XB_SPIN_CAP (1u << 18)
__device__ __forceinline__ unsigned xb_ld(unsigned* p)              { return __hip_atomic_load(p, __ATOMIC_RELAXED, __HIP_MEMORY_SCOPE_AGENT); }
__device__ __forceinline__ unsigned xb_add(unsigned* p, unsigned v) { return __hip_atomic_fetch_add(p, v, __ATOMIC_RELAXED, __HIP_MEMORY_SCOPE_AGENT); }
__device__ __forceinline__ unsigned xb_xcc_id() { return (unsigned)__builtin_amdgcn_s_getreg((3 << 11) | 20) & 0xFu; }
#define XB_SPIN(cond, bar) do { unsigned _sp = 0; while (cond) { __builtin_amdgcn_s_sleep(1); \
    if ((++_sp & 255u) == 0u) { if (xb_ld(&(bar)[XB_TMO])) break; if (_sp > XB_SPIN_CAP) { atomicAdd(&(bar)[XB_TMO], 1u); break; } } } } while (0)
struct XcdBarrier { unsigned* bar; unsigned x; volatile LAS unsigned* st; };
__device__ __forceinline__ XcdBarrier xcd_barrier_post(unsigned* bar, volatile LAS unsigned* st) {
    XcdBarrier b; b.bar = bar; b.x = xb_xcc_id(); b.st = st;
    if (threadIdx.x == 0) (void)xb_add(&bar[XB_XCNT(b.x)], 1u);
    return b;
}
__device__ __forceinline__ void xcd_barrier_complete(unsigned* bar, unsigned x, unsigned& nloc, unsigned& nx) {
    const unsigned G = gridDim.x * gridDim.y * gridDim.z;
    unsigned sum, cnt, mine, sp = 0u;
    for (;;) {
        sum = 0u; cnt = 0u; mine = 0u;
#pragma unroll
        for (unsigned j = 0; j < 16; ++j) { const unsigned c = xb_ld(&bar[XB_XCNT(j)]); sum += c; cnt += (c > 0u) ? 1u : 0u; mine = (j == x) ? c : mine; }
        if (sum == G) break;
        __builtin_amdgcn_s_sleep(1);
        if ((++sp & 255u) == 0u) { if (xb_ld(&bar[XB_TMO])) break; if (sp > XB_SPIN_CAP) { atomicAdd(&bar[XB_TMO], 1u); break; } }
    }
    nloc = mine > 0u ? mine : 1u; nx = cnt > 0u ? cnt : 1u;
}
__device__ __forceinline__ void xcd_barrier(const XcdBarrier& b) {
    asm volatile("s_waitcnt vmcnt(0)" ::: "memory");
    __syncthreads();
    if (threadIdx.x == 0) {
        unsigned* bar = b.bar;
        __builtin_amdgcn_s_waitcnt(0);
        unsigned nloc = b.st[0], nx = b.st[1];
        if (nloc == 0u) { xcd_barrier_complete(bar, b.x, nloc, nx); b.st[0] = nloc; b.st[1] = nx; }
        const unsigned old = xb_add(&bar[XB_XSUB(b.x)], 1u);
        const unsigned gen = old / nloc;
        if (old + 1u == (gen + 1u) * nloc) {
            __builtin_amdgcn_fence(__ATOMIC_RELEASE, "agent");
            asm volatile("s_waitcnt vmcnt(0)" ::: "memory");
            const unsigned og = xb_add(&bar[XB_TOP], 1u);
            const unsigned tg = og / nx;
            if (og + 1u == (tg + 1u) * nx) xb_add(&bar[XB_TOPGEN], 1u);
            else XB_SPIN(xb_ld(&bar[XB_TOPGEN]) == tg, bar);
            __builtin_amdgcn_fence(__ATOMIC_ACQUIRE, "agent");
            xb_add(&bar[XB_XGEN(b.x)], 1u);
            asm volatile("s_waitcnt vmcnt(0)" ::: "memory");
        } else {
            XB_SPIN(xb_ld(&bar[XB_XGEN(b.x)]) == gen, bar);
            __builtin_amdgcn_fence(__ATOMIC_ACQUIRE, "agent");
            asm volatile("s_waitcnt vmcnt(0)" ::: "memory");
        }
    }
    __syncthreads();
}

#define DBG_FINE (!(DBG_SEL >= 8 && DBG_SEL < 24))
#define TSTAMP(k) do { if (DBG_SEL >= 0 && (DBG_FINE || ((k) >= 8 && (k) < 24)) && F.bid == DBG_BLOCK && F.tid == 0) { volatile LAS unsigned long long* T_ = (volatile LAS unsigned long long*)(F.lds + DBG_LDS); const unsigned long long n_ = __builtin_amdgcn_s_memrealtime(); const unsigned long long m_ = __builtin_amdgcn_s_memtime(); T_[k] += n_ - T_[32]; T_[32] = n_; if ((k) < 8) { T_[24] += m_ - T_[33]; } T_[33] = m_; } } while (0)
#define TSTART() do { if (DBG_SEL >= 0 && F.bid == DBG_BLOCK && F.tid == 0) { volatile LAS unsigned long long* T_ = (volatile LAS unsigned long long*)(F.lds + DBG_LDS); T_[32] = __builtin_amdgcn_s_memrealtime(); T_[33] = __builtin_amdgcn_s_memtime(); } } while (0)
struct Frame {
    LAS unsigned char* lds;
    int tid, lane, wave, G, bid;
    const float *x, *c, *ctx, *c_ctx, *w_ada, *b_ada, *norm_g, *w_in, *mu_shift, *w0, *w2, *a0, *a2, *k_k, *k_a, *r_k, *ln_g, *ln_b, *qng, *kng, *sink, *w_out;
    float* out;
    float *MOD, *ROPE, *BON, *DBG;
    bf16 *W2T, *A2T, *WOUT, *P, *XN, *WIN, *YF, *YB, *MIX;
    unsigned char* GHQ;
};


typedef const float* cfp_t;
__device__ __forceinline__ const float* karg_f(int idx) { int off = idx * 8; asm volatile("" : "+s"(off)); const __attribute__((address_space(4))) char* kp = (const __attribute__((address_space(4))) char*)__builtin_amdgcn_kernarg_segment_ptr(); return *(const __attribute__((address_space(4))) cfp_t*)(kp + off); }
__device__ __forceinline__ void fresh(Frame& F) {
    int t_ = threadIdx.x; asm volatile("" : "+v"(t_)); F.tid = t_; F.lane = t_ & 63; F.wave = __builtin_amdgcn_readfirstlane(t_ >> 6);
    int b_ = blockIdx.x; asm volatile("" : "+s"(b_)); F.bid = b_;
    F.x = karg_f(0); F.c = karg_f(1); F.ctx = karg_f(2); F.c_ctx = karg_f(3); F.w_ada = karg_f(4); F.b_ada = karg_f(5); F.norm_g = karg_f(6); F.w_in = karg_f(7);
    F.mu_shift = karg_f(8); F.w0 = karg_f(9); F.w2 = karg_f(10); F.a0 = karg_f(11); F.a2 = karg_f(12); F.k_k = karg_f(13); F.k_a = karg_f(14); F.r_k = karg_f(15);
    F.ln_g = karg_f(16); F.ln_b = karg_f(17); F.qng = karg_f(18); F.kng = karg_f(19); F.sink = karg_f(20); F.w_out = karg_f(21);
    F.out = (float*)karg_f(22);
    unsigned char* ws = (unsigned char*)karg_f(23);
    F.MOD = (float*)(ws + WS_MOD); F.ROPE = (float*)(ws + WS_ROPE); F.BON = (float*)(ws + WS_BON); F.DBG = (float*)(ws + WS_DBG);
    F.W2T = (bf16*)(ws + WS_W2T); F.A2T = (bf16*)(ws + WS_A2T); F.WOUT = (bf16*)(ws + WS_WOUT); F.P = (bf16*)(ws + WS_P); F.XN = (bf16*)(ws + WS_XN); F.WIN = (bf16*)(ws + WS_WIN);
    F.YF = (bf16*)(ws + WS_YF); F.YB = (bf16*)(ws + WS_YB); F.MIX = (bf16*)(ws + WS_MIX); F.GHQ = ws + WS_GHQ;
}

struct Sched1 {
    int G, c;
    __device__ __forceinline__ void init(int G_, int c_) { G = G_; c = c_; }
    __device__ __forceinline__ bool next(int i, pg8::Unit& u) const {
        int grp, loc;
        if (G == 256) { if (i >= 7) return false; grp = c & 7; loc = i * 32 + (c >> 3); if (loc >= 216) { const int j = grp * 8 + (loc - 216); if (j >= 60) return false; u.pm = 64 + j / 15; const int q = j % 15; u.pn = q < 13 ? q : q + 8; return true; } }
        else { const int L = i * G + c; if (L >= 1788) return false; if (L >= 1728) { const int j = L - 1728; u.pm = 64 + j / 15; const int q = j % 15; u.pn = q < 13 ? q : q + 8; return true; } grp = L / 216; loc = L % 216; }
        u.pm = grp * 8 + (loc & 7); u.pn = loc >> 3; return true;
    }
    __device__ __forceinline__ void a_ready(const pg8::Unit&) const {}
    __device__ __forceinline__ void done(const pg8::Unit&) const {}
};

__device__ __forceinline__ void p0_transpose_item(const float* W, int K, int N, bf16* WT, LAS float* scr, int item, int lane) {
    const int nblk = N / 32, kb = item / nblk, nb = item % nblk, k0 = 64 * kb, n0 = 32 * nb;
#pragma unroll 8
    for (int i = 0; i < 32; ++i) { const int kk = 2 * i + (lane >> 5); scr[kk * 33 + (lane & 31)] = W[(size_t)(k0 + kk) * N + n0 + (lane & 31)]; }
    asm volatile("s_waitcnt lgkmcnt(0)" ::: "memory");
    const int c = lane & 7;
#pragma unroll
    for (int j = 0; j < 4; ++j) { const int n = (lane >> 3) + 8 * j; const LAS float* s = scr + (8 * c) * 33 + n;
        u32x4 o; o.x = pk2(s[0 * 33], s[1 * 33]); o.y = pk2(s[2 * 33], s[3 * 33]); o.z = pk2(s[4 * 33], s[5 * 33]); o.w = pk2(s[6 * 33], s[7 * 33]);
        *(GAS u32x4*)(WT + (size_t)(n0 + n) * K + k0 + 8 * c) = o; }
    asm volatile("s_waitcnt lgkmcnt(0)" ::: "memory");
}
__device__ __forceinline__ void p0_prologue(Frame& F) {
    const int tid = F.tid, lane = F.lane, wave = F.wave;
    if (F.bid < 192) {
        LAS float* sl = (LAS float*)F.lds;
        LAS float* red = sl + 5 * 2048;
        for (int i = tid; i < 5 * 2048; i += NWAVES * 64) { const int v = i >> 11, k = i & 2047; const float cv = v < 4 ? F.c[v * 2048 + k] : F.c_ctx[k]; sl[i] = cv / (1.0f + __expf(-cv)); }
        __syncthreads();
        const int n0 = 32 * F.bid, col = lane & 31, slot = wave * 2 + (lane >> 5);
        float acc[5] = {0.f, 0.f, 0.f, 0.f, 0.f};
        const float* wp = F.w_ada + n0 + col;
#pragma unroll 8
        for (int k = slot; k < 2048; k += 16) { const float w = wp[(size_t)k * 6144];
#pragma unroll
            for (int v = 0; v < 5; ++v) acc[v] += sl[v * 2048 + k] * w; }
#pragma unroll
        for (int v = 0; v < 5; ++v) red[(slot * 5 + v) * 32 + col] = acc[v];
        __syncthreads();
        if (tid < 160) { const int v = tid >> 5, cc = tid & 31; float s = 0.f;
#pragma unroll
            for (int q = 0; q < 16; ++q) s += red[(q * 5 + v) * 32 + cc];
            F.MOD[v * 6144 + n0 + cc] = s + F.b_ada[n0 + cc]; }
        __syncthreads();
    }
    if (F.bid == F.G - 1) {
        for (int i = tid; i < 1024; i += NWAVES * 64) { const int pos = i >> 4, f = i & 15; const float inv = exp2f(-(float)f * (13.287712379549449f / 16.0f)); const float ang = (float)pos * inv;
            F.ROPE[i] = cosf(ang); F.ROPE[1024 + i] = sinf(ang); }
    }
    LAS float* scr = (LAS float*)(F.lds + wave * 16384);
    const int gw = F.bid * NWAVES + wave, NGW = F.G * NWAVES;
    constexpr int I_IN = (DM / 64) * (NIN / 32), I_OUT = (DM / 64) * (DM / 32), I_L = 1024 / 32;
    constexpr int NITEMS = I_IN + I_OUT + 4 * I_L;
    for (int it = gw; it < NITEMS; it += NGW) {
        int r = it;
        if (r < I_IN) { p0_transpose_item(F.w_in, DM, NIN, F.WIN, scr, r, lane); continue; } r -= I_IN;
        if (r < I_OUT) { p0_transpose_item(F.w_out, DM, DM, F.WOUT, scr, r, lane); continue; } r -= I_OUT;
        const int q = r / I_L; r -= q * I_L;
        p0_transpose_item((q < 2 ? F.w2 : F.a2) + (size_t)(q & 1) * 64 * 1024, 64, 1024, (q < 2 ? F.W2T : F.A2T) + (size_t)(q & 1) * 1024 * 64, scr, r, lane);
    }
}

__device__ __forceinline__ void p1_modulate(Frame& F) {
    const int gw = F.bid * NWAVES + F.wave, NGW = F.G * NWAVES, lane = F.lane;
    const int m_lo = (int)(((long)gw * MT) / NGW), m_hi = (int)(((long)(gw + 1) * MT) / NGW);
    f32x4 gs[8], sh[8]; int cur = -1;
    for (int m = m_lo; m < m_hi; ++m) {
        const float* src = m < ML ? F.x + (size_t)m * DM : F.ctx + (size_t)(m - ML) * DM;
        const int bsel = m < ML ? (m >> 12) : 4;
        if (bsel != cur) { cur = bsel; const float* mod = F.MOD + bsel * 6144;
#pragma unroll
            for (int j = 0; j < 8; ++j) { const int d0 = (64 * j + lane) * 4; gs[j] = *(const f32x4*)(F.norm_g + d0) * (1.0f + *(const f32x4*)(mod + 2048 + d0)); sh[j] = *(const f32x4*)(mod + d0); } }
        const GAS f32x4* xr = (const GAS f32x4*)src + lane;
        f32x4 v[8]; float s = 0.f;
#pragma unroll
        for (int j = 0; j < 8; ++j) { v[j] = xr[64 * j]; s += (v[j].x * v[j].x + v[j].y * v[j].y) + (v[j].z * v[j].z + v[j].w * v[j].w); }
        const float rr = 1.0f / sqrtf(wave_sum(s) * (1.0f / DM) + 1e-6f);
        GAS u32x2* o8 = (GAS u32x2*)(F.XN + (size_t)m * DM) + lane;
#pragma unroll
        for (int j = 0; j < 8; ++j) { const f32x4 o = v[j] * rr * gs[j] + sh[j]; u32x2 w; w.x = pk2(o.x, o.y); w.y = pk2(o.z, o.w); o8[64 * j] = w; }
    }
}

__device__ __forceinline__ int seq_lo(int m) { return m < ML ? (m & ~(SEQ - 1)) : ML + ((m - ML) & ~(CTXL - 1)); }
__device__ __forceinline__ int seq_hi(int m) { return m < ML ? (m | (SEQ - 1)) : ML + ((m - ML) | (CTXL - 1)); }
__device__ __forceinline__ int scan_row(int b, int d, int blk, int tok) {
    const int j = blk < 4 ? blk * 64 + tok : (blk - 4) * 64 + tok;
    if (blk < 4) return ML + b * CTXL + (d ? (CTXL - 1 - j) : j);
    return b * SEQ + (d ? (SEQ - 1 - j) : j);
}
constexpr int CH_RS = 144, CH_MB = 64 * CH_RS;
constexpr int CB_AT = 0, CB_BT = 1, CB_KT = 2, CB_RT = 3, CB_ATT = 4, CB_BTT = 5, CB_KTT = 6, CB_VT = 7, CB_AAB = 8, CB_AABT = 9, CB_AAK = 10, CB_ARB = 11, CB_ARK = 12, CB_X1 = 13, CB_XT = 14, CB_INV = 4, CB_OY = 4, CB_OG = 5, CB_OH = 6, CB_OQ = 7;
constexpr int CH_WBUF = 8 * CH_MB, CH_ABUF = CH_WBUF + 16384;
constexpr int CH_PT = 15 * CH_MB, CH_GT = CH_PT + 1024, CH_CONST = CH_GT + 2048;
constexpr int CH_LW = 144384;
#ifndef FORCE_BF16
#define FORCE_BF16 0
#endif
constexpr size_t GHQ_ITEM = 24576;
#define LBAR() do { asm volatile("s_waitcnt lgkmcnt(0)" ::: "memory"); __builtin_amdgcn_s_barrier(); asm volatile("" ::: "memory"); } while (0)
__device__ __forceinline__ float h_lo(unsigned w) { return (float)__builtin_bit_cast(h2, w)[0]; }
__device__ __forceinline__ float h_hi(unsigned w) { return (float)__builtin_bit_cast(h2, w)[1]; }
__device__ __forceinline__ f32x4 unpack4x(bool f16, const u32x2 w) { f32x4 r;
    if (f16) { r.x = h_lo(w.x); r.y = h_hi(w.x); r.z = h_lo(w.y); r.w = h_hi(w.y); } else { r.x = bflo(w.x); r.y = bfhi(w.x); r.z = bflo(w.y); r.w = bfhi(w.y); }
    return r; }
__device__ __forceinline__ u32x4 pack8x(bool f16, const float* v) { u32x4 o;
    if (f16) { o.x = pkh(v[0], v[1]); o.y = pkh(v[2], v[3]); o.z = pkh(v[4], v[5]); o.w = pkh(v[6], v[7]); } else { o.x = pk2(v[0], v[1]); o.y = pk2(v[2], v[3]); o.z = pk2(v[4], v[5]); o.w = pk2(v[6], v[7]); }
    return o; }
__device__ __forceinline__ f32x16 mm32(bool f16, const LAS unsigned char* Aop, int mrow0, const LAS unsigned char* Blay, int nrow0, f32x16 acc, int l31, int hi) {
    const LAS unsigned char* pa = Aop + (mrow0 + l31) * CH_RS + hi * 16;
    const LAS unsigned char* pb = Blay + (nrow0 + l31) * CH_RS + hi * 16;
    bf16x8 a[4], b[4];
#pragma unroll
    for (int ks = 0; ks < 4; ++ks) { a[ks] = *(const LAS bf16x8*)(pa + ks * 32); b[ks] = *(const LAS bf16x8*)(pb + ks * 32); }
    if (f16) {
#pragma unroll
        for (int ks = 0; ks < 4; ++ks) acc = __builtin_amdgcn_mfma_f32_32x32x16_f16(__builtin_bit_cast(h8, a[ks]), __builtin_bit_cast(h8, b[ks]), acc, 0, 0, 0);
    } else {
#pragma unroll
        for (int ks = 0; ks < 4; ++ks) acc = __builtin_amdgcn_mfma_f32_32x32x16_bf16(a[ks], b[ks], acc, 0, 0, 0);
    }
    return acc;
}
__device__ __forceinline__ f32x16 mm32k(bool f16, const LAS unsigned char* Aop, int mrow0, const LAS unsigned char* Blay, int nrow0, int kb, f32x16 acc, int l31, int hi) {
    const LAS unsigned char* pa = Aop + (mrow0 + l31) * CH_RS + kb * 64 + hi * 16;
    const LAS unsigned char* pb = Blay + (nrow0 + l31) * CH_RS + kb * 64 + hi * 16;
    const bf16x8 a0 = *(const LAS bf16x8*)pa, a1 = *(const LAS bf16x8*)(pa + 32), b0 = *(const LAS bf16x8*)pb, b1 = *(const LAS bf16x8*)(pb + 32);
    if (f16) { acc = __builtin_amdgcn_mfma_f32_32x32x16_f16(__builtin_bit_cast(h8, a0), __builtin_bit_cast(h8, b0), acc, 0, 0, 0); acc = __builtin_amdgcn_mfma_f32_32x32x16_f16(__builtin_bit_cast(h8, a1), __builtin_bit_cast(h8, b1), acc, 0, 0, 0); }
    else { acc = __builtin_amdgcn_mfma_f32_32x32x16_bf16(a0, b0, acc, 0, 0, 0); acc = __builtin_amdgcn_mfma_f32_32x32x16_bf16(a1, b1, acc, 0, 0, 0); }
    return acc;
}
typedef short s16x4 __attribute__((ext_vector_type(4))); typedef short s16x8 __attribute__((ext_vector_type(8)));
__device__ __forceinline__ bf16x8 trfrag(const LAS unsigned char* Img, int j0, int c0, int lane) {
    const int g = lane >> 4, q = (lane >> 2) & 3, p = lane & 3;
    LAS unsigned char* a = (LAS unsigned char*)Img + (j0 + 8 * (g >> 1) + q) * CH_RS + (c0 + 16 * (g & 1) + 4 * p) * 2;
    const s16x4 r0 = __builtin_amdgcn_ds_read_tr16_b64_v4i16((LAS s16x4*)a), r1 = __builtin_amdgcn_ds_read_tr16_b64_v4i16((LAS s16x4*)(a + 4 * CH_RS));
    return __builtin_bit_cast(bf16x8, __builtin_shufflevector(r0, r1, 0, 1, 2, 3, 4, 5, 6, 7));
}
template<bool TA, bool TB> __device__ __forceinline__ f32x16 mm32x(bool f16, const LAS unsigned char* A, int a0, const LAS unsigned char* B, int b0, f32x16 acc, int lane) {
    const int l31 = lane & 31, hi = lane >> 5;
    bf16x8 a[4], b[4];
#pragma unroll
    for (int ks = 0; ks < 4; ++ks) {
        a[ks] = TA ? trfrag(A, 16 * ks, a0, lane) : *(const LAS bf16x8*)(A + (a0 + l31) * CH_RS + hi * 16 + ks * 32);
        b[ks] = TB ? trfrag(B, 16 * ks, b0, lane) : *(const LAS bf16x8*)(B + (b0 + l31) * CH_RS + hi * 16 + ks * 32); }
    if (f16) {
#pragma unroll
        for (int ks = 0; ks < 4; ++ks) acc = __builtin_amdgcn_mfma_f32_32x32x16_f16(__builtin_bit_cast(h8, a[ks]), __builtin_bit_cast(h8, b[ks]), acc, 0, 0, 0);
    } else {
#pragma unroll
        for (int ks = 0; ks < 4; ++ks) acc = __builtin_amdgcn_mfma_f32_32x32x16_bf16(a[ks], b[ks], acc, 0, 0, 0);
    }
    return acc;
}
__device__ __forceinline__ void st_nat(bool f16, LAS unsigned char* Out, int mrow0, int nrow0, const f32x16& acc, int l31, int hi) {
    LAS unsigned char* p = Out + (nrow0 + l31) * CH_RS + (mrow0 + 4 * hi) * 2;
    if (f16) {
#pragma unroll
        for (int rg = 0; rg < 4; ++rg) { u32x2 o; o.x = pkh(acc[4 * rg], acc[4 * rg + 1]); o.y = pkh(acc[4 * rg + 2], acc[4 * rg + 3]); *(LAS u32x2*)(p + rg * 16) = o; }
    } else {
#pragma unroll
        for (int rg = 0; rg < 4; ++rg) { u32x2 o; o.x = pk2(acc[4 * rg], acc[4 * rg + 1]); o.y = pk2(acc[4 * rg + 2], acc[4 * rg + 3]); *(LAS u32x2*)(p + rg * 16) = o; }
    }
}
__device__ __forceinline__ f32x16 zero16() { f32x16 z = {0.f, 0.f, 0.f, 0.f, 0.f, 0.f, 0.f, 0.f, 0.f, 0.f, 0.f, 0.f, 0.f, 0.f, 0.f, 0.f}; return z; }
struct ChRegs { u32x4 r, k, v, lw, la, halo; };
__device__ __forceinline__ int chunk_mlo(int b, int d, int c) { return d ? scan_row(b, d, c, 63) : scan_row(b, d, c, 0); }
__device__ __forceinline__ void ch_load(Frame& F, ChRegs& R, int b, int h, int d, int c) {
    const int tok = F.tid >> 3, ch = F.tid & 7, m = scan_row(b, d, c, tok);
    const bf16* pc = F.P + (size_t)m * NIN + 8 * ch;
    const int cr = C_R + h * 64, ck = C_K + h * 64, cv = C_V + h * 64, cw = C_LW + d * 64, ca = C_LA + d * 64;
    R.r = *(const u32x4*)(pc + cr); R.k = *(const u32x4*)(pc + ck); R.v = *(const u32x4*)(pc + cv); R.lw = *(const u32x4*)(pc + cw); R.la = *(const u32x4*)(pc + ca);
    const u32x4 z = {0u, 0u, 0u, 0u}; R.halo = z;
    if (F.tid < 80) { const int hrow = F.tid >= 40 ? 1 : 0, vec = (F.tid - 40 * hrow) >> 3, mlo = chunk_mlo(b, d, c), mh = hrow ? mlo + 64 : mlo - 1;
        const int col = vec == 0 ? cr : vec == 1 ? ck : vec == 2 ? cv : vec == 3 ? cw : ca;
        if (mh >= seq_lo(mlo) && mh <= seq_hi(mlo)) R.halo = *(const u32x4*)(F.P + (size_t)mh * NIN + col + 8 * ch); }
}
constexpr int CH_RAW3 = 0 * CH_MB, CH_RAWL = 10 * CH_MB;
__device__ __forceinline__ void ch_park(Frame& F, const ChRegs& R, int b, int d, int c) {
    LAS unsigned char* lds = F.lds; const int tok = F.tid >> 3, ch = F.tid & 7, ri = 1 + scan_row(b, d, c, tok) - chunk_mlo(b, d, c);
    LAS unsigned char* p3 = lds + CH_RAW3 + ri * 384 + ch * 16; LAS unsigned char* pl = lds + CH_RAWL + ri * 256 + ch * 16;
    *(LAS u32x4*)p3 = R.r; *(LAS u32x4*)(p3 + 128) = R.k; *(LAS u32x4*)(p3 + 256) = R.v; *(LAS u32x4*)pl = R.lw; *(LAS u32x4*)(pl + 128) = R.la;
    if (F.tid < 80) { const int hrow = F.tid >= 40 ? 1 : 0, vec = (F.tid - 40 * hrow) >> 3, rh = hrow ? 65 : 0;
        if (vec < 3) *(LAS u32x4*)(lds + CH_RAW3 + rh * 384 + vec * 128 + ch * 16) = R.halo; else *(LAS u32x4*)(lds + CH_RAWL + rh * 256 + (vec - 3) * 128 + ch * 16) = R.halo; }
}
__device__ __forceinline__ void shift8(const u32x4 c, const u32x4 p, const u32x4 n, const LAS f32x4* mu, float* o) {
    float vc[8], vp[8], vn[8]; unpack8(c, vc); unpack8(p, vp); unpack8(n, vn);
    const f32x4 m0 = mu[0], m1 = mu[1];
#pragma unroll
    for (int j = 0; j < 8; ++j) { const float mm = j < 4 ? m0[j & 3] : m1[j & 3]; o[j] = vc[j] + mm * (0.5f * (vp[j] + vn[j]) - vc[j]); }
}
template<bool F16> __device__ __forceinline__ f32x16 mf2(const u32x4 a0, const u32x4 a1, const u32x4 b0, const u32x4 b1, f32x16 acc) {
    if (F16) { acc = __builtin_amdgcn_mfma_f32_32x32x16_f16(__builtin_bit_cast(h8, a0), __builtin_bit_cast(h8, b0), acc, 0, 0, 0); acc = __builtin_amdgcn_mfma_f32_32x32x16_f16(__builtin_bit_cast(h8, a1), __builtin_bit_cast(h8, b1), acc, 0, 0, 0); }
    else { acc = __builtin_amdgcn_mfma_f32_32x32x16_bf16(__builtin_bit_cast(bf16x8, a0), __builtin_bit_cast(bf16x8, b0), acc, 0, 0, 0); acc = __builtin_amdgcn_mfma_f32_32x32x16_bf16(__builtin_bit_cast(bf16x8, a1), __builtin_bit_cast(bf16x8, b1), acc, 0, 0, 0); }
    return acc; }
template<bool F16> __device__ __forceinline__ void cv2(const f32x16& a, u32x4& s0, u32x4& s1) {
    if (F16) { s0.x = pkh(a[0], a[1]); s0.y = pkh(a[2], a[3]); s0.z = pkh(a[4], a[5]); s0.w = pkh(a[6], a[7]); s1.x = pkh(a[8], a[9]); s1.y = pkh(a[10], a[11]); s1.z = pkh(a[12], a[13]); s1.w = pkh(a[14], a[15]); }
    else { s0.x = pk2(a[0], a[1]); s0.y = pk2(a[2], a[3]); s0.z = pk2(a[4], a[5]); s0.w = pk2(a[6], a[7]); s1.x = pk2(a[8], a[9]); s1.y = pk2(a[10], a[11]); s1.z = pk2(a[12], a[13]); s1.w = pk2(a[14], a[15]); } }
template<bool F16, bool TR> __device__ __forceinline__ f32x16 inv_chain(const f32x16& ap0, const f32x16& aq0, int l31, int hi) {
    u32x4 p0, p1, q0, q1, x0, x1;
    cv2<F16>(ap0, p0, p1); cv2<F16>(aq0, q0, q1);
    f32x16 x = TR ? aq0 : ap0;
#pragma unroll
    for (int r = 0; r < 16; ++r) { const int row = (r & 3) + 8 * (r >> 2) + 4 * hi; if (row == l31) x[r] += 1.0f; }
    cv2<F16>(x, x0, x1);
#pragma unroll
    for (int k = 1; k <= 4; ++k) {
        const bool needP = (k < 4) || TR, needQ = (k < 4) || !TR;
        f32x16 ap = zero16(), aq = zero16();
        if (needP) ap = mf2<F16>(q0, q1, p0, p1, ap);
        if (needQ) aq = mf2<F16>(p0, p1, q0, q1, aq);
        if (needP) cv2<F16>(ap, p0, p1);
        if (needQ) cv2<F16>(aq, q0, q1);
        x = TR ? mf2<F16>(p0, p1, x0, x1, x) : mf2<F16>(q0, q1, x0, x1, x);
        if (k < 4) cv2<F16>(x, x0, x1);
    }
    return x;
}
template<bool F16> __device__ __forceinline__ void chain_wave(LAS unsigned char* lds, int wave, int lane, u32x4& t0, u32x4& t1) {
    const int l31 = lane & 31, hi = lane >> 5, o = wave == 2 ? 32 : 0;
    const LAS unsigned char* At = lds + CB_AT * CH_MB; const LAS unsigned char* Bt = lds + CB_BT * CH_MB;
    f32x16 aq = mm32(F16, Bt, o, At, o, zero16(), l31, hi);
    f32x16 ap = mm32(F16, At, o, Bt, o, zero16(), l31, hi);
#pragma unroll
    for (int r = 0; r < 16; ++r) { const int row = (r & 3) + 8 * (r >> 2) + 4 * hi; aq[r] = row < l31 ? aq[r] : 0.f; ap[r] = l31 < row ? ap[r] : 0.f; }
    if (wave != 3) { const f32x16 x = inv_chain<F16, true>(ap, aq, l31, hi); st_nat(F16, lds + CB_INV * CH_MB, o, o, x, l31, hi); if (wave == 2) cv2<F16>(x, t0, t1); }
    else { const f32x16 x1 = inv_chain<F16, false>(ap, aq, l31, hi);
        u32x4 b0, b1, a0, a1, u0, u1; cv2<F16>(x1, b0, b1);
        const f32x16 a21 = mm32(F16, Bt, 0, At, 32, zero16(), l31, hi);
        cv2<F16>(a21, a0, a1);
        const f32x16 u = mf2<F16>(a0, a1, b0, b1, zero16());
        cv2<F16>(u, u0, u1);
        *(LAS u32x4*)(lds + CB_AAB * CH_MB + lane * 16) = u0; *(LAS u32x4*)(lds + CB_AAB * CH_MB + 1024 + lane * 16) = u1; }
}
__device__ __forceinline__ void ch_tail(const bool f16, Frame& F, ChRegs& R, const float (&sr)[8], const float (&sk)[8], const float (&sv)[8], int b, int h, int d, int c, int chain, int ci) {
    int lane_ = F.lane; asm volatile("" : "+v"(lane_));
    const int tid = F.tid, lane = lane_, wave = F.wave, l31 = lane & 31, hi = lane >> 5;
    const int q4 = wave & 3, tb = q4 >> 1, cb = q4 & 1, tok = tid >> 3, ch = tid & 7;
    LAS unsigned char* lds = F.lds;
    const LAS f32x4* cs = (const LAS f32x4*)(lds + CH_CONST) + 2 * ch;
    const LAS float* pT = (const LAS float*)(lds + CH_PT);
#define CB(i) (lds + (i) * CH_MB)
    { const LAS f32x4* pw = (const LAS f32x4*)(lds + CH_WBUF) + tok * 16 + 2 * ch; const LAS f32x4* pab = (const LAS f32x4*)(lds + CH_ABUF) + tok * 16 + 2 * ch;
      const f32x4 p0 = pw[0], p1 = pw[1], a0v = pab[0], a1v = pab[1];
      f32x4 m0 = {1.f, 1.f, 1.f, 1.f}, m1 = m0; if (tok > 0) { m0 = pw[-16]; m1 = pw[-15]; }
      const f32x4 r0 = *(const LAS f32x4*)(pT + 64 + 8 * ch), r1 = *(const LAS f32x4*)(pT + 64 + 8 * ch + 4);
      const f32x4 kk0 = cs[80], kk1 = cs[81], ka0 = cs[96], ka1 = cs[97], rk0 = cs[112], rk1 = cs[113];
      float kk[8], ss = 0.f;
#pragma unroll
      for (int j = 0; j < 8; ++j) { kk[j] = sk[j] * (j < 4 ? kk0[j & 3] : kk1[j & 3]); ss += kk[j] * kk[j]; }
      ss += __shfl_xor(ss, 1); ss += __shfl_xor(ss, 2); ss += __shfl_xor(ss, 4);
      const float inv = __builtin_amdgcn_rsqf(fmaxf(ss, 1e-24f));
      float at[8], bt[8], kt[8], rt[8], bon = 0.f;
#pragma unroll
      for (int j = 0; j < 8; ++j) { const float P = j < 4 ? p0[j & 3] : p1[j & 3], Pm = j < 4 ? m0[j & 3] : m1[j & 3], a = j < 4 ? a0v[j & 3] : a1v[j & 3], pr = j < 4 ? r0[j & 3] : r1[j & 3];
          const float kac = j < 4 ? ka0[j & 3] : ka1[j & 3], rkc = j < 4 ? rk0[j & 3] : rk1[j & 3];
          const float kn = kk[j] * inv, kd = sk[j] * (1.0f + (a - 1.0f) * kac), ipr = __builtin_amdgcn_rcpf(pr), rp = pr * __builtin_amdgcn_rcpf(P);
          at[j] = -kn * Pm * ipr; bt[j] = kn * a * rp; kt[j] = kd * rp; rt[j] = sr[j] * P * ipr; bon += sr[j] * kd * rkc; }
      bon += __shfl_xor(bon, 1); bon += __shfl_xor(bon, 2); bon += __shfl_xor(bon, 4);
      if (ch == 0 && c >= 4) F.BON[((size_t)d * ML + scan_row(b, d, c, tok)) * 16 + h] = bon;
      *(LAS u32x4*)(CB(CB_AT) + tok * CH_RS + ch * 16) = pack8x(f16, at);
      *(LAS u32x4*)(CB(CB_BT) + tok * CH_RS + ch * 16) = pack8x(f16, bt);
      *(LAS u32x4*)(CB(CB_KT) + tok * CH_RS + ch * 16) = pack8x(f16, kt);
      *(LAS u32x4*)(CB(CB_RT) + tok * CH_RS + ch * 16) = pack8x(f16, rt);
      *(LAS u32x4*)(CB(CB_X1) + tok * CH_RS + ch * 16) = pack8x(f16, sv); }
    LBAR(); TSTAMP(3);
    const bool chainw = wave == 0 || wave == 2 || wave == 3;
    if (!chainw && ci + 1 < 34) ch_load(F, R, b, h, d, c - 1);
    u32x4 t0 = {0u, 0u, 0u, 0u}, t1 = t0;
    if (chainw) { if (f16) chain_wave<true>(lds, wave, lane, t0, t1); else chain_wave<false>(lds, wave, lane, t0, t1); }
    else { const bool mid = wave >= 4 && wave <= 6;
#pragma unroll 1
      for (int i = 0; i < 2; ++i) { if (wave == 1 && i == 1) break;
          const int pr = wave == 1 ? 1 : wave == 7 ? 2 + i : wave - 3, jb = mid ? i : 0, tbk = mid ? 1 : 0;
          const LAS unsigned char* Aop = CB((pr & 1) ? CB_KT : CB_BT); const LAS unsigned char* Blay = CB(pr < 2 ? CB_AT : CB_RT);
          LAS unsigned char* Out = CB(CB_AAB + 1 + pr);
          f32x16 a = mm32(f16, Aop, jb * 32, Blay, tbk * 32, zero16(), l31, hi);
          if (jb == tbk) { const bool incl = pr >= 2;
#pragma unroll
              for (int r = 0; r < 16; ++r) { const int j = (r & 3) + 8 * (r >> 2) + 4 * hi; const bool ok = incl ? (j <= l31) : (j < l31); a[r] = ok ? a[r] : 0.f; } }
          st_nat(f16, Out, jb * 32, tbk * 32, a, l31, hi); }
      if (wave == 1) { st_nat(f16, CB(CB_AAK), 32, 0, zero16(), l31, hi); st_nat(f16, CB(CB_INV), 32, 0, zero16(), l31, hi); }
      if (wave == 7) { st_nat(f16, CB(CB_ARB), 32, 0, zero16(), l31, hi); st_nat(f16, CB(CB_ARK), 32, 0, zero16(), l31, hi); } }
    LBAR(); TSTAMP(4);
    if ((wave == 0 || wave == 3) && ci + 1 < 34) ch_load(F, R, b, h, d, c - 1);
    if (wave == 2) { const u32x4 u0 = *(const LAS u32x4*)(CB(CB_AAB) + lane * 16), u1 = *(const LAS u32x4*)(CB(CB_AAB) + 1024 + lane * 16);
        const f32x16 y = f16 ? mf2<true>(u0, u1, t0, t1, zero16()) : mf2<false>(u0, u1, t0, t1, zero16());
        st_nat(f16, CB(CB_INV), 0, 32, y, l31, hi);
        if (ci + 1 < 34) ch_load(F, R, b, h, d, c - 1); }
    else if (wave >= 4) { const f32x16 acc = mm32x<false, true>(f16, CB(CB_AAK), tb * 32, CB(CB_X1), cb * 32, zero16(), lane); st_nat(f16, CB(CB_XT), tb * 32, cb * 32, acc, l31, hi); }
    LBAR();
    TSTAMP(5);
    { f32x16 acc = wave < 4 ? mm32x<false, true>(f16, CB(CB_INV), tb * 32, CB(CB_AT), cb * 32, zero16(), lane) : mm32(f16, CB(CB_INV), tb * 32, CB(CB_XT), cb * 32, zero16(), l31, hi);
      st_nat(f16, CB(wave < 4 ? CB_AAB : CB_AABT), tb * 32, cb * 32, acc, l31, hi); }
    LBAR(); TSTAMP(6);
    { const int om = wave >> 1, nb = wave & 1;
      int c_ = c; asm volatile("" : "+s"(c_));
#pragma unroll
      for (int mb = 0; mb < 2; ++mb) {
          if (om == 0) {
              f32x16 acc; const LAS unsigned char* p = CB(CB_RT) + (nb * 32 + l31) * CH_RS + (mb * 32 + 4 * hi) * 2;
#pragma unroll
              for (int rg = 0; rg < 4; ++rg) { const u32x2 w = *(const LAS u32x2*)(p + rg * 16); const f32x4 u = unpack4x(f16, w); acc[4 * rg] = u.x; acc[4 * rg + 1] = u.y; acc[4 * rg + 2] = u.z; acc[4 * rg + 3] = u.w; }
              acc = mm32(f16, CB(CB_AAB), mb * 32, CB(CB_ARB), nb * 32, acc, l31, hi);
              LAS unsigned char* o = CB(CB_OQ) + (nb * 32 + l31) * CH_RS + (mb * 32 + 4 * hi) * 2;
#pragma unroll
              for (int rg = 0; rg < 4; ++rg) { const f32x4 pv = *(const LAS f32x4*)(pT + 64 + mb * 32 + 8 * rg + 4 * hi);
                  u32x2 w; w.x = pkh(acc[4 * rg] * pv.x, acc[4 * rg + 1] * pv.y); w.y = pkh(acc[4 * rg + 2] * pv.z, acc[4 * rg + 3] * pv.w); *(LAS u32x2*)(o + rg * 16) = w; }
          } else if (om == 1) {
              f32x16 acc = mm32x<false, true>(f16, CB(CB_AAB), mb * 32, CB(CB_BT), nb * 32, zero16(), lane);
              const float pto = pT[nb * 32 + l31], ptk = pT[128 + nb * 32 + l31];
              LAS unsigned char* o = CB(CB_OG) + (nb * 32 + l31) * CH_RS + (mb * 32 + 4 * hi) * 2;
#pragma unroll
              for (int rg = 0; rg < 4; ++rg) { const f32x4 pv = *(const LAS f32x4*)(pT + 64 + mb * 32 + 8 * rg + 4 * hi); float g[4];
#pragma unroll
                  for (int i = 0; i < 4; ++i) { const int kp = mb * 32 + 8 * rg + 4 * hi + i; g[i] = pto * pv[i] * acc[4 * rg + i] + (kp == nb * 32 + l31 ? ptk : 0.0f); }
                  u32x2 w; w.x = pkh(g[0], g[1]); w.y = pkh(g[2], g[3]); *(LAS u32x2*)(o + rg * 16) = w; }
          } else if (om == 2) {
              f32x16 acc = mm32x<true, false>(f16, CB(CB_BT), mb * 32, CB(CB_AABT), nb * 32, zero16(), lane);
              acc = mm32x<true, true>(f16, CB(CB_KT), mb * 32, CB(CB_X1), nb * 32, acc, lane);
              LAS unsigned char* o = CB(CB_OH) + (nb * 32 + l31) * CH_RS + (mb * 32 + 4 * hi) * 2;
#pragma unroll
              for (int rg = 0; rg < 4; ++rg) { const f32x4 pv = *(const LAS f32x4*)(pT + mb * 32 + 8 * rg + 4 * hi);
                  u32x2 w; w.x = pkh(acc[4 * rg] * pv.x, acc[4 * rg + 1] * pv.y); w.y = pkh(acc[4 * rg + 2] * pv.z, acc[4 * rg + 3] * pv.w); *(LAS u32x2*)(o + rg * 16) = w; }
          } else if (c_ >= 4) {
              f32x16 acc = mm32(f16, CB(CB_AABT), mb * 32, CB(CB_ARB), nb * 32, zero16(), l31, hi);
              acc = mm32x<true, false>(f16, CB(CB_X1), mb * 32, CB(CB_ARK), nb * 32, acc, lane);
              LAS unsigned char* yp = CB(CB_OY) + (nb * 32 + l31) * CH_RS + (mb * 32 + 4 * hi) * 2;
#pragma unroll
              for (int rg = 0; rg < 4; ++rg) { u32x2 w; w.x = pkh(acc[4 * rg], acc[4 * rg + 1]); w.y = pkh(acc[4 * rg + 2], acc[4 * rg + 3]); *(LAS u32x2*)(yp + rg * 16) = w; }
          }
      } }
    LBAR();
    { int c_ = c; asm volatile("" : "+s"(c_));
      unsigned char* gq = (unsigned char*)F.GHQ + ((size_t)chain * 68 + c_) * GHQ_ITEM + tok * 128 + ch * 16; const int lo = tok * CH_RS + ch * 16;
      *(u32x4*)gq = *(const LAS u32x4*)(CB(CB_OG) + lo); *(u32x4*)(gq + 8192) = *(const LAS u32x4*)(CB(CB_OH) + lo); *(u32x4*)(gq + 16384) = *(const LAS u32x4*)(CB(CB_OQ) + lo);
      if (c_ >= 4) *(u32x4*)((unsigned char*)(d ? F.YB : F.YF) + (size_t)scan_row(b, d, c_, tok) * 2048 + h * 128 + ch * 16) = *(const LAS u32x4*)(CB(CB_OY) + lo); }
    TSTAMP(7);
#undef CB
}

__device__ __forceinline__ void p3_chunkA(Frame& F) {
    const int tid = F.tid, lane = F.lane, wave = F.wave, l31 = lane & 31, hi = lane >> 5;
    LAS unsigned char* lds = F.lds;
#define CB(i) (lds + (i) * CH_MB)
    for (int g = F.bid; g < 256; g += F.G) {
        const int chain = g >> 1, c0 = (g & 1) * 34, d = chain & 1, h = (chain >> 1) & 15, b = chain >> 5;
        { const int q = tid >> 6, n = tid & 63, c = h * 64 + n;
          const float val = q == 0 ? F.mu_shift[C_R + c] : q == 1 ? F.mu_shift[C_K + c] : q == 2 ? F.mu_shift[C_V + c] : q == 3 ? F.mu_shift[C_LW + d * 64 + n] : q == 4 ? F.mu_shift[C_LA + d * 64 + n] : q == 5 ? F.k_k[c] : q == 6 ? F.k_a[c] : F.r_k[c];
          ((LAS float*)(lds + CH_CONST))[tid] = val; }
        const int q4 = wave & 3, tb = q4 >> 1, cb = q4 & 1;
        { const int row = tid >> 3, chk = tid & 7;
          *(LAS u32x4*)(lds + CH_LW + row * CH_RS + chk * 16) = *(const u32x4*)(F.W2T + ((size_t)d * 1024 + h * 64 + row) * 64 + 8 * chk);
          *(LAS u32x4*)(lds + CH_LW + CH_MB + row * CH_RS + chk * 16) = *(const u32x4*)(F.A2T + ((size_t)d * 1024 + h * 64 + row) * 64 + 8 * chk); }
        const float lbias = (wave < 4 ? F.w0 : F.a0)[d * 1024 + h * 64 + cb * 32 + l31];
        LBAR();
        ChRegs R;
        ch_load(F, R, b, h, d, c0 + 33);
#pragma unroll 1
        for (int ci = 0; ci < 34; ++ci) {
            const int c = c0 + 33 - ci;
            const int tok = tid >> 3, ch = tid & 7;
            const LAS f32x4* cs = (const LAS f32x4*)(lds + CH_CONST) + 2 * ch;
            float sr[8], sk[8], sv[8];
            ch_park(F, R, b, d, c);
            LBAR();
            { float slw[8], sla[8];
              const int ri = 1 + scan_row(b, d, c, tok) - chunk_mlo(b, d, c);
              const LAS unsigned char* p3 = lds + CH_RAW3 + ri * 384 + ch * 16; const LAS unsigned char* pl = lds + CH_RAWL + ri * 256 + ch * 16;
              shift8(R.r, *(const LAS u32x4*)(p3 - 384), *(const LAS u32x4*)(p3 + 384), cs, sr); shift8(R.k, *(const LAS u32x4*)(p3 - 384 + 128), *(const LAS u32x4*)(p3 + 384 + 128), cs + 16, sk);
              shift8(R.v, *(const LAS u32x4*)(p3 - 384 + 256), *(const LAS u32x4*)(p3 + 384 + 256), cs + 32, sv);
              shift8(R.lw, *(const LAS u32x4*)(pl - 256), *(const LAS u32x4*)(pl + 256), cs + 48, slw); shift8(R.la, *(const LAS u32x4*)(pl - 256 + 128), *(const LAS u32x4*)(pl + 256 + 128), cs + 64, sla);
#pragma unroll
              for (int j = 0; j < 8; ++j) slw[j] = 1.0f - 2.0f * __builtin_amdgcn_rcpf(1.0f + fast_exp(2.0f * slw[j]));
              u32x4 o; o.x = pk2(slw[0], slw[1]); o.y = pk2(slw[2], slw[3]); o.z = pk2(slw[4], slw[5]); o.w = pk2(slw[6], slw[7]); *(LAS u32x4*)(CB(CB_X1) + tok * CH_RS + ch * 16) = o;
              o.x = pk2(sla[0], sla[1]); o.y = pk2(sla[2], sla[3]); o.z = pk2(sla[4], sla[5]); o.w = pk2(sla[6], sla[7]); *(LAS u32x4*)(CB(CB_XT) + tok * CH_RS + ch * 16) = o; }
            LBAR(); TSTAMP(0);
            { f32x16 acc = zero16();
              const LAS unsigned char* pa = CB(wave < 4 ? CB_X1 : CB_XT) + (tb * 32 + l31) * CH_RS + hi * 16;
              const LAS unsigned char* pw2 = lds + CH_LW + (wave < 4 ? 0 : CH_MB) + (cb * 32 + l31) * CH_RS + hi * 16;
#pragma unroll
              for (int ks = 0; ks < 4; ++ks) acc = __builtin_amdgcn_mfma_f32_32x32x16_bf16(*(const LAS bf16x8*)(pa + ks * 32), *(const LAS bf16x8*)(pw2 + ks * 32), acc, 0, 0, 0);
              LAS float* dst = (LAS float*)(lds + (wave < 4 ? CH_WBUF : CH_ABUF)) + cb * 32 + l31;
#pragma unroll
              for (int r = 0; r < 16; ++r) { const int t = tb * 32 + (r & 3) + 8 * (r >> 2) + 4 * hi; const float sg = sigmoidf_(acc[r] + lbias);
                  dst[t * 64] = wave < 4 ? fast_exp(-0.6065306597126334f * sg) : sg; } }
            LBAR(); TSTAMP(1);
            { LAS float* wb = (LAS float*)(lds + CH_WBUF) + (wave * 8) * 64 + (tid & 63); LAS float* gt = (LAS float*)(lds + CH_GT);
              float q[8]; q[0] = wb[0];
#pragma unroll
              for (int i = 1; i < 8; ++i) q[i] = q[i - 1] * wb[i * 64];
              gt[wave * 64 + (tid & 63)] = q[7];
              LBAR();
              float pre = 1.0f, p31 = 1.0f;
#pragma unroll
              for (int gg = 0; gg < 7; ++gg) { const float tv = gt[gg * 64 + (tid & 63)]; pre = gg < wave ? pre * tv : pre; p31 = gg < 4 ? p31 * tv : p31; }
#pragma unroll
              for (int i = 0; i < 8; ++i) wb[i * 64] = pre * q[i];
              if (wave == 7) { const float p63 = pre * q[7]; LAS float* pt = (LAS float*)(lds + CH_PT);
                  pt[tid & 63] = p63 / p31;
                  pt[64 + (tid & 63)] = p31;
                  pt[128 + (tid & 63)] = p63;
                  const bool ok = !FORCE_BF16 && p31 > 2.44140625e-4f && p63 > 2.44140625e-4f * p31;
                  if ((tid & 63) == 0) ((LAS unsigned*)pt)[192] = __all(ok) ? 1u : 0u; else (void)__all(ok); } }
            LBAR(); TSTAMP(2);
            { const bool f16 = __builtin_amdgcn_readfirstlane((int)((const LAS unsigned*)(lds + CH_PT))[192]) != 0;
              ch_tail(f16, F, R, sr, sk, sv, b, h, d, c, chain, ci); }
        }
    }
#undef CB
}

constexpr int BL_SLOT = 2 * CH_MB, BL_SLOTB = 4 * CH_MB, BL_YB = BL_SLOT + 2 * BL_SLOTB;
__device__ __forceinline__ void p4_chunkB(Frame& F) {
    const int lane = F.lane, wave = F.wave, l31 = lane & 31, hi = lane >> 5, srow = F.tid >> 3, sch = F.tid & 7;
    LAS unsigned char* lds = F.lds;
    for (int chain = F.bid; chain < 128; chain += F.G) {
        const int d = chain & 1, h = (chain >> 1) & 15, b = chain >> 5;
        const int q4 = wave & 3, mb = q4 >> 1, nb = q4 & 1;
        for (int i = F.tid; i < 2 * CH_MB / 4; i += NWAVES * 64) ((LAS unsigned*)lds)[i] = 0u;
        const unsigned char* gq0 = (const unsigned char*)F.GHQ + (size_t)chain * 68 * GHQ_ITEM;
        unsigned char* Yb = (unsigned char*)(d ? F.YB : F.YF) + h * 128;
        u32x4 Ra0, Ra1, Ra2, Ra3, Rb0, Rb1, Rb2, Rb3;
        { int c__ = (0); c__ = c__ < 67 ? c__ : 67; const unsigned char* gq = gq0 + (size_t)c__ * GHQ_ITEM + srow * 128 + sch * 16; const int cy = c__ < 4 ? 4 : c__;
              Ra0 = *(const u32x4*)gq; Ra1 = *(const u32x4*)(gq + 8192); Ra2 = *(const u32x4*)(gq + 16384);
              Ra3 = *(const u32x4*)(Yb + (size_t)scan_row(b, d, cy, srow) * 2048 + sch * 16); }
        { LAS unsigned char* sn = lds + BL_SLOT + srow * CH_RS + sch * 16; *(LAS u32x4*)sn = Ra0; *(LAS u32x4*)(sn + CH_MB) = Ra1; *(LAS u32x4*)(sn + 2 * CH_MB) = Ra2; *(LAS u32x4*)(sn + 3 * CH_MB) = Ra3; }
        { int c__ = (1); c__ = c__ < 67 ? c__ : 67; const unsigned char* gq = gq0 + (size_t)c__ * GHQ_ITEM + srow * 128 + sch * 16; const int cy = c__ < 4 ? 4 : c__;
              Ra0 = *(const u32x4*)gq; Ra1 = *(const u32x4*)(gq + 8192); Ra2 = *(const u32x4*)(gq + 16384);
              Ra3 = *(const u32x4*)(Yb + (size_t)scan_row(b, d, cy, srow) * 2048 + sch * 16); }
        { int c__ = (2); c__ = c__ < 67 ? c__ : 67; const unsigned char* gq = gq0 + (size_t)c__ * GHQ_ITEM + srow * 128 + sch * 16; const int cy = c__ < 4 ? 4 : c__;
              Rb0 = *(const u32x4*)gq; Rb1 = *(const u32x4*)(gq + 8192); Rb2 = *(const u32x4*)(gq + 16384);
              Rb3 = *(const u32x4*)(Yb + (size_t)scan_row(b, d, cy, srow) * 2048 + sch * 16); }
        LBAR();
#pragma unroll 1
        for (int c = 0; c < 68; c += 4) {
            { const int c_ = (c);
              LAS unsigned char* sn = lds + BL_SLOT + ((c_ + 1) & 1) * BL_SLOTB + srow * CH_RS + sch * 16;
              *(LAS u32x4*)sn = Ra0; *(LAS u32x4*)(sn + CH_MB) = Ra1; *(LAS u32x4*)(sn + 2 * CH_MB) = Ra2; *(LAS u32x4*)(sn + 3 * CH_MB) = Ra3;
              { int c__ = (c_ + 3); c__ = c__ < 67 ? c__ : 67; const unsigned char* gq = gq0 + (size_t)c__ * GHQ_ITEM + srow * 128 + sch * 16; const int cy = c__ < 4 ? 4 : c__;
              Ra0 = *(const u32x4*)gq; Ra1 = *(const u32x4*)(gq + 8192); Ra2 = *(const u32x4*)(gq + 16384);
              Ra3 = *(const u32x4*)(Yb + (size_t)scan_row(b, d, cy, srow) * 2048 + sch * 16); }
              if (c_ >= 5) { const u32x4 yv = *(const LAS u32x4*)(lds + BL_YB + ((c_ - 1) & 1) * CH_MB + srow * CH_RS + sch * 16);
                  *(u32x4*)(Yb + (size_t)scan_row(b, d, c_ - 1, srow) * 2048 + sch * 16) = yv; }
              const LAS unsigned char* sc = lds + BL_SLOT + (c_ & 1) * BL_SLOTB; const LAS unsigned char* zc = lds + (c_ & 1) * CH_MB; LAS unsigned char* zn = lds + ((c_ + 1) & 1) * CH_MB;
              if (wave < 4) {
                  f32x16 acc; const LAS unsigned char* ph = sc + CH_MB + (nb * 32 + l31) * CH_RS + (mb * 32 + 4 * hi) * 2;
#pragma unroll
                  for (int rg = 0; rg < 4; ++rg) { const u32x2 w = *(const LAS u32x2*)(ph + rg * 16); acc[4 * rg] = h_lo(w.x); acc[4 * rg + 1] = h_hi(w.x); acc[4 * rg + 2] = h_lo(w.y); acc[4 * rg + 3] = h_hi(w.y); }
                  acc = mm32(true, sc, mb * 32, zc, nb * 32, acc, l31, hi);
                  st_nat(true, zn, mb * 32, nb * 32, acc, l31, hi);
              } else if (c_ >= 4) {
                  f32x16 acc; const LAS unsigned char* py = sc + 3 * CH_MB + (nb * 32 + l31) * CH_RS + (mb * 32 + 4 * hi) * 2;
#pragma unroll
                  for (int rg = 0; rg < 4; ++rg) { const u32x2 w = *(const LAS u32x2*)(py + rg * 16); acc[4 * rg] = h_lo(w.x); acc[4 * rg + 1] = h_hi(w.x); acc[4 * rg + 2] = h_lo(w.y); acc[4 * rg + 3] = h_hi(w.y); }
                  acc = mm32(true, zc, mb * 32, sc + 2 * CH_MB, nb * 32, acc, l31, hi);
                  st_nat(true, lds + BL_YB + (c_ & 1) * CH_MB, mb * 32, nb * 32, acc, l31, hi);
              }
              LBAR(); }
            { const int c_ = (c + 1);
              LAS unsigned char* sn = lds + BL_SLOT + ((c_ + 1) & 1) * BL_SLOTB + srow * CH_RS + sch * 16;
              *(LAS u32x4*)sn = Rb0; *(LAS u32x4*)(sn + CH_MB) = Rb1; *(LAS u32x4*)(sn + 2 * CH_MB) = Rb2; *(LAS u32x4*)(sn + 3 * CH_MB) = Rb3;
              { int c__ = (c_ + 3); c__ = c__ < 67 ? c__ : 67; const unsigned char* gq = gq0 + (size_t)c__ * GHQ_ITEM + srow * 128 + sch * 16; const int cy = c__ < 4 ? 4 : c__;
              Rb0 = *(const u32x4*)gq; Rb1 = *(const u32x4*)(gq + 8192); Rb2 = *(const u32x4*)(gq + 16384);
              Rb3 = *(const u32x4*)(Yb + (size_t)scan_row(b, d, cy, srow) * 2048 + sch * 16); }
              if (c_ >= 5) { const u32x4 yv = *(const LAS u32x4*)(lds + BL_YB + ((c_ - 1) & 1) * CH_MB + srow * CH_RS + sch * 16);
                  *(u32x4*)(Yb + (size_t)scan_row(b, d, c_ - 1, srow) * 2048 + sch * 16) = yv; }
              const LAS unsigned char* sc = lds + BL_SLOT + (c_ & 1) * BL_SLOTB; const LAS unsigned char* zc = lds + (c_ & 1) * CH_MB; LAS unsigned char* zn = lds + ((c_ + 1) & 1) * CH_MB;
              if (wave < 4) {
                  f32x16 acc; const LAS unsigned char* ph = sc + CH_MB + (nb * 32 + l31) * CH_RS + (mb * 32 + 4 * hi) * 2;
#pragma unroll
                  for (int rg = 0; rg < 4; ++rg) { const u32x2 w = *(const LAS u32x2*)(ph + rg * 16); acc[4 * rg] = h_lo(w.x); acc[4 * rg + 1] = h_hi(w.x); acc[4 * rg + 2] = h_lo(w.y); acc[4 * rg + 3] = h_hi(w.y); }
                  acc = mm32(true, sc, mb * 32, zc, nb * 32, acc, l31, hi);
                  st_nat(true, zn, mb * 32, nb * 32, acc, l31, hi);
              } else if (c_ >= 4) {
                  f32x16 acc; const LAS unsigned char* py = sc + 3 * CH_MB + (nb * 32 + l31) * CH_RS + (mb * 32 + 4 * hi) * 2;
#pragma unroll
                  for (int rg = 0; rg < 4; ++rg) { const u32x2 w = *(const LAS u32x2*)(py + rg * 16); acc[4 * rg] = h_lo(w.x); acc[4 * rg + 1] = h_hi(w.x); acc[4 * rg + 2] = h_lo(w.y); acc[4 * rg + 3] = h_hi(w.y); }
                  acc = mm32(true, zc, mb * 32, sc + 2 * CH_MB, nb * 32, acc, l31, hi);
                  st_nat(true, lds + BL_YB + (c_ & 1) * CH_MB, mb * 32, nb * 32, acc, l31, hi);
              }
              LBAR(); }
            { const int c_ = (c + 2);
              LAS unsigned char* sn = lds + BL_SLOT + ((c_ + 1) & 1) * BL_SLOTB + srow * CH_RS + sch * 16;
              *(LAS u32x4*)sn = Ra0; *(LAS u32x4*)(sn + CH_MB) = Ra1; *(LAS u32x4*)(sn + 2 * CH_MB) = Ra2; *(LAS u32x4*)(sn + 3 * CH_MB) = Ra3;
              { int c__ = (c_ + 3); c__ = c__ < 67 ? c__ : 67; const unsigned char* gq = gq0 + (size_t)c__ * GHQ_ITEM + srow * 128 + sch * 16; const int cy = c__ < 4 ? 4 : c__;
              Ra0 = *(const u32x4*)gq; Ra1 = *(const u32x4*)(gq + 8192); Ra2 = *(const u32x4*)(gq + 16384);
              Ra3 = *(const u32x4*)(Yb + (size_t)scan_row(b, d, cy, srow) * 2048 + sch * 16); }
              if (c_ >= 5) { const u32x4 yv = *(const LAS u32x4*)(lds + BL_YB + ((c_ - 1) & 1) * CH_MB + srow * CH_RS + sch * 16);
                  *(u32x4*)(Yb + (size_t)scan_row(b, d, c_ - 1, srow) * 2048 + sch * 16) = yv; }
              const LAS unsigned char* sc = lds + BL_SLOT + (c_ & 1) * BL_SLOTB; const LAS unsigned char* zc = lds + (c_ & 1) * CH_MB; LAS unsigned char* zn = lds + ((c_ + 1) & 1) * CH_MB;
              if (wave < 4) {
                  f32x16 acc; const LAS unsigned char* ph = sc + CH_MB + (nb * 32 + l31) * CH_RS + (mb * 32 + 4 * hi) * 2;
#pragma unroll
                  for (int rg = 0; rg < 4; ++rg) { const u32x2 w = *(const LAS u32x2*)(ph + rg * 16); acc[4 * rg] = h_lo(w.x); acc[4 * rg + 1] = h_hi(w.x); acc[4 * rg + 2] = h_lo(w.y); acc[4 * rg + 3] = h_hi(w.y); }
                  acc = mm32(true, sc, mb * 32, zc, nb * 32, acc, l31, hi);
                  st_nat(true, zn, mb * 32, nb * 32, acc, l31, hi);
              } else if (c_ >= 4) {
                  f32x16 acc; const LAS unsigned char* py = sc + 3 * CH_MB + (nb * 32 + l31) * CH_RS + (mb * 32 + 4 * hi) * 2;
#pragma unroll
                  for (int rg = 0; rg < 4; ++rg) { const u32x2 w = *(const LAS u32x2*)(py + rg * 16); acc[4 * rg] = h_lo(w.x); acc[4 * rg + 1] = h_hi(w.x); acc[4 * rg + 2] = h_lo(w.y); acc[4 * rg + 3] = h_hi(w.y); }
                  acc = mm32(true, zc, mb * 32, sc + 2 * CH_MB, nb * 32, acc, l31, hi);
                  st_nat(true, lds + BL_YB + (c_ & 1) * CH_MB, mb * 32, nb * 32, acc, l31, hi);
              }
              LBAR(); }
            { const int c_ = (c + 3);
              LAS unsigned char* sn = lds + BL_SLOT + ((c_ + 1) & 1) * BL_SLOTB + srow * CH_RS + sch * 16;
              *(LAS u32x4*)sn = Rb0; *(LAS u32x4*)(sn + CH_MB) = Rb1; *(LAS u32x4*)(sn + 2 * CH_MB) = Rb2; *(LAS u32x4*)(sn + 3 * CH_MB) = Rb3;
              { int c__ = (c_ + 3); c__ = c__ < 67 ? c__ : 67; const unsigned char* gq = gq0 + (size_t)c__ * GHQ_ITEM + srow * 128 + sch * 16; const int cy = c__ < 4 ? 4 : c__;
              Rb0 = *(const u32x4*)gq; Rb1 = *(const u32x4*)(gq + 8192); Rb2 = *(const u32x4*)(gq + 16384);
              Rb3 = *(const u32x4*)(Yb + (size_t)scan_row(b, d, cy, srow) * 2048 + sch * 16); }
              if (c_ >= 5) { const u32x4 yv = *(const LAS u32x4*)(lds + BL_YB + ((c_ - 1) & 1) * CH_MB + srow * CH_RS + sch * 16);
                  *(u32x4*)(Yb + (size_t)scan_row(b, d, c_ - 1, srow) * 2048 + sch * 16) = yv; }
              const LAS unsigned char* sc = lds + BL_SLOT + (c_ & 1) * BL_SLOTB; const LAS unsigned char* zc = lds + (c_ & 1) * CH_MB; LAS unsigned char* zn = lds + ((c_ + 1) & 1) * CH_MB;
              if (wave < 4) {
                  f32x16 acc; const LAS unsigned char* ph = sc + CH_MB + (nb * 32 + l31) * CH_RS + (mb * 32 + 4 * hi) * 2;
#pragma unroll
                  for (int rg = 0; rg < 4; ++rg) { const u32x2 w = *(const LAS u32x2*)(ph + rg * 16); acc[4 * rg] = h_lo(w.x); acc[4 * rg + 1] = h_hi(w.x); acc[4 * rg + 2] = h_lo(w.y); acc[4 * rg + 3] = h_hi(w.y); }
                  acc = mm32(true, sc, mb * 32, zc, nb * 32, acc, l31, hi);
                  st_nat(true, zn, mb * 32, nb * 32, acc, l31, hi);
              } else if (c_ >= 4) {
                  f32x16 acc; const LAS unsigned char* py = sc + 3 * CH_MB + (nb * 32 + l31) * CH_RS + (mb * 32 + 4 * hi) * 2;
#pragma unroll
                  for (int rg = 0; rg < 4; ++rg) { const u32x2 w = *(const LAS u32x2*)(py + rg * 16); acc[4 * rg] = h_lo(w.x); acc[4 * rg + 1] = h_hi(w.x); acc[4 * rg + 2] = h_lo(w.y); acc[4 * rg + 3] = h_hi(w.y); }
                  acc = mm32(true, zc, mb * 32, sc + 2 * CH_MB, nb * 32, acc, l31, hi);
                  st_nat(true, lds + BL_YB + (c_ & 1) * CH_MB, mb * 32, nb * 32, acc, l31, hi);
              }
              LBAR(); }
        }
        { const u32x4 yv = *(const LAS u32x4*)(lds + BL_YB + CH_MB + srow * CH_RS + sch * 16); *(u32x4*)(Yb + (size_t)scan_row(b, d, 67, srow) * 2048 + sch * 16) = yv; }
        LBAR();
    }
}

constexpr int AT_K = 0, AT_V = 16384, AT_BUF = 16384 + 64 * 272;
struct KVRegs { u32x4 k1, k2, v0, v1; };
__device__ __forceinline__ void at_load(Frame& F, KVRegs& R, int mrow0, int kvh) {
    const int tid = F.tid;
    { const int key = tid >> 2, q4 = tid & 3, a = q4 >> 1, e = q4 & 1;
      const bf16* p = F.P + (size_t)(mrow0 + key) * NIN + C_KA + kvh * 64 + a * 32 + 8 * e; R.k1 = *(const u32x4*)p; R.k2 = *(const u32x4*)(p + 16); }
    { const int kp = tid >> 3, dc = tid & 7; const bf16* p = F.P + (size_t)(mrow0 + 2 * kp) * NIN + C_VA + kvh * 64 + 8 * dc; R.v0 = *(const u32x4*)p; R.v1 = *(const u32x4*)(p + NIN); }
}
__device__ __forceinline__ void qkprep_one(Frame& F, bf16* p, int a, int e, int kpos, bool rope, const float* gain, float scale) {
    float x1[8], x2[8]; unpack8(*(const u32x4*)p, x1); unpack8(*(const u32x4*)(p + 16), x2);
    float ss = 0.f;
#pragma unroll
    for (int j = 0; j < 8; ++j) ss += x1[j] * x1[j] + x2[j] * x2[j];
    ss += __shfl_xor(ss, 1); ss += __shfl_xor(ss, 2);
    const float rr = scale / sqrtf(ss * (1.0f / 64.0f) + 1e-6f);
    const int pos = a == 0 ? (kpos >> 6) : (kpos & 63);
#pragma unroll
    for (int j = 0; j < 8; ++j) { float y1 = x1[j] * rr * gain[a * 32 + 8 * e + j], y2 = x2[j] * rr * gain[a * 32 + 16 + 8 * e + j];
        if (rope) { const float c = F.ROPE[pos * 16 + 8 * e + j], sn = F.ROPE[1024 + pos * 16 + 8 * e + j]; const float t1 = y1 * c - y2 * sn, t2 = y2 * c + y1 * sn; y1 = t1; y2 = t2; }
        x1[j] = y1; x2[j] = y2; }
    u32x4 o; o.x = pk2(x1[0], x1[1]); o.y = pk2(x1[2], x1[3]); o.z = pk2(x1[4], x1[5]); o.w = pk2(x1[6], x1[7]); *(u32x4*)p = o;
    o.x = pk2(x2[0], x2[1]); o.y = pk2(x2[2], x2[3]); o.z = pk2(x2[4], x2[5]); o.w = pk2(x2[6], x2[7]); *(u32x4*)(p + 16) = o;
}
__device__ __forceinline__ void kprep(Frame& F) {
    const int total = F.G * NWAVES * 64;
    for (int idx = F.bid * NWAVES * 64 + F.tid; idx < MT * 16; idx += total) {
        const int q4 = idx & 3, kvh = (idx >> 2) & 3, m = idx >> 4, a = q4 >> 1, e = q4 & 1;
        qkprep_one(F, F.P + (size_t)m * NIN + C_KA + kvh * 64 + a * 32 + 8 * e, a, e, m & (SEQ - 1), m < ML, F.kng, 1.0f);
    }
}
__device__ __forceinline__ void at_write(Frame& F, const KVRegs& R, LAS unsigned char* buf) {
    const int tid = F.tid;
    { const int key = tid >> 2, q4 = tid & 3, a = q4 >> 1, e = q4 & 1;
      const int c1 = 4 * a + e, c2 = c1 + 2, sw = (key >> 1) & 7;
      *(LAS u32x4*)(buf + AT_K + key * 128 + ((c1 ^ sw) << 4)) = R.k1; *(LAS u32x4*)(buf + AT_K + key * 128 + ((c2 ^ sw) << 4)) = R.k2; }
    { const int kp = tid >> 3, dc = tid & 7, kq = kp >> 1;
        const int pos0 = (kq >> 2) * 16 + (kq & 1) * 8 + ((kq >> 1) & 1) * 4 + (kp & 1) * 2;
#pragma unroll
        for (int w = 0; w < 4; ++w) {
            const unsigned a0 = R.v0[w], a1 = R.v1[w];
            *(LAS unsigned*)(buf + AT_V + (8 * dc + 2 * w) * 272 + pos0 * 2) = __builtin_amdgcn_perm(a1, a0, 0x05040100u);
            *(LAS unsigned*)(buf + AT_V + (8 * dc + 2 * w + 1) * 272 + pos0 * 2) = __builtin_amdgcn_perm(a1, a0, 0x07060302u); }
    }
}
#ifndef ATTN_POOL
#define ATTN_POOL 0
#endif
#ifndef ATTN_BOUND
#define ATTN_BOUND 60.0f
#endif
template<bool NOMAX> __device__ __forceinline__ void p4_attn_t(Frame& F, int item) {
    const int n = item & 31, kvh = (item >> 5) & 3, b = item >> 7;
    const int lane = F.lane, wave = F.wave, l31 = lane & 31, hi = lane >> 5;
    const int hh = kvh * 4 + (wave >> 1), qloc = (wave & 1) * 64;
    LAS unsigned char* lds = F.lds;
    const int kfirst = n > 0 ? 0 : 1, nbnd = 3 - (n == 0 ? 1 : 0) - (n == 31 ? 1 : 0), nt = nbnd + 2;
#define TL_KIND(t) ((t) < nbnd ? kfirst + (t) : 3)
#define TL_ROW(t) ((t) < nbnd ? b * SEQ + (n - 1 + kfirst + (t)) * 128 : ML + b * CTXL + ((t) - nbnd) * 128)
#define TL_KPOS(t) ((t) < nbnd ? (n - 1 + kfirst + (t)) * 128 : 0)
    if (DBG_FINE) TSTART();
    KVRegs R;
    at_load(F, R, TL_ROW(0), kvh);
    LAS unsigned char* qbase = lds + 2 * AT_BUF + wave * 8192;
    LAS unsigned char* qlds = qbase + lane * 16;
    { const int rowl = lane >> 2, q4 = lane & 3, a = q4 >> 1, e = q4 & 1;
      const bf16* src = F.P + (size_t)(b * SEQ + n * 128 + qloc + rowl) * NIN + C_Q + hh * 64 + a * 32 + 8 * e;
      u32x4 r1[4], r2[4];
#pragma unroll
      for (int ps = 0; ps < 4; ++ps) { r1[ps] = *(const u32x4*)(src + (size_t)(16 * ps) * NIN); r2[ps] = *(const u32x4*)(src + (size_t)(16 * ps) * NIN + 16); }
      float g1[8], g2[8];
      { const f32x4 a0 = *(const f32x4*)(F.qng + a * 32 + 8 * e), a1 = *(const f32x4*)(F.qng + a * 32 + 8 * e + 4), b0 = *(const f32x4*)(F.qng + a * 32 + 16 + 8 * e), b1 = *(const f32x4*)(F.qng + a * 32 + 16 + 8 * e + 4);
#pragma unroll
        for (int j = 0; j < 4; ++j) { g1[j] = a0[j]; g1[4 + j] = a1[j]; g2[j] = b0[j]; g2[4 + j] = b1[j]; } }
#pragma unroll
      for (int ps = 0; ps < 4; ++ps) {
          const int r = 16 * ps + rowl, query = n * 128 + qloc + r, pos = a == 0 ? (query >> 6) : (query & 63);
          const f32x4 c0 = *(const f32x4*)(F.ROPE + pos * 16 + 8 * e), c1 = *(const f32x4*)(F.ROPE + pos * 16 + 8 * e + 4), s0 = *(const f32x4*)(F.ROPE + 1024 + pos * 16 + 8 * e), s1 = *(const f32x4*)(F.ROPE + 1024 + pos * 16 + 8 * e + 4);
          float x1[8], x2[8]; unpack8(r1[ps], x1); unpack8(r2[ps], x2);
          float ss = 0.f;
#pragma unroll
          for (int j = 0; j < 8; ++j) ss += x1[j] * x1[j] + x2[j] * x2[j];
          ss += __shfl_xor(ss, 1); ss += __shfl_xor(ss, 2);
          const float rr = (0.125f * LOG2E) / sqrtf(ss * (1.0f / 64.0f) + 1e-6f);
#pragma unroll
          for (int j = 0; j < 8; ++j) { const float y1 = x1[j] * rr * g1[j], y2 = x2[j] * rr * g2[j], cc = j < 4 ? c0[j & 3] : c1[j & 3], sn = j < 4 ? s0[j & 3] : s1[j & 3];
              x1[j] = y1 * cc - y2 * sn; x2[j] = y2 * cc + y1 * sn; }
          LAS unsigned char* dst = qbase + ((r >> 5) * 4 + 2 * a) * 1024 + (e * 32 + (r & 31)) * 16;
          u32x4 o; o.x = pk2(x1[0], x1[1]); o.y = pk2(x1[2], x1[3]); o.z = pk2(x1[4], x1[5]); o.w = pk2(x1[6], x1[7]); *(LAS u32x4*)dst = o;
          o.x = pk2(x2[0], x2[1]); o.y = pk2(x2[2], x2[3]); o.z = pk2(x2[4], x2[5]); o.w = pk2(x2[6], x2[7]); *(LAS u32x4*)(dst + 1024) = o;
      } }
    at_write(F, R, lds);
    LBAR(); TSTAMP(26);
    float mrun[2] = {NOMAX ? 0.f : -1e30f, NOMAX ? 0.f : -1e30f}, lrun[2] = {0.f, 0.f};
    f32x16 ot[2][2];
#pragma unroll
    for (int qb = 0; qb < 2; ++qb)
#pragma unroll
        for (int db = 0; db < 2; ++db)
#pragma unroll
            for (int r = 0; r < 16; ++r) ot[qb][db][r] = 0.f;
#pragma unroll 1
    for (int t = 0; t < nt; ++t) {
        LAS unsigned char* buf = lds + (t & 1) * AT_BUF;
        if (t + 1 < nt) at_load(F, R, TL_ROW(t + 1), kvh);
        const int kind = TL_KIND(t);
#pragma unroll 1
        for (int st = 0; st < 4; ++st) {
            int s0 = 1, s1 = 1;
            { const int dq0 = qloc >> 5, dq1 = dq0 + 1;
              if (kind == 0) { s0 = st < dq0 ? 0 : (st == dq0 ? 2 : 1); s1 = st < dq1 ? 0 : (st == dq1 ? 2 : 1); }
              else if (kind == 2) { s0 = st > dq0 ? 0 : (st == dq0 ? 2 : 1); s1 = st > dq1 ? 0 : (st == dq1 ? 2 : 1); } }
            if ((s0 | s1) == 0) continue;
            bf16x8 kf[4];
#pragma unroll
            for (int ks = 0; ks < 4; ++ks) { const int key = st * 32 + l31, ch = 2 * ks + hi; kf[ks] = *(const LAS bf16x8*)(buf + AT_K + key * 128 + ((ch ^ ((key >> 1) & 7)) << 4)); }
            f32x16 sc0 = {0.f, 0.f, 0.f, 0.f, 0.f, 0.f, 0.f, 0.f, 0.f, 0.f, 0.f, 0.f, 0.f, 0.f, 0.f, 0.f}, sc1 = sc0;
            { bf16x8 qf[4];
              if (s0) {
#pragma unroll
                  for (int ks = 0; ks < 4; ++ks) qf[ks] = *(const LAS bf16x8*)(qlds + ks * 1024);
#pragma unroll
                  for (int ks = 0; ks < 4; ++ks) sc0 = __builtin_amdgcn_mfma_f32_32x32x16_bf16(kf[ks], qf[ks], sc0, 0, 0, 0); }
              if (s1) {
#pragma unroll
                  for (int ks = 0; ks < 4; ++ks) qf[ks] = *(const LAS bf16x8*)(qlds + (4 + ks) * 1024);
#pragma unroll
                  for (int ks = 0; ks < 4; ++ks) sc1 = __builtin_amdgcn_mfma_f32_32x32x16_bf16(kf[ks], qf[ks], sc1, 0, 0, 0); } }
            bf16x8 vf[2][2];
#pragma unroll
            for (int db = 0; db < 2; ++db)
#pragma unroll
                for (int s = 0; s < 2; ++s) vf[db][s] = *(const LAS bf16x8*)(buf + AT_V + (db * 32 + l31) * 272 + ((st * 2 + s) * 16 + hi * 8) * 2);
#define AT_SOFTMAX(SC, QB, PF, DIAG) do { \
                const int qq = qloc + (QB) * 32 + l31; \
                if (DIAG) { const int th = qq - st * 32 - 4 * hi;        \
                    if (kind == 0) { _Pragma("unroll") for (int r = 0; r < 16; ++r) SC[r] = ((r & 3) + 8 * (r >> 2) >= th) ? SC[r] : -__builtin_inff(); } \
                    else { _Pragma("unroll") for (int r = 0; r < 16; ++r) SC[r] = ((r & 3) + 8 * (r >> 2) <= th) ? SC[r] : -__builtin_inff(); } } \
                if (!NOMAX) { \
                    float tm = SC[0]; \
                    _Pragma("unroll") for (int r = 1; r < 16; ++r) tm = fmaxf(tm, SC[r]); \
                    tm = fmaxf(tm, __shfl_xor(tm, 32)); \
                    if (__any(tm > mrun[QB] + 6.0f)) { \
                        const float mn = fmaxf(mrun[QB], tm), al = __builtin_amdgcn_exp2f(mrun[QB] - mn); \
                        mrun[QB] = mn; lrun[QB] *= al; \
                        _Pragma("unroll") for (int db = 0; db < 2; ++db) _Pragma("unroll") for (int r = 0; r < 16; ++r) ot[QB][db][r] *= al; } \
                    const float mm = mrun[QB]; \
                    _Pragma("unroll") for (int r = 0; r < 16; ++r) SC[r] -= mm; } \
                f32x2_t ps2 = {0.f, 0.f}; \
                _Pragma("unroll") for (int r = 0; r < 16; r += 2) { SC[r] = __builtin_amdgcn_exp2f(SC[r]); SC[r + 1] = __builtin_amdgcn_exp2f(SC[r + 1]); f32x2_t e2; e2.x = SC[r]; e2.y = SC[r + 1]; ps2 += e2; } \
                lrun[QB] += ps2.x + ps2.y; \
                _Pragma("unroll") for (int s = 0; s < 2; ++s) { u32x4 o; o.x = pk2(SC[8 * s], SC[8 * s + 1]); o.y = pk2(SC[8 * s + 2], SC[8 * s + 3]); o.z = pk2(SC[8 * s + 4], SC[8 * s + 5]); o.w = pk2(SC[8 * s + 6], SC[8 * s + 7]); PF[s] = __builtin_bit_cast(bf16x8, o); } \
            } while (0)
            bf16x8 pf0[2] = {kf[0], kf[0]}, pf1[2] = {kf[0], kf[0]};
            __builtin_amdgcn_sched_barrier(0);
            if (s0) AT_SOFTMAX(sc0, 0, pf0, s0 == 2);
            __builtin_amdgcn_sched_barrier(0);
            if (s1) AT_SOFTMAX(sc1, 1, pf1, s1 == 2);
            __builtin_amdgcn_sched_barrier(0);
#undef AT_SOFTMAX
#pragma unroll
            for (int db = 0; db < 2; ++db)
#pragma unroll
                for (int s = 0; s < 2; ++s) if (s0) ot[0][db] = __builtin_amdgcn_mfma_f32_32x32x16_bf16(vf[db][s], pf0[s], ot[0][db], 0, 0, 0);
#pragma unroll
            for (int db = 0; db < 2; ++db)
#pragma unroll
                for (int s = 0; s < 2; ++s) if (s1) ot[1][db] = __builtin_amdgcn_mfma_f32_32x32x16_bf16(vf[db][s], pf1[s], ot[1][db], 0, 0, 0);
        }
        TSTAMP(27);
        if (t + 1 < nt) at_write(F, R, lds + ((t + 1) & 1) * AT_BUF);
        LBAR(); TSTAMP(28);
    }
    constexpr int AT_ORS = 528;
    u32x4 zr[8];
    const bf16* pz = F.P + (size_t)(b * SEQ + n * 128) * NIN + kvh * 256;
#pragma unroll
    for (int i = 0; i < 8; ++i) { const int idx = F.tid + 512 * i, row = idx >> 5, c16 = idx & 31; zr[i] = *(const u32x4*)(pz + (size_t)row * NIN + C_ZA + 8 * c16); }
    const float sk2 = F.sink[hh] * LOG2E;
#pragma unroll
    for (int qb = 0; qb < 2; ++qb) {
        float l = lrun[qb]; l += __shfl_xor(l, 32); l += __builtin_amdgcn_exp2f(sk2 - mrun[qb]);
        const float il = 1.0f / l;
        LAS unsigned char* po = lds + (qloc + qb * 32 + l31) * AT_ORS + (wave >> 1) * 128 + 8 * hi;
#pragma unroll
        for (int db = 0; db < 2; ++db)
#pragma unroll
            for (int rg = 0; rg < 4; ++rg) { u32x2 o; o.x = pkh(ot[qb][db][4 * rg] * il, ot[qb][db][4 * rg + 1] * il); o.y = pkh(ot[qb][db][4 * rg + 2] * il, ot[qb][db][4 * rg + 3] * il);
                *(LAS u32x2*)(po + (db * 32 + 8 * rg) * 2) = o; }
    }
    LBAR();
#pragma unroll
    for (int i = 0; i < 8; ++i) { const int idx = F.tid + 512 * i, row = idx >> 5, c16 = idx & 31;
        const u32x4 ov = *(const LAS u32x4*)(lds + row * AT_ORS + c16 * 16);
        float z[8]; unpack8(zr[i], z);
        u32x4 w; w.x = pk2(h_lo(ov.x) * siluf_(z[0]), h_hi(ov.x) * siluf_(z[1])); w.y = pk2(h_lo(ov.y) * siluf_(z[2]), h_hi(ov.y) * siluf_(z[3]));
        w.z = pk2(h_lo(ov.z) * siluf_(z[4]), h_hi(ov.z) * siluf_(z[5])); w.w = pk2(h_lo(ov.w) * siluf_(z[6]), h_hi(ov.w) * siluf_(z[7]));
        *(u32x4*)(F.P + (size_t)(b * SEQ + n * 128 + row) * NIN + 1024 + kvh * 256 + 8 * c16) = w; }
    TSTAMP(29);
#undef TL_KIND
#undef TL_ROW
#undef TL_KPOS
}
__device__ __forceinline__ bool attn_nomax(Frame& F) {
    float gq = fabsf(F.qng[F.lane]), gk = fabsf(F.kng[F.lane]);
#pragma unroll
    for (int o = 1; o < 64; o <<= 1) { gq = fmaxf(gq, __shfl_xor(gq, o)); gk = fmaxf(gk, __shfl_xor(gk, o)); }
    const float bound = 8.0f * LOG2E * gq * gk;
    return __builtin_amdgcn_readfirstlane(bound <= ATTN_BOUND ? 1 : 0) != 0;
}

__device__ __forceinline__ void p5_mix(Frame& F) {
    const int total = F.G * NWAVES * 64, rstep = total >> 7, gi = F.bid * NWAVES * 64 + F.tid;
    const int ch = gi & 7, h = (gi >> 3) & 15, c0 = h * 64 + 8 * ch;
    float mus[8], lg[8], lb[8];
    { const f32x4 a0 = *(const f32x4*)(F.mu_shift + C_V + c0), a1 = *(const f32x4*)(F.mu_shift + C_V + c0 + 4), g0 = *(const f32x4*)(F.ln_g + c0), g1 = *(const f32x4*)(F.ln_g + c0 + 4), b0 = *(const f32x4*)(F.ln_b + c0), b1 = *(const f32x4*)(F.ln_b + c0 + 4);
#pragma unroll
      for (int j = 0; j < 4; ++j) { mus[j] = a0[j]; mus[4 + j] = a1[j]; lg[j] = g0[j]; lg[4 + j] = g1[j]; lb[j] = b0[j]; lb[4 + j] = b1[j]; } }
    const u32x4 z = {0u, 0u, 0u, 0u};
#pragma unroll 1
    for (int m0 = gi >> 7; m0 < ML; m0 += 4 * rstep) {
        u32x4 ryf[4], ryb[4], rvc[4], rvp[4], rvn[4], rzr[4]; float bon[4];
#pragma unroll
        for (int k = 0; k < 4; ++k) { const int m = m0 + k * rstep, mm = m < ML ? m : m0, t = mm & (SEQ - 1);
            const bf16* pc = F.P + (size_t)mm * NIN;
            ryf[k] = *(const u32x4*)(F.YF + (size_t)mm * 1024 + c0); ryb[k] = *(const u32x4*)(F.YB + (size_t)mm * 1024 + c0);
            rvc[k] = *(const u32x4*)(pc + C_V + c0); rvp[k] = *(const u32x4*)(pc - (t > 0 ? NIN : 0) + C_V + c0); rvn[k] = *(const u32x4*)(pc + (t < SEQ - 1 ? NIN : 0) + C_V + c0);
            rzr[k] = *(const u32x4*)(pc + C_ZR + c0);
            bon[k] = F.BON[(size_t)mm * 16 + h] + F.BON[(size_t)(ML + mm) * 16 + h]; }
#pragma unroll
        for (int k = 0; k < 4; ++k) { const int m = m0 + k * rstep; if (m >= ML) break;
            float y[8];
            { const h8 hf = __builtin_bit_cast(h8, ryf[k]), hb = __builtin_bit_cast(h8, ryb[k]);
#pragma unroll
              for (int j = 0; j < 8; ++j) y[j] = (float)hf[j] + (float)hb[j]; }
            float s = 0.f;
#pragma unroll
            for (int j = 0; j < 8; ++j) s += y[j];
            s += __shfl_xor(s, 1); s += __shfl_xor(s, 2); s += __shfl_xor(s, 4);
            const float mu = s * (1.0f / 64.0f); float q = 0.f;
#pragma unroll
            for (int j = 0; j < 8; ++j) { y[j] -= mu; q += y[j] * y[j]; }
            q += __shfl_xor(q, 1); q += __shfl_xor(q, 2); q += __shfl_xor(q, 4);
            const float rs = 1.0f / sqrtf(q * (1.0f / 64.0f) + 64e-5f);
            float vc[8], vp[8], vn[8], zr[8];
            const int t = m & (SEQ - 1);
            unpack8(rvc[k], vc); unpack8(t > 0 ? rvp[k] : z, vp); unpack8(t < SEQ - 1 ? rvn[k] : z, vn); unpack8(rzr[k], zr);
            float o[8];
#pragma unroll
            for (int j = 0; j < 8; ++j) { const float sv = vc[j] + mus[j] * (0.5f * (vp[j] + vn[j]) - vc[j]);
                const float yn = y[j] * rs * lg[j] + lb[j];
                o[j] = (yn + bon[k] * sv) * siluf_(zr[j]); }
            u32x4 w; w.x = pk2(o[0], o[1]); w.y = pk2(o[2], o[3]); w.z = pk2(o[4], o[5]); w.w = pk2(o[6], o[7]);
            *(u32x4*)(F.P + (size_t)m * NIN + c0) = w; }
    }
}

struct Args { const float* in[22]; float* out; unsigned char* ws; int ph_lo, ph_hi; };
__global__ void __launch_bounds__(NWAVES * 64, 2) hymba_fwd(Args args) {
    extern __shared__ __attribute__((aligned(16))) unsigned char lds_raw[];
    Frame F;
    F.lds = (LAS unsigned char*)lds_raw;
    F.tid = threadIdx.x; F.G = gridDim.x;
    unsigned char* ws = args.ws;
    volatile LAS unsigned* MISC = (volatile LAS unsigned*)(F.lds + MISC_OFF);
    for (int u = F.tid; u < 64; u += NWAVES * 64) MISC[u] = 0u;
    if (DBG_SEL >= 0) for (int u = F.tid; u < 72; u += NWAVES * 64) ((volatile LAS unsigned*)(F.lds + DBG_LDS))[u] = 0u;
    __syncthreads();
    const int lo = args.ph_lo, hi = args.ph_hi;
    XcdBarrier bar; bar.bar = (unsigned*)(ws + WS_CTL) + CW_BAR; bar.x = 0; bar.st = nullptr;
    if (hi - lo > 1) bar = xcd_barrier_post((unsigned*)(ws + WS_CTL) + CW_BAR, MISC + 8);
#define IN(k) (lo <= (k) && (k) < hi)
#define SEAM(k) do { if (IN(k) && IN((k) + 1)) xcd_barrier(bar); } while (0)
    fresh(F); TSTART();
    if (DBG_SEL >= 0 && F.bid == DBG_BLOCK && F.tid == 0) { volatile LAS unsigned long long* T_ = (volatile LAS unsigned long long*)(F.lds + DBG_LDS); T_[34] = T_[32]; }
    if (IN(0)) { fresh(F); p0_prologue(F); if (DUP_PHASE == 0) { fresh(F); p0_prologue(F); } } TSTAMP(8); SEAM(0); TSTAMP(9);
    if (IN(1)) { fresh(F); p1_modulate(F); if (DUP_PHASE == 1) { fresh(F); p1_modulate(F); } } TSTAMP(10); SEAM(1); TSTAMP(11);
    if (IN(2)) {
        fresh(F);
        pg8::Gemm g{F.XN, F.WIN, MT, NIN, DM, DM}; Sched1 S; S.init(F.G, F.bid);
        pg8::EpiBf16<0> E{F.P, NIN, nullptr, 0, 0, 1.f};
        pg8::gemm_phase<pg8::EpiBf16<0>, Sched1, true, true>(F.lds, g, S, E);
        if (DUP_PHASE == 2) { __syncthreads(); pg8::gemm_phase<pg8::EpiBf16<0>, Sched1, true, true>(F.lds, g, S, E); }
    } TSTAMP(12); SEAM(2); TSTAMP(13);
    if (IN(3)) { fresh(F); p3_chunkA(F); fresh(F); kprep(F); TSTAMP(14); if (DUP_PHASE == 3) { fresh(F); p3_chunkA(F); } } SEAM(3); TSTAMP(15);
    if (IN(4)) {
        fresh(F);
        { const bool g256 = F.G == 256; const int xg = F.bid & 7;
          int li0 = 3 * ((F.bid - 128) >> 3), cnt = 3;
          if (!g256 || F.bid < 128) { p4_chunkB(F); TSTAMP(30); LBAR(); fresh(F); li0 = 0; cnt = 0; }
          if (!g256) cnt = (512 - F.bid + F.G - 1) / F.G;
          unsigned* tq = (unsigned*)((unsigned char*)F.MOD - WS_MOD + WS_CTL) + CW_TICKET;
          volatile LAS unsigned* tk = (volatile LAS unsigned*)(F.lds + MISC_OFF) + 40;
#define ATTN_ITEMS(NM) \
          for (int j = 0; ; ++j) { int li = li0 + j, grp = xg; \
              if (j >= cnt) { if (!g256) break; \
                  if (F.tid == 0) tk[0] = __hip_atomic_fetch_add(tq, 1u, __ATOMIC_RELAXED, __HIP_MEMORY_SCOPE_AGENT); \
                  LBAR(); const unsigned q = tk[0]; LBAR(); if (q >= 128u) break; grp = (int)(q & 7u); li = 48 + (int)(q >> 3); } \
              fresh(F); p4_attn_t<NM>(F, g256 ? (2 * grp + (li >> 5)) * 32 + (li & 31) : F.bid + j * F.G); LBAR(); }
          if (attn_nomax(F)) {
#pragma unroll 1
              ATTN_ITEMS(true)
          } else {
#pragma unroll 1
              ATTN_ITEMS(false)
          }
#undef ATTN_ITEMS
        }
        TSTAMP(16);
    } SEAM(4); TSTAMP(17);
    if (IN(5)) { fresh(F); p5_mix(F); TSTAMP(18);
        if (DBG_SEL >= 0 && F.bid == DBG_BLOCK && F.tid == 0) { volatile LAS unsigned long long* T_ = (volatile LAS unsigned long long*)(F.lds + DBG_LDS);
            F.DBG[0] = (float)(DBG_SEL == 99 ? (T_[0] + T_[1] + T_[2] + T_[3] + T_[4] + T_[5] + T_[6] + T_[7]) : T_[DBG_SEL]) * (DBG_FINE ? 1e-6f : 2.5e-7f); F.DBG[1] = (DBG_SEL2 == 24 ? (float)T_[24] * 1e-7f : (float)T_[DBG_SEL2] * 1e-4f); }
    } SEAM(5); TSTAMP(19);
    if (IN(6)) {
        fresh(F);
        pg8::Gemm g{F.P, F.WOUT, ML, DM, DM, NIN};
        pg8::StaticOrder S; S.init(ML, DM, F.G, F.bid);
        pg8::EpiGate E{F.x, F.out, F.MOD + 4096, DM, DBG_SEL >= 0 ? F.DBG[0] : 0.f, DBG_SEL >= 0 ? F.DBG[1] : 0.f};
        pg8::gemm_phase<pg8::EpiGate, pg8::StaticOrder, true, true>(F.lds, g, S, E);
        if (DUP_PHASE == 6) { __syncthreads(); pg8::gemm_phase<pg8::EpiGate, pg8::StaticOrder, true, true>(F.lds, g, S, E); }
        if (DBG_SEL >= 0 && DBG_END > 0 && blockIdx.x == 0 && threadIdx.x == 0) { volatile LAS unsigned long long* T_ = (volatile LAS unsigned long long*)(F.lds + DBG_LDS);
            const unsigned long long n_ = __builtin_amdgcn_s_memrealtime(); asm volatile("s_waitcnt vmcnt(0)" ::: "memory");
            F.out[0] += DBG_END == 1 ? (float)(n_ - T_[34]) * 1e-5f : ((float)(n_ - T_[32]) - 10000.0f) * 1e-4f; }
    }
#undef IN
#undef SEAM
}

extern "C" void kernel_launch(void* const* d_in, const int* in_sizes, int n_in, void* d_out, int out_size, void* d_ws, size_t ws_size, hipStream_t stream) {
    static int grid = 0;
    if (grid == 0) {
        if (n_in != 22 || out_size != ML * DM || ws_size < WS_END) { fprintf(stderr, "kernel_launch: unexpected problem shape (n_in %d, out %d, ws %zu)\n", n_in, out_size, ws_size); grid = -1; return; }
        int dev = 0, cus = 0;
        if (hipGetDevice(&dev) != hipSuccess || hipDeviceGetAttribute(&cus, hipDeviceAttributeMultiprocessorCount, dev) != hipSuccess) { grid = -1; return; }
        if (hipFuncSetAttribute((const void*)hymba_fwd, hipFuncAttributeMaxDynamicSharedMemorySize, LDS_BYTES) != hipSuccess) { fprintf(stderr, "kernel_launch: hipFuncSetAttribute failed\n"); grid = -1; return; }
        (void)hipGetLastError();
        grid = cus;
    }
    if (grid < 0) return;
    (void)hipMemsetAsync((char*)d_ws + WS_CTL, 0, CTL_ZERO_BYTES, stream);
    Args a{};
    for (int i = 0; i < 22; ++i) a.in[i] = (const float*)d_in[i];
    a.out = (float*)d_out; a.ws = (unsigned char*)d_ws;
    if (MK_N_LAUNCHES == 1) { a.ph_lo = 0; a.ph_hi = N_PHASES; hipLaunchKernelGGL(hymba_fwd, dim3(grid), dim3(NWAVES * 64), LDS_BYTES, stream, a); }
    else for (int p = 0; p < N_PHASES; ++p) { a.ph_lo = p; a.ph_hi = p + 1; hipLaunchKernelGGL(hymba_fwd, dim3(grid), dim3(NWAVES * 64), LDS_BYTES, stream, a); }
}
```

```cpp
#include <hip/hip_runtime.h>
#include <cstdio>
#include <cstdint>
#ifndef DBG_SEL
#define DBG_SEL -1
#endif
#ifndef DBG_SEL2
#define DBG_SEL2 0
#endif
#ifndef DBG_BLOCK
#define DBG_BLOCK 0
#endif
#ifndef DBG_END
#define DBG_END 0
#endif
namespace pg8 {
#define PG8_LAS __attribute__((address_space(3)))
typedef unsigned short bf16_t;
typedef short bf16x8 __attribute__((ext_vector_type(8)));
typedef float f32x4 __attribute__((ext_vector_type(4)));
typedef unsigned u32x4 __attribute__((ext_vector_type(4)));
constexpr int BM = 256, BK = 64, HALF = 128, HTB = HALF * BK * 2  , STAGE_BYTES = 8 * HTB, NXCD = 8, WGM = 8;

__host__ __device__ __forceinline__ int lds_byte(int r, int c) { const int st = (r >> 4) * 2 + (c >> 5), rr = r & 15, cc = c & 31, ob = rr * 64 + cc * 2; return st * 1024 + (ob ^ (((ob >> 9) & 1) << 5)); }
__host__ __device__ __forceinline__ void stage_rc(int b, int& R, int& C) { const int st = b / 1024, sb = b % 1024, swz = sb ^ (((sb >> 9) & 1) << 5); R = (st >> 1) * 16 + swz / 64; C = (st & 1) * 32 + (swz % 64) / 2; }
__host__ __device__ __forceinline__ int perm32(int rho) { const int n = rho >> 4, i = rho & 15; return 8 * (i >> 2) + 4 * n + (i & 3); }

struct Unit { int pm, pn; };
struct Gemm { const bf16_t* A; const bf16_t* Bt; int M, N, K, lda; };

struct StaticOrder {
    int nM, nN, nwg, G, c;
    __host__ __device__ void init(int M, int N, int G_, int c_) { nM = M / BM; nN = N / BM; nwg = nM * nN; G = G_; c = c_; }
    __host__ __device__ bool next(int i, Unit& u) const {
        const long L = (long)i * G + c; if (L >= nwg) return false;
        int wgid = (int)L; { const int q = nwg / NXCD, r = nwg % NXCD, xcd = wgid % NXCD, off = wgid / NXCD; wgid = (xcd < r ? xcd * (q + 1) : r * (q + 1) + (xcd - r) * q) + off; }
        const int nig = WGM * nN, gid = wgid / nig, fm = gid * WGM, gsz = (nM - fm) < WGM ? (nM - fm) : WGM;
        u.pm = fm + ((wgid % nig) % gsz); u.pn = (wgid % nig) / gsz; return true;
    }
    __device__ __forceinline__ void a_ready(const Unit&) const {}
    __device__ __forceinline__ void done(const Unit&) const {}
};

__device__ __forceinline__ unsigned cvt_pk_bf16(float lo, float hi) { unsigned r; asm volatile("v_cvt_pk_bf16_f32 %0, %1, %2" : "=v"(r) : "v"(lo), "v"(hi)); return r; }
typedef float f32x2 __attribute__((ext_vector_type(2)));
__device__ __forceinline__ f32x2 gelu_pk(f32x2 v) {
    const f32x2 av = __builtin_elementwise_abs(v), d = av * 0.2316418882f + 1.0f;
    f32x2 t; t.x = __builtin_amdgcn_rcpf(d.x); t.y = __builtin_amdgcn_rcpf(d.y);
    f32x2 q = t * 0.5307027145f + (-0.7265760135f); q = q * t + 0.7107068705f; q = q * t + (-0.142248368f); q = q * t + 0.127414796f; q = q * t;
    const f32x2 s = (v * v) * (-0.72134752044f);
    f32x2 e; e.x = __builtin_amdgcn_exp2f(s.x); e.y = __builtin_amdgcn_exp2f(s.y);
    const f32x2 m = v * (q * e), r = v - m;
    f32x2 o; o.x = v.x < 0.f ? m.x : r.x; o.y = v.y < 0.f ? m.y : r.y; return o;
}

template <int ACT  > struct EpiBf16 {
    static constexpr bool PERM = true, AFTER_DRAIN = false; static_assert(ACT == 0 || ACT == 1, "EpiBf16: ACT is 0 (none) or 1 (gelu_pk)");
    bf16_t* O; int ldc; const float* bias; int split_cols; size_t split_stride; float scale0;
    __device__ __forceinline__ void operator()(const f32x4 (&acc)[2][2][4][2], const Unit& u, int wr, int wc, int fr, int fq) const {
        const int row0 = u.pm * BM + wr * 64 + fr; int colt = u.pn * BM; bf16_t* base = O;
        float sc = 1.f; if (split_cols) { const int t = colt / split_cols; base += (size_t)t * split_stride; colt -= t * split_cols; if (t == 0) sc = scale0; }
        const int col0 = colt + wc * 32 + 8 * fq, bcol0 = u.pn * BM + wc * 32 + 8 * fq;
        f32x4 bv[2][2];
#pragma unroll
        for (int bj = 0; bj < 2; ++bj)
#pragma unroll
            for (int n = 0; n < 2; ++n) bv[bj][n] = bias ? *(const f32x4*)(bias + bcol0 + bj * HALF + 4 * n) : (f32x4){0.f, 0.f, 0.f, 0.f};
#pragma unroll
        for (int ai = 0; ai < 2; ++ai)
#pragma unroll
            for (int m = 0; m < 4; ++m) { bf16_t* rowp = base + (size_t)(row0 + ai * HALF + m * 16) * ldc + col0;
#pragma unroll
                for (int bj = 0; bj < 2; ++bj) { f32x4 v0 = acc[ai][bj][m][0] + bv[bj][0], v1 = acc[ai][bj][m][1] + bv[bj][1];
                    if (ACT == 1) { f32x2 a = gelu_pk((f32x2){v0[0], v0[1]}), b = gelu_pk((f32x2){v0[2], v0[3]}), c = gelu_pk((f32x2){v1[0], v1[1]}), d = gelu_pk((f32x2){v1[2], v1[3]});
                        v0 = (f32x4){a.x, a.y, b.x, b.y}; v1 = (f32x4){c.x, c.y, d.x, d.y}; }
                    v0 = v0 * sc; v1 = v1 * sc; u32x4 w; w.x = cvt_pk_bf16(v0[0], v0[1]); w.y = cvt_pk_bf16(v0[2], v0[3]); w.z = cvt_pk_bf16(v1[0], v1[1]); w.w = cvt_pk_bf16(v1[2], v1[3]);
                    *(u32x4*)(rowp + bj * HALF) = w; } }
    }
};


struct EpiGate {
    static constexpr bool PERM = false, AFTER_DRAIN = false;
    const float* x; float* out; const float* gate; int ldc; float dbg0, dbg1;
    __device__ __forceinline__ void operator()(const f32x4 (&acc)[2][2][4][2], const Unit& u, int wr, int wc, int fr, int fq) const {
        const int col0 = u.pn * BM + wc * 32 + 4 * fq;
        const int b = (u.pm * BM) >> 12;
        f32x4 gv[2][2];
#pragma unroll
        for (int bj = 0; bj < 2; ++bj)
#pragma unroll
            for (int n = 0; n < 2; ++n) gv[bj][n] = *(const f32x4*)(gate + (size_t)b * 6144 + col0 + bj * HALF + n * 16);
#pragma unroll
        for (int ai = 0; ai < 2; ++ai)
#pragma unroll
            for (int mp = 0; mp < 2; ++mp) {
                f32x4 xv[2][2][2];
#pragma unroll
                for (int mm = 0; mm < 2; ++mm) { const size_t off = (size_t)(u.pm * BM + ai * HALF + wr * 64 + (2 * mp + mm) * 16 + fr) * ldc + col0;
#pragma unroll
                    for (int bj = 0; bj < 2; ++bj)
#pragma unroll
                        for (int n = 0; n < 2; ++n) xv[mm][bj][n] = *(const f32x4*)(x + off + bj * HALF + n * 16); }
                asm volatile("" ::: "memory");
#pragma unroll
                for (int mm = 0; mm < 2; ++mm) { const int m = 2 * mp + mm; const size_t off = (size_t)(u.pm * BM + ai * HALF + wr * 64 + m * 16 + fr) * ldc + col0;
#pragma unroll
                    for (int bj = 0; bj < 2; ++bj)
#pragma unroll
                        for (int n = 0; n < 2; ++n) { f32x4 o = xv[mm][bj][n] + gv[bj][n] * acc[ai][bj][m][n];
                            if (DBG_SEL >= 0) { o = o + dbg0; if (off + bj * HALF + n * 16 == 0) o.x += dbg1; }
                            *(f32x4*)(out + off + bj * HALF + n * 16) = o; } }
                asm volatile("" ::: "memory"); }
    }
};
template <class Epi, class Sched, bool ALIGN_EPI = false, bool SP2 = false>
__device__ __forceinline__ void gemm_phase(PG8_LAS unsigned char* lds, const Gemm g, const Sched& S, const Epi& E) {
    const int tid = threadIdx.x, wid = __builtin_amdgcn_readfirstlane(tid >> 6), lane = tid & 63, wr = wid >> 2, wc = wid & 3, fr = lane & 15, fq = lane >> 4;
    const int K = g.K, nt = K / BK, lda = g.lda;
    unsigned voffA[2], voffB[2];
#pragma unroll
    for (int i = 0; i < 2; ++i) { int R, C; stage_rc(tid * 16 + i * 8192, R, C); const int Rb = Epi::PERM ? ((R & ~31) + perm32(R & 31)) : R;
        voffA[i] = (unsigned)(R * lda + C) * 2u; voffB[i] = (unsigned)(Rb * K + C) * 2u; }
    const size_t kstep = (size_t)(BK * 2);
    const size_t hstepA = (size_t)HALF * lda * 2, hstepB = (size_t)HALF * K * 2;
    const size_t tstepA = 2 * hstepA, tstepB = 2 * hstepB;
    const unsigned ldsw = (unsigned)wid * 1024u;
    const int aoff = lds_byte(wr * 64 + fr, fq * 8), boff = lds_byte(wc * 32 + fr, fq * 8);
#define PG8_SA(b, h) (((b) * 2 + (h)) * HTB)
#define PG8_SB(b, h) ((4 + (b) * 2 + (h)) * HTB)
#define PG8_STAGE(bufoff, gbase, voff) do { _Pragma("unroll") for (int _i = 0; _i < 2; ++_i) \
        __builtin_amdgcn_global_load_lds((const unsigned*)((const char*)(gbase) + (voff)[_i]), (PG8_LAS unsigned*)(lds + (bufoff) + ldsw + _i * 8192), 16, 0, 0); } while (0)
#define PG8_LDA(dst, b, h) do { _Pragma("unroll") for (int m = 0; m < 4; ++m) _Pragma("unroll") for (int k = 0; k < 2; ++k) dst[m][k] = *(const PG8_LAS bf16x8*)(lds + PG8_SA(b, h) + aoff + m * 2048 + k * 1024); } while (0)
#define PG8_LDB(dst, b, h) do { _Pragma("unroll") for (int n = 0; n < 2; ++n) _Pragma("unroll") for (int k = 0; k < 2; ++k) dst[n][k] = *(const PG8_LAS bf16x8*)(lds + PG8_SB(b, h) + boff + n * 2048 + k * 1024); } while (0)
#define PG8_MMA(ai, bj, At, Bt) do { __builtin_amdgcn_s_setprio(1); _Pragma("unroll") for (int m = 0; m < 4; ++m) _Pragma("unroll") for (int n = 0; n < 2; ++n) _Pragma("unroll") for (int k = 0; k < 2; ++k) \
        acc[ai][bj][m][n] = __builtin_amdgcn_mfma_f32_16x16x32_bf16(Bt[n][k], At[m][k], acc[ai][bj][m][n], 0, 0, 0); __builtin_amdgcn_s_setprio(0); } while (0)
#define PG8_WAIT_V(n) asm volatile("s_waitcnt vmcnt(" #n ")" ::: "memory")
#define PG8_WAIT_L(n) asm volatile("s_waitcnt lgkmcnt(" #n ")" ::: "memory")
#define PG8_BAR __builtin_amdgcn_s_barrier()
#define PG8_SCHED __builtin_amdgcn_sched_barrier(0)
    Unit cur, nxt; int ui = 0;
    if (!S.next(0, cur)) return;
    f32x4 acc[2][2][4][2];
#pragma unroll
    for (int a = 0; a < 2; ++a)
#pragma unroll
        for (int b = 0; b < 2; ++b)
#pragma unroll
            for (int m = 0; m < 4; ++m)
#pragma unroll
                for (int n = 0; n < 2; ++n) acc[a][b][m][n] = (f32x4){0.f, 0.f, 0.f, 0.f};
    bf16x8 At[4][2], B0[2][2], B1[2][2];
    const char* cA = (const char*)g.A + (size_t)cur.pm * tstepA; const char* cB = (const char*)g.Bt + (size_t)cur.pn * tstepB;
    S.a_ready(cur);
    if constexpr (SP2) {
        PG8_STAGE(PG8_SB(0, 0), cB, voffB); PG8_STAGE(PG8_SB(0, 1), cB + hstepB, voffB); PG8_STAGE(PG8_SA(0, 0), cA, voffA); PG8_STAGE(PG8_SA(0, 1), cA + hstepA, voffA);
        if (wr == 1) PG8_BAR;
        PG8_WAIT_V(2); PG8_BAR;
        PG8_STAGE(PG8_SB(1, 0), cB + kstep, voffB); PG8_STAGE(PG8_SA(1, 0), cA + kstep, voffA); PG8_STAGE(PG8_SB(1, 1), cB + hstepB + kstep, voffB);
        PG8_WAIT_V(6); PG8_BAR;
    } else {
        PG8_STAGE(PG8_SB(0, 0), cB, voffB); PG8_STAGE(PG8_SA(0, 0), cA, voffA); PG8_STAGE(PG8_SB(0, 1), cB + hstepB, voffB); PG8_STAGE(PG8_SA(0, 1), cA + hstepA, voffA);
        if (wr == 1) PG8_BAR;
        PG8_WAIT_V(4); PG8_BAR;
        PG8_STAGE(PG8_SB(1, 0), cB + kstep, voffB); PG8_STAGE(PG8_SA(1, 0), cA + kstep, voffA); PG8_STAGE(PG8_SB(1, 1), cB + hstepB + kstep, voffB);
        PG8_WAIT_V(6); PG8_BAR;
    }
    for (;;) {
        const bool has_next = S.next(ui + 1, nxt);
        const char* nA = has_next ? (const char*)g.A + (size_t)nxt.pm * tstepA : cA; const char* nB = has_next ? (const char*)g.Bt + (size_t)nxt.pn * tstepB : cB;
        for (int t = 0; t < nt; t += 2) {
            const bool last = (t == nt - 2);
            const char* a1 = cA + (size_t)(t + 1) * kstep;
            const char* a2 = last ? nA : cA + (size_t)(t + 2) * kstep; const char* b2 = last ? nB : cB + (size_t)(t + 2) * kstep;
            const char* a3 = a2 + kstep; const char* b3 = b2 + kstep;
            if (last && has_next) S.a_ready(nxt);
            if constexpr (SP2) {
            PG8_LDB(B0, 0, 0); PG8_LDB(B1, 0, 1); PG8_SCHED; PG8_LDA(At, 0, 0); PG8_STAGE(PG8_SA(1, 1), a1 + hstepA, voffA);
            PG8_WAIT_V(8); PG8_WAIT_L(0); PG8_BAR; PG8_MMA(0, 0, At, B0); PG8_MMA(0, 1, At, B1); PG8_BAR; PG8_SCHED;
            PG8_LDA(At, 0, 1); PG8_STAGE(PG8_SB(0, 0), b2, voffB); PG8_STAGE(PG8_SB(0, 1), b2 + hstepB, voffB); PG8_STAGE(PG8_SA(0, 0), a2, voffA);
            PG8_WAIT_V(8); PG8_WAIT_L(0); PG8_BAR; PG8_MMA(1, 0, At, B0); PG8_MMA(1, 1, At, B1); PG8_BAR; PG8_SCHED;
            PG8_LDB(B0, 1, 0); PG8_LDB(B1, 1, 1); PG8_SCHED; PG8_LDA(At, 1, 0); PG8_STAGE(PG8_SA(0, 1), a2 + hstepA, voffA);
            PG8_WAIT_V(8); PG8_WAIT_L(0); PG8_BAR; PG8_MMA(0, 0, At, B0); PG8_MMA(0, 1, At, B1); PG8_BAR; PG8_SCHED;
            PG8_LDA(At, 1, 1); PG8_STAGE(PG8_SB(1, 0), b3, voffB); PG8_STAGE(PG8_SB(1, 1), b3 + hstepB, voffB); PG8_STAGE(PG8_SA(1, 0), a3, voffA);
            PG8_WAIT_V(8); PG8_WAIT_L(0); PG8_BAR; PG8_MMA(1, 0, At, B0); PG8_MMA(1, 1, At, B1); PG8_BAR; PG8_SCHED;
            } else {
            PG8_LDB(B0, 0, 0); PG8_SCHED; PG8_LDA(At, 0, 0); PG8_STAGE(PG8_SA(1, 1), a1 + hstepA, voffA);
            PG8_WAIT_L(8); PG8_BAR; PG8_WAIT_L(0); PG8_MMA(0, 0, At, B0); PG8_BAR; PG8_SCHED;
            PG8_LDB(B1, 0, 1); PG8_STAGE(PG8_SB(0, 0), b2, voffB);
            PG8_BAR; PG8_WAIT_L(0); PG8_MMA(0, 1, At, B1); PG8_BAR;
            PG8_LDA(At, 0, 1); PG8_STAGE(PG8_SA(0, 0), a2, voffA);
            PG8_BAR; PG8_WAIT_L(0); PG8_MMA(1, 0, At, B0); PG8_BAR; PG8_SCHED;
            PG8_STAGE(PG8_SB(0, 1), b2 + hstepB, voffB);
            PG8_WAIT_V(6); PG8_BAR; PG8_MMA(1, 1, At, B1); PG8_BAR;
            PG8_LDB(B0, 1, 0); PG8_SCHED; PG8_LDA(At, 1, 0); PG8_STAGE(PG8_SA(0, 1), a2 + hstepA, voffA);
            PG8_WAIT_L(8); PG8_BAR; PG8_WAIT_L(0); PG8_MMA(0, 0, At, B0); PG8_BAR; PG8_SCHED;
            PG8_LDB(B1, 1, 1); PG8_STAGE(PG8_SB(1, 0), b3, voffB);
            PG8_BAR; PG8_WAIT_L(0); PG8_MMA(0, 1, At, B1); PG8_BAR;
            PG8_LDA(At, 1, 1); PG8_STAGE(PG8_SA(1, 0), a3, voffA);
            PG8_BAR; PG8_WAIT_L(0); PG8_MMA(1, 0, At, B0); PG8_BAR; PG8_SCHED;
            PG8_STAGE(PG8_SB(1, 1), b3 + hstepB, voffB);
            PG8_WAIT_V(6); PG8_BAR; PG8_MMA(1, 1, At, B1); PG8_BAR;
            }
        }
        if constexpr (ALIGN_EPI) { if (wr == 0) PG8_BAR; }
        if constexpr (!Epi::AFTER_DRAIN) { E(acc, cur, wr, wc, fr, fq); S.done(cur); }
        if (!has_next) break;
#pragma unroll
        for (int a = 0; a < 2; ++a)
#pragma unroll
            for (int b = 0; b < 2; ++b)
#pragma unroll
                for (int m = 0; m < 4; ++m)
#pragma unroll
                    for (int n = 0; n < 2; ++n) acc[a][b][m][n] = (f32x4){0.f, 0.f, 0.f, 0.f};
        cur = nxt; cA = nA; cB = nB; ++ui;
        if constexpr (ALIGN_EPI) { if (wr == 1) PG8_BAR; }
    }
    PG8_WAIT_V(0);
    if constexpr (!ALIGN_EPI) { if (wr == 0) PG8_BAR; }
    PG8_BAR;
    if constexpr (Epi::AFTER_DRAIN) { E.fused(acc, cur, wr, wc, fr, fq, lds, wid, lane); S.done(cur); }
#undef PG8_SA
#undef PG8_SB
#undef PG8_STAGE
#undef PG8_LDA
#undef PG8_LDB
#undef PG8_MMA
#undef PG8_WAIT_V
#undef PG8_WAIT_L
#undef PG8_BAR
#undef PG8_SCHED
}
}

#ifndef MK_N_LAUNCHES
#define MK_N_LAUNCHES 1
#endif
#ifndef B_DUMMY
#define B_DUMMY 0
#endif
#ifndef DUP_PHASE
#define DUP_PHASE -1
#endif
constexpr int N_PHASES = 7;
constexpr int NWAVES = 8;
constexpr int DM = 2048, NB = 4, SEQ = 4096, CTXL = 256;
constexpr int ML = NB * SEQ, MC = NB * CTXL, MT = ML + MC;
constexpr int NIN = 6912;
constexpr int C_R = 0, C_K = 1024, C_V = 2048, C_LW = 3072, C_LA = 3200, C_ZR = 3328, C_Q = 4352, C_KA = 5376, C_VA = 5632, C_ZA = 5888;
constexpr float LOG2E = 1.4426950408889634f;
constexpr int DBG_LDS = 143360;

constexpr size_t MiB = 1u << 20;
constexpr size_t WS_CTL = 0, CTL_ZERO_BYTES = 64 * 1024;
constexpr size_t WS_MOD = 1 * MiB;
constexpr size_t WS_ROPE = 1 * MiB + 128 * 1024;
constexpr size_t WS_DBG = 1 * MiB + 192 * 1024;
constexpr size_t WS_W2T = 1 * MiB + 256 * 1024;
constexpr size_t WS_A2T = 1 * MiB + 512 * 1024;
constexpr size_t WS_WOUT = 2 * MiB;
constexpr size_t WS_P = 10 * MiB;
constexpr size_t WS_XN = 240 * MiB;
constexpr size_t WS_WIN = 308 * MiB;
constexpr size_t WS_GHQ = 240 * MiB;
constexpr size_t WS_MIX = 240 * MiB;
constexpr size_t WS_YF = 444 * MiB, WS_YB = 476 * MiB;
constexpr size_t WS_BON = 508 * MiB;
constexpr size_t WS_END = 510 * MiB;
static_assert(WS_P + (size_t)MT * NIN * 2 <= WS_XN && WS_XN + (size_t)MT * DM * 2 <= WS_WIN && WS_WIN + (size_t)NIN * DM * 2 <= WS_YF && WS_GHQ + (size_t)8704 * 24576 <= WS_YF && WS_YB + (size_t)ML * 1024 * 2 <= WS_BON, "ws map");

constexpr int CW_BAR = 1024;
constexpr int CW_TICKET = 8192;
constexpr int LDS_BYTES = 163840;
constexpr int MISC_OFF = LDS_BYTES - 256;

#define GAS __attribute__((address_space(1)))
#define LAS __attribute__((address_space(3)))
typedef unsigned short bf16;
typedef float f32x4 __attribute__((ext_vector_type(4)));
typedef float f32x16 __attribute__((ext_vector_type(16)));
typedef short bf16x8 __attribute__((ext_vector_type(8)));
typedef unsigned u32x4 __attribute__((ext_vector_type(4)));
typedef unsigned u32x2 __attribute__((ext_vector_type(2)));
typedef _Float16 h8 __attribute__((ext_vector_type(8)));
typedef _Float16 h4 __attribute__((ext_vector_type(4)));
typedef _Float16 h2 __attribute__((ext_vector_type(2)));
typedef GAS unsigned gu32;

__device__ __forceinline__ unsigned f2bf(float f) { unsigned u = __builtin_bit_cast(unsigned, f); return (u + 0x7fffu + ((u >> 16) & 1u)) >> 16; }
typedef float f32x2_t __attribute__((ext_vector_type(2))); typedef __bf16 bf16x2_t __attribute__((ext_vector_type(2)));
__device__ __forceinline__ unsigned pk2(float lo, float hi) { f32x2_t v = {lo, hi}; bf16x2_t b = __builtin_convertvector(v, bf16x2_t); return __builtin_bit_cast(unsigned, b); }
__device__ __forceinline__ float bflo(unsigned w) { return __builtin_bit_cast(float, w << 16); }
__device__ __forceinline__ float bfhi(unsigned w) { return __builtin_bit_cast(float, w & 0xffff0000u); }
__device__ __forceinline__ void unpack8(const u32x4 r, float* v) { v[0] = bflo(r.x); v[1] = bfhi(r.x); v[2] = bflo(r.y); v[3] = bfhi(r.y); v[4] = bflo(r.z); v[5] = bfhi(r.z); v[6] = bflo(r.w); v[7] = bfhi(r.w); }
__device__ __forceinline__ unsigned pkh(float a, float b) { h2 v = {(_Float16)a, (_Float16)b}; return __builtin_bit_cast(unsigned, v); }
__device__ __forceinline__ float wave_sum(float v) {
#pragma unroll
    for (int o = 1; o < 64; o <<= 1) v += __shfl_xor(v, o);
    return v;
}
__device__ __forceinline__ float fast_exp(float x) { return __builtin_amdgcn_exp2f(x * LOG2E); }
__device__ __forceinline__ float sigmoidf_(float x) { return __builtin_amdgcn_rcpf(1.0f + fast_exp(-x)); }
__device__ __forceinline__ float siluf_(float x) { return x * sigmoidf_(x); }
template <int CTRL> __device__ __forceinline__ float dpp_f(float x) { return __builtin_bit_cast(float, __builtin_amdgcn_update_dpp(0, __builtin_bit_cast(int, x), CTRL, 0xF, 0xF, false)); }

#define XB_TMO      128
#define XB_XCNT(j)  (256  + 64 * (j))
#define XB_XSUB(j)  (1280 + 64 * (j))
#define XB_XGEN(j)  (2304 + 64 * (j))
#define XB_TOP      3328
#define XB_TOPGEN   3392
#define XCD_BAR_WORDS 3456
#define XB_SPIN_CAP (1u << 18)
__device__ __forceinline__ unsigned xb_ld(unsigned* p)              { return __hip_atomic_load(p, __ATOMIC_RELAXED, __HIP_MEMORY_SCOPE_AGENT); }
__device__ __forceinline__ unsigned xb_add(unsigned* p, unsigned v) { return __hip_atomic_fetch_add(p, v, __ATOMIC_RELAXED, __HIP_MEMORY_SCOPE_AGENT); }
__device__ __forceinline__ unsigned xb_xcc_id() { return (unsigned)__builtin_amdgcn_s_getreg((3 << 11) | 20) & 0xFu; }
#define XB_SPIN(cond, bar) do { unsigned _sp = 0; while (cond) { __builtin_amdgcn_s_sleep(1); \
    if ((++_sp & 255u) == 0u) { if (xb_ld(&(bar)[XB_TMO])) break; if (_sp > XB_SPIN_CAP) { atomicAdd(&(bar)[XB_TMO], 1u); break; } } } } while (0)
struct XcdBarrier { unsigned* bar; unsigned x; volatile LAS unsigned* st; };
__device__ __forceinline__ XcdBarrier xcd_barrier_post(unsigned* bar, volatile LAS unsigned* st) {
    XcdBarrier b; b.bar = bar; b.x = xb_xcc_id(); b.st = st;
    if (threadIdx.x == 0) (void)xb_add(&bar[XB_XCNT(b.x)], 1u);
    return b;
}
__device__ __forceinline__ void xcd_barrier_complete(unsigned* bar, unsigned x, unsigned& nloc, unsigned& nx) {
    const unsigned G = gridDim.x * gridDim.y * gridDim.z;
    unsigned sum, cnt, mine, sp = 0u;
    for (;;) {
        sum = 0u; cnt = 0u; mine = 0u;
#pragma unroll
        for (unsigned j = 0; j < 16; ++j) { const unsigned c = xb_ld(&bar[XB_XCNT(j)]); sum += c; cnt += (c > 0u) ? 1u : 0u; mine = (j == x) ? c : mine; }
        if (sum == G) break;
        __builtin_amdgcn_s_sleep(1);
        if ((++sp & 255u) == 0u) { if (xb_ld(&bar[XB_TMO])) break; if (sp > XB_SPIN_CAP) { atomicAdd(&bar[XB_TMO], 1u); break; } }
    }
    nloc = mine > 0u ? mine : 1u; nx = cnt > 0u ? cnt : 1u;
}
__device__ __forceinline__ void xcd_barrier(const XcdBarrier& b) {
    asm volatile("s_waitcnt vmcnt(0)" ::: "memory");
    __syncthreads();
    if (threadIdx.x == 0) {
        unsigned* bar = b.bar;
        __builtin_amdgcn_s_waitcnt(0);
        unsigned nloc = b.st[0], nx = b.st[1];
        if (nloc == 0u) { xcd_barrier_complete(bar, b.x, nloc, nx); b.st[0] = nloc; b.st[1] = nx; }
        const unsigned old = xb_add(&bar[XB_XSUB(b.x)], 1u);
        const unsigned gen = old / nloc;
        if (old + 1u == (gen + 1u) * nloc) {
            __builtin_amdgcn_fence(__ATOMIC_RELEASE, "agent");
            asm volatile("s_waitcnt vmcnt(0)" ::: "memory");
            const unsigned og = xb_add(&bar[XB_TOP], 1u);
            const unsigned tg = og / nx;
            if (og + 1u == (tg + 1u) * nx) xb_add(&bar[XB_TOPGEN], 1u);
            else XB_SPIN(xb_ld(&bar[XB_TOPGEN]) == tg, bar);
            __builtin_amdgcn_fence(__ATOMIC_ACQUIRE, "agent");
            xb_add(&bar[XB_XGEN(b.x)], 1u);
            asm volatile("s_waitcnt vmcnt(0)" ::: "memory");
        } else {
            XB_SPIN(xb_ld(&bar[XB_XGEN(b.x)]) == gen, bar);
            __builtin_amdgcn_fence(__ATOMIC_ACQUIRE, "agent");
            asm volatile("s_waitcnt vmcnt(0)" ::: "memory");
        }
    }
    __syncthreads();
}

#define DBG_FINE (!(DBG_SEL >= 8 && DBG_SEL < 24))
#define TSTAMP(k) do { if (DBG_SEL >= 0 && (DBG_FINE || ((k) >= 8 && (k) < 24)) && F.bid == DBG_BLOCK && F.tid == 0) { volatile LAS unsigned long long* T_ = (volatile LAS unsigned long long*)(F.lds + DBG_LDS); const unsigned long long n_ = __builtin_amdgcn_s_memrealtime(); const unsigned long long m_ = __builtin_amdgcn_s_memtime(); T_[k] += n_ - T_[32]; T_[32] = n_; if ((k) < 8) { T_[24] += m_ - T_[33]; } T_[33] = m_; } } while (0)
#define TSTART() do { if (DBG_SEL >= 0 && F.bid == DBG_BLOCK && F.tid == 0) { volatile LAS unsigned long long* T_ = (volatile LAS unsigned long long*)(F.lds + DBG_LDS); T_[32] = __builtin_amdgcn_s_memrealtime(); T_[33] = __builtin_amdgcn_s_memtime(); } } while (0)
struct Frame {
    LAS unsigned char* lds;
    int tid, lane, wave, G, bid;
    const float *x, *c, *ctx, *c_ctx, *w_ada, *b_ada, *norm_g, *w_in, *mu_shift, *w0, *w2, *a0, *a2, *k_k, *k_a, *r_k, *ln_g, *ln_b, *qng, *kng, *sink, *w_out;
    float* out;
    float *MOD, *ROPE, *BON, *DBG;
    bf16 *W2T, *A2T, *WOUT, *P, *XN, *WIN, *YF, *YB, *MIX;
    unsigned char* GHQ;
};


typedef const float* cfp_t;
__device__ __forceinline__ const float* karg_f(int idx) { int off = idx * 8; asm volatile("" : "+s"(off)); const __attribute__((address_space(4))) char* kp = (const __attribute__((address_space(4))) char*)__builtin_amdgcn_kernarg_segment_ptr(); return *(const __attribute__((address_space(4))) cfp_t*)(kp + off); }
__device__ __forceinline__ void fresh(Frame& F) {
    int t_ = threadIdx.x; asm volatile("" : "+v"(t_)); F.tid = t_; F.lane = t_ & 63; F.wave = __builtin_amdgcn_readfirstlane(t_ >> 6);
    int b_ = blockIdx.x; asm volatile("" : "+s"(b_)); F.bid = b_;
    F.x = karg_f(0); F.c = karg_f(1); F.ctx = karg_f(2); F.c_ctx = karg_f(3); F.w_ada = karg_f(4); F.b_ada = karg_f(5); F.norm_g = karg_f(6); F.w_in = karg_f(7);
    F.mu_shift = karg_f(8); F.w0 = karg_f(9); F.w2 = karg_f(10); F.a0 = karg_f(11); F.a2 = karg_f(12); F.k_k = karg_f(13); F.k_a = karg_f(14); F.r_k = karg_f(15);
    F.ln_g = karg_f(16); F.ln_b = karg_f(17); F.qng = karg_f(18); F.kng = karg_f(19); F.sink = karg_f(20); F.w_out = karg_f(21);
    F.out = (float*)karg_f(22);
    unsigned char* ws = (unsigned char*)karg_f(23);
    F.MOD = (float*)(ws + WS_MOD); F.ROPE = (float*)(ws + WS_ROPE); F.BON = (float*)(ws + WS_BON); F.DBG = (float*)(ws + WS_DBG);
    F.W2T = (bf16*)(ws + WS_W2T); F.A2T = (bf16*)(ws + WS_A2T); F.WOUT = (bf16*)(ws + WS_WOUT); F.P = (bf16*)(ws + WS_P); F.XN = (bf16*)(ws + WS_XN); F.WIN = (bf16*)(ws + WS_WIN);
    F.YF = (bf16*)(ws + WS_YF); F.YB = (bf16*)(ws + WS_YB); F.MIX = (bf16*)(ws + WS_MIX); F.GHQ = ws + WS_GHQ;
}

struct Sched1 {
    int G, c;
    __device__ __forceinline__ void init(int G_, int c_) { G = G_; c = c_; }
    __device__ __forceinline__ bool next(int i, pg8::Unit& u) const {
        int grp, loc;
        if (G == 256) { if (i >= 7) return false; grp = c & 7; loc = i * 32 + (c >> 3); if (loc >= 216) { const int j = grp * 8 + (loc - 216); if (j >= 60) return false; u.pm = 64 + j / 15; const int q = j % 15; u.pn = q < 13 ? q : q + 8; return true; } }
        else { const int L = i * G + c; if (L >= 1788) return false; if (L >= 1728) { const int j = L - 1728; u.pm = 64 + j / 15; const int q = j % 15; u.pn = q < 13 ? q : q + 8; return true; } grp = L / 216; loc = L % 216; }
        u.pm = grp * 8 + (loc & 7); u.pn = loc >> 3; return true;
    }
    __device__ __forceinline__ void a_ready(const pg8::Unit&) const {}
    __device__ __forceinline__ void done(const pg8::Unit&) const {}
};

__device__ __forceinline__ void p0_transpose_item(const float* W, int K, int N, bf16* WT, LAS float* scr, int item, int lane) {
    const int nblk = N / 32, kb = item / nblk, nb = item % nblk, k0 = 64 * kb, n0 = 32 * nb;
#pragma unroll 8
    for (int i = 0; i < 32; ++i) { const int kk = 2 * i + (lane >> 5); scr[kk * 33 + (lane & 31)] = W[(size_t)(k0 + kk) * N + n0 + (lane & 31)]; }
    asm volatile("s_waitcnt lgkmcnt(0)" ::: "memory");
    const int c = lane & 7;
#pragma unroll
    for (int j = 0; j < 4; ++j) { const int n = (lane >> 3) + 8 * j; const LAS float* s = scr + (8 * c) * 33 + n;
        u32x4 o; o.x = pk2(s[0 * 33], s[1 * 33]); o.y = pk2(s[2 * 33], s[3 * 33]); o.z = pk2(s[4 * 33], s[5 * 33]); o.w = pk2(s[6 * 33], s[7 * 33]);
        *(GAS u32x4*)(WT + (size_t)(n0 + n) * K + k0 + 8 * c) = o; }
    asm volatile("s_waitcnt lgkmcnt(0)" ::: "memory");
}
__device__ __forceinline__ void p0_prologue(Frame& F) {
    const int tid = F.tid, lane = F.lane, wave = F.wave;
    if (F.bid < 192) {
        LAS float* sl = (LAS float*)F.lds;
        LAS float* red = sl + 5 * 2048;
        for (int i = tid; i < 5 * 2048; i += NWAVES * 64) { const int v = i >> 11, k = i & 2047; const float cv = v < 4 ? F.c[v * 2048 + k] : F.c_ctx[k]; sl[i] = cv / (1.0f + __expf(-cv)); }
        __syncthreads();
        const int n0 = 32 * F.bid, col = lane & 31, slot = wave * 2 + (lane >> 5);
        float acc[5] = {0.f, 0.f, 0.f, 0.f, 0.f};
        const float* wp = F.w_ada + n0 + col;
#pragma unroll 8
        for (int k = slot; k < 2048; k += 16) { const float w = wp[(size_t)k * 6144];
#pragma unroll
            for (int v = 0; v < 5; ++v) acc[v] += sl[v * 2048 + k] * w; }
#pragma unroll
        for (int v = 0; v < 5; ++v) red[(slot * 5 + v) * 32 + col] = acc[v];
        __syncthreads();
        if (tid < 160) { const int v = tid >> 5, cc = tid & 31; float s = 0.f;
#pragma unroll
            for (int q = 0; q < 16; ++q) s += red[(q * 5 + v) * 32 + cc];
            F.MOD[v * 6144 + n0 + cc] = s + F.b_ada[n0 + cc]; }
        __syncthreads();
    }
    if (F.bid == F.G - 1) {
        for (int i = tid; i < 1024; i += NWAVES * 64) { const int pos = i >> 4, f = i & 15; const float inv = exp2f(-(float)f * (13.287712379549449f / 16.0f)); const float ang = (float)pos * inv;
            F.ROPE[i] = cosf(ang); F.ROPE[1024 + i] = sinf(ang); }
    }
    LAS float* scr = (LAS float*)(F.lds + wave * 16384);
    const int gw = F.bid * NWAVES + wave, NGW = F.G * NWAVES;
    constexpr int I_IN = (DM / 64) * (NIN / 32), I_OUT = (DM / 64) * (DM / 32), I_L = 1024 / 32;
    constexpr int NITEMS = I_IN + I_OUT + 4 * I_L;
    for (int it = gw; it < NITEMS; it += NGW) {
        int r = it;
        if (r < I_IN) { p0_transpose_item(F.w_in, DM, NIN, F.WIN, scr, r, lane); continue; } r -= I_IN;
        if (r < I_OUT) { p0_transpose_item(F.w_out, DM, DM, F.WOUT, scr, r, lane); continue; } r -= I_OUT;
        const int q = r / I_L; r -= q * I_L;
        p0_transpose_item((q < 2 ? F.w2 : F.a2) + (size_t)(q & 1) * 64 * 1024, 64, 1024, (q < 2 ? F.W2T : F.A2T) + (size_t)(q & 1) * 1024 * 64, scr, r, lane);
    }
}

__device__ __forceinline__ void p1_modulate(Frame& F) {
    const int gw = F.bid * NWAVES + F.wave, NGW = F.G * NWAVES, lane = F.lane;
    const int m_lo = (int)(((long)gw * MT) / NGW), m_hi = (int)(((long)(gw + 1) * MT) / NGW);
    f32x4 gs[8], sh[8]; int cur = -1;
    for (int m = m_lo; m < m_hi; ++m) {
        const float* src = m < ML ? F.x + (size_t)m * DM : F.ctx + (size_t)(m - ML) * DM;
        const int bsel = m < ML ? (m >> 12) : 4;
        if (bsel != cur) { cur = bsel; const float* mod = F.MOD + bsel * 6144;
#pragma unroll
            for (int j = 0; j < 8; ++j) { const int d0 = (64 * j + lane) * 4; gs[j] = *(const f32x4*)(F.norm_g + d0) * (1.0f + *(const f32x4*)(mod + 2048 + d0)); sh[j] = *(const f32x4*)(mod + d0); } }
        const GAS f32x4* xr = (const GAS f32x4*)src + lane;
        f32x4 v[8]; float s = 0.f;
#pragma unroll
        for (int j = 0; j < 8; ++j) { v[j] = xr[64 * j]; s += (v[j].x * v[j].x + v[j].y * v[j].y) + (v[j].z * v[j].z + v[j].w * v[j].w); }
        const float rr = 1.0f / sqrtf(wave_sum(s) * (1.0f / DM) + 1e-6f);
        GAS u32x2* o8 = (GAS u32x2*)(F.XN + (size_t)m * DM) + lane;
#pragma unroll
        for (int j = 0; j < 8; ++j) { const f32x4 o = v[j] * rr * gs[j] + sh[j]; u32x2 w; w.x = pk2(o.x, o.y); w.y = pk2(o.z, o.w); o8[64 * j] = w; }
    }
}

__device__ __forceinline__ int seq_lo(int m) { return m < ML ? (m & ~(SEQ - 1)) : ML + ((m - ML) & ~(CTXL - 1)); }
__device__ __forceinline__ int seq_hi(int m) { return m < ML ? (m | (SEQ - 1)) : ML + ((m - ML) | (CTXL - 1)); }
__device__ __forceinline__ int scan_row(int b, int d, int blk, int tok) {
    const int j = blk < 4 ? blk * 64 + tok : (blk - 4) * 64 + tok;
    if (blk < 4) return ML + b * CTXL + (d ? (CTXL - 1 - j) : j);
    return b * SEQ + (d ? (SEQ - 1 - j) : j);
}
constexpr int CH_RS = 144, CH_MB = 64 * CH_RS;
constexpr int CB_AT = 0, CB_BT = 1, CB_KT = 2, CB_RT = 3, CB_ATT = 4, CB_BTT = 5, CB_KTT = 6, CB_VT = 7, CB_AAB = 8, CB_AABT = 9, CB_AAK = 10, CB_ARB = 11, CB_ARK = 12, CB_X1 = 13, CB_XT = 14, CB_INV = 4, CB_OY = 4, CB_OG = 5, CB_OH = 6, CB_OQ = 7;
constexpr int CH_WBUF = 8 * CH_MB, CH_ABUF = CH_WBUF + 16384;
constexpr int CH_PT = 15 * CH_MB, CH_GT = CH_PT + 1024, CH_CONST = CH_GT + 2048;
constexpr int CH_LW = 144384;
#ifndef FORCE_BF16
#define FORCE_BF16 0
#endif
constexpr size_t GHQ_ITEM = 24576;
#define LBAR() do { asm volatile("s_waitcnt lgkmcnt(0)" ::: "memory"); __builtin_amdgcn_s_barrier(); asm volatile("" ::: "memory"); } while (0)
__device__ __forceinline__ float h_lo(unsigned w) { return (float)__builtin_bit_cast(h2, w)[0]; }
__device__ __forceinline__ float h_hi(unsigned w) { return (float)__builtin_bit_cast(h2, w)[1]; }
__device__ __forceinline__ f32x4 unpack4x(bool f16, const u32x2 w) { f32x4 r;
    if (f16) { r.x = h_lo(w.x); r.y = h_hi(w.x); r.z = h_lo(w.y); r.w = h_hi(w.y); } else { r.x = bflo(w.x); r.y = bfhi(w.x); r.z = bflo(w.y); r.w = bfhi(w.y); }
    return r; }
__device__ __forceinline__ u32x4 pack8x(bool f16, const float* v) { u32x4 o;
    if (f16) { o.x = pkh(v[0], v[1]); o.y = pkh(v[2], v[3]); o.z = pkh(v[4], v[5]); o.w = pkh(v[6], v[7]); } else { o.x = pk2(v[0], v[1]); o.y = pk2(v[2], v[3]); o.z = pk2(v[4], v[5]); o.w = pk2(v[6], v[7]); }
    return o; }
__device__ __forceinline__ f32x16 mm32(bool f16, const LAS unsigned char* Aop, int mrow0, const LAS unsigned char* Blay, int nrow0, f32x16 acc, int l31, int hi) {
    const LAS unsigned char* pa = Aop + (mrow0 + l31) * CH_RS + hi * 16;
    const LAS unsigned char* pb = Blay + (nrow0 + l31) * CH_RS + hi * 16;
    bf16x8 a[4], b[4];
#pragma unroll
    for (int ks = 0; ks < 4; ++ks) { a[ks] = *(const LAS bf16x8*)(pa + ks * 32); b[ks] = *(const LAS bf16x8*)(pb + ks * 32); }
    if (f16) {
#pragma unroll
        for (int ks = 0; ks < 4; ++ks) acc = __builtin_amdgcn_mfma_f32_32x32x16_f16(__builtin_bit_cast(h8, a[ks]), __builtin_bit_cast(h8, b[ks]), acc, 0, 0, 0);
    } else {
#pragma unroll
        for (int ks = 0; ks < 4; ++ks) acc = __builtin_amdgcn_mfma_f32_32x32x16_bf16(a[ks], b[ks], acc, 0, 0, 0);
    }
    return acc;
}
__device__ __forceinline__ f32x16 mm32k(bool f16, const LAS unsigned char* Aop, int mrow0, const LAS unsigned char* Blay, int nrow0, int kb, f32x16 acc, int l31, int hi) {
    const LAS unsigned char* pa = Aop + (mrow0 + l31) * CH_RS + kb * 64 + hi * 16;
    const LAS unsigned char* pb = Blay + (nrow0 + l31) * CH_RS + kb * 64 + hi * 16;
    const bf16x8 a0 = *(const LAS bf16x8*)pa, a1 = *(const LAS bf16x8*)(pa + 32), b0 = *(const LAS bf16x8*)pb, b1 = *(const LAS bf16x8*)(pb + 32);
    if (f16) { acc = __builtin_amdgcn_mfma_f32_32x32x16_f16(__builtin_bit_cast(h8, a0), __builtin_bit_cast(h8, b0), acc, 0, 0, 0); acc = __builtin_amdgcn_mfma_f32_32x32x16_f16(__builtin_bit_cast(h8, a1), __builtin_bit_cast(h8, b1), acc, 0, 0, 0); }
    else { acc = __builtin_amdgcn_mfma_f32_32x32x16_bf16(a0, b0, acc, 0, 0, 0); acc = __builtin_amdgcn_mfma_f32_32x32x16_bf16(a1, b1, acc, 0, 0, 0); }
    return acc;
}
typedef short s16x4 __attribute__((ext_vector_type(4))); typedef short s16x8 __attribute__((ext_vector_type(8)));
__device__ __forceinline__ bf16x8 trfrag(const LAS unsigned char* Img, int j0, int c0, int lane) {
    const int g = lane >> 4, q = (lane >> 2) & 3, p = lane & 3;
    LAS unsigned char* a = (LAS unsigned char*)Img + (j0 + 8 * (g >> 1) + q) * CH_RS + (c0 + 16 * (g & 1) + 4 * p) * 2;
    const s16x4 r0 = __builtin_amdgcn_ds_read_tr16_b64_v4i16((LAS s16x4*)a), r1 = __builtin_amdgcn_ds_read_tr16_b64_v4i16((LAS s16x4*)(a + 4 * CH_RS));
    return __builtin_bit_cast(bf16x8, __builtin_shufflevector(r0, r1, 0, 1, 2, 3, 4, 5, 6, 7));
}
template<bool TA, bool TB> __device__ __forceinline__ f32x16 mm32x(bool f16, const LAS unsigned char* A, int a0, const LAS unsigned char* B, int b0, f32x16 acc, int lane) {
    const int l31 = lane & 31, hi = lane >> 5;
    bf16x8 a[4], b[4];
#pragma unroll
    for (int ks = 0; ks < 4; ++ks) {
        a[ks] = TA ? trfrag(A, 16 * ks, a0, lane) : *(const LAS bf16x8*)(A + (a0 + l31) * CH_RS + hi * 16 + ks * 32);
        b[ks] = TB ? trfrag(B, 16 * ks, b0, lane) : *(const LAS bf16x8*)(B + (b0 + l31) * CH_RS + hi * 16 + ks * 32); }
    if (f16) {
#pragma unroll
        for (int ks = 0; ks < 4; ++ks) acc = __builtin_amdgcn_mfma_f32_32x32x16_f16(__builtin_bit_cast(h8, a[ks]), __builtin_bit_cast(h8, b[ks]), acc, 0, 0, 0);
    } else {
#pragma unroll
        for (int ks = 0; ks < 4; ++ks) acc = __builtin_amdgcn_mfma_f32_32x32x16_bf16(a[ks], b[ks], acc, 0, 0, 0);
    }
    return acc;
}
__device__ __forceinline__ void st_nat(bool f16, LAS unsigned char* Out, int mrow0, int nrow0, const f32x16& acc, int l31, int hi) {
    LAS unsigned char* p = Out + (nrow0 + l31) * CH_RS + (mrow0 + 4 * hi) * 2;
    if (f16) {
#pragma unroll
        for (int rg = 0; rg < 4; ++rg) { u32x2 o; o.x = pkh(acc[4 * rg], acc[4 * rg + 1]); o.y = pkh(acc[4 * rg + 2], acc[4 * rg + 3]); *(LAS u32x2*)(p + rg * 16) = o; }
    } else {
#pragma unroll
        for (int rg = 0; rg < 4; ++rg) { u32x2 o; o.x = pk2(acc[4 * rg], acc[4 * rg + 1]); o.y = pk2(acc[4 * rg + 2], acc[4 * rg + 3]); *(LAS u32x2*)(p + rg * 16) = o; }
    }
}
__device__ __forceinline__ f32x16 zero16() { f32x16 z = {0.f, 0.f, 0.f, 0.f, 0.f, 0.f, 0.f, 0.f, 0.f, 0.f, 0.f, 0.f, 0.f, 0.f, 0.f, 0.f}; return z; }
struct ChRegs { u32x4 r, k, v, lw, la, halo; };
__device__ __forceinline__ int chunk_mlo(int b, int d, int c) { return d ? scan_row(b, d, c, 63) : scan_row(b, d, c, 0); }
__device__ __forceinline__ void ch_load(Frame& F, ChRegs& R, int b, int h, int d, int c) {
    const int tok = F.tid >> 3, ch = F.tid & 7, m = scan_row(b, d, c, tok);
    const bf16* pc = F.P + (size_t)m * NIN + 8 * ch;
    const int cr = C_R + h * 64, ck = C_K + h * 64, cv = C_V + h * 64, cw = C_LW + d * 64, ca = C_LA + d * 64;
    R.r = *(const u32x4*)(pc + cr); R.k = *(const u32x4*)(pc + ck); R.v = *(const u32x4*)(pc + cv); R.lw = *(const u32x4*)(pc + cw); R.la = *(const u32x4*)(pc + ca);
    const u32x4 z = {0u, 0u, 0u, 0u}; R.halo = z;
    if (F.tid < 80) { const int hrow = F.tid >= 40 ? 1 : 0, vec = (F.tid - 40 * hrow) >> 3, mlo = chunk_mlo(b, d, c), mh = hrow ? mlo + 64 : mlo - 1;
        const int col = vec == 0 ? cr : vec == 1 ? ck : vec == 2 ? cv : vec == 3 ? cw : ca;
        if (mh >= seq_lo(mlo) && mh <= seq_hi(mlo)) R.halo = *(const u32x4*)(F.P + (size_t)mh * NIN + col + 8 * ch); }
}
constexpr int CH_RAW3 = 0 * CH_MB, CH_RAWL = 10 * CH_MB;
__device__ __forceinline__ void ch_park(Frame& F, const ChRegs& R, int b, int d, int c) {
    LAS unsigned char* lds = F.lds; const int tok = F.tid >> 3, ch = F.tid & 7, ri = 1 + scan_row(b, d, c, tok) - chunk_mlo(b, d, c);
    LAS unsigned char* p3 = lds + CH_RAW3 + ri * 384 + ch * 16; LAS unsigned char* pl = lds + CH_RAWL + ri * 256 + ch * 16;
    *(LAS u32x4*)p3 = R.r; *(LAS u32x4*)(p3 + 128) = R.k; *(LAS u32x4*)(p3 + 256) = R.v; *(LAS u32x4*)pl = R.lw; *(LAS u32x4*)(pl + 128) = R.la;
    if (F.tid < 80) { const int hrow = F.tid >= 40 ? 1 : 0, vec = (F.tid - 40 * hrow) >> 3, rh = hrow ? 65 : 0;
        if (vec < 3) *(LAS u32x4*)(lds + CH_RAW3 + rh * 384 + vec * 128 + ch * 16) = R.halo; else *(LAS u32x4*)(lds + CH_RAWL + rh * 256 + (vec - 3) * 128 + ch * 16) = R.halo; }
}
__device__ __forceinline__ void shift8(const u32x4 c, const u32x4 p, const u32x4 n, const LAS f32x4* mu, float* o) {
    float vc[8], vp[8], vn[8]; unpack8(c, vc); unpack8(p, vp); unpack8(n, vn);
    const f32x4 m0 = mu[0], m1 = mu[1];
#pragma unroll
    for (int j = 0; j < 8; ++j) { const float mm = j < 4 ? m0[j & 3] : m1[j & 3]; o[j] = vc[j] + mm * (0.5f * (vp[j] + vn[j]) - vc[j]); }
}
template<bool F16> __device__ __forceinline__ f32x16 mf2(const u32x4 a0, const u32x4 a1, const u32x4 b0, const u32x4 b1, f32x16 acc) {
    if (F16) { acc = __builtin_amdgcn_mfma_f32_32x32x16_f16(__builtin_bit_cast(h8, a0), __builtin_bit_cast(h8, b0), acc, 0, 0, 0); acc = __builtin_amdgcn_mfma_f32_32x32x16_f16(__builtin_bit_cast(h8, a1), __builtin_bit_cast(h8, b1), acc, 0, 0, 0); }
    else { acc = __builtin_amdgcn_mfma_f32_32x32x16_bf16(__builtin_bit_cast(bf16x8, a0), __builtin_bit_cast(bf16x8, b0), acc, 0, 0, 0); acc = __builtin_amdgcn_mfma_f32_32x32x16_bf16(__builtin_bit_cast(bf16x8, a1), __builtin_bit_cast(bf16x8, b1), acc, 0, 0, 0); }
    return acc; }
template<bool F16> __device__ __forceinline__ void cv2(const f32x16& a, u32x4& s0, u32x4& s1) {
    if (F16) { s0.x = pkh(a[0], a[1]); s0.y = pkh(a[2], a[3]); s0.z = pkh(a[4], a[5]); s0.w = pkh(a[6], a[7]); s1.x = pkh(a[8], a[9]); s1.y = pkh(a[10], a[11]); s1.z = pkh(a[12], a[13]); s1.w = pkh(a[14], a[15]); }
    else { s0.x = pk2(a[0], a[1]); s0.y = pk2(a[2], a[3]); s0.z = pk2(a[4], a[5]); s0.w = pk2(a[6], a[7]); s1.x = pk2(a[8], a[9]); s1.y = pk2(a[10], a[11]); s1.z = pk2(a[12], a[13]); s1.w = pk2(a[14], a[15]); } }
template<bool F16, bool TR> __device__ __forceinline__ f32x16 inv_chain(const f32x16& ap0, const f32x16& aq0, int l31, int hi) {
    u32x4 p0, p1, q0, q1, x0, x1;
    cv2<F16>(ap0, p0, p1); cv2<F16>(aq0, q0, q1);
    f32x16 x = TR ? aq0 : ap0;
#pragma unroll
    for (int r = 0; r < 16; ++r) { const int row = (r & 3) + 8 * (r >> 2) + 4 * hi; if (row == l31) x[r] += 1.0f; }
    cv2<F16>(x, x0, x1);
#pragma unroll
    for (int k = 1; k <= 4; ++k) {
        const bool needP = (k < 4) || TR, needQ = (k < 4) || !TR;
        f32x16 ap = zero16(), aq = zero16();
        if (needP) ap = mf2<F16>(q0, q1, p0, p1, ap);
        if (needQ) aq = mf2<F16>(p0, p1, q0, q1, aq);
        if (needP) cv2<F16>(ap, p0, p1);
        if (needQ) cv2<F16>(aq, q0, q1);
        x = TR ? mf2<F16>(p0, p1, x0, x1, x) : mf2<F16>(q0, q1, x0, x1, x);
        if (k < 4) cv2<F16>(x, x0, x1);
    }
    return x;
}
template<bool F16> __device__ __forceinline__ void chain_wave(LAS unsigned char* lds, int wave, int lane, u32x4& t0, u32x4& t1) {
    const int l31 = lane & 31, hi = lane >> 5, o = wave == 2 ? 32 : 0;
    const LAS unsigned char* At = lds + CB_AT * CH_MB; const LAS unsigned char* Bt = lds + CB_BT * CH_MB;
    f32x16 aq = mm32(F16, Bt, o, At, o, zero16(), l31, hi);
    f32x16 ap = mm32(F16, At, o, Bt, o, zero16(), l31, hi);
#pragma unroll
    for (int r = 0; r < 16; ++r) { const int row = (r & 3) + 8 * (r >> 2) + 4 * hi; aq[r] = row < l31 ? aq[r] : 0.f; ap[r] = l31 < row ? ap[r] : 0.f; }
    if (wave != 3) { const f32x16 x = inv_chain<F16, true>(ap, aq, l31, hi); st_nat(F16, lds + CB_INV * CH_MB, o, o, x, l31, hi); if (wave == 2) cv2<F16>(x, t0, t1); }
    else { const f32x16 x1 = inv_chain<F16, false>(ap, aq, l31, hi);
        u32x4 b0, b1, a0, a1, u0, u1; cv2<F16>(x1, b0, b1);
        const f32x16 a21 = mm32(F16, Bt, 0, At, 32, zero16(), l31, hi);
        cv2<F16>(a21, a0, a1);
        const f32x16 u = mf2<F16>(a0, a1, b0, b1, zero16());
        cv2<F16>(u, u0, u1);
        *(LAS u32x4*)(lds + CB_AAB * CH_MB + lane * 16) = u0; *(LAS u32x4*)(lds + CB_AAB * CH_MB + 1024 + lane * 16) = u1; }
}
__device__ __forceinline__ void ch_tail(const bool f16, Frame& F, ChRegs& R, const float (&sr)[8], const float (&sk)[8], const float (&sv)[8], int b, int h, int d, int c, int chain, int ci) {
    int lane_ = F.lane; asm volatile("" : "+v"(lane_));
    const int tid = F.tid, lane = lane_, wave = F.wave, l31 = lane & 31, hi = lane >> 5;
    const int q4 = wave & 3, tb = q4 >> 1, cb = q4 & 1, tok = tid >> 3, ch = tid & 7;
    LAS unsigned char* lds = F.lds;
    const LAS f32x4* cs = (const LAS f32x4*)(lds + CH_CONST) + 2 * ch;
    const LAS float* pT = (const LAS float*)(lds + CH_PT);
#define CB(i) (lds + (i) * CH_MB)
    { const LAS f32x4* pw = (const LAS f32x4*)(lds + CH_WBUF) + tok * 16 + 2 * ch; const LAS f32x4* pab = (const LAS f32x4*)(lds + CH_ABUF) + tok * 16 + 2 * ch;
      const f32x4 p0 = pw[0], p1 = pw[1], a0v = pab[0], a1v = pab[1];
      f32x4 m0 = {1.f, 1.f, 1.f, 1.f}, m1 = m0; if (tok > 0) { m0 = pw[-16]; m1 = pw[-15]; }
      const f32x4 r0 = *(const LAS f32x4*)(pT + 64 + 8 * ch), r1 = *(const LAS f32x4*)(pT + 64 + 8 * ch + 4);
      const f32x4 kk0 = cs[80], kk1 = cs[81], ka0 = cs[96], ka1 = cs[97], rk0 = cs[112], rk1 = cs[113];
      float kk[8], ss = 0.f;
#pragma unroll
      for (int j = 0; j < 8; ++j) { kk[j] = sk[j] * (j < 4 ? kk0[j & 3] : kk1[j & 3]); ss += kk[j] * kk[j]; }
      ss += __shfl_xor(ss, 1); ss += __shfl_xor(ss, 2); ss += __shfl_xor(ss, 4);
      const float inv = __builtin_amdgcn_rsqf(fmaxf(ss, 1e-24f));
      float at[8], bt[8], kt[8], rt[8], bon = 0.f;
#pragma unroll
      for (int j = 0; j < 8; ++j) { const float P = j < 4 ? p0[j & 3] : p1[j & 3], Pm = j < 4 ? m0[j & 3] : m1[j & 3], a = j < 4 ? a0v[j & 3] : a1v[j & 3], pr = j < 4 ? r0[j & 3] : r1[j & 3];
          const float kac = j < 4 ? ka0[j & 3] : ka1[j & 3], rkc = j < 4 ? rk0[j & 3] : rk1[j & 3];
          const float kn = kk[j] * inv, kd = sk[j] * (1.0f + (a - 1.0f) * kac), ipr = __builtin_amdgcn_rcpf(pr), rp = pr * __builtin_amdgcn_rcpf(P);
          at[j] = -kn * Pm * ipr; bt[j] = kn * a * rp; kt[j] = kd * rp; rt[j] = sr[j] * P * ipr; bon += sr[j] * kd * rkc; }
      bon += __shfl_xor(bon, 1); bon += __shfl_xor(bon, 2); bon += __shfl_xor(bon, 4);
      if (ch == 0 && c >= 4) F.BON[((size_t)d * ML + scan_row(b, d, c, tok)) * 16 + h] = bon;
      *(LAS u32x4*)(CB(CB_AT) + tok * CH_RS + ch * 16) = pack8x(f16, at);
      *(LAS u32x4*)(CB(CB_BT) + tok * CH_RS + ch * 16) = pack8x(f16, bt);
      *(LAS u32x4*)(CB(CB_KT) + tok * CH_RS + ch * 16) = pack8x(f16, kt);
      *(LAS u32x4*)(CB(CB_RT) + tok * CH_RS + ch * 16) = pack8x(f16, rt);
      *(LAS u32x4*)(CB(CB_X1) + tok * CH_RS + ch * 16) = pack8x(f16, sv); }
    LBAR(); TSTAMP(3);
    const bool chainw = wave == 0 || wave == 2 || wave == 3;
    if (!chainw && ci + 1 < 34) ch_load(F, R, b, h, d, c - 1);
    u32x4 t0 = {0u, 0u, 0u, 0u}, t1 = t0;
    if (chainw) { if (f16) chain_wave<true>(lds, wave, lane, t0, t1); else chain_wave<false>(lds, wave, lane, t0, t1); }
    else { const bool mid = wave >= 4 && wave <= 6;
#pragma unroll 1
      for (int i = 0; i < 2; ++i) { if (wave == 1 && i == 1) break;
          const int pr = wave == 1 ? 1 : wave == 7 ? 2 + i : wave - 3, jb = mid ? i : 0, tbk = mid ? 1 : 0;
          const LAS unsigned char* Aop = CB((pr & 1) ? CB_KT : CB_BT); const LAS unsigned char* Blay = CB(pr < 2 ? CB_AT : CB_RT);
          LAS unsigned char* Out = CB(CB_AAB + 1 + pr);
          f32x16 a = mm32(f16, Aop, jb * 32, Blay, tbk * 32, zero16(), l31, hi);
          if (jb == tbk) { const bool incl = pr >= 2;
#pragma unroll
              for (int r = 0; r < 16; ++r) { const int j = (r & 3) + 8 * (r >> 2) + 4 * hi; const bool ok = incl ? (j <= l31) : (j < l31); a[r] = ok ? a[r] : 0.f; } }
          st_nat(f16, Out, jb * 32, tbk * 32, a, l31, hi); }
      if (wave == 1) { st_nat(f16, CB(CB_AAK), 32, 0, zero16(), l31, hi); st_nat(f16, CB(CB_INV), 32, 0, zero16(), l31, hi); }
      if (wave == 7) { st_nat(f16, CB(CB_ARB), 32, 0, zero16(), l31, hi); st_nat(f16, CB(CB_ARK), 32, 0, zero16(), l31, hi); } }
    LBAR(); TSTAMP(4);
    if ((wave == 0 || wave == 3) && ci + 1 < 34) ch_load(F, R, b, h, d, c - 1);
    if (wave == 2) { const u32x4 u0 = *(const LAS u32x4*)(CB(CB_AAB) + lane * 16), u1 = *(const LAS u32x4*)(CB(CB_AAB) + 1024 + lane * 16);
        const f32x16 y = f16 ? mf2<true>(u0, u1, t0, t1, zero16()) : mf2<false>(u0, u1, t0, t1, zero16());
        st_nat(f16, CB(CB_INV), 0, 32, y, l31, hi);
        if (ci + 1 < 34) ch_load(F, R, b, h, d, c - 1); }
    else if (wave >= 4) { const f32x16 acc = mm32x<false, true>(f16, CB(CB_AAK), tb * 32, CB(CB_X1), cb * 32, zero16(), lane); st_nat(f16, CB(CB_XT), tb * 32, cb * 32, acc, l31, hi); }
    LBAR();
    TSTAMP(5);
    { f32x16 acc = wave < 4 ? mm32x<false, true>(f16, CB(CB_INV), tb * 32, CB(CB_AT), cb * 32, zero16(), lane) : mm32(f16, CB(CB_INV), tb * 32, CB(CB_XT), cb * 32, zero16(), l31, hi);
      st_nat(f16, CB(wave < 4 ? CB_AAB : CB_AABT), tb * 32, cb * 32, acc, l31, hi); }
    LBAR(); TSTAMP(6);
    { const int om = wave >> 1, nb = wave & 1;
      int c_ = c; asm volatile("" : "+s"(c_));
#pragma unroll
      for (int mb = 0; mb < 2; ++mb) {
          if (om == 0) {
              f32x16 acc; const LAS unsigned char* p = CB(CB_RT) + (nb * 32 + l31) * CH_RS + (mb * 32 + 4 * hi) * 2;
#pragma unroll
              for (int rg = 0; rg < 4; ++rg) { const u32x2 w = *(const LAS u32x2*)(p + rg * 16); const f32x4 u = unpack4x(f16, w); acc[4 * rg] = u.x; acc[4 * rg + 1] = u.y; acc[4 * rg + 2] = u.z; acc[4 * rg + 3] = u.w; }
              acc = mm32(f16, CB(CB_AAB), mb * 32, CB(CB_ARB), nb * 32, acc, l31, hi);
              LAS unsigned char* o = CB(CB_OQ) + (nb * 32 + l31) * CH_RS + (mb * 32 + 4 * hi) * 2;
#pragma unroll
              for (int rg = 0; rg < 4; ++rg) { const f32x4 pv = *(const LAS f32x4*)(pT + 64 + mb * 32 + 8 * rg + 4 * hi);
                  u32x2 w; w.x = pkh(acc[4 * rg] * pv.x, acc[4 * rg + 1] * pv.y); w.y = pkh(acc[4 * rg + 2] * pv.z, acc[4 * rg + 3] * pv.w); *(LAS u32x2*)(o + rg * 16) = w; }
          } else if (om == 1) {
              f32x16 acc = mm32x<false, true>(f16, CB(CB_AAB), mb * 32, CB(CB_BT), nb * 32, zero16(), lane);
              const float pto = pT[nb * 32 + l31], ptk = pT[128 + nb * 32 + l31];
              LAS unsigned char* o = CB(CB_OG) + (nb * 32 + l31) * CH_RS + (mb * 32 + 4 * hi) * 2;
#pragma unroll
              for (int rg = 0; rg < 4; ++rg) { const f32x4 pv = *(const LAS f32x4*)(pT + 64 + mb * 32 + 8 * rg + 4 * hi); float g[4];
#pragma unroll
                  for (int i = 0; i < 4; ++i) { const int kp = mb * 32 + 8 * rg + 4 * hi + i; g[i] = pto * pv[i] * acc[4 * rg + i] + (kp == nb * 32 + l31 ? ptk : 0.0f); }
                  u32x2 w; w.x = pkh(g[0], g[1]); w.y = pkh(g[2], g[3]); *(LAS u32x2*)(o + rg * 16) = w; }
          } else if (om == 2) {
              f32x16 acc = mm32x<true, false>(f16, CB(CB_BT), mb * 32, CB(CB_AABT), nb * 32, zero16(), lane);
              acc = mm32x<true, true>(f16, CB(CB_KT), mb * 32, CB(CB_X1), nb * 32, acc, lane);
              LAS unsigned char* o = CB(CB_OH) + (nb * 32 + l31) * CH_RS + (mb * 32 + 4 * hi) * 2;
#pragma unroll
              for (int rg = 0; rg < 4; ++rg) { const f32x4 pv = *(const LAS f32x4*)(pT + mb * 32 + 8 * rg + 4 * hi);
                  u32x2 w; w.x = pkh(acc[4 * rg] * pv.x, acc[4 * rg + 1] * pv.y); w.y = pkh(acc[4 * rg + 2] * pv.z, acc[4 * rg + 3] * pv.w); *(LAS u32x2*)(o + rg * 16) = w; }
          } else if (c_ >= 4) {
              f32x16 acc = mm32(f16, CB(CB_AABT), mb * 32, CB(CB_ARB), nb * 32, zero16(), l31, hi);
              acc = mm32x<true, false>(f16, CB(CB_X1), mb * 32, CB(CB_ARK), nb * 32, acc, lane);
              LAS unsigned char* yp = CB(CB_OY) + (nb * 32 + l31) * CH_RS + (mb * 32 + 4 * hi) * 2;
#pragma unroll
              for (int rg = 0; rg < 4; ++rg) { u32x2 w; w.x = pkh(acc[4 * rg], acc[4 * rg + 1]); w.y = pkh(acc[4 * rg + 2], acc[4 * rg + 3]); *(LAS u32x2*)(yp + rg * 16) = w; }
          }
      } }
    LBAR();
    { int c_ = c; asm volatile("" : "+s"(c_));
      unsigned char* gq = (unsigned char*)F.GHQ + ((size_t)chain * 68 + c_) * GHQ_ITEM + tok * 128 + ch * 16; const int lo = tok * CH_RS + ch * 16;
      *(u32x4*)gq = *(const LAS u32x4*)(CB(CB_OG) + lo); *(u32x4*)(gq + 8192) = *(const LAS u32x4*)(CB(CB_OH) + lo); *(u32x4*)(gq + 16384) = *(const LAS u32x4*)(CB(CB_OQ) + lo);
      if (c_ >= 4) *(u32x4*)((unsigned char*)(d ? F.YB : F.YF) + (size_t)scan_row(b, d, c_, tok) * 2048 + h * 128 + ch * 16) = *(const LAS u32x4*)(CB(CB_OY) + lo); }
    TSTAMP(7);
#undef CB
}

__device__ __forceinline__ void p3_chunkA(Frame& F) {
    const int tid = F.tid, lane = F.lane, wave = F.wave, l31 = lane & 31, hi = lane >> 5;
    LAS unsigned char* lds = F.lds;
#define CB(i) (lds + (i) * CH_MB)
    for (int g = F.bid; g < 256; g += F.G) {
        const int chain = g >> 1, c0 = (g & 1) * 34, d = chain & 1, h = (chain >> 1) & 15, b = chain >> 5;
        { const int q = tid >> 6, n = tid & 63, c = h * 64 + n;
          const float val = q == 0 ? F.mu_shift[C_R + c] : q == 1 ? F.mu_shift[C_K + c] : q == 2 ? F.mu_shift[C_V + c] : q == 3 ? F.mu_shift[C_LW + d * 64 + n] : q == 4 ? F.mu_shift[C_LA + d * 64 + n] : q == 5 ? F.k_k[c] : q == 6 ? F.k_a[c] : F.r_k[c];
          ((LAS float*)(lds + CH_CONST))[tid] = val; }
        const int q4 = wave & 3, tb = q4 >> 1, cb = q4 & 1;
        { const int row = tid >> 3, chk = tid & 7;
          *(LAS u32x4*)(lds + CH_LW + row * CH_RS + chk * 16) = *(const u32x4*)(F.W2T + ((size_t)d * 1024 + h * 64 + row) * 64 + 8 * chk);
          *(LAS u32x4*)(lds + CH_LW + CH_MB + row * CH_RS + chk * 16) = *(const u32x4*)(F.A2T + ((size_t)d * 1024 + h * 64 + row) * 64 + 8 * chk); }
        const float lbias = (wave < 4 ? F.w0 : F.a0)[d * 1024 + h * 64 + cb * 32 + l31];
        LBAR();
        ChRegs R;
        ch_load(F, R, b, h, d, c0 + 33);
#pragma unroll 1
        for (int ci = 0; ci < 34; ++ci) {
            const int c = c0 + 33 - ci;
            const int tok = tid >> 3, ch = tid & 7;
            const LAS f32x4* cs = (const LAS f32x4*)(lds + CH_CONST) + 2 * ch;
            float sr[8], sk[8], sv[8];
            ch_park(F, R, b, d, c);
            LBAR();
            { float slw[8], sla[8];
              const int ri = 1 + scan_row(b, d, c, tok) - chunk_mlo(b, d, c);
              const LAS unsigned char* p3 = lds + CH_RAW3 + ri * 384 + ch * 16; const LAS unsigned char* pl = lds + CH_RAWL + ri * 256 + ch * 16;
              shift8(R.r, *(const LAS u32x4*)(p3 - 384), *(const LAS u32x4*)(p3 + 384), cs, sr); shift8(R.k, *(const LAS u32x4*)(p3 - 384 + 128), *(const LAS u32x4*)(p3 + 384 + 128), cs + 16, sk);
              shift8(R.v, *(const LAS u32x4*)(p3 - 384 + 256), *(const LAS u32x4*)(p3 + 384 + 256), cs + 32, sv);
              shift8(R.lw, *(const LAS u32x4*)(pl - 256), *(const LAS u32x4*)(pl + 256), cs + 48, slw); shift8(R.la, *(const LAS u32x4*)(pl - 256 + 128), *(const LAS u32x4*)(pl + 256 + 128), cs + 64, sla);
#pragma unroll
              for (int j = 0; j < 8; ++j) slw[j] = 1.0f - 2.0f * __builtin_amdgcn_rcpf(1.0f + fast_exp(2.0f * slw[j]));
              u32x4 o; o.x = pk2(slw[0], slw[1]); o.y = pk2(slw[2], slw[3]); o.z = pk2(slw[4], slw[5]); o.w = pk2(slw[6], slw[7]); *(LAS u32x4*)(CB(CB_X1) + tok * CH_RS + ch * 16) = o;
              o.x = pk2(sla[0], sla[1]); o.y = pk2(sla[2], sla[3]); o.z = pk2(sla[4], sla[5]); o.w = pk2(sla[6], sla[7]); *(LAS u32x4*)(CB(CB_XT) + tok * CH_RS + ch * 16) = o; }
            LBAR(); TSTAMP(0);
            { f32x16 acc = zero16();
              const LAS unsigned char* pa = CB(wave < 4 ? CB_X1 : CB_XT) + (tb * 32 + l31) * CH_RS + hi * 16;
              const LAS unsigned char* pw2 = lds + CH_LW + (wave < 4 ? 0 : CH_MB) + (cb * 32 + l31) * CH_RS + hi * 16;
#pragma unroll
              for (int ks = 0; ks < 4; ++ks) acc = __builtin_amdgcn_mfma_f32_32x32x16_bf16(*(const LAS bf16x8*)(pa + ks * 32), *(const LAS bf16x8*)(pw2 + ks * 32), acc, 0, 0, 0);
              LAS float* dst = (LAS float*)(lds + (wave < 4 ? CH_WBUF : CH_ABUF)) + cb * 32 + l31;
#pragma unroll
              for (int r = 0; r < 16; ++r) { const int t = tb * 32 + (r & 3) + 8 * (r >> 2) + 4 * hi; const float sg = sigmoidf_(acc[r] + lbias);
                  dst[t * 64] = wave < 4 ? fast_exp(-0.6065306597126334f * sg) : sg; } }
            LBAR(); TSTAMP(1);
            { LAS float* wb = (LAS float*)(lds + CH_WBUF) + (wave * 8) * 64 + (tid & 63); LAS float* gt = (LAS float*)(lds + CH_GT);
              float q[8]; q[0] = wb[0];
#pragma unroll
              for (int i = 1; i < 8; ++i) q[i] = q[i - 1] * wb[i * 64];
              gt[wave * 64 + (tid & 63)] = q[7];
              LBAR();
              float pre = 1.0f, p31 = 1.0f;
#pragma unroll
              for (int gg = 0; gg < 7; ++gg) { const float tv = gt[gg * 64 + (tid & 63)]; pre = gg < wave ? pre * tv : pre; p31 = gg < 4 ? p31 * tv : p31; }
#pragma unroll
              for (int i = 0; i < 8; ++i) wb[i * 64] = pre * q[i];
              if (wave == 7) { const float p63 = pre * q[7]; LAS float* pt = (LAS float*)(lds + CH_PT);
                  pt[tid & 63] = p63 / p31;
                  pt[64 + (tid & 63)] = p31;
                  pt[128 + (tid & 63)] = p63;
                  const bool ok = !FORCE_BF16 && p31 > 2.44140625e-4f && p63 > 2.44140625e-4f * p31;
                  if ((tid & 63) == 0) ((LAS unsigned*)pt)[192] = __all(ok) ? 1u : 0u; else (void)__all(ok); } }
            LBAR(); TSTAMP(2);
            { const bool f16 = __builtin_amdgcn_readfirstlane((int)((const LAS unsigned*)(lds + CH_PT))[192]) != 0;
              ch_tail(f16, F, R, sr, sk, sv, b, h, d, c, chain, ci); }
        }
    }
#undef CB
}

constexpr int BL_SLOT = 2 * CH_MB, BL_SLOTB = 4 * CH_MB, BL_YB = BL_SLOT + 2 * BL_SLOTB;
__device__ __forceinline__ void p4_chunkB(Frame& F) {
    const int lane = F.lane, wave = F.wave, l31 = lane & 31, hi = lane >> 5, srow = F.tid >> 3, sch = F.tid & 7;
    LAS unsigned char* lds = F.lds;
    for (int chain = F.bid; chain < 128; chain += F.G) {
        const int d = chain & 1, h = (chain >> 1) & 15, b = chain >> 5;
        const int q4 = wave & 3, mb = q4 >> 1, nb = q4 & 1;
        for (int i = F.tid; i < 2 * CH_MB / 4; i += NWAVES * 64) ((LAS unsigned*)lds)[i] = 0u;
        const unsigned char* gq0 = (const unsigned char*)F.GHQ + (size_t)chain * 68 * GHQ_ITEM;
        unsigned char* Yb = (unsigned char*)(d ? F.YB : F.YF) + h * 128;
        u32x4 Ra0, Ra1, Ra2, Ra3, Rb0, Rb1, Rb2, Rb3;
        { int c__ = (0); c__ = c__ < 67 ? c__ : 67; const unsigned char* gq = gq0 + (size_t)c__ * GHQ_ITEM + srow * 128 + sch * 16; const int cy = c__ < 4 ? 4 : c__;
              Ra0 = *(const u32x4*)gq; Ra1 = *(const u32x4*)(gq + 8192); Ra2 = *(const u32x4*)(gq + 16384);
              Ra3 = *(const u32x4*)(Yb + (size_t)scan_row(b, d, cy, srow) * 2048 + sch * 16); }
        { LAS unsigned char* sn = lds + BL_SLOT + srow * CH_RS + sch * 16; *(LAS u32x4*)sn = Ra0; *(LAS u32x4*)(sn + CH_MB) = Ra1; *(LAS u32x4*)(sn + 2 * CH_MB) = Ra2; *(LAS u32x4*)(sn + 3 * CH_MB) = Ra3; }
        { int c__ = (1); c__ = c__ < 67 ? c__ : 67; const unsigned char* gq = gq0 + (size_t)c__ * GHQ_ITEM + srow * 128 + sch * 16; const int cy = c__ < 4 ? 4 : c__;
              Ra0 = *(const u32x4*)gq; Ra1 = *(const u32x4*)(gq + 8192); Ra2 = *(const u32x4*)(gq + 16384);
              Ra3 = *(const u32x4*)(Yb + (size_t)scan_row(b, d, cy, srow) * 2048 + sch * 16); }
        { int c__ = (2); c__ = c__ < 67 ? c__ : 67; const unsigned char* gq = gq0 + (size_t)c__ * GHQ_ITEM + srow * 128 + sch * 16; const int cy = c__ < 4 ? 4 : c__;
              Rb0 = *(const u32x4*)gq; Rb1 = *(const u32x4*)(gq + 8192); Rb2 = *(const u32x4*)(gq + 16384);
              Rb3 = *(const u32x4*)(Yb + (size_t)scan_row(b, d, cy, srow) * 2048 + sch * 16); }
        LBAR();
#pragma unroll 1
        for (int c = 0; c < 68; c += 4) {
            { const int c_ = (c);
              LAS unsigned char* sn = lds + BL_SLOT + ((c_ + 1) & 1) * BL_SLOTB + srow * CH_RS + sch * 16;
              *(LAS u32x4*)sn = Ra0; *(LAS u32x4*)(sn + CH_MB) = Ra1; *(LAS u32x4*)(sn + 2 * CH_MB) = Ra2; *(LAS u32x4*)(sn + 3 * CH_MB) = Ra3;
              { int c__ = (c_ + 3); c__ = c__ < 67 ? c__ : 67; const unsigned char* gq = gq0 + (size_t)c__ * GHQ_ITEM + srow * 128 + sch * 16; const int cy = c__ < 4 ? 4 : c__;
              Ra0 = *(const u32x4*)gq; Ra1 = *(const u32x4*)(gq + 8192); Ra2 = *(const u32x4*)(gq + 16384);
              Ra3 = *(const u32x4*)(Yb + (size_t)scan_row(b, d, cy, srow) * 2048 + sch * 16); }
              if (c_ >= 5) { const u32x4 yv = *(const LAS u32x4*)(lds + BL_YB + ((c_ - 1) & 1) * CH_MB + srow * CH_RS + sch * 16);
                  *(u32x4*)(Yb + (size_t)scan_row(b, d, c_ - 1, srow) * 2048 + sch * 16) = yv; }
              const LAS unsigned char* sc = lds + BL_SLOT + (c_ & 1) * BL_SLOTB; const LAS unsigned char* zc = lds + (c_ & 1) * CH_MB; LAS unsigned char* zn = lds + ((c_ + 1) & 1) * CH_MB;
              if (wave < 4) {
                  f32x16 acc; const LAS unsigned char* ph = sc + CH_MB + (nb * 32 + l31) * CH_RS + (mb * 32 + 4 * hi) * 2;
#pragma unroll
                  for (int rg = 0; rg < 4; ++rg) { const u32x2 w = *(const LAS u32x2*)(ph + rg * 16); acc[4 * rg] = h_lo(w.x); acc[4 * rg + 1] = h_hi(w.x); acc[4 * rg + 2] = h_lo(w.y); acc[4 * rg + 3] = h_hi(w.y); }
                  acc = mm32(true, sc, mb * 32, zc, nb * 32, acc, l31, hi);
                  st_nat(true, zn, mb * 32, nb * 32, acc, l31, hi);
              } else if (c_ >= 4) {
                  f32x16 acc; const LAS unsigned char* py = sc + 3 * CH_MB + (nb * 32 + l31) * CH_RS + (mb * 32 + 4 * hi) * 2;
#pragma unroll
                  for (int rg = 0; rg < 4; ++rg) { const u32x2 w = *(const LAS u32x2*)(py + rg * 16); acc[4 * rg] = h_lo(w.x); acc[4 * rg + 1] = h_hi(w.x); acc[4 * rg + 2] = h_lo(w.y); acc[4 * rg + 3] = h_hi(w.y); }
                  acc = mm32(true, zc, mb * 32, sc + 2 * CH_MB, nb * 32, acc, l31, hi);
                  st_nat(true, lds + BL_YB + (c_ & 1) * CH_MB, mb * 32, nb * 32, acc, l31, hi);
              }
              LBAR(); }
            { const int c_ = (c + 1);
              LAS unsigned char* sn = lds + BL_SLOT + ((c_ + 1) & 1) * BL_SLOTB + srow * CH_RS + sch * 16;
              *(LAS u32x4*)sn = Rb0; *(LAS u32x4*)(sn + CH_MB) = Rb1; *(LAS u32x4*)(sn + 2 * CH_MB) = Rb2; *(LAS u32x4*)(sn + 3 * CH_MB) = Rb3;
              { int c__ = (c_ + 3); c__ = c__ < 67 ? c__ : 67; const unsigned char* gq = gq0 + (size_t)c__ * GHQ_ITEM + srow * 128 + sch * 16; const int cy = c__ < 4 ? 4 : c__;
              Rb0 = *(const u32x4*)gq; Rb1 = *(const u32x4*)(gq + 8192); Rb2 = *(const u32x4*)(gq + 16384);
              Rb3 = *(const u32x4*)(Yb + (size_t)scan_row(b, d, cy, srow) * 2048 + sch * 16); }
              if (c_ >= 5) { const u32x4 yv = *(const LAS u32x4*)(lds + BL_YB + ((c_ - 1) & 1) * CH_MB + srow * CH_RS + sch * 16);
                  *(u32x4*)(Yb + (size_t)scan_row(b, d, c_ - 1, srow) * 2048 + sch * 16) = yv; }
              const LAS unsigned char* sc = lds + BL_SLOT + (c_ & 1) * BL_SLOTB; const LAS unsigned char* zc = lds + (c_ & 1) * CH_MB; LAS unsigned char* zn = lds + ((c_ + 1) & 1) * CH_MB;
              if (wave < 4) {
                  f32x16 acc; const LAS unsigned char* ph = sc + CH_MB + (nb * 32 + l31) * CH_RS + (mb * 32 + 4 * hi) * 2;
#pragma unroll
                  for (int rg = 0; rg < 4; ++rg) { const u32x2 w = *(const LAS u32x2*)(ph + rg * 16); acc[4 * rg] = h_lo(w.x); acc[4 * rg + 1] = h_hi(w.x); acc[4 * rg + 2] = h_lo(w.y); acc[4 * rg + 3] = h_hi(w.y); }
                  acc = mm32(true, sc, mb * 32, zc, nb * 32, acc, l31, hi);
                  st_nat(true, zn, mb * 32, nb * 32, acc, l31, hi);
              } else if (c_ >= 4) {
                  f32x16 acc; const LAS unsigned char* py = sc + 3 * CH_MB + (nb * 32 + l31) * CH_RS + (mb * 32 + 4 * hi) * 2;
#pragma unroll
                  for (int rg = 0; rg < 4; ++rg) { const u32x2 w = *(const LAS u32x2*)(py + rg * 16); acc[4 * rg] = h_lo(w.x); acc[4 * rg + 1] = h_hi(w.x); acc[4 * rg + 2] = h_lo(w.y); acc[4 * rg + 3] = h_hi(w.y); }
                  acc = mm32(true, zc, mb * 32, sc + 2 * CH_MB, nb * 32, acc, l31, hi);
                  st_nat(true, lds + BL_YB + (c_ & 1) * CH_MB, mb * 32, nb * 32, acc, l31, hi);
              }
              LBAR(); }
            { const int c_ = (c + 2);
              LAS unsigned char* sn = lds + BL_SLOT + ((c_ + 1) & 1) * BL_SLOTB + srow * CH_RS + sch * 16;
              *(LAS u32x4*)sn = Ra0; *(LAS u32x4*)(sn + CH_MB) = Ra1; *(LAS u32x4*)(sn + 2 * CH_MB) = Ra2; *(LAS u32x4*)(sn + 3 * CH_MB) = Ra3;
              { int c__ = (c_ + 3); c__ = c__ < 67 ? c__ : 67; const unsigned char* gq = gq0 + (size_t)c__ * GHQ_ITEM + srow * 128 + sch * 16; const int cy = c__ < 4 ? 4 : c__;
              Ra0 = *(const u32x4*)gq; Ra1 = *(const u32x4*)(gq + 8192); Ra2 = *(const u32x4*)(gq + 16384);
              Ra3 = *(const u32x4*)(Yb + (size_t)scan_row(b, d, cy, srow) * 2048 + sch * 16); }
              if (c_ >= 5) { const u32x4 yv = *(const LAS u32x4*)(lds + BL_YB + ((c_ - 1) & 1) * CH_MB + srow * CH_RS + sch * 16);
                  *(u32x4*)(Yb + (size_t)scan_row(b, d, c_ - 1, srow) * 2048 + sch * 16) = yv; }
              const LAS unsigned char* sc = lds + BL_SLOT + (c_ & 1) * BL_SLOTB; const LAS unsigned char* zc = lds + (c_ & 1) * CH_MB; LAS unsigned char* zn = lds + ((c_ + 1) & 1) * CH_MB;
              if (wave < 4) {
                  f32x16 acc; const LAS unsigned char* ph = sc + CH_MB + (nb * 32 + l31) * CH_RS + (mb * 32 + 4 * hi) * 2;
#pragma unroll
                  for (int rg = 0; rg < 4; ++rg) { const u32x2 w = *(const LAS u32x2*)(ph + rg * 16); acc[4 * rg] = h_lo(w.x); acc[4 * rg + 1] = h_hi(w.x); acc[4 * rg + 2] = h_lo(w.y); acc[4 * rg + 3] = h_hi(w.y); }
                  acc = mm32(true, sc, mb * 32, zc, nb * 32, acc, l31, hi);
                  st_nat(true, zn, mb * 32, nb * 32, acc, l31, hi);
              } else if (c_ >= 4) {
                  f32x16 acc; const LAS unsigned char* py = sc + 3 * CH_MB + (nb * 32 + l31) * CH_RS + (mb * 32 + 4 * hi) * 2;
#pragma unroll
                  for (int rg = 0; rg < 4; ++rg) { const u32x2 w = *(const LAS u32x2*)(py + rg * 16); acc[4 * rg] = h_lo(w.x); acc[4 * rg + 1] = h_hi(w.x); acc[4 * rg + 2] = h_lo(w.y); acc[4 * rg + 3] = h_hi(w.y); }
                  acc = mm32(true, zc, mb * 32, sc + 2 * CH_MB, nb * 32, acc, l31, hi);
                  st_nat(true, lds + BL_YB + (c_ & 1) * CH_MB, mb * 32, nb * 32, acc, l31, hi);
              }
              LBAR(); }
            { const int c_ = (c + 3);
              LAS unsigned char* sn = lds + BL_SLOT + ((c_ + 1) & 1) * BL_SLOTB + srow * CH_RS + sch * 16;
              *(LAS u32x4*)sn = Rb0; *(LAS u32x4*)(sn + CH_MB) = Rb1; *(LAS u32x4*)(sn + 2 * CH_MB) = Rb2; *(LAS u32x4*)(sn + 3 * CH_MB) = Rb3;
              { int c__ = (c_ + 3); c__ = c__ < 67 ? c__ : 67; const unsigned char* gq = gq0 + (size_t)c__ * GHQ_ITEM + srow * 128 + sch * 16; const int cy = c__ < 4 ? 4 : c__;
              Rb0 = *(const u32x4*)gq; Rb1 = *(const u32x4*)(gq + 8192); Rb2 = *(const u32x4*)(gq + 16384);
              Rb3 = *(const u32x4*)(Yb + (size_t)scan_row(b, d, cy, srow) * 2048 + sch * 16); }
              if (c_ >= 5) { const u32x4 yv = *(const LAS u32x4*)(lds + BL_YB + ((c_ - 1) & 1) * CH_MB + srow * CH_RS + sch * 16);
                  *(u32x4*)(Yb + (size_t)scan_row(b, d, c_ - 1, srow) * 2048 + sch * 16) = yv; }
              const LAS unsigned char* sc = lds + BL_SLOT + (c_ & 1) * BL_SLOTB; const LAS unsigned char* zc = lds + (c_ & 1) * CH_MB; LAS unsigned char* zn = lds + ((c_ + 1) & 1) * CH_MB;
              if (wave < 4) {
                  f32x16 acc; const LAS unsigned char* ph = sc + CH_MB + (nb * 32 + l31) * CH_RS + (mb * 32 + 4 * hi) * 2;
#pragma unroll
                  for (int rg = 0; rg < 4; ++rg) { const u32x2 w = *(const LAS u32x2*)(ph + rg * 16); acc[4 * rg] = h_lo(w.x); acc[4 * rg + 1] = h_hi(w.x); acc[4 * rg + 2] = h_lo(w.y); acc[4 * rg + 3] = h_hi(w.y); }
                  acc = mm32(true, sc, mb * 32, zc, nb * 32, acc, l31, hi);
                  st_nat(true, zn, mb * 32, nb * 32, acc, l31, hi);
              } else if (c_ >= 4) {
                  f32x16 acc; const LAS unsigned char* py = sc + 3 * CH_MB + (nb * 32 + l31) * CH_RS + (mb * 32 + 4 * hi) * 2;
#pragma unroll
                  for (int rg = 0; rg < 4; ++rg) { const u32x2 w = *(const LAS u32x2*)(py + rg * 16); acc[4 * rg] = h_lo(w.x); acc[4 * rg + 1] = h_hi(w.x); acc[4 * rg + 2] = h_lo(w.y); acc[4 * rg + 3] = h_hi(w.y); }
                  acc = mm32(true, zc, mb * 32, sc + 2 * CH_MB, nb * 32, acc, l31, hi);
                  st_nat(true, lds + BL_YB + (c_ & 1) * CH_MB, mb * 32, nb * 32, acc, l31, hi);
              }
              LBAR(); }
        }
        { const u32x4 yv = *(const LAS u32x4*)(lds + BL_YB + CH_MB + srow * CH_RS + sch * 16); *(u32x4*)(Yb + (size_t)scan_row(b, d, 67, srow) * 2048 + sch * 16) = yv; }
        LBAR();
    }
}

constexpr int AT_K = 0, AT_V = 16384, AT_BUF = 16384 + 64 * 272;
struct KVRegs { u32x4 k1, k2, v0, v1; };
__device__ __forceinline__ void at_load(Frame& F, KVRegs& R, int mrow0, int kvh) {
    const int tid = F.tid;
    { const int key = tid >> 2, q4 = tid & 3, a = q4 >> 1, e = q4 & 1;
      const bf16* p = F.P + (size_t)(mrow0 + key) * NIN + C_KA + kvh * 64 + a * 32 + 8 * e; R.k1 = *(const u32x4*)p; R.k2 = *(const u32x4*)(p + 16); }
    { const int kp = tid >> 3, dc = tid & 7; const bf16* p = F.P + (size_t)(mrow0 + 2 * kp) * NIN + C_VA + kvh * 64 + 8 * dc; R.v0 = *(const u32x4*)p; R.v1 = *(const u32x4*)(p + NIN); }
}
__device__ __forceinline__ void qkprep_one(Frame& F, bf16* p, int a, int e, int kpos, bool rope, const float* gain, float scale) {
    float x1[8], x2[8]; unpack8(*(const u32x4*)p, x1); unpack8(*(const u32x4*)(p + 16), x2);
    float ss = 0.f;
#pragma unroll
    for (int j = 0; j < 8; ++j) ss += x1[j] * x1[j] + x2[j] * x2[j];
    ss += __shfl_xor(ss, 1); ss += __shfl_xor(ss, 2);
    const float rr = scale / sqrtf(ss * (1.0f / 64.0f) + 1e-6f);
    const int pos = a == 0 ? (kpos >> 6) : (kpos & 63);
#pragma unroll
    for (int j = 0; j < 8; ++j) { float y1 = x1[j] * rr * gain[a * 32 + 8 * e + j], y2 = x2[j] * rr * gain[a * 32 + 16 + 8 * e + j];
        if (rope) { const float c = F.ROPE[pos * 16 + 8 * e + j], sn = F.ROPE[1024 + pos * 16 + 8 * e + j]; const float t1 = y1 * c - y2 * sn, t2 = y2 * c + y1 * sn; y1 = t1; y2 = t2; }
        x1[j] = y1; x2[j] = y2; }
    u32x4 o; o.x = pk2(x1[0], x1[1]); o.y = pk2(x1[2], x1[3]); o.z = pk2(x1[4], x1[5]); o.w = pk2(x1[6], x1[7]); *(u32x4*)p = o;
    o.x = pk2(x2[0], x2[1]); o.y = pk2(x2[2], x2[3]); o.z = pk2(x2[4], x2[5]); o.w = pk2(x2[6], x2[7]); *(u32x4*)(p + 16) = o;
}
__device__ __forceinline__ void kprep(Frame& F) {
    const int total = F.G * NWAVES * 64;
    for (int idx = F.bid * NWAVES * 64 + F.tid; idx < MT * 16; idx += total) {
        const int q4 = idx & 3, kvh = (idx >> 2) & 3, m = idx >> 4, a = q4 >> 1, e = q4 & 1;
        qkprep_one(F, F.P + (size_t)m * NIN + C_KA + kvh * 64 + a * 32 + 8 * e, a, e, m & (SEQ - 1), m < ML, F.kng, 1.0f);
    }
}
__device__ __forceinline__ void at_write(Frame& F, const KVRegs& R, LAS unsigned char* buf) {
    const int tid = F.tid;
    { const int key = tid >> 2, q4 = tid & 3, a = q4 >> 1, e = q4 & 1;
      const int c1 = 4 * a + e, c2 = c1 + 2, sw = (key >> 1) & 7;
      *(LAS u32x4*)(buf + AT_K + key * 128 + ((c1 ^ sw) << 4)) = R.k1; *(LAS u32x4*)(buf + AT_K + key * 128 + ((c2 ^ sw) << 4)) = R.k2; }
    { const int kp = tid >> 3, dc = tid & 7, kq = kp >> 1;
        const int pos0 = (kq >> 2) * 16 + (kq & 1) * 8 + ((kq >> 1) & 1) * 4 + (kp & 1) * 2;
#pragma unroll
        for (int w = 0; w < 4; ++w) {
            const unsigned a0 = R.v0[w], a1 = R.v1[w];
            *(LAS unsigned*)(buf + AT_V + (8 * dc + 2 * w) * 272 + pos0 * 2) = __builtin_amdgcn_perm(a1, a0, 0x05040100u);
            *(LAS unsigned*)(buf + AT_V + (8 * dc + 2 * w + 1) * 272 + pos0 * 2) = __builtin_amdgcn_perm(a1, a0, 0x07060302u); }
    }
}
#ifndef ATTN_STATIC
#define ATTN_STATIC 2
#endif
#ifndef ATTN_POOL
#define ATTN_POOL 0
#endif
#ifndef ATTN_BOUND
#define ATTN_BOUND 60.0f
#endif
template<bool NOMAX> __device__ __forceinline__ void p4_attn_t(Frame& F, int item) {
    const int n = item & 31, kvh = (item >> 5) & 3, b = item >> 7;
    const int lane = F.lane, wave = F.wave, l31 = lane & 31, hi = lane >> 5;
    const int hh = kvh * 4 + (wave >> 1), qloc = (wave & 1) * 64;
    LAS unsigned char* lds = F.lds;
    const int kfirst = n > 0 ? 0 : 1, nbnd = 3 - (n == 0 ? 1 : 0) - (n == 31 ? 1 : 0), nt = nbnd + 2;
#define TL_KIND(t) ((t) < nbnd ? kfirst + (t) : 3)
#define TL_ROW(t) ((t) < nbnd ? b * SEQ + (n - 1 + kfirst + (t)) * 128 : ML + b * CTXL + ((t) - nbnd) * 128)
#define TL_KPOS(t) ((t) < nbnd ? (n - 1 + kfirst + (t)) * 128 : 0)
    if (DBG_FINE) TSTART();
    KVRegs R;
    at_load(F, R, TL_ROW(0), kvh);
    LAS unsigned char* qbase = lds + 2 * AT_BUF + wave * 8192;
    LAS unsigned char* qlds = qbase + lane * 16;
    { const int rowl = lane >> 2, q4 = lane & 3, a = q4 >> 1, e = q4 & 1;
      const bf16* src = F.P + (size_t)(b * SEQ + n * 128 + qloc + rowl) * NIN + C_Q + hh * 64 + a * 32 + 8 * e;
      u32x4 r1[4], r2[4];
#pragma unroll
      for (int ps = 0; ps < 4; ++ps) { r1[ps] = *(const u32x4*)(src + (size_t)(16 * ps) * NIN); r2[ps] = *(const u32x4*)(src + (size_t)(16 * ps) * NIN + 16); }
      float g1[8], g2[8];
      { const f32x4 a0 = *(const f32x4*)(F.qng + a * 32 + 8 * e), a1 = *(const f32x4*)(F.qng + a * 32 + 8 * e + 4), b0 = *(const f32x4*)(F.qng + a * 32 + 16 + 8 * e), b1 = *(const f32x4*)(F.qng + a * 32 + 16 + 8 * e + 4);
#pragma unroll
        for (int j = 0; j < 4; ++j) { g1[j] = a0[j]; g1[4 + j] = a1[j]; g2[j] = b0[j]; g2[4 + j] = b1[j]; } }
#pragma unroll
      for (int ps = 0; ps < 4; ++ps) {
          const int r = 16 * ps + rowl, query = n * 128 + qloc + r, pos = a == 0 ? (query >> 6) : (query & 63);
          const f32x4 c0 = *(const f32x4*)(F.ROPE + pos * 16 + 8 * e), c1 = *(const f32x4*)(F.ROPE + pos * 16 + 8 * e + 4), s0 = *(const f32x4*)(F.ROPE + 1024 + pos * 16 + 8 * e), s1 = *(const f32x4*)(F.ROPE + 1024 + pos * 16 + 8 * e + 4);
          float x1[8], x2[8]; unpack8(r1[ps], x1); unpack8(r2[ps], x2);
          float ss = 0.f;
#pragma unroll
          for (int j = 0; j < 8; ++j) ss += x1[j] * x1[j] + x2[j] * x2[j];
          ss += __shfl_xor(ss, 1); ss += __shfl_xor(ss, 2);
          const float rr = (0.125f * LOG2E) / sqrtf(ss * (1.0f / 64.0f) + 1e-6f);
#pragma unroll
          for (int j = 0; j < 8; ++j) { const float y1 = x1[j] * rr * g1[j], y2 = x2[j] * rr * g2[j], cc = j < 4 ? c0[j & 3] : c1[j & 3], sn = j < 4 ? s0[j & 3] : s1[j & 3];
              x1[j] = y1 * cc - y2 * sn; x2[j] = y2 * cc + y1 * sn; }
          LAS unsigned char* dst = qbase + ((r >> 5) * 4 + 2 * a) * 1024 + (e * 32 + (r & 31)) * 16;
          u32x4 o; o.x = pk2(x1[0], x1[1]); o.y = pk2(x1[2], x1[3]); o.z = pk2(x1[4], x1[5]); o.w = pk2(x1[6], x1[7]); *(LAS u32x4*)dst = o;
          o.x = pk2(x2[0], x2[1]); o.y = pk2(x2[2], x2[3]); o.z = pk2(x2[4], x2[5]); o.w = pk2(x2[6], x2[7]); *(LAS u32x4*)(dst + 1024) = o;
      } }
    at_write(F, R, lds);
    LBAR(); TSTAMP(26);
    float mrun[2] = {NOMAX ? 0.f : -1e30f, NOMAX ? 0.f : -1e30f}, lrun[2] = {0.f, 0.f};
    f32x16 ot[2][2];
#pragma unroll
    for (int qb = 0; qb < 2; ++qb)
#pragma unroll
        for (int db = 0; db < 2; ++db)
#pragma unroll
            for (int r = 0; r < 16; ++r) ot[qb][db][r] = 0.f;
#pragma unroll 1
    for (int t = 0; t < nt; ++t) {
        LAS unsigned char* buf = lds + (t & 1) * AT_BUF;
        if (t + 1 < nt) at_load(F, R, TL_ROW(t + 1), kvh);
        const int kind = TL_KIND(t);
#pragma unroll 1
        for (int st = 0; st < 4; ++st) {
            int s0 = 1, s1 = 1;
            { const int dq0 = qloc >> 5, dq1 = dq0 + 1;
              if (kind == 0) { s0 = st < dq0 ? 0 : (st == dq0 ? 2 : 1); s1 = st < dq1 ? 0 : (st == dq1 ? 2 : 1); }
              else if (kind == 2) { s0 = st > dq0 ? 0 : (st == dq0 ? 2 : 1); s1 = st > dq1 ? 0 : (st == dq1 ? 2 : 1); } }
            if ((s0 | s1) == 0) continue;
            bf16x8 kf[4];
#pragma unroll
            for (int ks = 0; ks < 4; ++ks) { const int key = st * 32 + l31, ch = 2 * ks + hi; kf[ks] = *(const LAS bf16x8*)(buf + AT_K + key * 128 + ((ch ^ ((key >> 1) & 7)) << 4)); }
            f32x16 sc0 = {0.f, 0.f, 0.f, 0.f, 0.f, 0.f, 0.f, 0.f, 0.f, 0.f, 0.f, 0.f, 0.f, 0.f, 0.f, 0.f}, sc1 = sc0;
            { bf16x8 qf[4];
              if (s0) {
#pragma unroll
                  for (int ks = 0; ks < 4; ++ks) qf[ks] = *(const LAS bf16x8*)(qlds + ks * 1024);
#pragma unroll
                  for (int ks = 0; ks < 4; ++ks) sc0 = __builtin_amdgcn_mfma_f32_32x32x16_bf16(kf[ks], qf[ks], sc0, 0, 0, 0); }
              if (s1) {
#pragma unroll
                  for (int ks = 0; ks < 4; ++ks) qf[ks] = *(const LAS bf16x8*)(qlds + (4 + ks) * 1024);
#pragma unroll
                  for (int ks = 0; ks < 4; ++ks) sc1 = __builtin_amdgcn_mfma_f32_32x32x16_bf16(kf[ks], qf[ks], sc1, 0, 0, 0); } }
            bf16x8 vf[2][2];
#pragma unroll
            for (int db = 0; db < 2; ++db)
#pragma unroll
                for (int s = 0; s < 2; ++s) vf[db][s] = *(const LAS bf16x8*)(buf + AT_V + (db * 32 + l31) * 272 + ((st * 2 + s) * 16 + hi * 8) * 2);
#define AT_SOFTMAX(SC, QB, PF, DIAG) do { \
                const int qq = qloc + (QB) * 32 + l31; \
                if (DIAG) { const int th = qq - st * 32 - 4 * hi;        \
                    if (kind == 0) { _Pragma("unroll") for (int r = 0; r < 16; ++r) SC[r] = ((r & 3) + 8 * (r >> 2) >= th) ? SC[r] : -__builtin_inff(); } \
                    else { _Pragma("unroll") for (int r = 0; r < 16; ++r) SC[r] = ((r & 3) + 8 * (r >> 2) <= th) ? SC[r] : -__builtin_inff(); } } \
                if (!NOMAX) { \
                    float tm = SC[0]; \
                    _Pragma("unroll") for (int r = 1; r < 16; ++r) tm = fmaxf(tm, SC[r]); \
                    tm = fmaxf(tm, __shfl_xor(tm, 32)); \
                    if (__any(tm > mrun[QB] + 6.0f)) { \
                        const float mn = fmaxf(mrun[QB], tm), al = __builtin_amdgcn_exp2f(mrun[QB] - mn); \
                        mrun[QB] = mn; lrun[QB] *= al; \
                        _Pragma("unroll") for (int db = 0; db < 2; ++db) _Pragma("unroll") for (int r = 0; r < 16; ++r) ot[QB][db][r] *= al; } \
                    const float mm = mrun[QB]; \
                    _Pragma("unroll") for (int r = 0; r < 16; ++r) SC[r] -= mm; } \
                f32x2_t ps2 = {0.f, 0.f}; \
                _Pragma("unroll") for (int r = 0; r < 16; r += 2) { SC[r] = __builtin_amdgcn_exp2f(SC[r]); SC[r + 1] = __builtin_amdgcn_exp2f(SC[r + 1]); f32x2_t e2; e2.x = SC[r]; e2.y = SC[r + 1]; ps2 += e2; } \
                lrun[QB] += ps2.x + ps2.y; \
                _Pragma("unroll") for (int s = 0; s < 2; ++s) { u32x4 o; o.x = pk2(SC[8 * s], SC[8 * s + 1]); o.y = pk2(SC[8 * s + 2], SC[8 * s + 3]); o.z = pk2(SC[8 * s + 4], SC[8 * s + 5]); o.w = pk2(SC[8 * s + 6], SC[8 * s + 7]); PF[s] = __builtin_bit_cast(bf16x8, o); } \
            } while (0)
            bf16x8 pf0[2] = {kf[0], kf[0]}, pf1[2] = {kf[0], kf[0]};
            __builtin_amdgcn_sched_barrier(0);
            if (s0) AT_SOFTMAX(sc0, 0, pf0, s0 == 2);
            __builtin_amdgcn_sched_barrier(0);
            if (s1) AT_SOFTMAX(sc1, 1, pf1, s1 == 2);
            __builtin_amdgcn_sched_barrier(0);
#undef AT_SOFTMAX
#pragma unroll
            for (int db = 0; db < 2; ++db)
#pragma unroll
                for (int s = 0; s < 2; ++s) if (s0) ot[0][db] = __builtin_amdgcn_mfma_f32_32x32x16_bf16(vf[db][s], pf0[s], ot[0][db], 0, 0, 0);
#pragma unroll
            for (int db = 0; db < 2; ++db)
#pragma unroll
                for (int s = 0; s < 2; ++s) if (s1) ot[1][db] = __builtin_amdgcn_mfma_f32_32x32x16_bf16(vf[db][s], pf1[s], ot[1][db], 0, 0, 0);
        }
        TSTAMP(27);
        if (t + 1 < nt) at_write(F, R, lds + ((t + 1) & 1) * AT_BUF);
        LBAR(); TSTAMP(28);
    }
    constexpr int AT_ORS = 528;
    u32x4 zr[8];
    const bf16* pz = F.P + (size_t)(b * SEQ + n * 128) * NIN + kvh * 256;
#pragma unroll
    for (int i = 0; i < 8; ++i) { const int idx = F.tid + 512 * i, row = idx >> 5, c16 = idx & 31; zr[i] = *(const u32x4*)(pz + (size_t)row * NIN + C_ZA + 8 * c16); }
    const float sk2 = F.sink[hh] * LOG2E;
#pragma unroll
    for (int qb = 0; qb < 2; ++qb) {
        float l = lrun[qb]; l += __shfl_xor(l, 32); l += __builtin_amdgcn_exp2f(sk2 - mrun[qb]);
        const float il = 1.0f / l;
        LAS unsigned char* po = lds + (qloc + qb * 32 + l31) * AT_ORS + (wave >> 1) * 128 + 8 * hi;
#pragma unroll
        for (int db = 0; db < 2; ++db)
#pragma unroll
            for (int rg = 0; rg < 4; ++rg) { u32x2 o; o.x = pkh(ot[qb][db][4 * rg] * il, ot[qb][db][4 * rg + 1] * il); o.y = pkh(ot[qb][db][4 * rg + 2] * il, ot[qb][db][4 * rg + 3] * il);
                *(LAS u32x2*)(po + (db * 32 + 8 * rg) * 2) = o; }
    }
    LBAR();
#pragma unroll
    for (int i = 0; i < 8; ++i) { const int idx = F.tid + 512 * i, row = idx >> 5, c16 = idx & 31;
        const u32x4 ov = *(const LAS u32x4*)(lds + row * AT_ORS + c16 * 16);
        float z[8]; unpack8(zr[i], z);
        u32x4 w; w.x = pk2(h_lo(ov.x) * siluf_(z[0]), h_hi(ov.x) * siluf_(z[1])); w.y = pk2(h_lo(ov.y) * siluf_(z[2]), h_hi(ov.y) * siluf_(z[3]));
        w.z = pk2(h_lo(ov.z) * siluf_(z[4]), h_hi(ov.z) * siluf_(z[5])); w.w = pk2(h_lo(ov.w) * siluf_(z[6]), h_hi(ov.w) * siluf_(z[7]));
        *(u32x4*)(F.P + (size_t)(b * SEQ + n * 128 + row) * NIN + 1024 + kvh * 256 + 8 * c16) = w; }
    TSTAMP(29);
#undef TL_KIND
#undef TL_ROW
#undef TL_KPOS
}
__device__ __forceinline__ bool attn_nomax(Frame& F) {
    float gq = fabsf(F.qng[F.lane]), gk = fabsf(F.kng[F.lane]);
#pragma unroll
    for (int o = 1; o < 64; o <<= 1) { gq = fmaxf(gq, __shfl_xor(gq, o)); gk = fmaxf(gk, __shfl_xor(gk, o)); }
    const float bound = 8.0f * LOG2E * gq * gk;
    return __builtin_amdgcn_readfirstlane(bound <= ATTN_BOUND ? 1 : 0) != 0;
}

__device__ __forceinline__ void p5_mix(Frame& F) {
    const int total = F.G * NWAVES * 64, rstep = total >> 7, gi = F.bid * NWAVES * 64 + F.tid;
    const int ch = gi & 7, h = (gi >> 3) & 15, c0 = h * 64 + 8 * ch;
    float mus[8], lg[8], lb[8];
    { const f32x4 a0 = *(const f32x4*)(F.mu_shift + C_V + c0), a1 = *(const f32x4*)(F.mu_shift + C_V + c0 + 4), g0 = *(const f32x4*)(F.ln_g + c0), g1 = *(const f32x4*)(F.ln_g + c0 + 4), b0 = *(const f32x4*)(F.ln_b + c0), b1 = *(const f32x4*)(F.ln_b + c0 + 4);
#pragma unroll
      for (int j = 0; j < 4; ++j) { mus[j] = a0[j]; mus[4 + j] = a1[j]; lg[j] = g0[j]; lg[4 + j] = g1[j]; lb[j] = b0[j]; lb[4 + j] = b1[j]; } }
    const u32x4 z = {0u, 0u, 0u, 0u};
#pragma unroll 1
    for (int m0 = gi >> 7; m0 < ML; m0 += 4 * rstep) {
        u32x4 ryf[4], ryb[4], rvc[4], rvp[4], rvn[4], rzr[4]; float bon[4];
#pragma unroll
        for (int k = 0; k < 4; ++k) { const int m = m0 + k * rstep, mm = m < ML ? m : m0, t = mm & (SEQ - 1);
            const bf16* pc = F.P + (size_t)mm * NIN;
            ryf[k] = *(const u32x4*)(F.YF + (size_t)mm * 1024 + c0); ryb[k] = *(const u32x4*)(F.YB + (size_t)mm * 1024 + c0);
            rvc[k] = *(const u32x4*)(pc + C_V + c0); rvp[k] = *(const u32x4*)(pc - (t > 0 ? NIN : 0) + C_V + c0); rvn[k] = *(const u32x4*)(pc + (t < SEQ - 1 ? NIN : 0) + C_V + c0);
            rzr[k] = *(const u32x4*)(pc + C_ZR + c0);
            bon[k] = F.BON[(size_t)mm * 16 + h] + F.BON[(size_t)(ML + mm) * 16 + h]; }
#pragma unroll
        for (int k = 0; k < 4; ++k) { const int m = m0 + k * rstep; if (m >= ML) break;
            float y[8];
            { const h8 hf = __builtin_bit_cast(h8, ryf[k]), hb = __builtin_bit_cast(h8, ryb[k]);
#pragma unroll
              for (int j = 0; j < 8; ++j) y[j] = (float)hf[j] + (float)hb[j]; }
            float s = 0.f;
#pragma unroll
            for (int j = 0; j < 8; ++j) s += y[j];
            s += __shfl_xor(s, 1); s += __shfl_xor(s, 2); s += __shfl_xor(s, 4);
            const float mu = s * (1.0f / 64.0f); float q = 0.f;
#pragma unroll
            for (int j = 0; j < 8; ++j) { y[j] -= mu; q += y[j] * y[j]; }
            q += __shfl_xor(q, 1); q += __shfl_xor(q, 2); q += __shfl_xor(q, 4);
            const float rs = 1.0f / sqrtf(q * (1.0f / 64.0f) + 64e-5f);
            float vc[8], vp[8], vn[8], zr[8];
            const int t = m & (SEQ - 1);
            unpack8(rvc[k], vc); unpack8(t > 0 ? rvp[k] : z, vp); unpack8(t < SEQ - 1 ? rvn[k] : z, vn); unpack8(rzr[k], zr);
            float o[8];
#pragma unroll
            for (int j = 0; j < 8; ++j) { const float sv = vc[j] + mus[j] * (0.5f * (vp[j] + vn[j]) - vc[j]);
                const float yn = y[j] * rs * lg[j] + lb[j];
                o[j] = (yn + bon[k] * sv) * siluf_(zr[j]); }
            u32x4 w; w.x = pk2(o[0], o[1]); w.y = pk2(o[2], o[3]); w.z = pk2(o[4], o[5]); w.w = pk2(o[6], o[7]);
            *(u32x4*)(F.P + (size_t)m * NIN + c0) = w; }
    }
}

struct Args { const float* in[22]; float* out; unsigned char* ws; int ph_lo, ph_hi; };
__global__ void __launch_bounds__(NWAVES * 64, 2) hymba_fwd(Args args) {
    extern __shared__ __attribute__((aligned(16))) unsigned char lds_raw[];
    Frame F;
    F.lds = (LAS unsigned char*)lds_raw;
    F.tid = threadIdx.x; F.G = gridDim.x;
    unsigned char* ws = args.ws;
    volatile LAS unsigned* MISC = (volatile LAS unsigned*)(F.lds + MISC_OFF);
    for (int u = F.tid; u < 64; u += NWAVES * 64) MISC[u] = 0u;
    if (DBG_SEL >= 0) for (int u = F.tid; u < 72; u += NWAVES * 64) ((volatile LAS unsigned*)(F.lds + DBG_LDS))[u] = 0u;
    __syncthreads();
    const int lo = args.ph_lo, hi = args.ph_hi;
    XcdBarrier bar; bar.bar = (unsigned*)(ws + WS_CTL) + CW_BAR; bar.x = 0; bar.st = nullptr;
    if (hi - lo > 1) bar = xcd_barrier_post((unsigned*)(ws + WS_CTL) + CW_BAR, MISC + 8);
#define IN(k) (lo <= (k) && (k) < hi)
#define SEAM(k) do { if (IN(k) && IN((k) + 1)) xcd_barrier(bar); } while (0)
    fresh(F); TSTART();
    if (DBG_SEL >= 0 && F.bid == DBG_BLOCK && F.tid == 0) { volatile LAS unsigned long long* T_ = (volatile LAS unsigned long long*)(F.lds + DBG_LDS); T_[34] = T_[32]; }
    if (IN(0)) { fresh(F); p0_prologue(F); if (DUP_PHASE == 0) { fresh(F); p0_prologue(F); } } TSTAMP(8); SEAM(0); TSTAMP(9);
    if (IN(1)) { fresh(F); p1_modulate(F); if (DUP_PHASE == 1) { fresh(F); p1_modulate(F); } } TSTAMP(10); SEAM(1); TSTAMP(11);
    if (IN(2)) {
        fresh(F);
        pg8::Gemm g{F.XN, F.WIN, MT, NIN, DM, DM}; Sched1 S; S.init(F.G, F.bid);
        pg8::EpiBf16<0> E{F.P, NIN, nullptr, 0, 0, 1.f};
        pg8::gemm_phase<pg8::EpiBf16<0>, Sched1, true, true>(F.lds, g, S, E);
        if (DUP_PHASE == 2) { __syncthreads(); pg8::gemm_phase<pg8::EpiBf16<0>, Sched1, true, true>(F.lds, g, S, E); }
    } TSTAMP(12); SEAM(2); TSTAMP(13);
    if (IN(3)) { fresh(F); p3_chunkA(F); fresh(F); kprep(F); TSTAMP(14); if (DUP_PHASE == 3) { fresh(F); p3_chunkA(F); } } SEAM(3); TSTAMP(15);
    if (IN(4)) {
        fresh(F);
        { const bool g256 = F.G == 256; const int xg = F.bid & 7;
          int li0 = ATTN_STATIC * ((F.bid - 128) >> 3), cnt = ATTN_STATIC;
          if (!g256 || F.bid < 128) { p4_chunkB(F); TSTAMP(30); LBAR(); fresh(F); li0 = 0; cnt = 0; }
          if (!g256) cnt = (512 - F.bid + F.G - 1) / F.G;
          unsigned* tq = (unsigned*)((unsigned char*)F.MOD - WS_MOD + WS_CTL) + CW_TICKET;
          volatile LAS unsigned* tk = (volatile LAS unsigned*)(F.lds + MISC_OFF) + 40;
#define ATTN_ITEMS(NM) \
          for (int j = 0; ; ++j) { int li = li0 + j, grp = xg; \
              if (j >= cnt) { if (!g256) break; \
                  if (F.tid == 0) tk[0] = __hip_atomic_fetch_add(tq, 1u, __ATOMIC_RELAXED, __HIP_MEMORY_SCOPE_AGENT); \
                  LBAR(); const unsigned q = tk[0]; LBAR(); if (q >= 8u * (64 - 16 * ATTN_STATIC)) break; grp = (int)(q & 7u); li = 16 * ATTN_STATIC + (int)(q >> 3); } \
              fresh(F); p4_attn_t<NM>(F, g256 ? (2 * grp + (li >> 5)) * 32 + (li & 31) : F.bid + j * F.G); LBAR(); }
          if (attn_nomax(F)) {
#pragma unroll 1
              ATTN_ITEMS(true)
          } else {
#pragma unroll 1
              ATTN_ITEMS(false)
          }
#undef ATTN_ITEMS
        }
        TSTAMP(16);
    } SEAM(4); TSTAMP(17);
    if (IN(5)) { fresh(F); p5_mix(F); TSTAMP(18);
        if (DBG_SEL >= 0 && F.bid == DBG_BLOCK && F.tid == 0) { volatile LAS unsigned long long* T_ = (volatile LAS unsigned long long*)(F.lds + DBG_LDS);
            F.DBG[0] = (float)(DBG_SEL == 99 ? (T_[0] + T_[1] + T_[2] + T_[3] + T_[4] + T_[5] + T_[6] + T_[7]) : T_[DBG_SEL]) * (DBG_FINE ? 1e-6f : 2.5e-7f); F.DBG[1] = (DBG_SEL2 == 24 ? (float)T_[24] * 1e-7f : (float)T_[DBG_SEL2] * 1e-4f); }
    } SEAM(5); TSTAMP(19);
    if (IN(6)) {
        fresh(F);
        pg8::Gemm g{F.P, F.WOUT, ML, DM, DM, NIN};
        pg8::StaticOrder S; S.init(ML, DM, F.G, F.bid);
        pg8::EpiGate E{F.x, F.out, F.MOD + 4096, DM, DBG_SEL >= 0 ? F.DBG[0] : 0.f, DBG_SEL >= 0 ? F.DBG[1] : 0.f};
        pg8::gemm_phase<pg8::EpiGate, pg8::StaticOrder, true, true>(F.lds, g, S, E);
        if (DUP_PHASE == 6) { __syncthreads(); pg8::gemm_phase<pg8::EpiGate, pg8::StaticOrder, true, true>(F.lds, g, S, E); }
        if (DBG_SEL >= 0 && DBG_END > 0 && blockIdx.x == 0 && threadIdx.x == 0) { volatile LAS unsigned long long* T_ = (volatile LAS unsigned long long*)(F.lds + DBG_LDS);
            const unsigned long long n_ = __builtin_amdgcn_s_memrealtime(); asm volatile("s_waitcnt vmcnt(0)" ::: "memory");
            F.out[0] += DBG_END == 1 ? (float)(n_ - T_[34]) * 1e-5f : ((float)(n_ - T_[32]) - 10000.0f) * 1e-4f; }
    }
#undef IN
#undef SEAM
}

extern "C" void kernel_launch(void* const* d_in, const int* in_sizes, int n_in, void* d_out, int out_size, void* d_ws, size_t ws_size, hipStream_t stream) {
    static int grid = 0;
    if (grid == 0) {
        if (n_in != 22 || out_size != ML * DM || ws_size < WS_END) { fprintf(stderr, "kernel_launch: unexpected problem shape (n_in %d, out %d, ws %zu)\n", n_in, out_size, ws_size); grid = -1; return; }
        int dev = 0, cus = 0;
        if (hipGetDevice(&dev) != hipSuccess || hipDeviceGetAttribute(&cus, hipDeviceAttributeMultiprocessorCount, dev) != hipSuccess) { grid = -1; return; }
        if (hipFuncSetAttribute((const void*)hymba_fwd, hipFuncAttributeMaxDynamicSharedMemorySize, LDS_BYTES) != hipSuccess) { fprintf(stderr, "kernel_launch: hipFuncSetAttribute failed\n"); grid = -1; return; }
        (void)hipGetLastError();
        grid = cus;
    }
    if (grid < 0) return;
    (void)hipMemsetAsync((char*)d_ws + WS_CTL, 0, CTL_ZERO_BYTES, stream);
    Args a{};
    for (int i = 0; i < 22; ++i) a.in[i] = (const float*)d_in[i];
    a.out = (float*)d_out; a.ws = (unsigned char*)d_ws;
    if (MK_N_LAUNCHES == 1) { a.ph_lo = 0; a.ph_hi = N_PHASES; hipLaunchKernelGGL(hymba_fwd, dim3(grid), dim3(NWAVES * 64), LDS_BYTES, stream, a); }
    else for (int p = 0; p < N_PHASES; ++p) { a.ph_lo = p; a.ph_hi = p + 1; hipLaunchKernelGGL(hymba_fwd, dim3(grid), dim3(NWAVES * 64), LDS_BYTES, stream, a); }
}
```

```cpp
#include <hip/hip_runtime.h>
#include <cstdio>
#include <cstdint>
#ifndef DBG_SEL
#define DBG_SEL -1
#endif
#ifndef DBG_SEL2
#define DBG_SEL2 0
#endif
#ifndef DBG_BLOCK
#define DBG_BLOCK 0
#endif
#ifndef DBG_END
#define DBG_END 0
#endif
namespace pg8 {
#define PG8_LAS __attribute__((address_space(3)))
typedef unsigned short bf16_t;
typedef short bf16x8 __attribute__((ext_vector_type(8)));
typedef float f32x4 __attribute__((ext_vector_type(4)));
typedef unsigned u32x4 __attribute__((ext_vector_type(4)));
constexpr int BM = 256, BK = 64, HALF = 128, HTB = HALF * BK * 2  , STAGE_BYTES = 8 * HTB, NXCD = 8, WGM = 8;

__host__ __device__ __forceinline__ int lds_byte(int r, int c) { const int st = (r >> 4) * 2 + (c >> 5), rr = r & 15, cc = c & 31, ob = rr * 64 + cc * 2; return st * 1024 + (ob ^ (((ob >> 9) & 1) << 5)); }
__host__ __device__ __forceinline__ void stage_rc(int b, int& R, int& C) { const int st = b / 1024, sb = b % 1024, swz = sb ^ (((sb >> 9) & 1) << 5); R = (st >> 1) * 16 + swz / 64; C = (st & 1) * 32 + (swz % 64) / 2; }
__host__ __device__ __forceinline__ int perm32(int rho) { const int n = rho >> 4, i = rho & 15; return 8 * (i >> 2) + 4 * n + (i & 3); }

struct Unit { int pm, pn; };
struct Gemm { const bf16_t* A; const bf16_t* Bt; int M, N, K, lda; };

struct StaticOrder {
    int nM, nN, nwg, G, c;
    __host__ __device__ void init(int M, int N, int G_, int c_) { nM = M / BM; nN = N / BM; nwg = nM * nN; G = G_; c = c_; }
    __host__ __device__ bool next(int i, Unit& u) const {
        const long L = (long)i * G + c; if (L >= nwg) return false;
        int wgid = (int)L; { const int q = nwg / NXCD, r = nwg % NXCD, xcd = wgid % NXCD, off = wgid / NXCD; wgid = (xcd < r ? xcd * (q + 1) : r * (q + 1) + (xcd - r) * q) + off; }
        const int nig = WGM * nN, gid = wgid / nig, fm = gid * WGM, gsz = (nM - fm) < WGM ? (nM - fm) : WGM;
        u.pm = fm + ((wgid % nig) % gsz); u.pn = (wgid % nig) / gsz; return true;
    }
    __device__ __forceinline__ void a_ready(const Unit&) const {}
    __device__ __forceinline__ void done(const Unit&) const {}
};

__device__ __forceinline__ unsigned cvt_pk_bf16(float lo, float hi) { unsigned r; asm volatile("v_cvt_pk_bf16_f32 %0, %1, %2" : "=v"(r) : "v"(lo), "v"(hi)); return r; }
typedef float f32x2 __attribute__((ext_vector_type(2)));
__device__ __forceinline__ f32x2 gelu_pk(f32x2 v) {
    const f32x2 av = __builtin_elementwise_abs(v), d = av * 0.2316418882f + 1.0f;
    f32x2 t; t.x = __builtin_amdgcn_rcpf(d.x); t.y = __builtin_amdgcn_rcpf(d.y);
    f32x2 q = t * 0.5307027145f + (-0.7265760135f); q = q * t + 0.7107068705f; q = q * t + (-0.142248368f); q = q * t + 0.127414796f; q = q * t;
    const f32x2 s = (v * v) * (-0.72134752044f);
    f32x2 e; e.x = __builtin_amdgcn_exp2f(s.x); e.y = __builtin_amdgcn_exp2f(s.y);
    const f32x2 m = v * (q * e), r = v - m;
    f32x2 o; o.x = v.x < 0.f ? m.x : r.x; o.y = v.y < 0.f ? m.y : r.y; return o;
}

template <int ACT  > struct EpiBf16 {
    static constexpr bool PERM = true, AFTER_DRAIN = false; static_assert(ACT == 0 || ACT == 1, "EpiBf16: ACT is 0 (none) or 1 (gelu_pk)");
    bf16_t* O; int ldc; const float* bias; int split_cols; size_t split_stride; float scale0;
    __device__ __forceinline__ void operator()(const f32x4 (&acc)[2][2][4][2], const Unit& u, int wr, int wc, int fr, int fq) const {
        const int row0 = u.pm * BM + wr * 64 + fr; int colt = u.pn * BM; bf16_t* base = O;
        float sc = 1.f; if (split_cols) { const int t = colt / split_cols; base += (size_t)t * split_stride; colt -= t * split_cols; if (t == 0) sc = scale0; }
        const int col0 = colt + wc * 32 + 8 * fq, bcol0 = u.pn * BM + wc * 32 + 8 * fq;
        f32x4 bv[2][2];
#pragma unroll
        for (int bj = 0; bj < 2; ++bj)
#pragma unroll
            for (int n = 0; n < 2; ++n) bv[bj][n] = bias ? *(const f32x4*)(bias + bcol0 + bj * HALF + 4 * n) : (f32x4){0.f, 0.f, 0.f, 0.f};
#pragma unroll
        for (int ai = 0; ai < 2; ++ai)
#pragma unroll
            for (int m = 0; m < 4; ++m) { bf16_t* rowp = base + (size_t)(row0 + ai * HALF + m * 16) * ldc + col0;
#pragma unroll
                for (int bj = 0; bj < 2; ++bj) { f32x4 v0 = acc[ai][bj][m][0] + bv[bj][0], v1 = acc[ai][bj][m][1] + bv[bj][1];
                    if (ACT == 1) { f32x2 a = gelu_pk((f32x2){v0[0], v0[1]}), b = gelu_pk((f32x2){v0[2], v0[3]}), c = gelu_pk((f32x2){v1[0], v1[1]}), d = gelu_pk((f32x2){v1[2], v1[3]});
                        v0 = (f32x4){a.x, a.y, b.x, b.y}; v1 = (f32x4){c.x, c.y, d.x, d.y}; }
                    v0 = v0 * sc; v1 = v1 * sc; u32x4 w; w.x = cvt_pk_bf16(v0[0], v0[1]); w.y = cvt_pk_bf16(v0[2], v0[3]); w.z = cvt_pk_bf16(v1[0], v1[1]); w.w = cvt_pk_bf16(v1[2], v1[3]);
                    *(u32x4*)(rowp + bj * HALF) = w; } }
    }
};


struct EpiGate {
    static constexpr bool PERM = false, AFTER_DRAIN = false;
    const float* x; float* out; const float* gate; int ldc; float dbg0, dbg1;
    __device__ __forceinline__ void operator()(const f32x4 (&acc)[2][2][4][2], const Unit& u, int wr, int wc, int fr, int fq) const {
        const int col0 = u.pn * BM + wc * 32 + 4 * fq;
        const int b = (u.pm * BM) >> 12;
        f32x4 gv[2][2];
#pragma unroll
        for (int bj = 0; bj < 2; ++bj)
#pragma unroll
            for (int n = 0; n < 2; ++n) gv[bj][n] = *(const f32x4*)(gate + (size_t)b * 6144 + col0 + bj * HALF + n * 16);
#pragma unroll
        for (int ai = 0; ai < 2; ++ai)
#pragma unroll
            for (int mp = 0; mp < 2; ++mp) {
                f32x4 xv[2][2][2];
#pragma unroll
                for (int mm = 0; mm < 2; ++mm) { const size_t off = (size_t)(u.pm * BM + ai * HALF + wr * 64 + (2 * mp + mm) * 16 + fr) * ldc + col0;
#pragma unroll
                    for (int bj = 0; bj < 2; ++bj)
#pragma unroll
                        for (int n = 0; n < 2; ++n) xv[mm][bj][n] = *(const f32x4*)(x + off + bj * HALF + n * 16); }
                asm volatile("" ::: "memory");
#pragma unroll
                for (int mm = 0; mm < 2; ++mm) { const int m = 2 * mp + mm; const size_t off = (size_t)(u.pm * BM + ai * HALF + wr * 64 + m * 16 + fr) * ldc + col0;
#pragma unroll
                    for (int bj = 0; bj < 2; ++bj)
#pragma unroll
                        for (int n = 0; n < 2; ++n) { f32x4 o = xv[mm][bj][n] + gv[bj][n] * acc[ai][bj][m][n];
                            if (DBG_SEL >= 0) { o = o + dbg0; if (off + bj * HALF + n * 16 == 0) o.x += dbg1; }
                            *(f32x4*)(out + off + bj * HALF + n * 16) = o; } }
                asm volatile("" ::: "memory"); }
    }
};
template <class Epi, class Sched, bool ALIGN_EPI = false, bool SP2 = false>
__device__ __forceinline__ void gemm_phase(PG8_LAS unsigned char* lds, const Gemm g, const Sched& S, const Epi& E) {
    const int tid = threadIdx.x, wid = __builtin_amdgcn_readfirstlane(tid >> 6), lane = tid & 63, wr = wid >> 2, wc = wid & 3, fr = lane & 15, fq = lane >> 4;
    const int K = g.K, nt = K / BK, lda = g.lda;
    unsigned voffA[2], voffB[2];
#pragma unroll
    for (int i = 0; i < 2; ++i) { int R, C; stage_rc(tid * 16 + i * 8192, R, C); const int Rb = Epi::PERM ? ((R & ~31) + perm32(R & 31)) : R;
        voffA[i] = (unsigned)(R * lda + C) * 2u; voffB[i] = (unsigned)(Rb * K + C) * 2u; }
    const size_t kstep = (size_t)(BK * 2);
    const size_t hstepA = (size_t)HALF * lda * 2, hstepB = (size_t)HALF * K * 2;
    const size_t tstepA = 2 * hstepA, tstepB = 2 * hstepB;
    const unsigned ldsw = (unsigned)wid * 1024u;
    const int aoff = lds_byte(wr * 64 + fr, fq * 8), boff = lds_byte(wc * 32 + fr, fq * 8);
#define PG8_SA(b, h) (((b) * 2 + (h)) * HTB)
#define PG8_SB(b, h) ((4 + (b) * 2 + (h)) * HTB)
#define PG8_STAGE(bufoff, gbase, voff) do { _Pragma("unroll") for (int _i = 0; _i < 2; ++_i) \
        __builtin_amdgcn_global_load_lds((const unsigned*)((const char*)(gbase) + (voff)[_i]), (PG8_LAS unsigned*)(lds + (bufoff) + ldsw + _i * 8192), 16, 0, 0); } while (0)
#define PG8_LDA(dst, b, h) do { _Pragma("unroll") for (int m = 0; m < 4; ++m) _Pragma("unroll") for (int k = 0; k < 2; ++k) dst[m][k] = *(const PG8_LAS bf16x8*)(lds + PG8_SA(b, h) + aoff + m * 2048 + k * 1024); } while (0)
#define PG8_LDB(dst, b, h) do { _Pragma("unroll") for (int n = 0; n < 2; ++n) _Pragma("unroll") for (int k = 0; k < 2; ++k) dst[n][k] = *(const PG8_LAS bf16x8*)(lds + PG8_SB(b, h) + boff + n * 2048 + k * 1024); } while (0)
#define PG8_MMA(ai, bj, At, Bt) do { __builtin_amdgcn_s_setprio(1); _Pragma("unroll") for (int m = 0; m < 4; ++m) _Pragma("unroll") for (int n = 0; n < 2; ++n) _Pragma("unroll") for (int k = 0; k < 2; ++k) \
        acc[ai][bj][m][n] = __builtin_amdgcn_mfma_f32_16x16x32_bf16(Bt[n][k], At[m][k], acc[ai][bj][m][n], 0, 0, 0); __builtin_amdgcn_s_setprio(0); } while (0)
#define PG8_WAIT_V(n) asm volatile("s_waitcnt vmcnt(" #n ")" ::: "memory")
#define PG8_WAIT_L(n) asm volatile("s_waitcnt lgkmcnt(" #n ")" ::: "memory")
#define PG8_BAR __builtin_amdgcn_s_barrier()
#define PG8_SCHED __builtin_amdgcn_sched_barrier(0)
    Unit cur, nxt; int ui = 0;
    if (!S.next(0, cur)) return;
    f32x4 acc[2][2][4][2];
#pragma unroll
    for (int a = 0; a < 2; ++a)
#pragma unroll
        for (int b = 0; b < 2; ++b)
#pragma unroll
            for (int m = 0; m < 4; ++m)
#pragma unroll
                for (int n = 0; n < 2; ++n) acc[a][b][m][n] = (f32x4){0.f, 0.f, 0.f, 0.f};
    bf16x8 At[4][2], B0[2][2], B1[2][2];
    const char* cA = (const char*)g.A + (size_t)cur.pm * tstepA; const char* cB = (const char*)g.Bt + (size_t)cur.pn * tstepB;
    S.a_ready(cur);
    if constexpr (SP2) {
        PG8_STAGE(PG8_SB(0, 0), cB, voffB); PG8_STAGE(PG8_SB(0, 1), cB + hstepB, voffB); PG8_STAGE(PG8_SA(0, 0), cA, voffA); PG8_STAGE(PG8_SA(0, 1), cA + hstepA, voffA);
        if (wr == 1) PG8_BAR;
        PG8_WAIT_V(2); PG8_BAR;
        PG8_STAGE(PG8_SB(1, 0), cB + kstep, voffB); PG8_STAGE(PG8_SA(1, 0), cA + kstep, voffA); PG8_STAGE(PG8_SB(1, 1), cB + hstepB + kstep, voffB);
        PG8_WAIT_V(6); PG8_BAR;
    } else {
        PG8_STAGE(PG8_SB(0, 0), cB, voffB); PG8_STAGE(PG8_SA(0, 0), cA, voffA); PG8_STAGE(PG8_SB(0, 1), cB + hstepB, voffB); PG8_STAGE(PG8_SA(0, 1), cA + hstepA, voffA);
        if (wr == 1) PG8_BAR;
        PG8_WAIT_V(4); PG8_BAR;
        PG8_STAGE(PG8_SB(1, 0), cB + kstep, voffB); PG8_STAGE(PG8_SA(1, 0), cA + kstep, voffA); PG8_STAGE(PG8_SB(1, 1), cB + hstepB + kstep, voffB);
        PG8_WAIT_V(6); PG8_BAR;
    }
    for (;;) {
        const bool has_next = S.next(ui + 1, nxt);
        const char* nA = has_next ? (const char*)g.A + (size_t)nxt.pm * tstepA : cA; const char* nB = has_next ? (const char*)g.Bt + (size_t)nxt.pn * tstepB : cB;
        for (int t = 0; t < nt; t += 2) {
            const bool last = (t == nt - 2);
            const char* a1 = cA + (size_t)(t + 1) * kstep;
            const char* a2 = last ? nA : cA + (size_t)(t + 2) * kstep; const char* b2 = last ? nB : cB + (size_t)(t + 2) * kstep;
            const char* a3 = a2 + kstep; const char* b3 = b2 + kstep;
            if (last && has_next) S.a_ready(nxt);
            if constexpr (SP2) {
            PG8_LDB(B0, 0, 0); PG8_LDB(B1, 0, 1); PG8_SCHED; PG8_LDA(At, 0, 0); PG8_STAGE(PG8_SA(1, 1), a1 + hstepA, voffA);
            PG8_WAIT_V(8); PG8_WAIT_L(0); PG8_BAR; PG8_MMA(0, 0, At, B0); PG8_MMA(0, 1, At, B1); PG8_BAR; PG8_SCHED;
            PG8_LDA(At, 0, 1); PG8_STAGE(PG8_SB(0, 0), b2, voffB); PG8_STAGE(PG8_SB(0, 1), b2 + hstepB, voffB); PG8_STAGE(PG8_SA(0, 0), a2, voffA);
            PG8_WAIT_V(8); PG8_WAIT_L(0); PG8_BAR; PG8_MMA(1, 0, At, B0); PG8_MMA(1, 1, At, B1); PG8_BAR; PG8_SCHED;
            PG8_LDB(B0, 1, 0); PG8_LDB(B1, 1, 1); PG8_SCHED; PG8_LDA(At, 1, 0); PG8_STAGE(PG8_SA(0, 1), a2 + hstepA, voffA);
            PG8_WAIT_V(8); PG8_WAIT_L(0); PG8_BAR; PG8_MMA(0, 0, At, B0); PG8_MMA(0, 1, At, B1); PG8_BAR; PG8_SCHED;
            PG8_LDA(At, 1, 1); PG8_STAGE(PG8_SB(1, 0), b3, voffB); PG8_STAGE(PG8_SB(1, 1), b3 + hstepB, voffB); PG8_STAGE(PG8_SA(1, 0), a3, voffA);
            PG8_WAIT_V(8); PG8_WAIT_L(0); PG8_BAR; PG8_MMA(1, 0, At, B0); PG8_MMA(1, 1, At, B1); PG8_BAR; PG8_SCHED;
            } else {
            PG8_LDB(B0, 0, 0); PG8_SCHED; PG8_LDA(At, 0, 0); PG8_STAGE(PG8_SA(1, 1), a1 + hstepA, voffA);
            PG8_WAIT_L(8); PG8_BAR; PG8_WAIT_L(0); PG8_MMA(0, 0, At, B0); PG8_BAR; PG8_SCHED;
            PG8_LDB(B1, 0, 1); PG8_STAGE(PG8_SB(0, 0), b2, voffB);
            PG8_BAR; PG8_WAIT_L(0); PG8_MMA(0, 1, At, B1); PG8_BAR;
            PG8_LDA(At, 0, 1); PG8_STAGE(PG8_SA(0, 0), a2, voffA);
            PG8_BAR; PG8_WAIT_L(0); PG8_MMA(1, 0, At, B0); PG8_BAR; PG8_SCHED;
            PG8_STAGE(PG8_SB(0, 1), b2 + hstepB, voffB);
            PG8_WAIT_V(6); PG8_BAR; PG8_MMA(1, 1, At, B1); PG8_BAR;
            PG8_LDB(B0, 1, 0); PG8_SCHED; PG8_LDA(At, 1, 0); PG8_STAGE(PG8_SA(0, 1), a2 + hstepA, voffA);
            PG8_WAIT_L(8); PG8_BAR; PG8_WAIT_L(0); PG8_MMA(0, 0, At, B0); PG8_BAR; PG8_SCHED;
            PG8_LDB(B1, 1, 1); PG8_STAGE(PG8_SB(1, 0), b3, voffB);
            PG8_BAR; PG8_WAIT_L(0); PG8_MMA(0, 1, At, B1); PG8_BAR;
            PG8_LDA(At, 1, 1); PG8_STAGE(PG8_SA(1, 0), a3, voffA);
            PG8_BAR; PG8_WAIT_L(0); PG8_MMA(1, 0, At, B0); PG8_BAR; PG8_SCHED;
            PG8_STAGE(PG8_SB(1, 1), b3 + hstepB, voffB);
            PG8_WAIT_V(6); PG8_BAR; PG8_MMA(1, 1, At, B1); PG8_BAR;
            }
        }
        if constexpr (ALIGN_EPI) { if (wr == 0) PG8_BAR; }
        if constexpr (!Epi::AFTER_DRAIN) { E(acc, cur, wr, wc, fr, fq); S.done(cur); }
        if (!has_next) break;
#pragma unroll
        for (int a = 0; a < 2; ++a)
#pragma unroll
            for (int b = 0; b < 2; ++b)
#pragma unroll
                for (int m = 0; m < 4; ++m)
#pragma unroll
                    for (int n = 0; n < 2; ++n) acc[a][b][m][n] = (f32x4){0.f, 0.f, 0.f, 0.f};
        cur = nxt; cA = nA; cB = nB; ++ui;
        if constexpr (ALIGN_EPI) { if (wr == 1) PG8_BAR; }
    }
    PG8_WAIT_V(0);
    if constexpr (!ALIGN_EPI) { if (wr == 0) PG8_BAR; }
    PG8_BAR;
    if constexpr (Epi::AFTER_DRAIN) { E.fused(acc, cur, wr, wc, fr, fq, lds, wid, lane); S.done(cur); }
#undef PG8_SA
#undef PG8_SB
#undef PG8_STAGE
#undef PG8_LDA
#undef PG8_LDB
#undef PG8_MMA
#undef PG8_WAIT_V
#undef PG8_WAIT_L
#undef PG8_BAR
#undef PG8_SCHED
}
}

#ifndef MK_N_LAUNCHES
#define MK_N_LAUNCHES 1
#endif
#ifndef B_DUMMY
#define B_DUMMY 0
#endif
#ifndef DUP_PHASE
#define DUP_PHASE -1
#endif
constexpr int N_PHASES = 7;
constexpr int NWAVES = 8;
constexpr int DM = 2048, NB = 4, SEQ = 4096, CTXL = 256;
constexpr int ML = NB * SEQ, MC = NB * CTXL, MT = ML + MC;
constexpr int NIN = 6912;
constexpr int C_R = 0, C_K = 1024, C_V = 2048, C_LW = 3072, C_LA = 3200, C_ZR = 3328, C_Q = 4352, C_KA = 5376, C_VA = 5632, C_ZA = 5888;
constexpr float LOG2E = 1.4426950408889634f;
constexpr int DBG_LDS = 143360;

constexpr size_t MiB = 1u << 20;
constexpr size_t WS_CTL = 0, CTL_ZERO_BYTES = 64 * 1024;
constexpr size_t WS_MOD = 1 * MiB;
constexpr size_t WS_ROPE = 1 * MiB + 128 * 1024;
constexpr size_t WS_DBG = 1 * MiB + 192 * 1024;
constexpr size_t WS_W2T = 1 * MiB + 256 * 1024;
constexpr size_t WS_A2T = 1 * MiB + 512 * 1024;
constexpr size_t WS_WOUT = 2 * MiB;
constexpr size_t WS_P = 10 * MiB;
constexpr size_t WS_XN = 240 * MiB;
constexpr size_t WS_WIN = 308 * MiB;
constexpr size_t WS_GHQ = 240 * MiB;
constexpr size_t WS_MIX = 240 * MiB;
constexpr size_t WS_YF = 444 * MiB, WS_YB = 476 * MiB;
constexpr size_t WS_BON = 508 * MiB;
constexpr size_t WS_END = 510 * MiB;
static_assert(WS_P + (size_t)MT * NIN * 2 <= WS_XN && WS_XN + (size_t)MT * DM * 2 <= WS_WIN && WS_WIN + (size_t)NIN * DM * 2 <= WS_YF && WS_GHQ + (size_t)8704 * 24576 <= WS_YF && WS_YB + (size_t)ML * 1024 * 2 <= WS_BON, "ws map");

constexpr int CW_BAR = 1024;
constexpr int CW_TICKET = 8192;
constexpr int LDS_BYTES = 163840;
constexpr int MISC_OFF = LDS_BYTES - 256;

#define GAS __attribute__((address_space(1)))
#define LAS __attribute__((address_space(3)))
typedef unsigned short bf16;
typedef float f32x4 __attribute__((ext_vector_type(4)));
typedef float f32x16 __attribute__((ext_vector_type(16)));
typedef short bf16x8 __attribute__((ext_vector_type(8)));
typedef unsigned u32x4 __attribute__((ext_vector_type(4)));
typedef unsigned u32x2 __attribute__((ext_vector_type(2)));
typedef _Float16 h8 __attribute__((ext_vector_type(8)));
typedef _Float16 h4 __attribute__((ext_vector_type(4)));
typedef _Float16 h2 __attribute__((ext_vector_type(2)));
typedef GAS unsigned gu32;

__device__ __forceinline__ unsigned f2bf(float f) { unsigned u = __builtin_bit_cast(unsigned, f); return (u + 0x7fffu + ((u >> 16) & 1u)) >> 16; }
typedef float f32x2_t __attribute__((ext_vector_type(2))); typedef __bf16 bf16x2_t __attribute__((ext_vector_type(2)));
__device__ __forceinline__ unsigned pk2(float lo, float hi) { f32x2_t v = {lo, hi}; bf16x2_t b = __builtin_convertvector(v, bf16x2_t); return __builtin_bit_cast(unsigned, b); }
__device__ __forceinline__ float bflo(unsigned w) { return __builtin_bit_cast(float, w << 16); }
__device__ __forceinline__ float bfhi(unsigned w) { return __builtin_bit_cast(float, w & 0xffff0000u); }
__device__ __forceinline__ void unpack8(const u32x4 r, float* v) { v[0] = bflo(r.x); v[1] = bfhi(r.x); v[2] = bflo(r.y); v[3] = bfhi(r.y); v[4] = bflo(r.z); v[5] = bfhi(r.z); v[6] = bflo(r.w); v[7] = bfhi(r.w); }
__device__ __forceinline__ unsigned pkh(float a, float b) { h2 v = {(_Float16)a, (_Float16)b}; return __builtin_bit_cast(unsigned, v); }
__device__ __forceinline__ float wave_sum(float v) {
#pragma unroll
    for (int o = 1; o < 64; o <<= 1) v += __shfl_xor(v, o);
    return v;
}
__device__ __forceinline__ float fast_exp(float x) { return __builtin_amdgcn_exp2f(x * LOG2E); }
__device__ __forceinline__ float sigmoidf_(float x) { return __builtin_amdgcn_rcpf(1.0f + fast_exp(-x)); }
__device__ __forceinline__ float siluf_(float x) { return x * sigmoidf_(x); }
template <int CTRL> __device__ __forceinline__ float dpp_f(float x) { return __builtin_bit_cast(float, __builtin_amdgcn_update_dpp(0, __builtin_bit_cast(int, x), CTRL, 0xF, 0xF, false)); }

#define XB_TMO      128
#define XB_XCNT(j)  (256  + 64 * (j))
#define XB_XSUB(j)  (1280 + 64 * (j))
#define XB_XGEN(j)  (2304 + 64 * (j))
#define XB_TOP      3328
#define XB_TOPGEN   3392
#define XCD_BAR_WORDS 3456
#define XB_SPIN_CAP (1u << 18)
__device__ __forceinline__ unsigned xb_ld(unsigned* p)              { return __hip_atomic_load(p, __ATOMIC_RELAXED, __HIP_MEMORY_SCOPE_AGENT); }
__device__ __forceinline__ unsigned xb_add(unsigned* p, unsigned v) { return __hip_atomic_fetch_add(p, v, __ATOMIC_RELAXED, __HIP_MEMORY_SCOPE_AGENT); }
__device__ __forceinline__ unsigned xb_xcc_id() { return (unsigned)__builtin_amdgcn_s_getreg((3 << 11) | 20) & 0xFu; }
#define XB_SPIN(cond, bar) do { unsigned _sp = 0; while (cond) { __builtin_amdgcn_s_sleep(1); \
    if ((++_sp & 255u) == 0u) { if (xb_ld(&(bar)[XB_TMO])) break; if (_sp > XB_SPIN_CAP) { atomicAdd(&(bar)[XB_TMO], 1u); break; } } } } while (0)
struct XcdBarrier { unsigned* bar; unsigned x; volatile LAS unsigned* st; };
__device__ __forceinline__ XcdBarrier xcd_barrier_post(unsigned* bar, volatile LAS unsigned* st) {
    XcdBarrier b; b.bar = bar; b.x = xb_xcc_id(); b.st = st;
    if (threadIdx.x == 0) (void)xb_add(&bar[XB_XCNT(b.x)], 1u);
    return b;
}
__device__ __forceinline__ void xcd_barrier_complete(unsigned* bar, unsigned x, unsigned& nloc, unsigned& nx) {
    const unsigned G = gridDim.x * gridDim.y * gridDim.z;
    unsigned sum, cnt, mine, sp = 0u;
    for (;;) {
        sum = 0u; cnt = 0u; mine = 0u;
#pragma unroll
        for (unsigned j = 0; j < 16; ++j) { const unsigned c = xb_ld(&bar[XB_XCNT(j)]); sum += c; cnt += (c > 0u) ? 1u : 0u; mine = (j == x) ? c : mine; }
        if (sum == G) break;
        __builtin_amdgcn_s_sleep(1);
        if ((++sp & 255u) == 0u) { if (xb_ld(&bar[XB_TMO])) break; if (sp > XB_SPIN_CAP) { atomicAdd(&bar[XB_TMO], 1u); break; } }
    }
    nloc = mine > 0u ? mine : 1u; nx = cnt > 0u ? cnt : 1u;
}
__device__ __forceinline__ void xcd_barrier(const XcdBarrier& b) {
    asm volatile("s_waitcnt vmcnt(0)" ::: "memory");
    __syncthreads();
    if (threadIdx.x == 0) {
        unsigned* bar = b.bar;
        __builtin_amdgcn_s_waitcnt(0);
        unsigned nloc = b.st[0], nx = b.st[1];
        if (nloc == 0u) { xcd_barrier_complete(bar, b.x, nloc, nx); b.st[0] = nloc; b.st[1] = nx; }
        const unsigned old = xb_add(&bar[XB_XSUB(b.x)], 1u);
        const unsigned gen = old / nloc;
        if (old + 1u == (gen + 1u) * nloc) {
            __builtin_amdgcn_fence(__ATOMIC_RELEASE, "agent");
            asm volatile("s_waitcnt vmcnt(0)" ::: "memory");
            const unsigned og = xb_add(&bar[XB_TOP], 1u);
            const unsigned tg = og / nx;
            if (og + 1u == (tg + 1u) * nx) xb_add(&bar[XB_TOPGEN], 1u);
            else XB_SPIN(xb_ld(&bar[XB_TOPGEN]) == tg, bar);
            __builtin_amdgcn_fence(__ATOMIC_ACQUIRE, "agent");
            xb_add(&bar[XB_XGEN(b.x)], 1u);
            asm volatile("s_waitcnt vmcnt(0)" ::: "memory");
        } else {
            XB_SPIN(xb_ld(&bar[XB_XGEN(b.x)]) == gen, bar);
            __builtin_amdgcn_fence(__ATOMIC_ACQUIRE, "agent");
            asm volatile("s_waitcnt vmcnt(0)" ::: "memory");
        }
    }
    __syncthreads();
}

#define DBG_FINE (!(DBG_SEL >= 8 && DBG_SEL < 24))
#define TSTAMP(k) do { if (DBG_SEL >= 0 && (DBG_FINE || ((k) >= 8 && (k) < 24)) && F.bid == DBG_BLOCK && F.tid == 0) { volatile LAS unsigned long long* T_ = (volatile LAS unsigned long long*)(F.lds + DBG_LDS); const unsigned long long n_ = __builtin_amdgcn_s_memrealtime(); const unsigned long long m_ = __builtin_amdgcn_s_memtime(); T_[k] += n_ - T_[32]; T_[32] = n_; if ((k) < 8) { T_[24] += m_ - T_[33]; } T_[33] = m_; } } while (0)
#define TSTART() do { if (DBG_SEL >= 0 && F.bid == DBG_BLOCK && F.tid == 0) { volatile LAS unsigned long long* T_ = (volatile LAS unsigned long long*)(F.lds + DBG_LDS); T_[32] = __builtin_amdgcn_s_memrealtime(); T_[33] = __builtin_amdgcn_s_memtime(); } } while (0)
struct Frame {
    LAS unsigned char* lds;
    int tid, lane, wave, G, bid;
    const float *x, *c, *ctx, *c_ctx, *w_ada, *b_ada, *norm_g, *w_in, *mu_shift, *w0, *w2, *a0, *a2, *k_k, *k_a, *r_k, *ln_g, *ln_b, *qng, *kng, *sink, *w_out;
    float* out;
    float *MOD, *ROPE, *BON, *DBG;
    bf16 *W2T, *A2T, *WOUT, *P, *XN, *WIN, *YF, *YB, *MIX;
    unsigned char* GHQ;
};


typedef const float* cfp_t;
__device__ __forceinline__ const float* karg_f(int idx) { int off = idx * 8; asm volatile("" : "+s"(off)); const __attribute__((address_space(4))) char* kp = (const __attribute__((address_space(4))) char*)__builtin_amdgcn_kernarg_segment_ptr(); return *(const __attribute__((address_space(4))) cfp_t*)(kp + off); }
__device__ __forceinline__ void fresh(Frame& F) {
    int t_ = threadIdx.x; asm volatile("" : "+v"(t_)); F.tid = t_; F.lane = t_ & 63; F.wave = __builtin_amdgcn_readfirstlane(t_ >> 6);
    int b_ = blockIdx.x; asm volatile("" : "+s"(b_)); F.bid = b_;
    F.x = karg_f(0); F.c = karg_f(1); F.ctx = karg_f(2); F.c_ctx = karg_f(3); F.w_ada = karg_f(4); F.b_ada = karg_f(5); F.norm_g = karg_f(6); F.w_in = karg_f(7);
    F.mu_shift = karg_f(8); F.w0 = karg_f(9); F.w2 = karg_f(10); F.a0 = karg_f(11); F.a2 = karg_f(12); F.k_k = karg_f(13); F.k_a = karg_f(14); F.r_k = karg_f(15);
    F.ln_g = karg_f(16); F.ln_b = karg_f(17); F.qng = karg_f(18); F.kng = karg_f(19); F.sink = karg_f(20); F.w_out = karg_f(21);
    F.out = (float*)karg_f(22);
    unsigned char* ws = (unsigned char*)karg_f(23);
    F.MOD = (float*)(ws + WS_MOD); F.ROPE = (float*)(ws + WS_ROPE); F.BON = (float*)(ws + WS_BON); F.DBG = (float*)(ws + WS_DBG);
    F.W2T = (bf16*)(ws + WS_W2T); F.A2T = (bf16*)(ws + WS_A2T); F.WOUT = (bf16*)(ws + WS_WOUT); F.P = (bf16*)(ws + WS_P); F.XN = (bf16*)(ws + WS_XN); F.WIN = (bf16*)(ws + WS_WIN);
    F.YF = (bf16*)(ws + WS_YF); F.YB = (bf16*)(ws + WS_YB); F.MIX = (bf16*)(ws + WS_MIX); F.GHQ = ws + WS_GHQ;
}

struct Sched1 {
    int G, c;
    __device__ __forceinline__ void init(int G_, int c_) { G = G_; c = c_; }
    __device__ __forceinline__ bool next(int i, pg8::Unit& u) const {
        int grp, loc;
        if (G == 256) { if (i >= 7) return false; grp = c & 7; loc = i * 32 + (c >> 3); if (loc >= 216) { const int j = grp * 8 + (loc - 216); if (j >= 60) return false; u.pm = 64 + j / 15; const int q = j % 15; u.pn = q < 13 ? q : q + 8; return true; } }
        else { const int L = i * G + c; if (L >= 1788) return false; if (L >= 1728) { const int j = L - 1728; u.pm = 64 + j / 15; const int q = j % 15; u.pn = q < 13 ? q : q + 8; return true; } grp = L / 216; loc = L % 216; }
        u.pm = grp * 8 + (loc & 7); u.pn = loc >> 3; return true;
    }
    __device__ __forceinline__ void a_ready(const pg8::Unit&) const {}
    __device__ __forceinline__ void done(const pg8::Unit&) const {}
};

__device__ __forceinline__ void p0_transpose_item(const float* W, int K, int N, bf16* WT, LAS float* scr, int item, int lane) {
    const int nblk = N / 32, kb = item / nblk, nb = item % nblk, k0 = 64 * kb, n0 = 32 * nb;
    { const int kr = lane >> 3, c4 = lane & 7;
      f32x4 w[8];
#pragma unroll
      for (int u = 0; u < 8; ++u) w[u] = __builtin_nontemporal_load((const f32x4*)(W + (size_t)(k0 + 8 * u + kr) * N + n0 + 4 * c4));
#pragma unroll
      for (int u = 0; u < 8; ++u) { LAS float* d = scr + (8 * u + kr) * 33 + 4 * c4; d[0] = w[u].x; d[1] = w[u].y; d[2] = w[u].z; d[3] = w[u].w; } }
    asm volatile("s_waitcnt lgkmcnt(0)" ::: "memory");
    const int c = lane & 7;
#pragma unroll
    for (int j = 0; j < 4; ++j) { const int n = (lane >> 3) + 8 * j; const LAS float* s = scr + (8 * c) * 33 + n;
        u32x4 o; o.x = pk2(s[0 * 33], s[1 * 33]); o.y = pk2(s[2 * 33], s[3 * 33]); o.z = pk2(s[4 * 33], s[5 * 33]); o.w = pk2(s[6 * 33], s[7 * 33]);
        *(GAS u32x4*)(WT + (size_t)(n0 + n) * K + k0 + 8 * c) = o; }
    asm volatile("s_waitcnt lgkmcnt(0)" ::: "memory");
}
__device__ __forceinline__ void p0_prologue(Frame& F) {
    const int tid = F.tid, lane = F.lane, wave = F.wave;
    if (F.bid < 192) {
        LAS float* sl = (LAS float*)F.lds;
        LAS float* red = sl + 5 * 2048;
        for (int i = tid; i < 5 * 2048; i += NWAVES * 64) { const int v = i >> 11, k = i & 2047; const float cv = v < 4 ? F.c[v * 2048 + k] : F.c_ctx[k]; sl[i] = cv / (1.0f + __expf(-cv)); }
        __syncthreads();
        const int n0 = 32 * F.bid, col = lane & 31, slot = wave * 2 + (lane >> 5);
        float acc[5] = {0.f, 0.f, 0.f, 0.f, 0.f};
        const float* wp = F.w_ada + n0 + col;
#pragma unroll 8
        for (int k = slot; k < 2048; k += 16) { const float w = __builtin_nontemporal_load(wp + (size_t)k * 6144);
#pragma unroll
            for (int v = 0; v < 5; ++v) acc[v] += sl[v * 2048 + k] * w; }
#pragma unroll
        for (int v = 0; v < 5; ++v) red[(slot * 5 + v) * 32 + col] = acc[v];
        __syncthreads();
        if (tid < 160) { const int v = tid >> 5, cc = tid & 31; float s = 0.f;
#pragma unroll
            for (int q = 0; q < 16; ++q) s += red[(q * 5 + v) * 32 + cc];
            F.MOD[v * 6144 + n0 + cc] = s + F.b_ada[n0 + cc]; }
        __syncthreads();
    }
    if (F.bid == F.G - 1) {
        for (int i = tid; i < 1024; i += NWAVES * 64) { const int pos = i >> 4, f = i & 15; const float inv = exp2f(-(float)f * (13.287712379549449f / 16.0f)); const float ang = (float)pos * inv;
            F.ROPE[i] = cosf(ang); F.ROPE[1024 + i] = sinf(ang); }
    }
    LAS float* scr = (LAS float*)(F.lds + wave * 16384);
    const int gw = F.bid * NWAVES + wave, NGW = F.G * NWAVES;
    constexpr int I_IN = (DM / 64) * (NIN / 32), I_OUT = (DM / 64) * (DM / 32), I_L = 1024 / 32;
    constexpr int NITEMS = I_IN + I_OUT + 4 * I_L;
    for (int it = gw; it < NITEMS; it += NGW) {
        int r = it;
        if (r < I_IN) { p0_transpose_item(F.w_in, DM, NIN, F.WIN, scr, r, lane); continue; } r -= I_IN;
        if (r < I_OUT) { p0_transpose_item(F.w_out, DM, DM, F.WOUT, scr, r, lane); continue; } r -= I_OUT;
        const int q = r / I_L; r -= q * I_L;
        p0_transpose_item((q < 2 ? F.w2 : F.a2) + (size_t)(q & 1) * 64 * 1024, 64, 1024, (q < 2 ? F.W2T : F.A2T) + (size_t)(q & 1) * 1024 * 64, scr, r, lane);
    }
}

__device__ __forceinline__ void p1_modulate(Frame& F) {
    const int gw = F.bid * NWAVES + F.wave, NGW = F.G * NWAVES, lane = F.lane;
    const int m_lo = (int)(((long)gw * MT) / NGW), m_hi = (int)(((long)(gw + 1) * MT) / NGW);
    f32x4 gs[8], sh[8]; int cur = -1;
    for (int m = m_lo; m < m_hi; ++m) {
        const float* src = m < ML ? F.x + (size_t)m * DM : F.ctx + (size_t)(m - ML) * DM;
        const int bsel = m < ML ? (m >> 12) : 4;
        if (bsel != cur) { cur = bsel; const float* mod = F.MOD + bsel * 6144;
#pragma unroll
            for (int j = 0; j < 8; ++j) { const int d0 = (64 * j + lane) * 4; gs[j] = *(const f32x4*)(F.norm_g + d0) * (1.0f + *(const f32x4*)(mod + 2048 + d0)); sh[j] = *(const f32x4*)(mod + d0); } }
        const GAS f32x4* xr = (const GAS f32x4*)src + lane;
        f32x4 v[8]; float s = 0.f;
#pragma unroll
        for (int j = 0; j < 8; ++j) { v[j] = __builtin_nontemporal_load(xr + 64 * j); s += (v[j].x * v[j].x + v[j].y * v[j].y) + (v[j].z * v[j].z + v[j].w * v[j].w); }
        const float rr = 1.0f / sqrtf(wave_sum(s) * (1.0f / DM) + 1e-6f);
        GAS u32x2* o8 = (GAS u32x2*)(F.XN + (size_t)m * DM) + lane;
#pragma unroll
        for (int j = 0; j < 8; ++j) { const f32x4 o = v[j] * rr * gs[j] + sh[j]; u32x2 w; w.x = pk2(o.x, o.y); w.y = pk2(o.z, o.w); o8[64 * j] = w; }
    }
}

__device__ __forceinline__ int seq_lo(int m) { return m < ML ? (m & ~(SEQ - 1)) : ML + ((m - ML) & ~(CTXL - 1)); }
__device__ __forceinline__ int seq_hi(int m) { return m < ML ? (m | (SEQ - 1)) : ML + ((m - ML) | (CTXL - 1)); }
__device__ __forceinline__ int scan_row(int b, int d, int blk, int tok) {
    const int j = blk < 4 ? blk * 64 + tok : (blk - 4) * 64 + tok;
    if (blk < 4) return ML + b * CTXL + (d ? (CTXL - 1 - j) : j);
    return b * SEQ + (d ? (SEQ - 1 - j) : j);
}
constexpr int CH_RS = 144, CH_MB = 64 * CH_RS;
constexpr int CB_AT = 0, CB_BT = 1, CB_KT = 2, CB_RT = 3, CB_ATT = 4, CB_BTT = 5, CB_KTT = 6, CB_VT = 7, CB_AAB = 8, CB_AABT = 9, CB_AAK = 10, CB_ARB = 11, CB_ARK = 12, CB_X1 = 13, CB_XT = 14, CB_INV = 4, CB_OY = 4, CB_OG = 5, CB_OH = 6, CB_OQ = 7;
constexpr int CH_WBUF = 8 * CH_MB, CH_ABUF = CH_WBUF + 16384;
constexpr int CH_PT = 15 * CH_MB, CH_GT = CH_PT + 1024, CH_CONST = CH_GT + 2048;
constexpr int CH_LW = 144384;
#ifndef FORCE_BF16
#define FORCE_BF16 0
#endif
constexpr size_t GHQ_ITEM = 24576;
#define LBAR() do { asm volatile("s_waitcnt lgkmcnt(0)" ::: "memory"); __builtin_amdgcn_s_barrier(); asm volatile("" ::: "memory"); } while (0)
__device__ __forceinline__ float h_lo(unsigned w) { return (float)__builtin_bit_cast(h2, w)[0]; }
__device__ __forceinline__ float h_hi(unsigned w) { return (float)__builtin_bit_cast(h2, w)[1]; }
__device__ __forceinline__ f32x4 unpack4x(bool f16, const u32x2 w) { f32x4 r;
    if (f16) { r.x = h_lo(w.x); r.y = h_hi(w.x); r.z = h_lo(w.y); r.w = h_hi(w.y); } else { r.x = bflo(w.x); r.y = bfhi(w.x); r.z = bflo(w.y); r.w = bfhi(w.y); }
    return r; }
__device__ __forceinline__ u32x4 pack8x(bool f16, const float* v) { u32x4 o;
    if (f16) { o.x = pkh(v[0], v[1]); o.y = pkh(v[2], v[3]); o.z = pkh(v[4], v[5]); o.w = pkh(v[6], v[7]); } else { o.x = pk2(v[0], v[1]); o.y = pk2(v[2], v[3]); o.z = pk2(v[4], v[5]); o.w = pk2(v[6], v[7]); }
    return o; }
__device__ __forceinline__ f32x16 mm32(bool f16, const LAS unsigned char* Aop, int mrow0, const LAS unsigned char* Blay, int nrow0, f32x16 acc, int l31, int hi) {
    const LAS unsigned char* pa = Aop + (mrow0 + l31) * CH_RS + hi * 16;
    const LAS unsigned char* pb = Blay + (nrow0 + l31) * CH_RS + hi * 16;
    bf16x8 a[4], b[4];
#pragma unroll
    for (int ks = 0; ks < 4; ++ks) { a[ks] = *(const LAS bf16x8*)(pa + ks * 32); b[ks] = *(const LAS bf16x8*)(pb + ks * 32); }
    if (f16) {
#pragma unroll
        for (int ks = 0; ks < 4; ++ks) acc = __builtin_amdgcn_mfma_f32_32x32x16_f16(__builtin_bit_cast(h8, a[ks]), __builtin_bit_cast(h8, b[ks]), acc, 0, 0, 0);
    } else {
#pragma unroll
        for (int ks = 0; ks < 4; ++ks) acc = __builtin_amdgcn_mfma_f32_32x32x16_bf16(a[ks], b[ks], acc, 0, 0, 0);
    }
    return acc;
}
__device__ __forceinline__ f32x16 mm32k(bool f16, const LAS unsigned char* Aop, int mrow0, const LAS unsigned char* Blay, int nrow0, int kb, f32x16 acc, int l31, int hi) {
    const LAS unsigned char* pa = Aop + (mrow0 + l31) * CH_RS + kb * 64 + hi * 16;
    const LAS unsigned char* pb = Blay + (nrow0 + l31) * CH_RS + kb * 64 + hi * 16;
    const bf16x8 a0 = *(const LAS bf16x8*)pa, a1 = *(const LAS bf16x8*)(pa + 32), b0 = *(const LAS bf16x8*)pb, b1 = *(const LAS bf16x8*)(pb + 32);
    if (f16) { acc = __builtin_amdgcn_mfma_f32_32x32x16_f16(__builtin_bit_cast(h8, a0), __builtin_bit_cast(h8, b0), acc, 0, 0, 0); acc = __builtin_amdgcn_mfma_f32_32x32x16_f16(__builtin_bit_cast(h8, a1), __builtin_bit_cast(h8, b1), acc, 0, 0, 0); }
    else { acc = __builtin_amdgcn_mfma_f32_32x32x16_bf16(a0, b0, acc, 0, 0, 0); acc = __builtin_amdgcn_mfma_f32_32x32x16_bf16(a1, b1, acc, 0, 0, 0); }
    return acc;
}
typedef short s16x4 __attribute__((ext_vector_type(4))); typedef short s16x8 __attribute__((ext_vector_type(8)));
__device__ __forceinline__ bf16x8 trfrag(const LAS unsigned char* Img, int j0, int c0, int lane) {
    const int g = lane >> 4, q = (lane >> 2) & 3, p = lane & 3;
    LAS unsigned char* a = (LAS unsigned char*)Img + (j0 + 8 * (g >> 1) + q) * CH_RS + (c0 + 16 * (g & 1) + 4 * p) * 2;
    const s16x4 r0 = __builtin_amdgcn_ds_read_tr16_b64_v4i16((LAS s16x4*)a), r1 = __builtin_amdgcn_ds_read_tr16_b64_v4i16((LAS s16x4*)(a + 4 * CH_RS));
    return __builtin_bit_cast(bf16x8, __builtin_shufflevector(r0, r1, 0, 1, 2, 3, 4, 5, 6, 7));
}
template<bool TA, bool TB> __device__ __forceinline__ f32x16 mm32x(bool f16, const LAS unsigned char* A, int a0, const LAS unsigned char* B, int b0, f32x16 acc, int lane) {
    const int l31 = lane & 31, hi = lane >> 5;
    bf16x8 a[4], b[4];
#pragma unroll
    for (int ks = 0; ks < 4; ++ks) {
        a[ks] = TA ? trfrag(A, 16 * ks, a0, lane) : *(const LAS bf16x8*)(A + (a0 + l31) * CH_RS + hi * 16 + ks * 32);
        b[ks] = TB ? trfrag(B, 16 * ks, b0, lane) : *(const LAS bf16x8*)(B + (b0 + l31) * CH_RS + hi * 16 + ks * 32); }
    if (f16) {
#pragma unroll
        for (int ks = 0; ks < 4; ++ks) acc = __builtin_amdgcn_mfma_f32_32x32x16_f16(__builtin_bit_cast(h8, a[ks]), __builtin_bit_cast(h8, b[ks]), acc, 0, 0, 0);
    } else {
#pragma unroll
        for (int ks = 0; ks < 4; ++ks) acc = __builtin_amdgcn_mfma_f32_32x32x16_bf16(a[ks], b[ks], acc, 0, 0, 0);
    }
    return acc;
}
__device__ __forceinline__ void st_nat(bool f16, LAS unsigned char* Out, int mrow0, int nrow0, const f32x16& acc, int l31, int hi) {
    LAS unsigned char* p = Out + (nrow0 + l31) * CH_RS + (mrow0 + 4 * hi) * 2;
    if (f16) {
#pragma unroll
        for (int rg = 0; rg < 4; ++rg) { u32x2 o; o.x = pkh(acc[4 * rg], acc[4 * rg + 1]); o.y = pkh(acc[4 * rg + 2], acc[4 * rg + 3]); *(LAS u32x2*)(p + rg * 16) = o; }
    } else {
#pragma unroll
        for (int rg = 0; rg < 4; ++rg) { u32x2 o; o.x = pk2(acc[4 * rg], acc[4 * rg + 1]); o.y = pk2(acc[4 * rg + 2], acc[4 * rg + 3]); *(LAS u32x2*)(p + rg * 16) = o; }
    }
}
__device__ __forceinline__ f32x16 zero16() { f32x16 z = {0.f, 0.f, 0.f, 0.f, 0.f, 0.f, 0.f, 0.f, 0.f, 0.f, 0.f, 0.f, 0.f, 0.f, 0.f, 0.f}; return z; }
struct ChRegs { u32x4 r, k, v, lw, la, halo; };
__device__ __forceinline__ int chunk_mlo(int b, int d, int c) { return d ? scan_row(b, d, c, 63) : scan_row(b, d, c, 0); }
__device__ __forceinline__ void ch_load(Frame& F, ChRegs& R, int b, int h, int d, int c) {
    const int tok = F.tid >> 3, ch = F.tid & 7, mlo = chunk_mlo(b, d, c);
    const unsigned voff = (unsigned)((d ? 63 - tok : tok) * (NIN * 2) + ch * 16);
    const unsigned char* rb = (const unsigned char*)(F.P + (size_t)mlo * NIN);
    const int cr = C_R + h * 64, ck = C_K + h * 64, cv = C_V + h * 64, cw = C_LW + d * 64, ca = C_LA + d * 64;
    R.r = *(const u32x4*)(rb + cr * 2 + voff); R.k = *(const u32x4*)(rb + ck * 2 + voff); R.v = *(const u32x4*)(rb + cv * 2 + voff); R.lw = *(const u32x4*)(rb + cw * 2 + voff); R.la = *(const u32x4*)(rb + ca * 2 + voff);
    const u32x4 z = {0u, 0u, 0u, 0u}; R.halo = z;
    if (F.tid < 80) { const int hrow = F.tid >= 40 ? 1 : 0, vec = (F.tid - 40 * hrow) >> 3, mh = hrow ? mlo + 64 : mlo - 1;
        const int col = vec == 0 ? cr : vec == 1 ? ck : vec == 2 ? cv : vec == 3 ? cw : ca;
        if (mh >= seq_lo(mlo) && mh <= seq_hi(mlo)) R.halo = *(const u32x4*)(F.P + (size_t)mh * NIN + col + 8 * ch); }
}
constexpr int CH_RAW3 = 0 * CH_MB, CH_RAWL = 10 * CH_MB;
__device__ __forceinline__ void ch_park(Frame& F, const ChRegs& R, int b, int d, int c) {
    LAS unsigned char* lds = F.lds; const int tok = F.tid >> 3, ch = F.tid & 7, ri = 1 + (d ? 63 - tok : tok);
    LAS unsigned char* p3 = lds + CH_RAW3 + ri * 384 + ch * 16; LAS unsigned char* pl = lds + CH_RAWL + ri * 256 + ch * 16;
    *(LAS u32x4*)p3 = R.r; *(LAS u32x4*)(p3 + 128) = R.k; *(LAS u32x4*)(p3 + 256) = R.v; *(LAS u32x4*)pl = R.lw; *(LAS u32x4*)(pl + 128) = R.la;
    if (F.tid < 80) { const int hrow = F.tid >= 40 ? 1 : 0, vec = (F.tid - 40 * hrow) >> 3, rh = hrow ? 65 : 0;
        if (vec < 3) *(LAS u32x4*)(lds + CH_RAW3 + rh * 384 + vec * 128 + ch * 16) = R.halo; else *(LAS u32x4*)(lds + CH_RAWL + rh * 256 + (vec - 3) * 128 + ch * 16) = R.halo; }
}
__device__ __forceinline__ void shift8(const u32x4 c, const u32x4 p, const u32x4 n, const LAS f32x4* mu, float* o) {
    float vc[8], vp[8], vn[8]; unpack8(c, vc); unpack8(p, vp); unpack8(n, vn);
    const f32x4 m0 = mu[0], m1 = mu[1];
#pragma unroll
    for (int j = 0; j < 8; ++j) { const float mm = j < 4 ? m0[j & 3] : m1[j & 3]; o[j] = vc[j] + mm * (0.5f * (vp[j] + vn[j]) - vc[j]); }
}
template<bool F16> __device__ __forceinline__ f32x16 mf2(const u32x4 a0, const u32x4 a1, const u32x4 b0, const u32x4 b1, f32x16 acc) {
    if (F16) { acc = __builtin_amdgcn_mfma_f32_32x32x16_f16(__builtin_bit_cast(h8, a0), __builtin_bit_cast(h8, b0), acc, 0, 0, 0); acc = __builtin_amdgcn_mfma_f32_32x32x16_f16(__builtin_bit_cast(h8, a1), __builtin_bit_cast(h8, b1), acc, 0, 0, 0); }
    else { acc = __builtin_amdgcn_mfma_f32_32x32x16_bf16(__builtin_bit_cast(bf16x8, a0), __builtin_bit_cast(bf16x8, b0), acc, 0, 0, 0); acc = __builtin_amdgcn_mfma_f32_32x32x16_bf16(__builtin_bit_cast(bf16x8, a1), __builtin_bit_cast(bf16x8, b1), acc, 0, 0, 0); }
    return acc; }
template<bool F16> __device__ __forceinline__ void cv2(const f32x16& a, u32x4& s0, u32x4& s1) {
    if (F16) { s0.x = pkh(a[0], a[1]); s0.y = pkh(a[2], a[3]); s0.z = pkh(a[4], a[5]); s0.w = pkh(a[6], a[7]); s1.x = pkh(a[8], a[9]); s1.y = pkh(a[10], a[11]); s1.z = pkh(a[12], a[13]); s1.w = pkh(a[14], a[15]); }
    else { s0.x = pk2(a[0], a[1]); s0.y = pk2(a[2], a[3]); s0.z = pk2(a[4], a[5]); s0.w = pk2(a[6], a[7]); s1.x = pk2(a[8], a[9]); s1.y = pk2(a[10], a[11]); s1.z = pk2(a[12], a[13]); s1.w = pk2(a[14], a[15]); } }
template<bool F16, bool TR> __device__ __forceinline__ f32x16 inv_chain(const f32x16& ap0, const f32x16& aq0, int l31, int hi) {
    u32x4 p0, p1, q0, q1, x0, x1;
    cv2<F16>(ap0, p0, p1); cv2<F16>(aq0, q0, q1);
    f32x16 x = TR ? aq0 : ap0;
#pragma unroll
    for (int r = 0; r < 16; ++r) { const int row = (r & 3) + 8 * (r >> 2) + 4 * hi; if (row == l31) x[r] += 1.0f; }
    cv2<F16>(x, x0, x1);
#pragma unroll
    for (int k = 1; k <= 4; ++k) {
        const bool needP = (k < 4) || TR, needQ = (k < 4) || !TR;
        f32x16 ap = zero16(), aq = zero16();
        if (needP) ap = mf2<F16>(q0, q1, p0, p1, ap);
        if (needQ) aq = mf2<F16>(p0, p1, q0, q1, aq);
        if (needP) cv2<F16>(ap, p0, p1);
        if (needQ) cv2<F16>(aq, q0, q1);
        x = TR ? mf2<F16>(p0, p1, x0, x1, x) : mf2<F16>(q0, q1, x0, x1, x);
        if (k < 4) cv2<F16>(x, x0, x1);
    }
    return x;
}
template<bool F16> __device__ __forceinline__ void chain_wave(LAS unsigned char* lds, int wave, int lane, u32x4& t0, u32x4& t1) {
    const int l31 = lane & 31, hi = lane >> 5, o = wave == 2 ? 32 : 0;
    const LAS unsigned char* At = lds + CB_AT * CH_MB; const LAS unsigned char* Bt = lds + CB_BT * CH_MB;
    f32x16 aq = mm32(F16, Bt, o, At, o, zero16(), l31, hi);
    f32x16 ap = mm32(F16, At, o, Bt, o, zero16(), l31, hi);
#pragma unroll
    for (int r = 0; r < 16; ++r) { const int row = (r & 3) + 8 * (r >> 2) + 4 * hi; aq[r] = row < l31 ? aq[r] : 0.f; ap[r] = l31 < row ? ap[r] : 0.f; }
    if (wave != 3) { const f32x16 x = inv_chain<F16, true>(ap, aq, l31, hi); st_nat(F16, lds + CB_INV * CH_MB, o, o, x, l31, hi); if (wave == 2) cv2<F16>(x, t0, t1); }
    else { u32x4 b0, b1, a0, a1, u0, u1;
        { const f32x16 a21 = mm32(F16, Bt, 0, At, 32, zero16(), l31, hi);
          cv2<F16>(a21, a0, a1); }
        const f32x16 x1 = inv_chain<F16, false>(ap, aq, l31, hi);
        cv2<F16>(x1, b0, b1);
        const f32x16 u = mf2<F16>(a0, a1, b0, b1, zero16());
        cv2<F16>(u, u0, u1);
        *(LAS u32x4*)(lds + CB_AAB * CH_MB + lane * 16) = u0; *(LAS u32x4*)(lds + CB_AAB * CH_MB + 1024 + lane * 16) = u1; }
}
__device__ __forceinline__ void ch_tail(const bool f16, Frame& F, ChRegs& R, const float (&sr)[8], const float (&sk)[8], const float (&sv)[8], int b, int h, int d, int c, int chain, int ci) {
    int lane_ = F.lane; asm volatile("" : "+v"(lane_));
    const int tid = F.tid, lane = lane_, wave = F.wave, l31 = lane & 31, hi = lane >> 5;
    const int q4 = wave & 3, tb = q4 >> 1, cb = q4 & 1, tok = tid >> 3, ch = tid & 7;
    LAS unsigned char* lds = F.lds;
    const LAS f32x4* cs = (const LAS f32x4*)(lds + CH_CONST) + 2 * ch;
    const LAS float* pT = (const LAS float*)(lds + CH_PT);
#define CB(i) (lds + (i) * CH_MB)
    { const LAS f32x4* pw = (const LAS f32x4*)(lds + CH_WBUF) + tok * 16 + 2 * ch; const LAS f32x4* pab = (const LAS f32x4*)(lds + CH_ABUF) + tok * 16 + 2 * ch;
      const f32x4 p0 = pw[0], p1 = pw[1], a0v = pab[0], a1v = pab[1];
      f32x4 m0, m1;
      if (tok > 0) { m0 = pw[-16]; m1 = pw[-15]; }
      else { const f32x4 r0 = *(const LAS f32x4*)(pT + 64 + 8 * ch), r1 = *(const LAS f32x4*)(pT + 64 + 8 * ch + 4);
#pragma unroll
          for (int j = 0; j < 4; ++j) { m0[j] = __builtin_amdgcn_rcpf(r0[j]); m1[j] = __builtin_amdgcn_rcpf(r1[j]); } }
      const f32x4 kk0 = cs[80], kk1 = cs[81], ka0 = cs[96], ka1 = cs[97], rk0 = cs[112], rk1 = cs[113];
      float kk[8], ss = 0.f;
#pragma unroll
      for (int j = 0; j < 8; ++j) { kk[j] = sk[j] * (j < 4 ? kk0[j & 3] : kk1[j & 3]); ss += kk[j] * kk[j]; }
      ss += __shfl_xor(ss, 1); ss += __shfl_xor(ss, 2); ss += __shfl_xor(ss, 4);
      const float inv = __builtin_amdgcn_rsqf(fmaxf(ss, 1e-24f));
      float at[8], bt[8], kt[8], rt[8], bon = 0.f;
#pragma unroll
      for (int j = 0; j < 8; ++j) { const float P = j < 4 ? p0[j & 3] : p1[j & 3], Pm = j < 4 ? m0[j & 3] : m1[j & 3], a = j < 4 ? a0v[j & 3] : a1v[j & 3];
          const float kac = j < 4 ? ka0[j & 3] : ka1[j & 3], rkc = j < 4 ? rk0[j & 3] : rk1[j & 3];
          const float kn = kk[j] * inv, kd = sk[j] * (1.0f + (a - 1.0f) * kac), rp = __builtin_amdgcn_rcpf(P);
          at[j] = -kn * Pm; bt[j] = kn * a * rp; kt[j] = kd * rp; rt[j] = sr[j] * P; bon += sr[j] * kd * rkc; }
      bon += __shfl_xor(bon, 1); bon += __shfl_xor(bon, 2); bon += __shfl_xor(bon, 4);
      if (ch == 0 && c >= 4) F.BON[((size_t)d * ML + scan_row(b, d, c, tok)) * 16 + h] = bon;
      *(LAS u32x4*)(CB(CB_AT) + tok * CH_RS + ch * 16) = pack8x(f16, at);
      *(LAS u32x4*)(CB(CB_BT) + tok * CH_RS + ch * 16) = pack8x(f16, bt);
      *(LAS u32x4*)(CB(CB_KT) + tok * CH_RS + ch * 16) = pack8x(f16, kt);
      *(LAS u32x4*)(CB(CB_RT) + tok * CH_RS + ch * 16) = pack8x(f16, rt);
      *(LAS u32x4*)(CB(CB_X1) + tok * CH_RS + ch * 16) = pack8x(f16, sv); }
    LBAR(); TSTAMP(3);
    const bool chainw = wave == 0 || wave == 2 || wave == 3;
    if (!chainw && ci + 1 < 34) ch_load(F, R, b, h, d, c - 1);
    u32x4 t0 = {0u, 0u, 0u, 0u}, t1 = t0;
    if (chainw) { if (f16) chain_wave<true>(lds, wave, lane, t0, t1); else chain_wave<false>(lds, wave, lane, t0, t1); }
    else { const bool mid = wave >= 4 && wave <= 6;
#pragma unroll 1
      for (int i = 0; i < 2; ++i) { if (wave == 1 && i == 1) break;
          const int pr = wave == 1 ? 1 : wave == 7 ? 2 + i : wave - 3, jb = mid ? i : 0, tbk = mid ? 1 : 0;
          const LAS unsigned char* Aop = CB((pr & 1) ? CB_KT : CB_BT); const LAS unsigned char* Blay = CB(pr < 2 ? CB_AT : CB_RT);
          LAS unsigned char* Out = CB(CB_AAB + 1 + pr);
          f32x16 a = mm32(f16, Aop, jb * 32, Blay, tbk * 32, zero16(), l31, hi);
          if (jb == tbk) { const bool incl = pr >= 2;
#pragma unroll
              for (int r = 0; r < 16; ++r) { const int j = (r & 3) + 8 * (r >> 2) + 4 * hi; const bool ok = incl ? (j <= l31) : (j < l31); a[r] = ok ? a[r] : 0.f; } }
          st_nat(f16, Out, jb * 32, tbk * 32, a, l31, hi); }
      if (wave == 1) { st_nat(f16, CB(CB_AAK), 32, 0, zero16(), l31, hi); st_nat(f16, CB(CB_INV), 32, 0, zero16(), l31, hi); }
      if (wave == 7) { st_nat(f16, CB(CB_ARB), 32, 0, zero16(), l31, hi); st_nat(f16, CB(CB_ARK), 32, 0, zero16(), l31, hi); } }
    LBAR(); TSTAMP(4);
    if ((wave == 0 || wave == 3) && ci + 1 < 34) ch_load(F, R, b, h, d, c - 1);
    if (wave == 2) { const u32x4 u0 = *(const LAS u32x4*)(CB(CB_AAB) + lane * 16), u1 = *(const LAS u32x4*)(CB(CB_AAB) + 1024 + lane * 16);
        const f32x16 y = f16 ? mf2<true>(u0, u1, t0, t1, zero16()) : mf2<false>(u0, u1, t0, t1, zero16());
        st_nat(f16, CB(CB_INV), 0, 32, y, l31, hi);
        if (ci + 1 < 34) ch_load(F, R, b, h, d, c - 1); }
    else if (wave >= 4) { const f32x16 acc = mm32x<false, true>(f16, CB(CB_AAK), tb * 32, CB(CB_X1), cb * 32, zero16(), lane); st_nat(f16, CB(CB_XT), tb * 32, cb * 32, acc, l31, hi); }
    LBAR();
    TSTAMP(5);
    { f32x16 acc = wave < 4 ? mm32x<false, true>(f16, CB(CB_INV), tb * 32, CB(CB_AT), cb * 32, zero16(), lane) : mm32(f16, CB(CB_INV), tb * 32, CB(CB_XT), cb * 32, zero16(), l31, hi);
      st_nat(f16, CB(wave < 4 ? CB_AAB : CB_AABT), tb * 32, cb * 32, acc, l31, hi); }
    LBAR(); TSTAMP(6);
    { const int om = wave >> 1, nb = wave & 1;
      int c_ = c; asm volatile("" : "+s"(c_));
#pragma unroll
      for (int mb = 0; mb < 2; ++mb) {
          if (om == 0) {
              f32x16 acc; const LAS unsigned char* p = CB(CB_RT) + (nb * 32 + l31) * CH_RS + (mb * 32 + 4 * hi) * 2;
#pragma unroll
              for (int rg = 0; rg < 4; ++rg) { const u32x2 w = *(const LAS u32x2*)(p + rg * 16); const f32x4 u = unpack4x(f16, w); acc[4 * rg] = u.x; acc[4 * rg + 1] = u.y; acc[4 * rg + 2] = u.z; acc[4 * rg + 3] = u.w; }
              acc = mm32(f16, CB(CB_AAB), mb * 32, CB(CB_ARB), nb * 32, acc, l31, hi);
              LAS unsigned char* o = CB(CB_OQ) + (nb * 32 + l31) * CH_RS + (mb * 32 + 4 * hi) * 2;
#pragma unroll
              for (int rg = 0; rg < 4; ++rg) { const f32x4 pv = *(const LAS f32x4*)(pT + 64 + mb * 32 + 8 * rg + 4 * hi);
                  u32x2 w; w.x = pkh(acc[4 * rg] * pv.x, acc[4 * rg + 1] * pv.y); w.y = pkh(acc[4 * rg + 2] * pv.z, acc[4 * rg + 3] * pv.w); *(LAS u32x2*)(o + rg * 16) = w; }
          } else if (om == 1) {
              f32x16 acc = mm32x<false, true>(f16, CB(CB_AAB), mb * 32, CB(CB_BT), nb * 32, zero16(), lane);
              const float pto = pT[nb * 32 + l31], ptk = pT[128 + nb * 32 + l31];
              LAS unsigned char* o = CB(CB_OG) + (nb * 32 + l31) * CH_RS + (mb * 32 + 4 * hi) * 2;
#pragma unroll
              for (int rg = 0; rg < 4; ++rg) { const f32x4 pv = *(const LAS f32x4*)(pT + 64 + mb * 32 + 8 * rg + 4 * hi); float g[4];
#pragma unroll
                  for (int i = 0; i < 4; ++i) { const int kp = mb * 32 + 8 * rg + 4 * hi + i; g[i] = pto * pv[i] * acc[4 * rg + i] + (kp == nb * 32 + l31 ? ptk : 0.0f); }
                  u32x2 w; w.x = pkh(g[0], g[1]); w.y = pkh(g[2], g[3]); *(LAS u32x2*)(o + rg * 16) = w; }
          } else if (om == 2) {
              f32x16 acc = mm32x<true, false>(f16, CB(CB_BT), mb * 32, CB(CB_AABT), nb * 32, zero16(), lane);
              acc = mm32x<true, true>(f16, CB(CB_KT), mb * 32, CB(CB_X1), nb * 32, acc, lane);
              LAS unsigned char* o = CB(CB_OH) + (nb * 32 + l31) * CH_RS + (mb * 32 + 4 * hi) * 2;
#pragma unroll
              for (int rg = 0; rg < 4; ++rg) { const f32x4 pv = *(const LAS f32x4*)(pT + mb * 32 + 8 * rg + 4 * hi);
                  u32x2 w; w.x = pkh(acc[4 * rg] * pv.x, acc[4 * rg + 1] * pv.y); w.y = pkh(acc[4 * rg + 2] * pv.z, acc[4 * rg + 3] * pv.w); *(LAS u32x2*)(o + rg * 16) = w; }
          } else if (c_ >= 4) {
              f32x16 acc = mm32(f16, CB(CB_AABT), mb * 32, CB(CB_ARB), nb * 32, zero16(), l31, hi);
              acc = mm32x<true, false>(f16, CB(CB_X1), mb * 32, CB(CB_ARK), nb * 32, acc, lane);
              LAS unsigned char* yp = CB(CB_OY) + (nb * 32 + l31) * CH_RS + (mb * 32 + 4 * hi) * 2;
#pragma unroll
              for (int rg = 0; rg < 4; ++rg) { u32x2 w; w.x = pkh(acc[4 * rg], acc[4 * rg + 1]); w.y = pkh(acc[4 * rg + 2], acc[4 * rg + 3]); *(LAS u32x2*)(yp + rg * 16) = w; }
          }
      } }
    LBAR();
    { int c_ = c; asm volatile("" : "+s"(c_));
      unsigned char* gq = (unsigned char*)F.GHQ + ((size_t)chain * 68 + c_) * GHQ_ITEM + tok * 128 + ch * 16; const int lo = tok * CH_RS + ch * 16;
      *(u32x4*)gq = *(const LAS u32x4*)(CB(CB_OG) + lo); *(u32x4*)(gq + 8192) = *(const LAS u32x4*)(CB(CB_OH) + lo); *(u32x4*)(gq + 16384) = *(const LAS u32x4*)(CB(CB_OQ) + lo);
      if (c_ >= 4) *(u32x4*)((unsigned char*)(d ? F.YB : F.YF) + (size_t)scan_row(b, d, c_, tok) * 2048 + h * 128 + ch * 16) = *(const LAS u32x4*)(CB(CB_OY) + lo); }
    TSTAMP(7);
#undef CB
}

__device__ __forceinline__ void p3_chunkA(Frame& F) {
    const int tid = F.tid, lane = F.lane, wave = F.wave, l31 = lane & 31, hi = lane >> 5;
    LAS unsigned char* lds = F.lds;
#define CB(i) (lds + (i) * CH_MB)
    for (int g = F.bid; g < 256; g += F.G) {
        const int chain = g >> 1, c0 = (g & 1) * 34, d = chain & 1, h = (chain >> 1) & 15, b = chain >> 5;
        { const int q = tid >> 6, n = tid & 63, c = h * 64 + n;
          const float val = q == 0 ? F.mu_shift[C_R + c] : q == 1 ? F.mu_shift[C_K + c] : q == 2 ? F.mu_shift[C_V + c] : q == 3 ? F.mu_shift[C_LW + d * 64 + n] : q == 4 ? F.mu_shift[C_LA + d * 64 + n] : q == 5 ? F.k_k[c] : q == 6 ? F.k_a[c] : F.r_k[c];
          ((LAS float*)(lds + CH_CONST))[tid] = val; }
        const int q4 = wave & 3, tb = q4 >> 1, cb = q4 & 1;
        { const int row = tid >> 3, chk = tid & 7;
          *(LAS u32x4*)(lds + CH_LW + row * CH_RS + chk * 16) = *(const u32x4*)(F.W2T + ((size_t)d * 1024 + h * 64 + row) * 64 + 8 * chk);
          *(LAS u32x4*)(lds + CH_LW + CH_MB + row * CH_RS + chk * 16) = *(const u32x4*)(F.A2T + ((size_t)d * 1024 + h * 64 + row) * 64 + 8 * chk); }
        const float lbias = (wave < 4 ? F.w0 : F.a0)[d * 1024 + h * 64 + cb * 32 + l31];
        LBAR();
        ChRegs R;
        ch_load(F, R, b, h, d, c0 + 33);
#pragma unroll 1
        for (int ci = 0; ci < 34; ++ci) {
            const int c = c0 + 33 - ci;
            const int tok = tid >> 3, ch = tid & 7;
            const LAS f32x4* cs = (const LAS f32x4*)(lds + CH_CONST) + 2 * ch;
            float sr[8], sk[8], sv[8];
            ch_park(F, R, b, d, c);
            LBAR();
            { float slw[8], sla[8];
              const int ri = 1 + (d ? 63 - tok : tok);
              const LAS unsigned char* p3 = lds + CH_RAW3 + ri * 384 + ch * 16; const LAS unsigned char* pl = lds + CH_RAWL + ri * 256 + ch * 16;
              shift8(R.r, *(const LAS u32x4*)(p3 - 384), *(const LAS u32x4*)(p3 + 384), cs, sr); shift8(R.k, *(const LAS u32x4*)(p3 - 384 + 128), *(const LAS u32x4*)(p3 + 384 + 128), cs + 16, sk);
              shift8(R.v, *(const LAS u32x4*)(p3 - 384 + 256), *(const LAS u32x4*)(p3 + 384 + 256), cs + 32, sv);
              shift8(R.lw, *(const LAS u32x4*)(pl - 256), *(const LAS u32x4*)(pl + 256), cs + 48, slw); shift8(R.la, *(const LAS u32x4*)(pl - 256 + 128), *(const LAS u32x4*)(pl + 256 + 128), cs + 64, sla);
#pragma unroll
              for (int j = 0; j < 8; ++j) slw[j] = 1.0f - 2.0f * __builtin_amdgcn_rcpf(1.0f + fast_exp(2.0f * slw[j]));
              u32x4 o; o.x = pk2(slw[0], slw[1]); o.y = pk2(slw[2], slw[3]); o.z = pk2(slw[4], slw[5]); o.w = pk2(slw[6], slw[7]); *(LAS u32x4*)(CB(CB_X1) + tok * CH_RS + ch * 16) = o;
              o.x = pk2(sla[0], sla[1]); o.y = pk2(sla[2], sla[3]); o.z = pk2(sla[4], sla[5]); o.w = pk2(sla[6], sla[7]); *(LAS u32x4*)(CB(CB_XT) + tok * CH_RS + ch * 16) = o; }
            LBAR(); TSTAMP(0);
            { f32x16 acc = zero16();
              const LAS unsigned char* pa = CB(wave < 4 ? CB_X1 : CB_XT) + (tb * 32 + l31) * CH_RS + hi * 16;
              const LAS unsigned char* pw2 = lds + CH_LW + (wave < 4 ? 0 : CH_MB) + (cb * 32 + l31) * CH_RS + hi * 16;
#pragma unroll
              for (int ks = 0; ks < 4; ++ks) acc = __builtin_amdgcn_mfma_f32_32x32x16_bf16(*(const LAS bf16x8*)(pa + ks * 32), *(const LAS bf16x8*)(pw2 + ks * 32), acc, 0, 0, 0);
              LAS float* dst = (LAS float*)(lds + (wave < 4 ? CH_WBUF : CH_ABUF)) + cb * 32 + l31;
#pragma unroll
              for (int r = 0; r < 16; ++r) { const int t = tb * 32 + (r & 3) + 8 * (r >> 2) + 4 * hi; const float sg = sigmoidf_(acc[r] + lbias);
                  dst[t * 64] = wave < 4 ? fast_exp(-0.6065306597126334f * sg) : sg; } }
            LBAR(); TSTAMP(1);
            { LAS float* wb = (LAS float*)(lds + CH_WBUF) + (wave * 8) * 64 + (tid & 63); LAS float* gt = (LAS float*)(lds + CH_GT);
              float q[8]; q[0] = wb[0];
#pragma unroll
              for (int i = 1; i < 8; ++i) q[i] = q[i - 1] * wb[i * 64];
              gt[wave * 64 + (tid & 63)] = q[7];
              LBAR();
              float pre = 1.0f, p31 = 1.0f;
#pragma unroll
              for (int gg = 0; gg < 7; ++gg) { const float tv = gt[gg * 64 + (tid & 63)]; pre = gg < wave ? pre * tv : pre; p31 = gg < 4 ? p31 * tv : p31; }
              { const float pren = pre * (1.0f / p31);
#pragma unroll
                for (int i = 0; i < 8; ++i) wb[i * 64] = pren * q[i]; }
              if (wave == 7) { const float p63 = pre * q[7]; LAS float* pt = (LAS float*)(lds + CH_PT);
                  pt[tid & 63] = p63 / p31;
                  pt[64 + (tid & 63)] = p31;
                  pt[128 + (tid & 63)] = p63;
                  const bool ok = !FORCE_BF16 && p31 > 2.44140625e-4f && p63 > 2.44140625e-4f * p31;
                  if ((tid & 63) == 0) ((LAS unsigned*)pt)[192] = __all(ok) ? 1u : 0u; else (void)__all(ok); } }
            LBAR(); TSTAMP(2);
            { const bool f16 = __builtin_amdgcn_readfirstlane((int)((const LAS unsigned*)(lds + CH_PT))[192]) != 0;
              ch_tail(f16, F, R, sr, sk, sv, b, h, d, c, chain, ci); }
        }
    }
#undef CB
}

constexpr int BL_SLOT = 2 * CH_MB, BL_SLOTB = 4 * CH_MB, BL_YB = BL_SLOT + 2 * BL_SLOTB;
__device__ __forceinline__ void p4_chunkB(Frame& F) {
    const int lane = F.lane, wave = F.wave, l31 = lane & 31, hi = lane >> 5, srow = F.tid >> 3, sch = F.tid & 7;
    LAS unsigned char* lds = F.lds;
    for (int chain = F.bid; chain < 128; chain += F.G) {
        const int d = chain & 1, h = (chain >> 1) & 15, b = chain >> 5;
        const int q4 = wave & 3, mb = q4 >> 1, nb = q4 & 1;
        for (int i = F.tid; i < 2 * CH_MB / 4; i += NWAVES * 64) ((LAS unsigned*)lds)[i] = 0u;
        const unsigned char* gq0 = (const unsigned char*)F.GHQ + (size_t)chain * 68 * GHQ_ITEM;
        unsigned char* Yb = (unsigned char*)(d ? F.YB : F.YF) + h * 128;
        u32x4 Ra0, Ra1, Ra2, Ra3, Rb0, Rb1, Rb2, Rb3;
        { int c__ = (0); c__ = c__ < 67 ? c__ : 67; const unsigned char* gq = gq0 + (size_t)c__ * GHQ_ITEM + srow * 128 + sch * 16; const int cy = c__ < 4 ? 4 : c__;
              Ra0 = __builtin_nontemporal_load((const u32x4*)gq); Ra1 = __builtin_nontemporal_load((const u32x4*)(gq + 8192)); Ra2 = __builtin_nontemporal_load((const u32x4*)(gq + 16384));
              Ra3 = __builtin_nontemporal_load((const u32x4*)(Yb + (size_t)scan_row(b, d, cy, srow) * 2048 + sch * 16)); }
        { LAS unsigned char* sn = lds + BL_SLOT + srow * CH_RS + sch * 16; *(LAS u32x4*)sn = Ra0; *(LAS u32x4*)(sn + CH_MB) = Ra1; *(LAS u32x4*)(sn + 2 * CH_MB) = Ra2; *(LAS u32x4*)(sn + 3 * CH_MB) = Ra3; }
        { int c__ = (1); c__ = c__ < 67 ? c__ : 67; const unsigned char* gq = gq0 + (size_t)c__ * GHQ_ITEM + srow * 128 + sch * 16; const int cy = c__ < 4 ? 4 : c__;
              Ra0 = __builtin_nontemporal_load((const u32x4*)gq); Ra1 = __builtin_nontemporal_load((const u32x4*)(gq + 8192)); Ra2 = __builtin_nontemporal_load((const u32x4*)(gq + 16384));
              Ra3 = __builtin_nontemporal_load((const u32x4*)(Yb + (size_t)scan_row(b, d, cy, srow) * 2048 + sch * 16)); }
        { int c__ = (2); c__ = c__ < 67 ? c__ : 67; const unsigned char* gq = gq0 + (size_t)c__ * GHQ_ITEM + srow * 128 + sch * 16; const int cy = c__ < 4 ? 4 : c__;
              Rb0 = __builtin_nontemporal_load((const u32x4*)gq); Rb1 = __builtin_nontemporal_load((const u32x4*)(gq + 8192)); Rb2 = __builtin_nontemporal_load((const u32x4*)(gq + 16384));
              Rb3 = __builtin_nontemporal_load((const u32x4*)(Yb + (size_t)scan_row(b, d, cy, srow) * 2048 + sch * 16)); }
        LBAR();
#pragma unroll 1
        for (int c = 0; c < 68; c += 4) {
            { const int c_ = (c);
              LAS unsigned char* sn = lds + BL_SLOT + ((c_ + 1) & 1) * BL_SLOTB + srow * CH_RS + sch * 16;
              *(LAS u32x4*)sn = Ra0; *(LAS u32x4*)(sn + CH_MB) = Ra1; *(LAS u32x4*)(sn + 2 * CH_MB) = Ra2; *(LAS u32x4*)(sn + 3 * CH_MB) = Ra3;
              { int c__ = (c_ + 3); c__ = c__ < 67 ? c__ : 67; const unsigned char* gq = gq0 + (size_t)c__ * GHQ_ITEM + srow * 128 + sch * 16; const int cy = c__ < 4 ? 4 : c__;
              Ra0 = __builtin_nontemporal_load((const u32x4*)gq); Ra1 = __builtin_nontemporal_load((const u32x4*)(gq + 8192)); Ra2 = __builtin_nontemporal_load((const u32x4*)(gq + 16384));
              Ra3 = __builtin_nontemporal_load((const u32x4*)(Yb + (size_t)scan_row(b, d, cy, srow) * 2048 + sch * 16)); }
              if (c_ >= 5) { const u32x4 yv = *(const LAS u32x4*)(lds + BL_YB + ((c_ - 1) & 1) * CH_MB + srow * CH_RS + sch * 16);
                  *(u32x4*)(Yb + (size_t)scan_row(b, d, c_ - 1, srow) * 2048 + sch * 16) = yv; }
              const LAS unsigned char* sc = lds + BL_SLOT + (c_ & 1) * BL_SLOTB; const LAS unsigned char* zc = lds + (c_ & 1) * CH_MB; LAS unsigned char* zn = lds + ((c_ + 1) & 1) * CH_MB;
              if (wave < 4) {
                  f32x16 acc; const LAS unsigned char* ph = sc + CH_MB + (nb * 32 + l31) * CH_RS + (mb * 32 + 4 * hi) * 2;
#pragma unroll
                  for (int rg = 0; rg < 4; ++rg) { const u32x2 w = *(const LAS u32x2*)(ph + rg * 16); acc[4 * rg] = h_lo(w.x); acc[4 * rg + 1] = h_hi(w.x); acc[4 * rg + 2] = h_lo(w.y); acc[4 * rg + 3] = h_hi(w.y); }
                  acc = mm32(true, sc, mb * 32, zc, nb * 32, acc, l31, hi);
                  st_nat(true, zn, mb * 32, nb * 32, acc, l31, hi);
              } else if (c_ >= 4) {
                  f32x16 acc; const LAS unsigned char* py = sc + 3 * CH_MB + (nb * 32 + l31) * CH_RS + (mb * 32 + 4 * hi) * 2;
#pragma unroll
                  for (int rg = 0; rg < 4; ++rg) { const u32x2 w = *(const LAS u32x2*)(py + rg * 16); acc[4 * rg] = h_lo(w.x); acc[4 * rg + 1] = h_hi(w.x); acc[4 * rg + 2] = h_lo(w.y); acc[4 * rg + 3] = h_hi(w.y); }
                  acc = mm32(true, zc, mb * 32, sc + 2 * CH_MB, nb * 32, acc, l31, hi);
                  st_nat(true, lds + BL_YB + (c_ & 1) * CH_MB, mb * 32, nb * 32, acc, l31, hi);
              }
              LBAR(); }
            { const int c_ = (c + 1);
              LAS unsigned char* sn = lds + BL_SLOT + ((c_ + 1) & 1) * BL_SLOTB + srow * CH_RS + sch * 16;
              *(LAS u32x4*)sn = Rb0; *(LAS u32x4*)(sn + CH_MB) = Rb1; *(LAS u32x4*)(sn + 2 * CH_MB) = Rb2; *(LAS u32x4*)(sn + 3 * CH_MB) = Rb3;
              { int c__ = (c_ + 3); c__ = c__ < 67 ? c__ : 67; const unsigned char* gq = gq0 + (size_t)c__ * GHQ_ITEM + srow * 128 + sch * 16; const int cy = c__ < 4 ? 4 : c__;
              Rb0 = __builtin_nontemporal_load((const u32x4*)gq); Rb1 = __builtin_nontemporal_load((const u32x4*)(gq + 8192)); Rb2 = __builtin_nontemporal_load((const u32x4*)(gq + 16384));
              Rb3 = __builtin_nontemporal_load((const u32x4*)(Yb + (size_t)scan_row(b, d, cy, srow) * 2048 + sch * 16)); }
              if (c_ >= 5) { const u32x4 yv = *(const LAS u32x4*)(lds + BL_YB + ((c_ - 1) & 1) * CH_MB + srow * CH_RS + sch * 16);
                  *(u32x4*)(Yb + (size_t)scan_row(b, d, c_ - 1, srow) * 2048 + sch * 16) = yv; }
              const LAS unsigned char* sc = lds + BL_SLOT + (c_ & 1) * BL_SLOTB; const LAS unsigned char* zc = lds + (c_ & 1) * CH_MB; LAS unsigned char* zn = lds + ((c_ + 1) & 1) * CH_MB;
              if (wave < 4) {
                  f32x16 acc; const LAS unsigned char* ph = sc + CH_MB + (nb * 32 + l31) * CH_RS + (mb * 32 + 4 * hi) * 2;
#pragma unroll
                  for (int rg = 0; rg < 4; ++rg) { const u32x2 w = *(const LAS u32x2*)(ph + rg * 16); acc[4 * rg] = h_lo(w.x); acc[4 * rg + 1] = h_hi(w.x); acc[4 * rg + 2] = h_lo(w.y); acc[4 * rg + 3] = h_hi(w.y); }
                  acc = mm32(true, sc, mb * 32, zc, nb * 32, acc, l31, hi);
                  st_nat(true, zn, mb * 32, nb * 32, acc, l31, hi);
              } else if (c_ >= 4) {
                  f32x16 acc; const LAS unsigned char* py = sc + 3 * CH_MB + (nb * 32 + l31) * CH_RS + (mb * 32 + 4 * hi) * 2;
#pragma unroll
                  for (int rg = 0; rg < 4; ++rg) { const u32x2 w = *(const LAS u32x2*)(py + rg * 16); acc[4 * rg] = h_lo(w.x); acc[4 * rg + 1] = h_hi(w.x); acc[4 * rg + 2] = h_lo(w.y); acc[4 * rg + 3] = h_hi(w.y); }
                  acc = mm32(true, zc, mb * 32, sc + 2 * CH_MB, nb * 32, acc, l31, hi);
                  st_nat(true, lds + BL_YB + (c_ & 1) * CH_MB, mb * 32, nb * 32, acc, l31, hi);
              }
              LBAR(); }
            { const int c_ = (c + 2);
              LAS unsigned char* sn = lds + BL_SLOT + ((c_ + 1) & 1) * BL_SLOTB + srow * CH_RS + sch * 16;
              *(LAS u32x4*)sn = Ra0; *(LAS u32x4*)(sn + CH_MB) = Ra1; *(LAS u32x4*)(sn + 2 * CH_MB) = Ra2; *(LAS u32x4*)(sn + 3 * CH_MB) = Ra3;
              { int c__ = (c_ + 3); c__ = c__ < 67 ? c__ : 67; const unsigned char* gq = gq0 + (size_t)c__ * GHQ_ITEM + srow * 128 + sch * 16; const int cy = c__ < 4 ? 4 : c__;
              Ra0 = __builtin_nontemporal_load((const u32x4*)gq); Ra1 = __builtin_nontemporal_load((const u32x4*)(gq + 8192)); Ra2 = __builtin_nontemporal_load((const u32x4*)(gq + 16384));
              Ra3 = __builtin_nontemporal_load((const u32x4*)(Yb + (size_t)scan_row(b, d, cy, srow) * 2048 + sch * 16)); }
              if (c_ >= 5) { const u32x4 yv = *(const LAS u32x4*)(lds + BL_YB + ((c_ - 1) & 1) * CH_MB + srow * CH_RS + sch * 16);
                  *(u32x4*)(Yb + (size_t)scan_row(b, d, c_ - 1, srow) * 2048 + sch * 16) = yv; }
              const LAS unsigned char* sc = lds + BL_SLOT + (c_ & 1) * BL_SLOTB; const LAS unsigned char* zc = lds + (c_ & 1) * CH_MB; LAS unsigned char* zn = lds + ((c_ + 1) & 1) * CH_MB;
              if (wave < 4) {
                  f32x16 acc; const LAS unsigned char* ph = sc + CH_MB + (nb * 32 + l31) * CH_RS + (mb * 32 + 4 * hi) * 2;
#pragma unroll
                  for (int rg = 0; rg < 4; ++rg) { const u32x2 w = *(const LAS u32x2*)(ph + rg * 16); acc[4 * rg] = h_lo(w.x); acc[4 * rg + 1] = h_hi(w.x); acc[4 * rg + 2] = h_lo(w.y); acc[4 * rg + 3] = h_hi(w.y); }
                  acc = mm32(true, sc, mb * 32, zc, nb * 32, acc, l31, hi);
                  st_nat(true, zn, mb * 32, nb * 32, acc, l31, hi);
              } else if (c_ >= 4) {
                  f32x16 acc; const LAS unsigned char* py = sc + 3 * CH_MB + (nb * 32 + l31) * CH_RS + (mb * 32 + 4 * hi) * 2;
#pragma unroll
                  for (int rg = 0; rg < 4; ++rg) { const u32x2 w = *(const LAS u32x2*)(py + rg * 16); acc[4 * rg] = h_lo(w.x); acc[4 * rg + 1] = h_hi(w.x); acc[4 * rg + 2] = h_lo(w.y); acc[4 * rg + 3] = h_hi(w.y); }
                  acc = mm32(true, zc, mb * 32, sc + 2 * CH_MB, nb * 32, acc, l31, hi);
                  st_nat(true, lds + BL_YB + (c_ & 1) * CH_MB, mb * 32, nb * 32, acc, l31, hi);
              }
              LBAR(); }
            { const int c_ = (c + 3);
              LAS unsigned char* sn = lds + BL_SLOT + ((c_ + 1) & 1) * BL_SLOTB + srow * CH_RS + sch * 16;
              *(LAS u32x4*)sn = Rb0; *(LAS u32x4*)(sn + CH_MB) = Rb1; *(LAS u32x4*)(sn + 2 * CH_MB) = Rb2; *(LAS u32x4*)(sn + 3 * CH_MB) = Rb3;
              { int c__ = (c_ + 3); c__ = c__ < 67 ? c__ : 67; const unsigned char* gq = gq0 + (size_t)c__ * GHQ_ITEM + srow * 128 + sch * 16; const int cy = c__ < 4 ? 4 : c__;
              Rb0 = __builtin_nontemporal_load((const u32x4*)gq); Rb1 = __builtin_nontemporal_load((const u32x4*)(gq + 8192)); Rb2 = __builtin_nontemporal_load((const u32x4*)(gq + 16384));
              Rb3 = __builtin_nontemporal_load((const u32x4*)(Yb + (size_t)scan_row(b, d, cy, srow) * 2048 + sch * 16)); }
              if (c_ >= 5) { const u32x4 yv = *(const LAS u32x4*)(lds + BL_YB + ((c_ - 1) & 1) * CH_MB + srow * CH_RS + sch * 16);
                  *(u32x4*)(Yb + (size_t)scan_row(b, d, c_ - 1, srow) * 2048 + sch * 16) = yv; }
              const LAS unsigned char* sc = lds + BL_SLOT + (c_ & 1) * BL_SLOTB; const LAS unsigned char* zc = lds + (c_ & 1) * CH_MB; LAS unsigned char* zn = lds + ((c_ + 1) & 1) * CH_MB;
              if (wave < 4) {
                  f32x16 acc; const LAS unsigned char* ph = sc + CH_MB + (nb * 32 + l31) * CH_RS + (mb * 32 + 4 * hi) * 2;
#pragma unroll
                  for (int rg = 0; rg < 4; ++rg) { const u32x2 w = *(const LAS u32x2*)(ph + rg * 16); acc[4 * rg] = h_lo(w.x); acc[4 * rg + 1] = h_hi(w.x); acc[4 * rg + 2] = h_lo(w.y); acc[4 * rg + 3] = h_hi(w.y); }
                  acc = mm32(true, sc, mb * 32, zc, nb * 32, acc, l31, hi);
                  st_nat(true, zn, mb * 32, nb * 32, acc, l31, hi);
              } else if (c_ >= 4) {
                  f32x16 acc; const LAS unsigned char* py = sc + 3 * CH_MB + (nb * 32 + l31) * CH_RS + (mb * 32 + 4 * hi) * 2;
#pragma unroll
                  for (int rg = 0; rg < 4; ++rg) { const u32x2 w = *(const LAS u32x2*)(py + rg * 16); acc[4 * rg] = h_lo(w.x); acc[4 * rg + 1] = h_hi(w.x); acc[4 * rg + 2] = h_lo(w.y); acc[4 * rg + 3] = h_hi(w.y); }
                  acc = mm32(true, zc, mb * 32, sc + 2 * CH_MB, nb * 32, acc, l31, hi);
                  st_nat(true, lds + BL_YB + (c_ & 1) * CH_MB, mb * 32, nb * 32, acc, l31, hi);
              }
              LBAR(); }
        }
        { const u32x4 yv = *(const LAS u32x4*)(lds + BL_YB + CH_MB + srow * CH_RS + sch * 16); *(u32x4*)(Yb + (size_t)scan_row(b, d, 67, srow) * 2048 + sch * 16) = yv; }
        LBAR();
    }
}

constexpr int AT_K = 0, AT_V = 16384, AT_BUF = 16384 + 64 * 272;
struct KVRegs { u32x4 k1, k2, v0, v1; };
__device__ __forceinline__ void at_load(Frame& F, KVRegs& R, int mrow0, int kvh) {
    const int tid = F.tid;
    { const int key = tid >> 2, q4 = tid & 3, a = q4 >> 1, e = q4 & 1;
      const bf16* p = F.P + (size_t)(mrow0 + key) * NIN + C_KA + kvh * 64 + a * 32 + 8 * e; R.k1 = *(const u32x4*)p; R.k2 = *(const u32x4*)(p + 16); }
    { const int kp = tid >> 3, dc = tid & 7; const bf16* p = F.P + (size_t)(mrow0 + 2 * kp) * NIN + C_VA + kvh * 64 + 8 * dc; R.v0 = *(const u32x4*)p; R.v1 = *(const u32x4*)(p + NIN); }
}
__device__ __forceinline__ void qkprep_one(Frame& F, bf16* p, int a, int e, int kpos, bool rope, const float* gain, float scale) {
    float x1[8], x2[8]; unpack8(*(const u32x4*)p, x1); unpack8(*(const u32x4*)(p + 16), x2);
    float ss = 0.f;
#pragma unroll
    for (int j = 0; j < 8; ++j) ss += x1[j] * x1[j] + x2[j] * x2[j];
    ss += __shfl_xor(ss, 1); ss += __shfl_xor(ss, 2);
    const float rr = scale / sqrtf(ss * (1.0f / 64.0f) + 1e-6f);
    const int pos = a == 0 ? (kpos >> 6) : (kpos & 63);
#pragma unroll
    for (int j = 0; j < 8; ++j) { float y1 = x1[j] * rr * gain[a * 32 + 8 * e + j], y2 = x2[j] * rr * gain[a * 32 + 16 + 8 * e + j];
        if (rope) { const float c = F.ROPE[pos * 16 + 8 * e + j], sn = F.ROPE[1024 + pos * 16 + 8 * e + j]; const float t1 = y1 * c - y2 * sn, t2 = y2 * c + y1 * sn; y1 = t1; y2 = t2; }
        x1[j] = y1; x2[j] = y2; }
    u32x4 o; o.x = pk2(x1[0], x1[1]); o.y = pk2(x1[2], x1[3]); o.z = pk2(x1[4], x1[5]); o.w = pk2(x1[6], x1[7]); *(u32x4*)p = o;
    o.x = pk2(x2[0], x2[1]); o.y = pk2(x2[2], x2[3]); o.z = pk2(x2[4], x2[5]); o.w = pk2(x2[6], x2[7]); *(u32x4*)(p + 16) = o;
}
__device__ __forceinline__ void kprep(Frame& F) {
    const int total = F.G * NWAVES * 64;
    for (int idx = F.bid * NWAVES * 64 + F.tid; idx < MT * 16; idx += total) {
        const int q4 = idx & 3, kvh = (idx >> 2) & 3, m = idx >> 4, a = q4 >> 1, e = q4 & 1;
        qkprep_one(F, F.P + (size_t)m * NIN + C_KA + kvh * 64 + a * 32 + 8 * e, a, e, m & (SEQ - 1), m < ML, F.kng, 1.0f);
    }
}
__device__ __forceinline__ void at_write(Frame& F, const KVRegs& R, LAS unsigned char* buf) {
    const int tid = F.tid;
    { const int key = tid >> 2, q4 = tid & 3, a = q4 >> 1, e = q4 & 1;
      const int c1 = 4 * a + e, c2 = c1 + 2, sw = (key >> 1) & 7;
      *(LAS u32x4*)(buf + AT_K + key * 128 + ((c1 ^ sw) << 4)) = R.k1; *(LAS u32x4*)(buf + AT_K + key * 128 + ((c2 ^ sw) << 4)) = R.k2; }
    { const int kp = tid >> 3, dc = tid & 7, kq = kp >> 1;
        const int pos0 = (kq >> 2) * 16 + (kq & 1) * 8 + ((kq >> 1) & 1) * 4 + (kp & 1) * 2;
#pragma unroll
        for (int w = 0; w < 4; ++w) {
            const unsigned a0 = R.v0[w], a1 = R.v1[w];
            *(LAS unsigned*)(buf + AT_V + (8 * dc + 2 * w) * 272 + pos0 * 2) = __builtin_amdgcn_perm(a1, a0, 0x05040100u);
            *(LAS unsigned*)(buf + AT_V + (8 * dc + 2 * w + 1) * 272 + pos0 * 2) = __builtin_amdgcn_perm(a1, a0, 0x07060302u); }
    }
}
#ifndef ATTN_STATIC
#define ATTN_STATIC 2
#endif
#ifndef ATTN_POOL
#define ATTN_POOL 0
#endif
#ifndef ATTN_BOUND
#define ATTN_BOUND 60.0f
#endif
template<bool NOMAX> __device__ __forceinline__ void p4_attn_t(Frame& F, int item) {
    const int n = item & 31, kvh = (item >> 5) & 3, b = item >> 7;
    const int lane = F.lane, wave = F.wave, l31 = lane & 31, hi = lane >> 5;
    const int hh = kvh * 4 + (wave >> 1), qloc = (wave & 1) * 64;
    LAS unsigned char* lds = F.lds;
    const int kfirst = n > 0 ? 0 : 1, nbnd = 3 - (n == 0 ? 1 : 0) - (n == 31 ? 1 : 0), nt = nbnd + 2;
#define TL_KIND(t) ((t) < nbnd ? kfirst + (t) : 3)
#define TL_ROW(t) ((t) < nbnd ? b * SEQ + (n - 1 + kfirst + (t)) * 128 : ML + b * CTXL + ((t) - nbnd) * 128)
#define TL_KPOS(t) ((t) < nbnd ? (n - 1 + kfirst + (t)) * 128 : 0)
    if (DBG_FINE) TSTART();
    KVRegs R;
    at_load(F, R, TL_ROW(0), kvh);
    LAS unsigned char* qbase = lds + 2 * AT_BUF + wave * 8192;
    LAS unsigned char* qlds = qbase + lane * 16;
    { const int rowl = lane >> 2, q4 = lane & 3, a = q4 >> 1, e = q4 & 1;
      const bf16* src = F.P + (size_t)(b * SEQ + n * 128 + qloc + rowl) * NIN + C_Q + hh * 64 + a * 32 + 8 * e;
      u32x4 r1[4], r2[4];
#pragma unroll
      for (int ps = 0; ps < 4; ++ps) { r1[ps] = *(const u32x4*)(src + (size_t)(16 * ps) * NIN); r2[ps] = *(const u32x4*)(src + (size_t)(16 * ps) * NIN + 16); }
      float g1[8], g2[8];
      { const f32x4 a0 = *(const f32x4*)(F.qng + a * 32 + 8 * e), a1 = *(const f32x4*)(F.qng + a * 32 + 8 * e + 4), b0 = *(const f32x4*)(F.qng + a * 32 + 16 + 8 * e), b1 = *(const f32x4*)(F.qng + a * 32 + 16 + 8 * e + 4);
#pragma unroll
        for (int j = 0; j < 4; ++j) { g1[j] = a0[j]; g1[4 + j] = a1[j]; g2[j] = b0[j]; g2[4 + j] = b1[j]; } }
#pragma unroll
      for (int ps = 0; ps < 4; ++ps) {
          const int r = 16 * ps + rowl, query = n * 128 + qloc + r, pos = a == 0 ? (query >> 6) : (query & 63);
          const f32x4 c0 = *(const f32x4*)(F.ROPE + pos * 16 + 8 * e), c1 = *(const f32x4*)(F.ROPE + pos * 16 + 8 * e + 4), s0 = *(const f32x4*)(F.ROPE + 1024 + pos * 16 + 8 * e), s1 = *(const f32x4*)(F.ROPE + 1024 + pos * 16 + 8 * e + 4);
          float x1[8], x2[8]; unpack8(r1[ps], x1); unpack8(r2[ps], x2);
          float ss = 0.f;
#pragma unroll
          for (int j = 0; j < 8; ++j) ss += x1[j] * x1[j] + x2[j] * x2[j];
          ss += __shfl_xor(ss, 1); ss += __shfl_xor(ss, 2);
          const float rr = (0.125f * LOG2E) / sqrtf(ss * (1.0f / 64.0f) + 1e-6f);
#pragma unroll
          for (int j = 0; j < 8; ++j) { const float y1 = x1[j] * rr * g1[j], y2 = x2[j] * rr * g2[j], cc = j < 4 ? c0[j & 3] : c1[j & 3], sn = j < 4 ? s0[j & 3] : s1[j & 3];
              x1[j] = y1 * cc - y2 * sn; x2[j] = y2 * cc + y1 * sn; }
          LAS unsigned char* dst = qbase + ((r >> 5) * 4 + 2 * a) * 1024 + (e * 32 + (r & 31)) * 16;
          u32x4 o; o.x = pk2(x1[0], x1[1]); o.y = pk2(x1[2], x1[3]); o.z = pk2(x1[4], x1[5]); o.w = pk2(x1[6], x1[7]); *(LAS u32x4*)dst = o;
          o.x = pk2(x2[0], x2[1]); o.y = pk2(x2[2], x2[3]); o.z = pk2(x2[4], x2[5]); o.w = pk2(x2[6], x2[7]); *(LAS u32x4*)(dst + 1024) = o;
      } }
    at_write(F, R, lds);
    LBAR(); TSTAMP(26);
    float mrun[2] = {NOMAX ? 0.f : -1e30f, NOMAX ? 0.f : -1e30f}, lrun[2] = {0.f, 0.f};
    f32x16 ot[2][2];
#pragma unroll
    for (int qb = 0; qb < 2; ++qb)
#pragma unroll
        for (int db = 0; db < 2; ++db)
#pragma unroll
            for (int r = 0; r < 16; ++r) ot[qb][db][r] = 0.f;
#pragma unroll 1
    for (int t = 0; t < nt; ++t) {
        LAS unsigned char* buf = lds + (t & 1) * AT_BUF;
        if (t + 1 < nt) at_load(F, R, TL_ROW(t + 1), kvh);
        const int kind = TL_KIND(t);
#pragma unroll 1
        for (int st = 0; st < 4; ++st) {
            int s0 = 1, s1 = 1;
            { const int dq0 = qloc >> 5, dq1 = dq0 + 1;
              if (kind == 0) { s0 = st < dq0 ? 0 : (st == dq0 ? 2 : 1); s1 = st < dq1 ? 0 : (st == dq1 ? 2 : 1); }
              else if (kind == 2) { s0 = st > dq0 ? 0 : (st == dq0 ? 2 : 1); s1 = st > dq1 ? 0 : (st == dq1 ? 2 : 1); } }
            if ((s0 | s1) == 0) continue;
            bf16x8 kf[4];
#pragma unroll
            for (int ks = 0; ks < 4; ++ks) { const int key = st * 32 + l31, ch = 2 * ks + hi; kf[ks] = *(const LAS bf16x8*)(buf + AT_K + key * 128 + ((ch ^ ((key >> 1) & 7)) << 4)); }
            f32x16 sc0 = {0.f, 0.f, 0.f, 0.f, 0.f, 0.f, 0.f, 0.f, 0.f, 0.f, 0.f, 0.f, 0.f, 0.f, 0.f, 0.f}, sc1 = sc0;
            { bf16x8 qf[4];
              if (s0) {
#pragma unroll
                  for (int ks = 0; ks < 4; ++ks) qf[ks] = *(const LAS bf16x8*)(qlds + ks * 1024);
#pragma unroll
                  for (int ks = 0; ks < 4; ++ks) sc0 = __builtin_amdgcn_mfma_f32_32x32x16_bf16(kf[ks], qf[ks], sc0, 0, 0, 0); }
              if (s1) {
#pragma unroll
                  for (int ks = 0; ks < 4; ++ks) qf[ks] = *(const LAS bf16x8*)(qlds + (4 + ks) * 1024);
#pragma unroll
                  for (int ks = 0; ks < 4; ++ks) sc1 = __builtin_amdgcn_mfma_f32_32x32x16_bf16(kf[ks], qf[ks], sc1, 0, 0, 0); } }
            bf16x8 vf[2][2];
#pragma unroll
            for (int db = 0; db < 2; ++db)
#pragma unroll
                for (int s = 0; s < 2; ++s) vf[db][s] = *(const LAS bf16x8*)(buf + AT_V + (db * 32 + l31) * 272 + ((st * 2 + s) * 16 + hi * 8) * 2);
#define AT_SOFTMAX(SC, QB, PF, DIAG) do { \
                const int qq = qloc + (QB) * 32 + l31; \
                if (DIAG) { const int th = qq - st * 32 - 4 * hi;        \
                    if (kind == 0) { _Pragma("unroll") for (int r = 0; r < 16; ++r) SC[r] = ((r & 3) + 8 * (r >> 2) >= th) ? SC[r] : -__builtin_inff(); } \
                    else { _Pragma("unroll") for (int r = 0; r < 16; ++r) SC[r] = ((r & 3) + 8 * (r >> 2) <= th) ? SC[r] : -__builtin_inff(); } } \
                if (!NOMAX) { \
                    float tm = SC[0]; \
                    _Pragma("unroll") for (int r = 1; r < 16; ++r) tm = fmaxf(tm, SC[r]); \
                    tm = fmaxf(tm, __shfl_xor(tm, 32)); \
                    if (__any(tm > mrun[QB] + 6.0f)) { \
                        const float mn = fmaxf(mrun[QB], tm), al = __builtin_amdgcn_exp2f(mrun[QB] - mn); \
                        mrun[QB] = mn; lrun[QB] *= al; \
                        _Pragma("unroll") for (int db = 0; db < 2; ++db) _Pragma("unroll") for (int r = 0; r < 16; ++r) ot[QB][db][r] *= al; } \
                    const float mm = mrun[QB]; \
                    _Pragma("unroll") for (int r = 0; r < 16; ++r) SC[r] -= mm; } \
                f32x2_t ps2 = {0.f, 0.f}; \
                _Pragma("unroll") for (int r = 0; r < 16; r += 2) { SC[r] = __builtin_amdgcn_exp2f(SC[r]); SC[r + 1] = __builtin_amdgcn_exp2f(SC[r + 1]); f32x2_t e2; e2.x = SC[r]; e2.y = SC[r + 1]; ps2 += e2; } \
                lrun[QB] += ps2.x + ps2.y; \
                _Pragma("unroll") for (int s = 0; s < 2; ++s) { u32x4 o; o.x = pk2(SC[8 * s], SC[8 * s + 1]); o.y = pk2(SC[8 * s + 2], SC[8 * s + 3]); o.z = pk2(SC[8 * s + 4], SC[8 * s + 5]); o.w = pk2(SC[8 * s + 6], SC[8 * s + 7]); PF[s] = __builtin_bit_cast(bf16x8, o); } \
            } while (0)
            bf16x8 pf0[2] = {kf[0], kf[0]}, pf1[2] = {kf[0], kf[0]};
            __builtin_amdgcn_sched_barrier(0);
            if (s0) AT_SOFTMAX(sc0, 0, pf0, s0 == 2);
            __builtin_amdgcn_sched_barrier(0);
            if (s1) AT_SOFTMAX(sc1, 1, pf1, s1 == 2);
            __builtin_amdgcn_sched_barrier(0);
#undef AT_SOFTMAX
#pragma unroll
            for (int db = 0; db < 2; ++db)
#pragma unroll
                for (int s = 0; s < 2; ++s) if (s0) ot[0][db] = __builtin_amdgcn_mfma_f32_32x32x16_bf16(vf[db][s], pf0[s], ot[0][db], 0, 0, 0);
#pragma unroll
            for (int db = 0; db < 2; ++db)
#pragma unroll
                for (int s = 0; s < 2; ++s) if (s1) ot[1][db] = __builtin_amdgcn_mfma_f32_32x32x16_bf16(vf[db][s], pf1[s], ot[1][db], 0, 0, 0);
        }
        TSTAMP(27);
        if (t + 1 < nt) at_write(F, R, lds + ((t + 1) & 1) * AT_BUF);
        LBAR(); TSTAMP(28);
    }
    constexpr int AT_ORS = 528;
    u32x4 zr[8];
    const bf16* pz = F.P + (size_t)(b * SEQ + n * 128) * NIN + kvh * 256;
#pragma unroll
    for (int i = 0; i < 8; ++i) { const int idx = F.tid + 512 * i, row = idx >> 5, c16 = idx & 31; zr[i] = *(const u32x4*)(pz + (size_t)row * NIN + C_ZA + 8 * c16); }
    const float sk2 = F.sink[hh] * LOG2E;
#pragma unroll
    for (int qb = 0; qb < 2; ++qb) {
        float l = lrun[qb]; l += __shfl_xor(l, 32); l += __builtin_amdgcn_exp2f(sk2 - mrun[qb]);
        const float il = 1.0f / l;
        LAS unsigned char* po = lds + (qloc + qb * 32 + l31) * AT_ORS + (wave >> 1) * 128 + 8 * hi;
#pragma unroll
        for (int db = 0; db < 2; ++db)
#pragma unroll
            for (int rg = 0; rg < 4; ++rg) { u32x2 o; o.x = pkh(ot[qb][db][4 * rg] * il, ot[qb][db][4 * rg + 1] * il); o.y = pkh(ot[qb][db][4 * rg + 2] * il, ot[qb][db][4 * rg + 3] * il);
                *(LAS u32x2*)(po + (db * 32 + 8 * rg) * 2) = o; }
    }
    LBAR();
#pragma unroll
    for (int i = 0; i < 8; ++i) { const int idx = F.tid + 512 * i, row = idx >> 5, c16 = idx & 31;
        const u32x4 ov = *(const LAS u32x4*)(lds + row * AT_ORS + c16 * 16);
        float z[8]; unpack8(zr[i], z);
        u32x4 w; w.x = pk2(h_lo(ov.x) * siluf_(z[0]), h_hi(ov.x) * siluf_(z[1])); w.y = pk2(h_lo(ov.y) * siluf_(z[2]), h_hi(ov.y) * siluf_(z[3]));
        w.z = pk2(h_lo(ov.z) * siluf_(z[4]), h_hi(ov.z) * siluf_(z[5])); w.w = pk2(h_lo(ov.w) * siluf_(z[6]), h_hi(ov.w) * siluf_(z[7]));
        *(u32x4*)(F.P + (size_t)(b * SEQ + n * 128 + row) * NIN + 1024 + kvh * 256 + 8 * c16) = w; }
    TSTAMP(29);
#undef TL_KIND
#undef TL_ROW
#undef TL_KPOS
}
__device__ __forceinline__ bool attn_nomax(Frame& F) {
    float gq = fabsf(F.qng[F.lane]), gk = fabsf(F.kng[F.lane]);
#pragma unroll
    for (int o = 1; o < 64; o <<= 1) { gq = fmaxf(gq, __shfl_xor(gq, o)); gk = fmaxf(gk, __shfl_xor(gk, o)); }
    const float bound = 8.0f * LOG2E * gq * gk;
    return __builtin_amdgcn_readfirstlane(bound <= ATTN_BOUND ? 1 : 0) != 0;
}

__device__ __forceinline__ void p5_mix(Frame& F) {
    const int total = F.G * NWAVES * 64, rstep = total >> 7, gi = F.bid * NWAVES * 64 + F.tid;
    const int ch = gi & 7, h = (gi >> 3) & 15, c0 = h * 64 + 8 * ch;
    float mus[8], lg[8], lb[8];
    { const f32x4 a0 = *(const f32x4*)(F.mu_shift + C_V + c0), a1 = *(const f32x4*)(F.mu_shift + C_V + c0 + 4), g0 = *(const f32x4*)(F.ln_g + c0), g1 = *(const f32x4*)(F.ln_g + c0 + 4), b0 = *(const f32x4*)(F.ln_b + c0), b1 = *(const f32x4*)(F.ln_b + c0 + 4);
#pragma unroll
      for (int j = 0; j < 4; ++j) { mus[j] = a0[j]; mus[4 + j] = a1[j]; lg[j] = g0[j]; lg[4 + j] = g1[j]; lb[j] = b0[j]; lb[4 + j] = b1[j]; } }
    const u32x4 z = {0u, 0u, 0u, 0u};
#define MIX_LOAD(S, M0) do { const int m0_ = (M0); const int t0 = m0_ & (SEQ - 1); const bf16* pv = F.P + (size_t)m0_ * NIN + C_V + c0; \
        S##v[0] = *(const u32x4*)(pv - (t0 > 0 ? NIN : 0)); S##v[1] = *(const u32x4*)pv; S##v[2] = *(const u32x4*)(pv + NIN); S##v[3] = *(const u32x4*)(pv + (size_t)(t0 + 2 < SEQ ? 2 : 1) * NIN); \
        _Pragma("unroll") for (int k = 0; k < 2; ++k) { const int mm = m0_ + k; \
            S##yf[k] = *(const u32x4*)(F.YF + (size_t)mm * 1024 + c0); S##yb[k] = *(const u32x4*)(F.YB + (size_t)mm * 1024 + c0); \
            S##zr[k] = __builtin_nontemporal_load((const u32x4*)(F.P + (size_t)mm * NIN + C_ZR + c0));        \
            S##bon[k] = F.BON[(size_t)mm * 16 + h] + F.BON[(size_t)(ML + mm) * 16 + h]; } } while (0)
#define MIX_COMPUTE(S, M0) do { const int m0_ = (M0); \
        _Pragma("unroll") for (int k = 0; k < 2; ++k) { const int m = m0_ + k; \
            float y[8]; \
            { const h8 hf = __builtin_bit_cast(h8, S##yf[k]), hb = __builtin_bit_cast(h8, S##yb[k]); \
              _Pragma("unroll") for (int j = 0; j < 8; ++j) y[j] = (float)hf[j] + (float)hb[j]; } \
            float s = 0.f; \
            _Pragma("unroll") for (int j = 0; j < 8; ++j) s += y[j]; \
            s += __shfl_xor(s, 1); s += __shfl_xor(s, 2); s += __shfl_xor(s, 4); \
            const float mu = s * (1.0f / 64.0f); float q = 0.f; \
            _Pragma("unroll") for (int j = 0; j < 8; ++j) { y[j] -= mu; q += y[j] * y[j]; } \
            q += __shfl_xor(q, 1); q += __shfl_xor(q, 2); q += __shfl_xor(q, 4); \
            const float rs = 1.0f / sqrtf(q * (1.0f / 64.0f) + 64e-5f); \
            float vc[8], vp[8], vn[8], zr[8]; \
            const int t = m & (SEQ - 1); \
            unpack8(S##v[1 + k], vc); unpack8(t > 0 ? S##v[k] : z, vp); unpack8(t < SEQ - 1 ? S##v[2 + k] : z, vn); unpack8(S##zr[k], zr); \
            float o[8]; \
            _Pragma("unroll") for (int j = 0; j < 8; ++j) { const float sv = vc[j] + mus[j] * (0.5f * (vp[j] + vn[j]) - vc[j]); \
                const float yn = y[j] * rs * lg[j] + lb[j]; \
                o[j] = (yn + S##bon[k] * sv) * siluf_(zr[j]); } \
            u32x4 w; w.x = pk2(o[0], o[1]); w.y = pk2(o[2], o[3]); w.z = pk2(o[4], o[5]); w.w = pk2(o[6], o[7]); \
            *(u32x4*)(F.P + (size_t)m * NIN + c0) = w; } } while (0)
    u32x4 Ayf[2], Ayb[2], Av[4], Azr[2], Byf[2], Byb[2], Bv[4], Bzr[2]; float Abon[2], Bbon[2];
    const int mstep = 4 * rstep; int m0 = 4 * (gi >> 7);
    if (m0 < ML) MIX_LOAD(A, m0);
#pragma unroll 1
    for (; m0 < ML; m0 += mstep) {
        MIX_LOAD(B, m0 + 2);
        MIX_COMPUTE(A, m0);
        if (m0 + mstep < ML) MIX_LOAD(A, m0 + mstep);
        MIX_COMPUTE(B, m0 + 2);
    }
#undef MIX_LOAD
#undef MIX_COMPUTE
}

struct Args { const float* in[22]; float* out; unsigned char* ws; int ph_lo, ph_hi; };
__global__ void __launch_bounds__(NWAVES * 64, 2) hymba_fwd(Args args) {
    extern __shared__ __attribute__((aligned(16))) unsigned char lds_raw[];
    Frame F;
    F.lds = (LAS unsigned char*)lds_raw;
    F.tid = threadIdx.x; F.G = gridDim.x;
    unsigned char* ws = args.ws;
    volatile LAS unsigned* MISC = (volatile LAS unsigned*)(F.lds + MISC_OFF);
    for (int u = F.tid; u < 64; u += NWAVES * 64) MISC[u] = 0u;
    if (DBG_SEL >= 0) for (int u = F.tid; u < 72; u += NWAVES * 64) ((volatile LAS unsigned*)(F.lds + DBG_LDS))[u] = 0u;
    __syncthreads();
    const int lo = args.ph_lo, hi = args.ph_hi;
    XcdBarrier bar; bar.bar = (unsigned*)(ws + WS_CTL) + CW_BAR; bar.x = 0; bar.st = nullptr;
    if (hi - lo > 1) bar = xcd_barrier_post((unsigned*)(ws + WS_CTL) + CW_BAR, MISC + 8);
#define IN(k) (lo <= (k) && (k) < hi)
#define SEAM(k) do { if (IN(k) && IN((k) + 1)) xcd_barrier(bar); } while (0)
    fresh(F); TSTART();
    if (DBG_SEL >= 0 && F.bid == DBG_BLOCK && F.tid == 0) { volatile LAS unsigned long long* T_ = (volatile LAS unsigned long long*)(F.lds + DBG_LDS); T_[34] = T_[32]; }
    if (IN(0)) { fresh(F); p0_prologue(F); if (DUP_PHASE == 0) { fresh(F); p0_prologue(F); } } TSTAMP(8); SEAM(0); TSTAMP(9);
    if (IN(1)) { fresh(F); p1_modulate(F); if (DUP_PHASE == 1) { fresh(F); p1_modulate(F); } } TSTAMP(10); SEAM(1); TSTAMP(11);
    if (IN(2)) {
        fresh(F);
        pg8::Gemm g{F.XN, F.WIN, MT, NIN, DM, DM}; Sched1 S; S.init(F.G, F.bid);
        pg8::EpiBf16<0> E{F.P, NIN, nullptr, 0, 0, 1.f};
        pg8::gemm_phase<pg8::EpiBf16<0>, Sched1, false, true>(F.lds, g, S, E);
        if (DUP_PHASE == 2) { __syncthreads(); pg8::gemm_phase<pg8::EpiBf16<0>, Sched1, true, true>(F.lds, g, S, E); }
    } TSTAMP(12); SEAM(2); TSTAMP(13);
    if (IN(3)) { fresh(F); p3_chunkA(F); fresh(F); kprep(F); TSTAMP(14); if (DUP_PHASE == 3) { fresh(F); p3_chunkA(F); } } SEAM(3); TSTAMP(15);
    if (IN(4)) {
        fresh(F);
        { const bool g256 = F.G == 256; const int xg = F.bid & 7;
          int li0 = ATTN_STATIC * ((F.bid - 128) >> 3), cnt = ATTN_STATIC;
          if (!g256 || F.bid < 128) { p4_chunkB(F); TSTAMP(30); LBAR(); fresh(F); li0 = 0; cnt = 0; }
          if (!g256) cnt = (512 - F.bid + F.G - 1) / F.G;
          unsigned* tq = (unsigned*)((unsigned char*)F.MOD - WS_MOD + WS_CTL) + CW_TICKET;
          volatile LAS unsigned* tk = (volatile LAS unsigned*)(F.lds + MISC_OFF) + 40;
#define ATTN_ITEMS(NM) \
          for (int j = 0; ; ++j) { int li = li0 + j, grp = xg; \
              if (j >= cnt) { if (!g256) break; \
                  if (F.tid == 0) tk[0] = __hip_atomic_fetch_add(tq, 1u, __ATOMIC_RELAXED, __HIP_MEMORY_SCOPE_AGENT); \
                  LBAR(); const unsigned q = tk[0]; LBAR(); if (q >= 8u * (64 - 16 * ATTN_STATIC)) break; grp = (int)(q & 7u); li = 16 * ATTN_STATIC + (int)(q >> 3); } \
              fresh(F); p4_attn_t<NM>(F, g256 ? (2 * grp + (li >> 5)) * 32 + (li & 31) : F.bid + j * F.G); LBAR(); }
          if (attn_nomax(F)) {
#pragma unroll 1
              ATTN_ITEMS(true)
          } else {
#pragma unroll 1
              ATTN_ITEMS(false)
          }
#undef ATTN_ITEMS
        }
        TSTAMP(16);
    } SEAM(4); TSTAMP(17);
    if (IN(5)) { fresh(F); p5_mix(F); TSTAMP(18);
        if (DBG_SEL >= 0 && F.bid == DBG_BLOCK && F.tid == 0) { volatile LAS unsigned long long* T_ = (volatile LAS unsigned long long*)(F.lds + DBG_LDS);
            F.DBG[0] = (float)(DBG_SEL == 99 ? (T_[0] + T_[1] + T_[2] + T_[3] + T_[4] + T_[5] + T_[6] + T_[7]) : T_[DBG_SEL]) * (DBG_FINE ? 1e-6f : 2.5e-7f); F.DBG[1] = (DBG_SEL2 == 24 ? (float)T_[24] * 1e-7f : (float)T_[DBG_SEL2] * 1e-4f); }
    } SEAM(5); TSTAMP(19);
    if (IN(6)) {
        fresh(F);
        pg8::Gemm g{F.P, F.WOUT, ML, DM, DM, NIN};
        pg8::StaticOrder S; S.init(ML, DM, F.G, F.bid);
        pg8::EpiGate E{F.x, F.out, F.MOD + 4096, DM, DBG_SEL >= 0 ? F.DBG[0] : 0.f, DBG_SEL >= 0 ? F.DBG[1] : 0.f};
        pg8::gemm_phase<pg8::EpiGate, pg8::StaticOrder, true, true>(F.lds, g, S, E);
        if (DUP_PHASE == 6) { __syncthreads(); pg8::gemm_phase<pg8::EpiGate, pg8::StaticOrder, true, true>(F.lds, g, S, E); }
        if (DBG_SEL >= 0 && DBG_END > 0 && blockIdx.x == 0 && threadIdx.x == 0) { volatile LAS unsigned long long* T_ = (volatile LAS unsigned long long*)(F.lds + DBG_LDS);
            const unsigned long long n_ = __builtin_amdgcn_s_memrealtime(); asm volatile("s_waitcnt vmcnt(0)" ::: "memory");
            F.out[0] += DBG_END == 1 ? (float)(n_ - T_[34]) * 1e-5f : ((float)(n_ - T_[32]) - 10000.0f) * 1e-4f; }
    }
#undef IN
#undef SEAM
}

extern "C" void kernel_launch(void* const* d_in, const int* in_sizes, int n_in, void* d_out, int out_size, void* d_ws, size_t ws_size, hipStream_t stream) {
    static int grid = 0;
    if (grid == 0) {
        if (n_in != 22 || out_size != ML * DM || ws_size < WS_END) { fprintf(stderr, "kernel_launch: unexpected problem shape (n_in %d, out %d, ws %zu)\n", n_in, out_size, ws_size); grid = -1; return; }
        int dev = 0, cus = 0;
        if (hipGetDevice(&dev) != hipSuccess || hipDeviceGetAttribute(&cus, hipDeviceAttributeMultiprocessorCount, dev) != hipSuccess) { grid = -1; return; }
        if (hipFuncSetAttribute((const void*)hymba_fwd, hipFuncAttributeMaxDynamicSharedMemorySize, LDS_BYTES) != hipSuccess) { fprintf(stderr, "kernel_launch: hipFuncSetAttribute failed\n"); grid = -1; return; }
        (void)hipGetLastError();
        grid = cus;
    }
    if (grid < 0) return;
    (void)hipMemsetAsync((char*)d_ws + WS_CTL, 0, CTL_ZERO_BYTES, stream);
    Args a{};
    for (int i = 0; i < 22; ++i) a.in[i] = (const float*)d_in[i];
    a.out = (float*)d_out; a.ws = (unsigned char*)d_ws;
    if (MK_N_LAUNCHES == 1) { a.ph_lo = 0; a.ph_hi = N_PHASES; hipLaunchKernelGGL(hymba_fwd, dim3(grid), dim3(NWAVES * 64), LDS_BYTES, stream, a); }
    else for (int p = 0; p < N_PHASES; ++p) { a.ph_lo = p; a.ph_hi = p + 1; hipLaunchKernelGGL(hymba_fwd, dim3(grid), dim3(NWAVES * 64), LDS_BYTES, stream, a); }
}
```
